# Optimizing an MI355X kernel written in HIP

```python
import math
import jax, jax.numpy as jnp
from jax import lax
import numpy as np

D_MODEL = 2048
BATCH = 4
SEQ = 2048
DEPTH = 1

CHUNK = 64
D_MIX = 2048
ATT_HEADS = 8
ATT_HEAD_DIM = 128
ATT_WIDTH = ATT_HEADS * ATT_HEAD_DIM
Q_BLOCK = 128
SSD_WIDTH = D_MIX - ATT_WIDTH
SSD_HEAD_DIM = 64
SSD_HEADS = SSD_WIDTH // SSD_HEAD_DIM
SSD_GROUPS = 2
SSD_STATE = 128
CONV_WIDTH = 4
CONV_CH = SSD_WIDTH + 2 * SSD_GROUPS * SSD_STATE
N_EXPERTS = 32
TOP_K = 4
D_FF = D_MODEL
SWIGLU_ALPHA = 1.702
SWIGLU_LIMIT = 7.0
MOE_BLOCK = 256
EPS = 1e-6
IN_COLS = 3 * ATT_WIDTH + ATT_HEADS + SSD_WIDTH + CONV_CH + SSD_HEADS

kernel_name = "hybrid_fox_ssd_moe_block"


def _rms_norm(x, g):
    x32 = x.astype(jnp.float32)
    y = x32 * lax.rsqrt(jnp.mean(x32 * x32, axis=-1, keepdims=True) + EPS)
    return (y * g.astype(jnp.float32)).astype(x.dtype)


def _forgetting_attention(q, k, v, log_f):
    b, s, h, d = q.shape
    nb = s // Q_BLOCK
    scale = 1.0 / math.sqrt(d)
    cum = jnp.cumsum(log_f.astype(jnp.float32), axis=1).transpose(0, 2, 1)
    qh = (q * scale).transpose(0, 2, 1, 3)
    kh = k.transpose(0, 2, 1, 3)
    vh = v.transpose(0, 2, 1, 3)
    q_blocks = qh.reshape(b, h, nb, Q_BLOCK, d).transpose(2, 0, 1, 3, 4)
    c_blocks = cum.reshape(b, h, nb, Q_BLOCK).transpose(2, 0, 1, 3)
    key_pos = jnp.arange(s)

    def one_block(args):
        qb, cb, i = args
        logits = jnp.einsum("bhqd,bhkd->bhqk", qb, kh).astype(jnp.float32)
        logits = logits + cb[..., None] - cum[:, :, None, :]
        q_pos = i * Q_BLOCK + jnp.arange(Q_BLOCK)
        mask = key_pos[None, :] <= q_pos[:, None]
        logits = jnp.where(mask, logits, -jnp.inf)
        p = jax.nn.softmax(logits, axis=-1)
        return jnp.einsum("bhqk,bhkd->bhqd", p.astype(vh.dtype), vh)

    out = lax.map(one_block, (q_blocks, c_blocks, jnp.arange(nb)))
    return out.transpose(1, 0, 3, 2, 4).reshape(b, s, h * d)


def _ssd_mixer(xbc, z, dt_raw, conv_w, conv_b, dt_bias, a_log, d_skip, norm_g):
    b, s, _ = xbc.shape
    H, P, G, N, L = SSD_HEADS, SSD_HEAD_DIM, SSD_GROUPS, SSD_STATE, CHUNK
    R = H // G
    nc = s // L
    xp = jnp.pad(xbc, ((0, 0), (CONV_WIDTH - 1, 0), (0, 0)))
    conv = conv_b
    for tap in range(CONV_WIDTH):
        conv = conv + xp[:, tap:tap + s, :] * conv_w[tap]
    conv = jax.nn.silu(conv)
    xs = conv[..., :SSD_WIDTH].reshape(b, s, H, P)
    Bm = conv[..., SSD_WIDTH:SSD_WIDTH + G * N].reshape(b, nc, L, G, N)
    Cm = conv[..., SSD_WIDTH + G * N:].reshape(b, nc, L, G, N)
    dt = jax.nn.softplus(dt_raw.astype(jnp.float32) + dt_bias.astype(jnp.float32))
    A = -jnp.exp(a_log.astype(jnp.float32))
    dA = (dt * A).reshape(b, nc, L, G, R)
    X = (xs * dt[..., None]).reshape(b, nc, L, G, R, P)
    a_cs = jnp.moveaxis(jnp.cumsum(dA, axis=2), 2, -1)
    diff = a_cs[..., :, None] - a_cs[..., None, :]
    tril = jnp.tril(jnp.ones((L, L), dtype=bool))
    Lmat = jnp.exp(jnp.where(tril, diff, -jnp.inf))
    CB = jnp.einsum("bclgn,bcsgn->bcgls", Cm, Bm)
    W = CB[:, :, :, None] * Lmat
    y_diag = jnp.einsum("bcgrls,bcsgrp->bclgrp", W, X)
    decay_states = jnp.exp(a_cs[..., -1:] - a_cs)
    states = jnp.einsum("bclgn,bcgrl,bclgrp->bcgrpn", Bm, decay_states, X)
    chunk_decay = jnp.exp(a_cs[..., -1])

    def step(hstate, inp):
        st, dec = inp
        return hstate * dec[..., None, None] + st, hstate

    _, h_prev = lax.scan(step, jnp.zeros_like(states[:, 0]),
                         (jnp.moveaxis(states, 1, 0), jnp.moveaxis(chunk_decay, 1, 0)))
    h_prev = jnp.moveaxis(h_prev, 0, 1)
    y_off = jnp.einsum("bclgn,bcgrpn,bcgrl->bclgrp", Cm, h_prev, jnp.exp(a_cs))
    y = (y_diag + y_off).reshape(b, s, H, P) + xs * d_skip[:, None]
    y = y.reshape(b, s, SSD_WIDTH)
    return _rms_norm(y * jax.nn.silu(z), norm_g)


def _moe(h, layer, w_router, b_router, w_gate, b_gate, w_up, b_up, w_down, b_down):
    b, s, d = h.shape
    n_tok = b * s
    nk = n_tok * TOP_K
    hf = h.reshape(n_tok, d)
    logits = (hf @ w_router[layer] + b_router[layer]).astype(jnp.float32)
    top_vals, top_idx = lax.top_k(logits, TOP_K)
    gates = jax.nn.softmax(top_vals, axis=-1)
    flat_e = top_idx.reshape(-1)
    flat_tok = jnp.repeat(jnp.arange(n_tok, dtype=jnp.int32), TOP_K)
    flat_w = gates.reshape(-1)
    order = jnp.argsort(flat_e)
    sorted_e = flat_e[order]
    sorted_tok = flat_tok[order]
    sorted_w = flat_w[order]
    counts = jnp.bincount(flat_e, length=N_EXPERTS)
    starts = jnp.cumsum(counts) - counts
    padded = ((counts + MOE_BLOCK - 1) // MOE_BLOCK) * MOE_BLOCK
    pend = jnp.cumsum(padded)
    pstart = pend - padded
    rank = jnp.arange(nk) - starts[sorted_e]
    dest = pstart[sorted_e] + rank
    n_blocks = -(-nk // MOE_BLOCK) + N_EXPERTS
    n_slots = n_blocks * MOE_BLOCK
    slot_tok = jnp.full((n_slots,), n_tok, dtype=jnp.int32).at[dest].set(sorted_tok)
    slot_w = jnp.zeros((n_slots,), dtype=jnp.float32).at[dest].set(sorted_w)
    block_start = jnp.arange(n_blocks) * MOE_BLOCK
    block_e = jnp.minimum(jnp.searchsorted(pend, block_start, side="right"), N_EXPERTS - 1)
    h_pad = jnp.concatenate([hf, jnp.zeros((1, d), hf.dtype)], axis=0)
    xb = h_pad[slot_tok].reshape(n_blocks, MOE_BLOCK, d)

    def expert_block(args):
        xblk, e = args
        g = xblk @ w_gate[layer, e] + b_gate[layer, e]
        u = xblk @ w_up[layer, e] + b_up[layer, e]
        g = jnp.minimum(g, SWIGLU_LIMIT)
        u = jnp.clip(u, -SWIGLU_LIMIT, SWIGLU_LIMIT)
        glu = g * jax.nn.sigmoid(SWIGLU_ALPHA * g)
        return ((u + 1.0) * glu) @ w_down[layer, e] + b_down[layer, e]

    yb = lax.map(expert_block, (xb, block_e)).reshape(n_slots, d) * slot_w[:, None]
    y = jax.ops.segment_sum(yb, slot_tok, num_segments=n_tok + 1)[:n_tok]
    return y.reshape(b, s, d).astype(h.dtype)


def setup_inputs(seed: int = 0) -> dict:
    key = jax.random.key(seed)
    ks = jax.random.split(key, 24)
    f32 = jnp.float32
    Ld = DEPTH

    def nrm(k, shape, scale):
        return jax.random.normal(k, shape, f32) * scale

    x = nrm(ks[0], (BATCH, SEQ, D_MODEL), 1.0)
    attn_norm_g = 1.0 + nrm(ks[1], (Ld, D_MODEL), 0.02)
    w_in = nrm(ks[2], (Ld, D_MODEL, IN_COLS), D_MODEL ** -0.5)
    forget_bias = jax.random.uniform(ks[3], (Ld, ATT_HEADS), f32, 2.5, 4.5)
    q_norm_g = 1.0 + nrm(ks[4], (Ld, ATT_HEAD_DIM), 0.02)
    k_norm_g = 1.0 + nrm(ks[5], (Ld, ATT_HEAD_DIM), 0.02)
    conv_w = nrm(ks[6], (Ld, CONV_WIDTH, CONV_CH), CONV_WIDTH ** -0.5)
    conv_b = nrm(ks[7], (Ld, CONV_CH), 0.01)
    dt0 = jnp.exp(jax.random.uniform(ks[8], (Ld, SSD_HEADS), f32, math.log(1e-3), math.log(1e-1)))
    dt_bias = dt0 + jnp.log(-jnp.expm1(-dt0))
    a_log = jnp.log(jax.random.uniform(ks[9], (Ld, SSD_HEADS), f32, 1.0, 16.0))
    d_skip = 1.0 + nrm(ks[10], (Ld, SSD_HEADS), 0.02)
    ssd_norm_g = 1.0 + nrm(ks[11], (Ld, SSD_WIDTH), 0.02)
    w_out = nrm(ks[12], (Ld, D_MIX, D_MODEL), D_MIX ** -0.5)
    ffn_norm_g = 1.0 + nrm(ks[13], (Ld, D_MODEL), 0.02)
    w_router = nrm(ks[14], (Ld, D_MODEL, N_EXPERTS), D_MODEL ** -0.5)
    b_router = nrm(ks[15], (Ld, N_EXPERTS), 0.01)
    w_gate = nrm(ks[16], (Ld, N_EXPERTS, D_MODEL, D_FF), D_MODEL ** -0.5)
    b_gate = nrm(ks[17], (Ld, N_EXPERTS, D_FF), 0.01)
    w_up = nrm(ks[18], (Ld, N_EXPERTS, D_MODEL, D_FF), D_MODEL ** -0.5)
    b_up = nrm(ks[19], (Ld, N_EXPERTS, D_FF), 0.01)
    w_down = nrm(ks[20], (Ld, N_EXPERTS, D_FF, D_MODEL), D_FF ** -0.5)
    b_down = nrm(ks[21], (Ld, N_EXPERTS, D_MODEL), 0.01)
    return {"x": x, "attn_norm_g": attn_norm_g, "w_in": w_in, "forget_bias": forget_bias,
            "q_norm_g": q_norm_g, "k_norm_g": k_norm_g, "conv_w": conv_w, "conv_b": conv_b,
            "dt_bias": dt_bias, "a_log": a_log, "d_skip": d_skip, "ssd_norm_g": ssd_norm_g,
            "w_out": w_out, "ffn_norm_g": ffn_norm_g, "w_router": w_router, "b_router": b_router,
            "w_gate": w_gate, "b_gate": b_gate, "w_up": w_up, "b_up": b_up,
            "w_down": w_down, "b_down": b_down}


def reference(x, attn_norm_g, w_in, forget_bias, q_norm_g, k_norm_g, conv_w, conv_b,
              dt_bias, a_log, d_skip, ssd_norm_g, w_out, ffn_norm_g, w_router, b_router,
              w_gate, b_gate, w_up, b_up, w_down, b_down):
    b, s, _ = x.shape
    o1 = ATT_WIDTH
    o2 = o1 + ATT_WIDTH
    o3 = o2 + ATT_WIDTH
    o4 = o3 + ATT_HEADS
    o5 = o4 + SSD_WIDTH
    o6 = o5 + CONV_CH
    for layer in range(DEPTH):
        h = _rms_norm(x, attn_norm_g[layer])
        proj = h @ w_in[layer]
        q, k, v, f_raw, z, xbc, dt_raw = jnp.split(proj, [o1, o2, o3, o4, o5, o6], axis=-1)
        q = _rms_norm(q.reshape(b, s, ATT_HEADS, ATT_HEAD_DIM), q_norm_g[layer])
        k = _rms_norm(k.reshape(b, s, ATT_HEADS, ATT_HEAD_DIM), k_norm_g[layer])
        v = v.reshape(b, s, ATT_HEADS, ATT_HEAD_DIM)
        log_f = jax.nn.log_sigmoid(f_raw.astype(jnp.float32) + forget_bias[layer].astype(jnp.float32))
        att = _forgetting_attention(q, k, v, log_f)
        ssd = _ssd_mixer(xbc, z, dt_raw, conv_w[layer], conv_b[layer], dt_bias[layer],
                         a_log[layer], d_skip[layer], ssd_norm_g[layer])
        mix = jnp.concatenate([att.astype(x.dtype), ssd.astype(x.dtype)], axis=-1)
        x = x + (mix @ w_out[layer]).astype(x.dtype)
        h = _rms_norm(x, ffn_norm_g[layer])
        x = x + _moe(h, layer, w_router, b_router, w_gate, b_gate, w_up, b_up, w_down, b_down)
    return x
```

```cpp
#include <hip/hip_runtime.h>
#define MK_N_LAUNCHES 1
#define NAIVE_ATTN 0
#define NAIVE_SSD 0
#define FP8_MOE 1
#define NC1_CFG 13
#define NC5_CFG 0
#define NC7_CFG 0
#define B_NT_CFG 1
#include <cstdio>
#include <cstdint>

#ifndef MK_N_LAUNCHES
#define MK_N_LAUNCHES 1
#endif
#ifndef NAIVE_ATTN
#define NAIVE_ATTN 1
#endif
#ifndef NAIVE_SSD
#define NAIVE_SSD 1
#endif

#define GAS __attribute__((address_space(1)))
#define LAS __attribute__((address_space(3)))
typedef unsigned short bf16;
typedef unsigned v4u __attribute__((ext_vector_type(4)));
typedef unsigned v2u __attribute__((ext_vector_type(2)));
typedef float f32x4 __attribute__((ext_vector_type(4)));
typedef float f32x2 __attribute__((ext_vector_type(2)));
typedef short bf16x8 __attribute__((ext_vector_type(8)));
typedef GAS unsigned gu32;
#define RLX_AGENT __ATOMIC_RELAXED, __HIP_MEMORY_SCOPE_AGENT
#define LDS_WAIT() asm volatile("s_waitcnt lgkmcnt(0)" ::: "memory")
#define VM_WAIT() asm volatile("s_waitcnt vmcnt(0)" ::: "memory")

constexpr int BATCH = 4, SEQ = 2048, DM = 2048, NTOK = BATCH * SEQ;
constexpr int AH = 8, AHD = 128, AW = AH * AHD;
constexpr int SW = 1024, SHD = 64, SH = 16, SG = 2, SN = 128, CONVCH = SW + 2 * SG * SN;
constexpr int NE = 32, TOPK = 4, DFF = 2048;
constexpr int INCOLS = 5656, NP = 5888;
constexpr int O_Q = 0, O_K = 1024, O_V = 2048, O_F = 3072, O_Z = 3080, O_XBC = 4104, O_DT = 5640;
constexpr float EPS = 1e-6f, SW_ALPHA = 1.702f, SW_LIMIT = 7.0f;
constexpr float LOG2E = 1.4426950408889634f;
constexpr float QSCALE = 0.08838834764831845f * LOG2E;
constexpr int SLOTCAP = NTOK;
constexpr int MAXMT = (NTOK * TOPK) / 256 + NE;

constexpr size_t MiB = 1u << 20;
constexpr size_t WS_CTL = 0, CTL_ZERO_BYTES = 1 * MiB;
constexpr size_t WS_WIN = 1 * MiB;
constexpr size_t WS_WOUT = 24 * MiB;
constexpr size_t WS_WR = 32 * MiB;
constexpr size_t WS_ACUM = 33 * MiB;
constexpr size_t WS_DTV = 34 * MiB, WS_DAV = 35 * MiB;
constexpr size_t WS_STOK = 36 * MiB, WS_SGATE = 37 * MiB, WS_SDEST = 38 * MiB;
constexpr size_t WS_XN = 40 * MiB;
constexpr size_t WS_PROJ = 72 * MiB;
constexpr size_t WS_QN = 164 * MiB, WS_KN = 180 * MiB;
constexpr size_t WS_XCONV = 196 * MiB;
constexpr size_t WS_MIX = 220 * MiB;
constexpr size_t WS_ACT = 252 * MiB;
constexpr size_t WS_YSLOT = 412 * MiB;
constexpr size_t WS_WGU = 540 * MiB;
constexpr size_t WS_WD = 1052 * MiB;
constexpr size_t WS_END = 1308 * MiB;
constexpr int CW_BAR = 4096;
constexpr int CW_HEAD = 8192;
constexpr int CW_DONE = 8192 + 64;
constexpr int CW_MOEQ = 10240;
constexpr int CW_CNT = 16384;
constexpr int CW_SSQ = 32768;
static_assert((CW_SSQ + NTOK) * 4 <= (int)CTL_ZERO_BYTES, "ctl");

constexpr int RING_OFF = 0, RING_BYTES = 131072;
constexpr int LDSCTL_OFF = RING_BYTES;
constexpr int MISC_OFF = LDSCTL_OFF;
constexpr int BGW_OFF = LDSCTL_OFF + 64;
constexpr int TB_OFF = LDSCTL_OFF + 256;
constexpr int DMA_T_OFF = LDSCTL_OFF + 1024;
constexpr int LDS_BYTES = 163840 - 8192;
constexpr int NWAVES = 8, NTHR = 512;

__device__ __forceinline__ unsigned f2bf(float f) { unsigned u = __builtin_bit_cast(unsigned, f); return (u + 0x7fffu + ((u >> 16) & 1u)) >> 16; }
__device__ __forceinline__ unsigned pk2(float lo, float hi) { unsigned r; asm volatile("v_cvt_pk_bf16_f32 %0, %1, %2" : "=v"(r) : "v"(lo), "v"(hi)); return r; }
__device__ __forceinline__ float bf2f(unsigned h) { return __builtin_bit_cast(float, h << 16); }
__device__ __forceinline__ float bflo(unsigned w) { return __builtin_bit_cast(float, w << 16); }
__device__ __forceinline__ float bfhi(unsigned w) { return __builtin_bit_cast(float, w & 0xffff0000u); }
__device__ __forceinline__ float wave_sum(float v) {
#pragma unroll
    for (int o = 1; o < 64; o <<= 1) v += __shfl_xor(v, o);
    return v;
}
__device__ __forceinline__ float wave_max(float v) {
#pragma unroll
    for (int o = 1; o < 64; o <<= 1) v = fmaxf(v, __shfl_xor(v, o));
    return v;
}
#ifndef NC1_CFG
#define NC1_CFG 9
#endif
#ifndef NC5_CFG
#define NC5_CFG 16
#endif
#ifndef NC7_CFG
#define NC7_CFG 3
#endif
#ifndef HALF_LAST
#define HALF_LAST 0
#endif
#ifndef CONV_NTS
#define CONV_NTS 1
#endif
#ifndef CONV_NT
#define CONV_NT 1
#endif
#ifndef DYN_MOE
#define DYN_MOE 0
#endif
#ifndef HALF_UNITS_CFG
#define HALF_UNITS_CFG 1
#endif
#ifndef YSLOT_FP8
#define YSLOT_FP8 0
#endif
#ifndef CONV_DMA
#define CONV_DMA 0
#endif
#ifndef CONV_WG
#define CONV_WG 1
#endif
#ifndef CONV_PIPE
#define CONV_PIPE 0
#endif
#ifndef BG_POOL
#define BG_POOL 1
#endif
#ifndef FP8_MOE
#define FP8_MOE 1
#endif
#ifndef EMU_FP8
#define EMU_FP8 0
#endif
__device__ __forceinline__ unsigned pk4_fp8(float a, float b, float c, float d) { int p = __builtin_amdgcn_cvt_pk_fp8_f32(a, b, 0, false); p = __builtin_amdgcn_cvt_pk_fp8_f32(c, d, p, true); return (unsigned)p; }
typedef short v2s_ __attribute__((ext_vector_type(2)));
#ifndef CVT_SCALE
#define CVT_SCALE 0.015625f
#endif
__device__ __forceinline__ unsigned pk4_fp8_x64(float a, float b, float c, float d) { v2s_ o = {0, 0}; o = __builtin_amdgcn_cvt_scalef32_pk_fp8_f32(o, a, b, CVT_SCALE, false); o = __builtin_amdgcn_cvt_scalef32_pk_fp8_f32(o, c, d, CVT_SCALE, true); return __builtin_bit_cast(unsigned, o); }
__device__ __forceinline__ float q8(float x) { return __builtin_amdgcn_cvt_f32_fp8(__builtin_amdgcn_cvt_pk_fp8_f32(x, x, 0, false), 0); }
__device__ __forceinline__ float sigmoidf_(float x) { return 1.f / (1.f + __expf(-x)); }
__device__ __forceinline__ float siluf_(float x) { return x / (1.f + __expf(-x)); }
__device__ __forceinline__ float softplusf_(float x) { return fmaxf(x, 0.f) + log1pf(__expf(-fabsf(x))); }

#define XB_TMO      128
#define XB_XCNT(j)  (256  + 64 * (j))
#define XB_XSUB(j)  (1280 + 64 * (j))
#define XB_XGEN(j)  (2304 + 64 * (j))
#define XB_TOP      3328
#define XB_TOPGEN   3392
#define XCD_BAR_WORDS 3456
#define XB_SPIN_CAP (1u << 18)

__device__ __forceinline__ unsigned xb_ld(unsigned* p)              { return __hip_atomic_load(p, __ATOMIC_RELAXED, __HIP_MEMORY_SCOPE_AGENT); }
__device__ __forceinline__ unsigned xb_add(unsigned* p, unsigned v) { return __hip_atomic_fetch_add(p, v, __ATOMIC_RELAXED, __HIP_MEMORY_SCOPE_AGENT); }
__device__ __forceinline__ unsigned xb_xcc_id() { return (unsigned)__builtin_amdgcn_s_getreg((3 << 11) | 20) & 0xFu; }
#define XB_SPIN(cond, bar) do { unsigned _sp = 0; while (cond) { __builtin_amdgcn_s_sleep(1); \
    if ((++_sp & 255u) == 0u) { if (xb_ld(&(bar)[XB_TMO])) break; if (_sp > XB_SPIN_CAP) { atomicAdd(&(bar)[XB_TMO], 1u); break; } } } } while (0)

struct XcdBarrier {
    unsigned* bar; unsigned x;
    volatile LAS unsigned* st;
};
__device__ __forceinline__ XcdBarrier xcd_barrier_post(unsigned* bar, volatile LAS unsigned* st) {
    XcdBarrier b; b.bar = bar; b.x = xb_xcc_id(); b.st = st;
    if (threadIdx.x == 0) (void)xb_add(&bar[XB_XCNT(b.x)], 1u);
    return b;
}
__device__ __forceinline__ void xcd_barrier_complete(unsigned* bar, unsigned x, unsigned& nloc, unsigned& nx) {
    const unsigned G = gridDim.x * gridDim.y * gridDim.z;
    unsigned sum, cnt, mine, sp = 0u;
    for (;;) {
        sum = 0u; cnt = 0u; mine = 0u;
#pragma unroll
        for (unsigned j = 0; j < 16; ++j) { const unsigned c = xb_ld(&bar[XB_XCNT(j)]); sum += c; cnt += (c > 0u) ? 1u : 0u; mine = (j == x) ? c : mine; }
        if (sum == G) break;
        __builtin_amdgcn_s_sleep(1);
        if ((++sp & 255u) == 0u) { if (xb_ld(&bar[XB_TMO])) break; if (sp > XB_SPIN_CAP) { atomicAdd(&bar[XB_TMO], 1u); break; } }
    }
    nloc = mine > 0u ? mine : 1u; nx = cnt > 0u ? cnt : 1u;
}
__device__ __forceinline__ void xcd_barrier(const XcdBarrier& b) {
    asm volatile("s_waitcnt vmcnt(0)" ::: "memory");
    __syncthreads();
    if (threadIdx.x == 0) {
        unsigned* bar = b.bar;
        __builtin_amdgcn_s_waitcnt(0);
        unsigned nloc = b.st[0], nx = b.st[1];
        if (nloc == 0u) { xcd_barrier_complete(bar, b.x, nloc, nx); b.st[0] = nloc; b.st[1] = nx; }
        const unsigned old = xb_add(&bar[XB_XSUB(b.x)], 1u);
        const unsigned gen = old / nloc;
        if (old + 1u == (gen + 1u) * nloc) {
            __builtin_amdgcn_fence(__ATOMIC_RELEASE, "agent");
            asm volatile("s_waitcnt vmcnt(0)" ::: "memory");
            const unsigned og = xb_add(&bar[XB_TOP], 1u);
            const unsigned tg = og / nx;
            if (og + 1u == (tg + 1u) * nx) xb_add(&bar[XB_TOPGEN], 1u);
            else XB_SPIN(xb_ld(&bar[XB_TOPGEN]) == tg, bar);
            __builtin_amdgcn_fence(__ATOMIC_ACQUIRE, "agent");
            xb_add(&bar[XB_XGEN(b.x)], 1u);
            asm volatile("s_waitcnt vmcnt(0)" ::: "memory");
        } else {
            XB_SPIN(xb_ld(&bar[XB_XGEN(b.x)]) == gen, bar);
            __builtin_amdgcn_fence(__ATOMIC_ACQUIRE, "agent");
            asm volatile("s_waitcnt vmcnt(0)" ::: "memory");
        }
    }
    __syncthreads();
}
#ifndef B_NT_CFG
#define B_NT_CFG 0
#endif
#ifndef FP8_DIAG
#define FP8_DIAG 0
#endif
namespace pg8 {
#define PG8_LAS __attribute__((address_space(3)))
typedef unsigned short bf16_t;
typedef short bf16x8 __attribute__((ext_vector_type(8)));
typedef float f32x4 __attribute__((ext_vector_type(4)));
typedef unsigned u32x4 __attribute__((ext_vector_type(4)));
constexpr int BM = 256, BK = 64, HALF = 128, HTB = HALF * BK * 2  , STAGE_BYTES = 8 * HTB, NXCD = 8, WGM = 8;
constexpr int GK = 2048;
typedef int i32x8 __attribute__((ext_vector_type(8)));
typedef int i32x4_ __attribute__((ext_vector_type(4)));

__host__ __device__ __forceinline__ int lds_byte(int r, int c) { const int st = (r >> 4) * 2 + (c >> 5), rr = r & 15, cc = c & 31, ob = rr * 64 + cc * 2; return st * 1024 + (ob ^ (((ob >> 9) & 1) << 5)); }
__host__ __device__ __forceinline__ void stage_rc(int b, int& R, int& C) { const int st = b / 1024, sb = b % 1024, swz = sb ^ (((sb >> 9) & 1) << 5); R = (st >> 1) * 16 + swz / 64; C = (st & 1) * 32 + (swz % 64) / 2; }
__host__ __device__ __forceinline__ int perm32(int rho) { const int n = rho >> 4, i = rho & 15; return 8 * (i >> 2) + 4 * n + (i & 3); }

struct Unit { int pm, pn, e, mt, nrows; };

__device__ __forceinline__ unsigned cvt_pk_bf16(float lo, float hi) { unsigned r; asm volatile("v_cvt_pk_bf16_f32 %0, %1, %2" : "=v"(r) : "v"(lo), "v"(hi)); return r; }

template <class Epi, class Sched, bool GATHER, bool ALIGN_EPI, bool FP8 = false>
__device__ __forceinline__ void gemm_phase(PG8_LAS unsigned char* lds, const Sched& S, const Epi& E) {
    const int tid = threadIdx.x, wid = __builtin_amdgcn_readfirstlane(tid >> 6), lane = tid & 63, wr = wid >> 2, wc = wid & 3, fr = lane & 15, fq = lane >> 4;
    constexpr int K = FP8 ? GK / 2 : GK, nt = K / BK;
    unsigned vB[2]; int Ri[2], Ci[2];
#pragma unroll
    for (int i = 0; i < 2; ++i) { int R, C; stage_rc(tid * 16 + i * 8192, R, C); const int Rb = Epi::PERM ? ((R & ~31) + perm32(R & 31)) : R;
        vB[i] = Sched::B_BLOCKED ? (unsigned)(Rb * BK + C) * 2u : (unsigned)(Rb * K + C) * 2u; Ri[i] = R; Ci[i] = C; }
    constexpr unsigned kstep = (unsigned)(BK * 2);
    constexpr unsigned hstepB = Sched::B_BLOCKED ? (unsigned)HALF * BK * 2 : (unsigned)HALF * K * 2;
    const unsigned kstepB = Sched::B_BLOCKED ? S.b_kstep() : kstep;
    const char* const rA = (const char*)S.a_base(); const char* const rB = (const char*)S.b_base();
    const unsigned ldsw = (unsigned)wid * 1024u;
    const int aoff = lds_byte(wr * 64 + fr, fq * 8), boff = lds_byte(wc * 32 + fr, fq * 8);
#define PG8_SA(b, h) (((b) * 2 + (h)) * HTB)
#define PG8_SB(b, h) ((4 + (b) * 2 + (h)) * HTB)
#define PG8_STAGE(bufoff, gbase, soff, voff) do { _Pragma("unroll") for (int _i = 0; _i < 2; ++_i) { \
        if (FP8 && B_NT_CFG && (bufoff) >= 4 * HTB) __builtin_amdgcn_global_load_lds((const unsigned*)((gbase) + (size_t)(soff) + (voff)[_i]), (PG8_LAS unsigned*)(lds + (bufoff) + ldsw + _i * 8192), 16, 0, 2); \
        else __builtin_amdgcn_global_load_lds((const unsigned*)((gbase) + (size_t)(soff) + (voff)[_i]), (PG8_LAS unsigned*)(lds + (bufoff) + ldsw + _i * 8192), 16, 0, 0); } } while (0)
#define PG8_LDA(dst, b, h) do { _Pragma("unroll") for (int m = 0; m < 4; ++m) { dst[m].lo = *(const PG8_LAS i32x4_*)(lds + PG8_SA(b, h) + aoff + m * 2048); dst[m].hi = *(const PG8_LAS i32x4_*)(lds + PG8_SA(b, h) + aoff + m * 2048 + 1024); } } while (0)
#define PG8_LDB(dst, b, h) do { _Pragma("unroll") for (int n = 0; n < 2; ++n) { dst[n].lo = *(const PG8_LAS i32x4_*)(lds + PG8_SB(b, h) + boff + n * 2048); dst[n].hi = *(const PG8_LAS i32x4_*)(lds + PG8_SB(b, h) + boff + n * 2048 + 1024); } } while (0)
#define PG8_MMA(ai, bj, At, Bt) do { __builtin_amdgcn_s_setprio(1); _Pragma("unroll") for (int m = 0; m < 4; ++m) _Pragma("unroll") for (int n = 0; n < 2; ++n) { \
        if constexpr (FP8) { if (FP8_DIAG) { _Pragma("unroll") for (int q_ = 0; q_ < 4; ++q_) { \
                const long b_ = (long)(unsigned)Bt[n][2 * q_] | ((long)Bt[n][2 * q_ + 1] << 32), a_ = (long)(unsigned)At[m][2 * q_] | ((long)At[m][2 * q_ + 1] << 32); \
                acc[ai][bj][m][n] = __builtin_amdgcn_mfma_f32_16x16x32_fp8_fp8(b_, a_, acc[ai][bj][m][n], 0, 0, 0); } } \
            else asm volatile("v_mfma_scale_f32_16x16x128_f8f6f4 %0, %1, %2, %0, %3, %3 op_sel_hi:[0,0,0]" : "+v"(acc[ai][bj][m][n]) : "v"(Bt[n]), "v"(At[m]), "v"(sc8)); } \
        else { const i32x4_ bl_ = __builtin_shufflevector(Bt[n], Bt[n], 0, 1, 2, 3), bh_ = __builtin_shufflevector(Bt[n], Bt[n], 4, 5, 6, 7), al_ = __builtin_shufflevector(At[m], At[m], 0, 1, 2, 3), ah_ = __builtin_shufflevector(At[m], At[m], 4, 5, 6, 7); \
               acc[ai][bj][m][n] = __builtin_amdgcn_mfma_f32_16x16x32_bf16(__builtin_bit_cast(bf16x8, bl_), __builtin_bit_cast(bf16x8, al_), acc[ai][bj][m][n], 0, 0, 0); \
               acc[ai][bj][m][n] = __builtin_amdgcn_mfma_f32_16x16x32_bf16(__builtin_bit_cast(bf16x8, bh_), __builtin_bit_cast(bf16x8, ah_), acc[ai][bj][m][n], 0, 0, 0); } } \
        __builtin_amdgcn_s_setprio(0); } while (0)
#define PG8_WAIT_V(n) asm volatile("s_waitcnt vmcnt(" #n ")" ::: "memory")
#define PG8_WAIT_L(n) asm volatile("s_waitcnt lgkmcnt(" #n ")" ::: "memory")
#define PG8_BAR __builtin_amdgcn_s_barrier()
#define PG8_SCHED __builtin_amdgcn_sched_barrier(0)
#define PG8_VOFF(v, u) do { _Pragma("unroll") for (int h_ = 0; h_ < 2; ++h_) _Pragma("unroll") for (int i_ = 0; i_ < 2; ++i_) { \
        const int r_ = h_ * HALF + Ri[i_]; const int src_ = GATHER ? S.a_row(u, r_) : r_; v[h_][i_] = (unsigned)(src_ * K + Ci[i_]) * 2u; } } while (0)
    Unit cur, nxt; int ui = 0;
    if (!S.next(0, cur)) return;
    f32x4 acc[2][2][4][2];
#pragma unroll
    for (int a = 0; a < 2; ++a)
#pragma unroll
        for (int b = 0; b < 2; ++b)
#pragma unroll
            for (int m = 0; m < 4; ++m)
#pragma unroll
                for (int n = 0; n < 2; ++n) acc[a][b][m][n] = (f32x4){0.f, 0.f, 0.f, 0.f};
    const int sc8 = 0x7c7c7c7c;
    i32x8 At[4], B0[2], B1[2];
    unsigned vAc[2][2], vAn[2][2];
    PG8_VOFF(vAc, cur);
    unsigned cA = S.a_off(cur), cB = S.b_off(cur);
    PG8_STAGE(PG8_SB(0, 0), rB, cB, vB); PG8_STAGE(PG8_SB(0, 1), rB, cB + hstepB, vB); PG8_STAGE(PG8_SA(0, 0), rA, cA, vAc[0]); PG8_STAGE(PG8_SA(0, 1), rA, cA, vAc[1]);
    if (wr == 1) PG8_BAR;
    PG8_WAIT_V(2); PG8_BAR;
    PG8_STAGE(PG8_SB(1, 0), rB, cB + kstepB, vB); PG8_STAGE(PG8_SA(1, 0), rA, cA + kstep, vAc[0]); PG8_STAGE(PG8_SB(1, 1), rB, cB + hstepB + kstepB, vB);
    PG8_WAIT_V(6); PG8_BAR;
    for (;;) {
        const bool has_next = S.next(ui + 1, nxt);
        unsigned nA = cA, nB = cB;
        if (has_next) { nA = S.a_off(nxt); nB = S.b_off(nxt); PG8_VOFF(vAn, nxt); }
        else {
#pragma unroll
            for (int h = 0; h < 2; ++h)
#pragma unroll
                for (int i = 0; i < 2; ++i) vAn[h][i] = vAc[h][i]; }
        const bool halfu = Sched::HALF_UNITS && cur.nrows <= HALF;
        for (int t = 0; t < nt; t += 2) {
            const bool last = (t == nt - 2);
            const unsigned a1 = cA + (unsigned)(t + 1) * kstep;
            const unsigned a2 = last ? nA : cA + (unsigned)(t + 2) * kstep, b2 = last ? nB : cB + (unsigned)(t + 2) * kstepB;
            const unsigned a3 = a2 + kstep, b3 = b2 + kstepB;
            unsigned v2[2][2];
#pragma unroll
            for (int h = 0; h < 2; ++h)
#pragma unroll
                for (int i = 0; i < 2; ++i) v2[h][i] = last ? vAn[h][i] : vAc[h][i];
            PG8_LDB(B0, 0, 0); PG8_LDB(B1, 0, 1); PG8_SCHED; PG8_LDA(At, 0, 0); PG8_STAGE(PG8_SA(1, 1), rA, a1, vAc[1]);
            PG8_WAIT_V(8); PG8_WAIT_L(0); PG8_BAR; PG8_MMA(0, 0, At, B0); PG8_MMA(0, 1, At, B1); PG8_BAR; PG8_SCHED;
            if (!halfu) PG8_LDA(At, 0, 1); PG8_STAGE(PG8_SB(0, 0), rB, b2, vB); PG8_STAGE(PG8_SB(0, 1), rB, b2 + hstepB, vB); PG8_STAGE(PG8_SA(0, 0), rA, a2, v2[0]);
            PG8_WAIT_V(8); PG8_WAIT_L(0); PG8_BAR; if (!halfu) { PG8_MMA(1, 0, At, B0); PG8_MMA(1, 1, At, B1); } PG8_BAR; PG8_SCHED;
            PG8_LDB(B0, 1, 0); PG8_LDB(B1, 1, 1); PG8_SCHED; PG8_LDA(At, 1, 0); PG8_STAGE(PG8_SA(0, 1), rA, a2, v2[1]);
            PG8_WAIT_V(8); PG8_WAIT_L(0); PG8_BAR; PG8_MMA(0, 0, At, B0); PG8_MMA(0, 1, At, B1); PG8_BAR; PG8_SCHED;
            if (!halfu) PG8_LDA(At, 1, 1); PG8_STAGE(PG8_SB(1, 0), rB, b3, vB); PG8_STAGE(PG8_SB(1, 1), rB, b3 + hstepB, vB); PG8_STAGE(PG8_SA(1, 0), rA, a3, v2[0]);
            PG8_WAIT_V(8); PG8_WAIT_L(0); PG8_BAR; if (!halfu) { PG8_MMA(1, 0, At, B0); PG8_MMA(1, 1, At, B1); } PG8_BAR; PG8_SCHED;
        }
        if constexpr (FP8) asm volatile("s_nop 15\n\ts_nop 15" ::: "memory");
        if constexpr (ALIGN_EPI) { if (wr == 0) PG8_BAR; }
        E(acc, cur, wr, wc, fr, fq);
        if (!has_next) break;
#pragma unroll
        for (int a = 0; a < 2; ++a)
#pragma unroll
            for (int b = 0; b < 2; ++b)
#pragma unroll
                for (int m = 0; m < 4; ++m)
#pragma unroll
                    for (int n = 0; n < 2; ++n) acc[a][b][m][n] = (f32x4){0.f, 0.f, 0.f, 0.f};
        cur = nxt; cA = nA; cB = nB; ++ui;
#pragma unroll
        for (int h = 0; h < 2; ++h)
#pragma unroll
            for (int i = 0; i < 2; ++i) vAc[h][i] = vAn[h][i];
        if constexpr (ALIGN_EPI) { if (wr == 1) PG8_BAR; }
    }
    PG8_WAIT_V(0);
    if constexpr (!ALIGN_EPI) { if (wr == 0) PG8_BAR; }
    PG8_BAR;
#undef PG8_SA
#undef PG8_SB
#undef PG8_STAGE
#undef PG8_LDA
#undef PG8_LDB
#undef PG8_MMA
#undef PG8_WAIT_V
#undef PG8_WAIT_L
#undef PG8_BAR
#undef PG8_SCHED
#undef PG8_VOFF
}
}
struct Frame {
    LAS unsigned char* lds;
    volatile LAS unsigned* MISC;
    gu32* ctl;
    int wave, vcu, G;
    const float *x, *g1, *w_in, *fbias, *gq, *gk, *conv_w, *conv_b, *dt_bias, *a_log, *d_skip, *ssd_g, *w_out, *g2, *w_router, *b_router, *w_gate, *b_gate, *w_up, *b_up, *w_down, *b_down;
    float* out; unsigned char* ws;
};
#define WSP(T, off) ((T*)(F.ws + (off)))
__device__ __forceinline__ int TTID() { int t = threadIdx.x; asm volatile("" : "+v"(t)); return t; }
__device__ __forceinline__ int TLANE() { return TTID() & 63; }

template <bool Q8>
__device__ __forceinline__ void conv_item(const float* W, int ldn, int nvalid, int k0, int n0, bf16* dst, LAS unsigned* T, int lane) {
    const int kq = lane >> 4, nq = lane & 15, col = n0 + 4 * nq;
    const bool ok = col < nvalid;
    f32x4 a[8], b[8];
#pragma unroll
    for (int i = 0; i < 8; ++i) { const float* p = W + (size_t)(k0 + 8 * i + 2 * kq) * ldn + col;
        a[i] = ok ? *(const f32x4*)p : (f32x4){0.f, 0.f, 0.f, 0.f}; b[i] = ok ? *(const f32x4*)(p + ldn) : (f32x4){0.f, 0.f, 0.f, 0.f}; }
#pragma unroll
    for (int i = 0; i < 8; ++i)
#pragma unroll
        for (int j = 0; j < 4; ++j) T[(4 * nq + j) * 33 + 4 * i + kq] = (Q8 && EMU_FP8) ? pk2(q8(a[i][j] * 64.f) * (1.f / 64.f), q8(b[i][j] * 64.f) * (1.f / 64.f)) : pk2(a[i][j], b[i][j]);
    LDS_WAIT();
    const int c = lane & 7;
#pragma unroll
    for (int r = 0; r < 8; ++r) { const int n = 8 * r + (lane >> 3); const LAS unsigned* s = T + n * 33 + 4 * c;
        v4u o; o.x = s[0]; o.y = s[1]; o.z = s[2]; o.w = s[3];
        *(v4u*)(dst + (size_t)n * 2048 + k0 + 8 * c) = o; }
    LDS_WAIT();
}
__device__ __forceinline__ void conv_item8(const float* W, int k0, int n0, unsigned char* dst, LAS unsigned* T, int lane) {
    const int kq = lane >> 4, nq = lane & 15, col = n0 + 4 * nq;
    f32x4 a[8][4];
#pragma unroll
    for (int i = 0; i < 8; ++i)
#pragma unroll
        for (int r = 0; r < 4; ++r) a[i][r] = __builtin_nontemporal_load((const GAS f32x4*)(W + (size_t)(k0 + 16 * i + 4 * kq + r) * 2048 + col));
#pragma unroll
    for (int i = 0; i < 8; ++i)
#pragma unroll
        for (int j = 0; j < 4; ++j) T[(4 * nq + j) * 33 + 4 * i + kq] = pk4_fp8_x64(a[i][0][j], a[i][1][j], a[i][2][j], a[i][3][j]);
    LDS_WAIT();
    const int c = lane & 7;
#pragma unroll
    for (int r = 0; r < 8; ++r) { const int n = 8 * r + (lane >> 3); const LAS unsigned* s = T + n * 33 + 4 * c;
        v4u o; o.x = s[0]; o.y = s[1]; o.z = s[2]; o.w = s[3];
        *(GAS v4u*)(dst + (size_t)n * 128 + 16 * c) = o; }
    LDS_WAIT();
}
struct Conv8Regs { f32x4 a[4][4]; };
__device__ __forceinline__ void conv8_load(Conv8Regs& R, const float* W, int k0, int n0, int lane) {
    const int kq = lane >> 4, nq = lane & 15, col = n0 + 4 * nq;
#pragma unroll
    for (int i = 0; i < 4; ++i)
#pragma unroll
        for (int r = 0; r < 4; ++r) R.a[i][r] = __builtin_nontemporal_load((const GAS f32x4*)(W + (size_t)(k0 + 16 * i + 4 * kq + r) * 2048 + col));
}
__device__ __forceinline__ void conv8_pack(const Conv8Regs& R, int k0, unsigned char* dst, LAS unsigned* T, int lane) {
    const int kq = lane >> 4, nq = lane & 15;
#pragma unroll
    for (int i = 0; i < 4; ++i)
#pragma unroll
        for (int j = 0; j < 4; ++j) T[(4 * nq + j) * 17 + 4 * i + kq] = pk4_fp8_x64(R.a[i][0][j], R.a[i][1][j], R.a[i][2][j], R.a[i][3][j]);
    LDS_WAIT();
    const int c = lane & 3;
#pragma unroll
    for (int r = 0; r < 4; ++r) { const int n = 16 * r + (lane >> 2); const LAS unsigned* s = T + n * 17 + 4 * c;
        v4u o; o.x = s[0]; o.y = s[1]; o.z = s[2]; o.w = s[3];
        *(GAS v4u*)(dst + (size_t)n * 2048 + k0 + 16 * c) = o; }
    LDS_WAIT();
}
constexpr int MKB = (FP8_MOE && !CONV_PIPE) ? 16 : 32;
constexpr int IT_IN = 32 * (NP / 64), IT_OUT = 32 * 32, IT_EXP = MKB * 32, IT_MOE = 3 * NE * IT_EXP, IT_TOTAL = IT_IN + IT_OUT + IT_MOE;
constexpr int IT_GU = 2 * NE * IT_EXP;
struct MoeItem { const float* src; unsigned char* dst; int k0, n0; };
__device__ __forceinline__ MoeItem moe_item(Frame& F, int r) {
    const int m = r / (NE * IT_EXP); r -= m * (NE * IT_EXP);
    const int e = r / IT_EXP; r -= e * IT_EXP; const int kb = r >> 5, nb = r & 31;
    const size_t eo = (size_t)e * 2048 * 2048; const int es = FP8_MOE ? 1 : 2;
    MoeItem it; it.k0 = kb * ((FP8_MOE && !CONV_PIPE) ? 128 : 64); it.n0 = nb * 64;
    const int rgu = (nb >> 1) * 256 + (nb & 1) * 64;
#if FP8_MOE && !CONV_PIPE
    unsigned char* dgu = WSP(unsigned char, WS_WGU) + (size_t)e * (4096 * 2048) + ((size_t)kb * 4096 + rgu) * 128;
    unsigned char* ddn = WSP(unsigned char, WS_WD) + (size_t)e * (2048 * 2048) + ((size_t)kb * 2048 + nb * 64) * 128;
    constexpr size_t up_off = (size_t)128 * 128;
#else
    unsigned char* dgu = WSP(unsigned char, WS_WGU) + ((size_t)e * 4096 + rgu) * (2048 * es);
    unsigned char* ddn = WSP(unsigned char, WS_WD) + ((size_t)e * 2048 + nb * 64) * (2048 * es);
    constexpr size_t up_off = (size_t)128 * (2048 * es);
#endif
    const float* pg = F.w_gate; const float* pu = F.w_up; const float* pd = F.w_down; asm volatile("" : "+s"(pg), "+s"(pu), "+s"(pd));
    const float* base = pg; it.dst = dgu;
    if (m == 1) { base = pu; it.dst = dgu + up_off; }
    if (m == 2) { base = pd; it.dst = ddn; }
    it.src = base + eo; return it;
}
__device__ __forceinline__ void conv_moe_item(Frame& F, int r, LAS unsigned* T, int lane0) {
    const MoeItem it = moe_item(F, r);
#if FP8_MOE && CONV_PIPE
    { Conv8Regs R; conv8_load(R, it.src, it.k0, it.n0, lane0); conv8_pack(R, it.k0, it.dst, T, lane0); }
#elif FP8_MOE
    conv_item8(it.src, it.k0, it.n0, it.dst, T, lane0);
#else
    conv_item<true>(it.src, 2048, 2048, it.k0, it.n0, (bf16*)it.dst, T, lane0);
#endif
}
__device__ __forceinline__ void conv_dispatch(Frame& F, int it, LAS unsigned* T, int lane0) {
    int r = it;
    if (r < IT_IN) { const int kb = r / (NP / 64), nb = r % (NP / 64); conv_item<false>(F.w_in, INCOLS, INCOLS, kb * 64, nb * 64, WSP(bf16, WS_WIN) + (size_t)(nb * 64) * 2048, T, lane0); return; }
    r -= IT_IN;
    if (r < IT_OUT) { const int kb = r >> 5, nb = r & 31; conv_item<false>(F.w_out, DM, DM, kb * 64, nb * 64, WSP(bf16, WS_WOUT) + (size_t)(nb * 64) * 2048, T, lane0); return; }
    r -= IT_OUT;
    conv_moe_item(F, r, T, lane0);
}
constexpr int WNB = CONV_DMA ? 16 : 8;
constexpr int WIT_EXP = 16 * WNB, WIT_GU = 2 * NE * WIT_EXP, WIT_MOE = 3 * NE * WIT_EXP;
struct WgItem { const float* src; unsigned char* blk; int m, nb; };
__device__ __forceinline__ WgItem wg_item(Frame& F, int r) {
    const int m = r / (NE * WIT_EXP); r -= m * (NE * WIT_EXP);
    const int e = r / WIT_EXP; r -= e * WIT_EXP; const int kb = r / WNB, nb = r % WNB;
    const float* pg = F.w_gate; const float* pu = F.w_up; const float* pd = F.w_down; asm volatile("" : "+s"(pg), "+s"(pu), "+s"(pd));
    WgItem it; it.m = m; it.nb = nb;
    const float* base = pg; if (m == 1) base = pu; if (m == 2) base = pd;
    it.src = base + (size_t)e * 2048 * 2048 + (size_t)(kb * 128) * 2048 + nb * (CONV_DMA ? 128 : 256);
    it.blk = (m == 2) ? WSP(unsigned char, WS_WD) + (size_t)e * (2048 * 2048) + (size_t)kb * (2048 * 128)
                      : WSP(unsigned char, WS_WGU) + (size_t)e * (4096 * 2048) + (size_t)kb * (4096 * 128);
    return it;
}
__device__ __forceinline__ void wg_load(f32x4 (&a)[16], const WgItem& it, int wave, int lane) {
#pragma unroll
    for (int i = 0; i < 16; ++i) a[i] = CONV_NT ? __builtin_nontemporal_load((const GAS f32x4*)(it.src + (size_t)(16 * wave + i) * 2048 + 4 * lane)) : *(const GAS f32x4*)(it.src + (size_t)(16 * wave + i) * 2048 + 4 * lane);
}
__device__ __forceinline__ void wg_pack(const f32x4 (&a)[16], LAS unsigned char* T, int wave, int lane) {
#pragma unroll
    for (int j = 0; j < 4; ++j) { v4u d;
        d.x = pk4_fp8_x64(a[0][j], a[1][j], a[2][j], a[3][j]); d.y = pk4_fp8_x64(a[4][j], a[5][j], a[6][j], a[7][j]);
        d.z = pk4_fp8_x64(a[8][j], a[9][j], a[10][j], a[11][j]); d.w = pk4_fp8_x64(a[12][j], a[13][j], a[14][j], a[15][j]);
        *(LAS v4u*)(T + (4 * lane + j) * 128 + ((wave ^ (lane & 7)) << 4)) = d; }
}
__device__ __forceinline__ void wg_store(const LAS unsigned char* T, const WgItem& it, int wave, int lane) {
    const int rb = (it.m == 2) ? it.nb * 256 : (2 * it.nb + (wave >> 2)) * 256 + (it.m == 1 ? 128 : 0);
#pragma unroll
    for (int s = 0; s < 4; ++s) { const int n = 32 * wave + 8 * s + (lane >> 3), c = lane & 7;
        const v4u v = *(const LAS v4u*)(T + n * 128 + ((c ^ ((n >> 2) & 7)) << 4));
        const int row = (it.m == 2) ? rb + n : rb + (n & 127);
        if (CONV_NTS) __builtin_nontemporal_store(v, (GAS v4u*)(it.blk + (size_t)row * 128 + 16 * c)); else *(GAS v4u*)(it.blk + (size_t)row * 128 + 16 * c) = v; }
}
__device__ __forceinline__ void dma_issue(const WgItem& it, unsigned sbase, int wave, int lane) {
#pragma unroll
    for (int i2 = 0; i2 < 8; ++i2) { const float* g = it.src + (size_t)(16 * wave + 2 * i2 + (lane >> 5)) * 2048 + 4 * (lane & 31); unsigned keep;
        asm volatile("s_mov_b32 %0, m0\n\ts_mov_b32 m0, %2\n\ts_nop 0\n\tglobal_load_lds_dwordx4 %1, off nt\n\ts_mov_b32 m0, %0" : "=&s"(keep) : "v"(g), "s"(sbase + 1024u * i2) : "memory"); }
}
__device__ __forceinline__ void dma_pack(const LAS unsigned char* Sw, LAS unsigned char* T, int wave, int lane) {
    const int n4 = lane & 31, kh = lane >> 5;
    f32x4 a[8];
#pragma unroll
    for (int r = 0; r < 8; ++r) { const int k = 8 * kh + r; a[r] = *(const LAS f32x4*)(Sw + (k >> 1) * 1024 + (k & 1) * 512 + n4 * 16); }
#pragma unroll
    for (int j = 0; j < 4; ++j) { v2u d; d.x = pk4_fp8_x64(a[0][j], a[1][j], a[2][j], a[3][j]); d.y = pk4_fp8_x64(a[4][j], a[5][j], a[6][j], a[7][j]);
        const int n = 4 * n4 + j; *(LAS v2u*)(T + n * 128 + ((wave ^ (n4 & 7)) << 4) + 8 * kh) = d; }
}
__device__ __forceinline__ void dma_store(const LAS unsigned char* T, const WgItem& it, int wave, int lane) {
    const int rb = (it.m == 2) ? it.nb * 128 : it.nb * 256 + (it.m == 1 ? 128 : 0);
#pragma unroll
    for (int s = 0; s < 2; ++s) { const int n = 16 * wave + 8 * s + (lane >> 3), c = lane & 7;
        const v4u v = *(const LAS v4u*)(T + n * 128 + ((c ^ ((n >> 2) & 7)) << 4));
        *(GAS v4u*)(it.blk + (size_t)(rb + n) * 128 + 16 * c) = v; }
}
constexpr int BG_BATCH = CONV_WG ? 4 : 32;
constexpr int POOL_GU = CONV_WG ? WIT_GU : IT_GU, POOL_ALL = CONV_WG ? WIT_MOE : IT_MOE;
__device__ __forceinline__ bool bg_batch(Frame& F, int limit) {
    LAS unsigned* T = (LAS unsigned*)(F.lds + RING_OFF + F.wave * 16384); volatile LAS int* BW = (volatile LAS int*)(F.lds + BGW_OFF);
    const int lane = TLANE();
    if (F.wave == 0) { int v = (int)__hip_atomic_load(F.ctl + CW_HEAD, RLX_AGENT);
        if (v < limit) v = (int)__hip_atomic_fetch_add(F.ctl + CW_HEAD, lane == 0 ? (unsigned)BG_BATCH : 0u, RLX_AGENT); else v = POOL_ALL;
        BW[0] = __builtin_amdgcn_readfirstlane(v); }
    __syncthreads();
    const int it0 = __builtin_amdgcn_readfirstlane(BW[0]);
    __syncthreads();
    if (it0 >= POOL_ALL) return false;
#if CONV_WG && CONV_DMA
    { LAS unsigned char* S0 = F.lds + RING_OFF; LAS unsigned char* T = F.lds + DMA_T_OFF; const int w = F.wave;
      const unsigned sb0 = (unsigned)(uintptr_t)(S0 + 8192 * w), sb1 = sb0 + 65536u;
      const WgItem i0 = wg_item(F, it0), i1 = wg_item(F, it0 + 1), i2 = wg_item(F, it0 + 2), i3 = wg_item(F, it0 + 3);
#define DMA_STEP(cur, sbc, NEXT_ISSUE, NWAIT) do { NEXT_ISSUE; asm volatile("s_waitcnt vmcnt(" #NWAIT ")" ::: "memory"); \
        dma_pack(S0 + ((sbc) - sb0) + 8192 * w, T, w, lane); LDS_WAIT(); __syncthreads(); dma_store(T, cur, w, lane); LDS_WAIT(); __syncthreads(); } while (0)
      dma_issue(i0, sb0, w, lane);
      DMA_STEP(i0, sb0, dma_issue(i1, sb1, w, lane), 8);
      DMA_STEP(i1, sb1, dma_issue(i2, sb0, w, lane), 8);
      DMA_STEP(i2, sb0, dma_issue(i3, sb1, w, lane), 8);
      DMA_STEP(i3, sb1, (void)0, 0);
#undef DMA_STEP
    }
#elif CONV_WG
    { LAS unsigned char* T0 = F.lds + RING_OFF; LAS unsigned char* T1 = T0 + 32768; const int w = F.wave;
      f32x4 A[16], B[16];
      const WgItem i0 = wg_item(F, it0), i1 = wg_item(F, it0 + 1), i2 = wg_item(F, it0 + 2), i3 = wg_item(F, it0 + 3);
      wg_load(A, i0, w, lane);
      wg_load(B, i1, w, lane); wg_pack(A, T0, w, lane); LDS_WAIT(); __syncthreads(); wg_store(T0, i0, w, lane);
      wg_load(A, i2, w, lane); wg_pack(B, T1, w, lane); LDS_WAIT(); __syncthreads(); wg_store(T1, i1, w, lane);
      wg_load(B, i3, w, lane); wg_pack(A, T0, w, lane); LDS_WAIT(); __syncthreads(); wg_store(T0, i2, w, lane);
      wg_pack(B, T1, w, lane); LDS_WAIT(); __syncthreads(); wg_store(T1, i3, w, lane);
      LDS_WAIT(); __syncthreads(); }
#else
#pragma unroll 1
    for (int j = 0; j < BG_BATCH / NWAVES; ++j) conv_moe_item(F, it0 + j * NWAVES + F.wave, T, lane);
#endif
    return true;
}
__device__ __forceinline__ void bg_fill(Frame& F, int k, int limit) {
    volatile LAS int* BW = (volatile LAS int*)(F.lds + BGW_OFF);
    const int lane = TLANE();
    VM_WAIT(); __syncthreads();
    if (F.wave == 0) (void)__hip_atomic_fetch_add(F.ctl + CW_DONE + 64 * k, lane == 0 ? 1u : 0u, RLX_AGENT);
    bool more = true;
    while (more) {
        if (F.wave == 0) BW[1] = ((int)__hip_atomic_load(F.ctl + CW_DONE + 64 * k, RLX_AGENT) >= F.G) ? 1 : 0;
        __syncthreads();
        const int stop = __builtin_amdgcn_readfirstlane(BW[1]);
        __syncthreads();
        more = !stop;
        if (more) more = bg_batch(F, limit);
    }
}
__device__ __forceinline__ bool bg_finish(Frame& F, int limit) {
    bool any = false;
    while (bg_batch(F, limit)) any = true;
    return any;
}
__device__ __forceinline__ bool bg_open(Frame& F, int limit) {
    return (int)__hip_atomic_load(F.ctl + CW_HEAD, RLX_AGENT) < limit;
}
__device__ __forceinline__ void rms_row_to_bf16(const float* xrow, const float* g, bf16* orow, int lane) {
    const f32x4* xr = (const f32x4*)xrow + lane; const f32x4* gr = (const f32x4*)g + lane;
    f32x4 v[8]; float s = 0.f;
#pragma unroll
    for (int j = 0; j < 8; ++j) { v[j] = xr[64 * j]; s += (v[j].x * v[j].x + v[j].y * v[j].y) + (v[j].z * v[j].z + v[j].w * v[j].w); }
    const float rstd = 1.f / sqrtf(wave_sum(s) * (1.f / 2048.f) + EPS);
    v2u* o8 = (v2u*)orow + lane;
#pragma unroll
    for (int j = 0; j < 8; ++j) { const f32x4 gg = gr[64 * j]; v2u w; w.x = pk2(v[j].x * rstd * gg.x, v[j].y * rstd * gg.y); w.y = pk2(v[j].z * rstd * gg.z, v[j].w * rstd * gg.w); o8[64 * j] = w; }
}
__device__ __forceinline__ void p0_prologue(Frame& F) {
    LAS unsigned* T = (LAS unsigned*)(F.lds + RING_OFF + F.wave * 16384); const int lane0 = TLANE();
    const int gw = F.vcu * NWAVES + F.wave, NGW = F.G * NWAVES;
    for (int it = gw; it < (BG_POOL ? IT_IN + IT_OUT : IT_TOTAL); it += NGW) conv_dispatch(F, it, T, lane0);
    for (int i = gw * 64 + lane0; i < NE * 2048; i += NGW * 64) { const int e = i >> 11, k = i & 2047; const float w = F.g2[k] * F.w_router[k * NE + e];
        const unsigned hi = f2bf(w); const float lo = w - bf2f(hi); WSP(bf16, WS_WR)[i] = (bf16)hi; WSP(bf16, WS_WR)[NE * 2048 + i] = (bf16)f2bf(lo); }
    for (int m0 = 2 * gw; m0 < NTOK; m0 += 2 * NGW) {
        const f32x4* x0 = (const f32x4*)(F.x + (size_t)m0 * DM) + lane0; const f32x4* x1 = x0 + DM / 4; const f32x4* gr = (const f32x4*)F.g1 + lane0;
        f32x4 v0[8], v1[8]; float s0 = 0.f, s1 = 0.f;
#pragma unroll
        for (int j = 0; j < 8; ++j) { v0[j] = x0[64 * j]; v1[j] = x1[64 * j]; }
#pragma unroll
        for (int j = 0; j < 8; ++j) { s0 += (v0[j].x * v0[j].x + v0[j].y * v0[j].y) + (v0[j].z * v0[j].z + v0[j].w * v0[j].w); s1 += (v1[j].x * v1[j].x + v1[j].y * v1[j].y) + (v1[j].z * v1[j].z + v1[j].w * v1[j].w); }
        const float r0 = 1.f / sqrtf(wave_sum(s0) * (1.f / 2048.f) + EPS), r1 = 1.f / sqrtf(wave_sum(s1) * (1.f / 2048.f) + EPS);
        v2u* o0 = (v2u*)(WSP(bf16, WS_XN) + (size_t)m0 * DM) + lane0; v2u* o1 = o0 + DM / 4;
#pragma unroll
        for (int j = 0; j < 8; ++j) { const f32x4 gg = gr[64 * j]; v2u w;
            w.x = pk2(v0[j].x * r0 * gg.x, v0[j].y * r0 * gg.y); w.y = pk2(v0[j].z * r0 * gg.z, v0[j].w * r0 * gg.w); o0[64 * j] = w;
            w.x = pk2(v1[j].x * r1 * gg.x, v1[j].y * r1 * gg.y); w.y = pk2(v1[j].z * r1 * gg.z, v1[j].w * r1 * gg.w); o1[64 * j] = w; }
    }
}

struct OrderStatic {
    static constexpr bool B_BLOCKED = false, HALF_UNITS = false; __device__ __forceinline__ unsigned b_kstep() const { return 128u; }
    int nM, nN, nwg, G, c; const char* A; const char* Bt;
    __device__ __forceinline__ void init(int M, int N, int G_, int c_, const void* A_, const void* Bt_) { nM = M / 256; nN = N / 256; nwg = nM * nN; G = G_; c = c_; A = (const char*)A_; Bt = (const char*)Bt_; }
    __device__ __forceinline__ bool next(int i, pg8::Unit& u) const {
        const long L = (long)i * G + c; if (L >= nwg) return false;
        int wgid = (int)L; { const int q = nwg / 8, r = nwg % 8, xcd = wgid % 8, off = wgid / 8; wgid = (xcd < r ? xcd * (q + 1) : r * (q + 1) + (xcd - r) * q) + off; }
        const int nig = 8 * nN, gid = wgid / nig, fm = gid * 8, gsz = (nM - fm) < 8 ? (nM - fm) : 8;
        u.pm = fm + ((wgid % nig) % gsz); u.pn = (wgid % nig) / gsz; u.e = 0; u.mt = 0; u.nrows = 256; return true;
    }
    __device__ __forceinline__ const void* a_base() const { return A; }
    __device__ __forceinline__ const void* b_base() const { return Bt; }
    __device__ __forceinline__ unsigned a_off(const pg8::Unit& u) const { return (unsigned)u.pm * (256u * 2048 * 2); }
    __device__ __forceinline__ unsigned b_off(const pg8::Unit& u) const { return (unsigned)u.pn * (256u * 2048 * 2); }
    __device__ __forceinline__ int a_row(const pg8::Unit&, int r) const { return r; }
};
template <int NT, bool GATHER_A, int RB  > struct OrderMoe {
    static constexpr bool HALF_UNITS = HALF_UNITS_CFG != 0;
    static constexpr bool B_BLOCKED = FP8_MOE != 0;
    __device__ __forceinline__ unsigned b_kstep() const { return (unsigned)(bstride / 16); }
    int G, c, tb_lane, cn_lane, tbf_lane, tbh_lane; const char* A; const char* Bt; const int* stok; size_t bstride;
    gu32* qcnt; volatile LAS int* bw; int xc; bool dyn;
    __device__ __forceinline__ void init(int G_, int c_, const LAS int* TB, const LAS int* CN, int lane, const void* A_, const void* Bt_, size_t bstride_, const int* stok_, gu32* qcnt_, volatile LAS int* bw_, bool dyn_) {
        G = G_; c = c_; tb_lane = TB[lane < 32 ? lane : 32]; cn_lane = CN[lane & 31]; tbf_lane = TB[128 + (lane < 32 ? lane : 32)]; tbh_lane = TB[192 + (lane < 32 ? lane : 32)]; A = (const char*)A_; Bt = (const char*)Bt_; bstride = bstride_; stok = stok_;
        dyn = dyn_; xc = c_ >> 5; qcnt = qcnt_ + 64 * xc; bw = bw_; }
    __device__ __forceinline__ bool next(int i, pg8::Unit& u) const {
        int L = i * G + c;
        if (dyn) {
            if (__builtin_amdgcn_readfirstlane((int)(threadIdx.x >> 6)) == 0) { const unsigned v = __hip_atomic_fetch_add(qcnt, (threadIdx.x & 63) == 0 ? 1u : 0u, RLX_AGENT); bw[0] = __builtin_amdgcn_readfirstlane((int)v); }
            asm volatile("s_waitcnt lgkmcnt(0)" ::: "memory"); __builtin_amdgcn_s_barrier(); asm volatile("" ::: "memory");
            const int j = __builtin_amdgcn_readfirstlane(bw[0]);
            L = ((j >> 5) * 8 + xc) * 32 + (j & 31);
        }
        const int tfl = HALF_LAST ? tbf_lane : tb_lane;
        const int nfull = __builtin_amdgcn_readlane(tfl, 32) * NT, total = nfull + (HALF_LAST ? __builtin_amdgcn_readlane(tbh_lane, 32) * NT : 0); if (L >= total) return false;
        const int lane = threadIdx.x & 63;
        if (L < nfull) {
            const unsigned long long mk = __ballot(lane < 32 && tfl * NT <= L);
            const int e = __builtin_popcountll(mk) - 1;
            const int tfe = __builtin_amdgcn_readlane(tfl, e), tfe1 = __builtin_amdgcn_readlane(tfl, e + 1), tbe = __builtin_amdgcn_readlane(tb_lane, e), cne = __builtin_amdgcn_readlane(cn_lane, e);
            const int r = L - tfe * NT, mtiles = tfe1 - tfe, grp = mtiles * 8, ng = r / grp, r2 = r - ng * grp, mt = r2 >> 3, n8 = r2 & 7;
            u.e = e; u.mt = mt; u.pm = tbe + mt; u.pn = ng * 8 + n8; const int left = cne - mt * 256; u.nrows = left < 256 ? left : 256;
        } else {
            const int Lh = L - nfull;
            const unsigned long long mk = __ballot(lane < 32 && tbh_lane * NT <= Lh);
            const int e = __builtin_popcountll(mk) - 1;
            const int the = __builtin_amdgcn_readlane(tbh_lane, e), tbe = __builtin_amdgcn_readlane(tb_lane, e), tbe1 = __builtin_amdgcn_readlane(tb_lane, e + 1), cne = __builtin_amdgcn_readlane(cn_lane, e);
            const int mt = tbe1 - tbe - 1;
            u.e = e; u.mt = mt; u.pm = tbe + mt; u.pn = Lh - the * NT; u.nrows = cne - mt * 256;
        }
        return true;
    }
    __device__ __forceinline__ const void* a_base() const { return A; }
    __device__ __forceinline__ const void* b_base() const { return Bt; }
    __device__ __forceinline__ unsigned a_off(const pg8::Unit& u) const { return GATHER_A ? 0u : (unsigned)u.pm * (256u * RB); }
    __device__ __forceinline__ unsigned b_off(const pg8::Unit& u) const { return (unsigned)u.e * (unsigned)bstride + (unsigned)u.pn * (256u * (B_BLOCKED ? 128 : RB)); }
    __device__ __forceinline__ int a_row(const pg8::Unit& u, int r) const { return stok[u.e * SLOTCAP + u.mt * 256 + (r < u.nrows ? r : 0)]; }
};

struct EpiProj {
    static constexpr bool PERM = true; bf16* O; int ldc;
    __device__ __forceinline__ void operator()(const f32x4 (&acc)[2][2][4][2], const pg8::Unit& u, int wr, int wc, int fr, int fq) const {
        const int row0 = u.pm * 256 + wr * 64 + fr, col0 = u.pn * 256 + wc * 32 + 8 * fq;
#pragma unroll
        for (int ai = 0; ai < 2; ++ai)
#pragma unroll
            for (int m = 0; m < 4; ++m) { bf16* rowp = O + (size_t)(row0 + ai * 128 + m * 16) * ldc + col0;
#pragma unroll
                for (int bj = 0; bj < 2; ++bj) { const f32x4 v0 = acc[ai][bj][m][0], v1 = acc[ai][bj][m][1];
                    v4u w; w.x = pk2(v0[0], v0[1]); w.y = pk2(v0[2], v0[3]); w.z = pk2(v1[0], v1[1]); w.w = pk2(v1[2], v1[3]);
                    *(v4u*)(rowp + bj * 128) = w; } }
    }
};
struct EpiRes {
    static constexpr bool PERM = false; const float* base; float* out;
    __device__ __forceinline__ void operator()(const f32x4 (&acc)[2][2][4][2], const pg8::Unit& u, int wr, int wc, int fr, int fq) const {
        const int row0 = u.pm * 256 + wr * 64 + fr, col0 = u.pn * 256 + wc * 32 + 4 * fq;
#pragma unroll
        for (int ai = 0; ai < 2; ++ai)
#pragma unroll
            for (int m = 0; m < 4; ++m) { const size_t off = (size_t)(row0 + ai * 128 + m * 16) * DM + col0;
                f32x4 xb[2][2];
#pragma unroll
                for (int bj = 0; bj < 2; ++bj)
#pragma unroll
                    for (int n = 0; n < 2; ++n) xb[bj][n] = *(const f32x4*)(base + off + bj * 128 + n * 16);
#pragma unroll
                for (int bj = 0; bj < 2; ++bj)
#pragma unroll
                    for (int n = 0; n < 2; ++n) *(f32x4*)(out + off + bj * 128 + n * 16) = xb[bj][n] + acc[ai][bj][m][n]; }
    }
};
__device__ __forceinline__ float swiglu1(float g, float u) {
    g = fminf(g, SW_LIMIT); u = fminf(fmaxf(u, -SW_LIMIT), SW_LIMIT);
    const float glu = g / (1.f + __expf(-SW_ALPHA * g));
    return (u + 1.f) * glu;
}
struct EpiGlu {
    static constexpr bool PERM = true; void* act; const float* bg; const float* bu;
    __device__ __forceinline__ void operator()(const f32x4 (&acc)[2][2][4][2], const pg8::Unit& u, int wr, int wc, int fr, int fq) const {
        const int row0 = u.pm * 256 + wr * 64 + fr, colf = u.pn * 128 + wc * 32 + 8 * fq;
        f32x4 g_b[2], u_b[2];
#pragma unroll
        for (int n = 0; n < 2; ++n) { g_b[n] = *(const f32x4*)(bg + (size_t)u.e * DFF + colf + 4 * n); u_b[n] = *(const f32x4*)(bu + (size_t)u.e * DFF + colf + 4 * n); }
#pragma unroll
        for (int ai = 0; ai < 2; ++ai)
#pragma unroll
            for (int m = 0; m < 4; ++m) { float r[8];
#pragma unroll
                for (int n = 0; n < 2; ++n) { const float ds_ = (FP8_MOE && FP8_DIAG) ? (1.f / 64.f) : 1.f; const f32x4 g = acc[ai][0][m][n] * ds_ + g_b[n], uu = acc[ai][1][m][n] * ds_ + u_b[n];
#pragma unroll
                    for (int j = 0; j < 4; ++j) { r[4 * n + j] = swiglu1(g[j], uu[j]); if (EMU_FP8) r[4 * n + j] = q8(r[4 * n + j]); } }
#if FP8_MOE
                v2u w; w.x = pk4_fp8(r[0], r[1], r[2], r[3]); w.y = pk4_fp8(r[4], r[5], r[6], r[7]);
                *(v2u*)((unsigned char*)act + (size_t)(row0 + ai * 128 + m * 16) * DFF + colf) = w; }
#else
                v4u w; w.x = pk2(r[0], r[1]); w.y = pk2(r[2], r[3]); w.z = pk2(r[4], r[5]); w.w = pk2(r[6], r[7]);
                *(v4u*)((bf16*)act + (size_t)(row0 + ai * 128 + m * 16) * DFF + colf) = w; }
#endif
    }
};
struct EpiDown {
    static constexpr bool PERM = true; bf16* ys; const float* bd; const float* sgate; const int* sdest;
    __device__ __forceinline__ void operator()(const f32x4 (&acc)[2][2][4][2], const pg8::Unit& u, int wr, int wc, int fr, int fq) const {
        const int col0 = u.pn * 256 + wc * 32 + 8 * fq;
        f32x4 bv[2][2];
#pragma unroll
        for (int bj = 0; bj < 2; ++bj)
#pragma unroll
            for (int n = 0; n < 2; ++n) bv[bj][n] = *(const f32x4*)(bd + (size_t)u.e * DM + col0 + bj * 128 + 4 * n);
        float gts[2][4]; int dsts[2][4];
#pragma unroll
        for (int ai = 0; ai < 2; ++ai)
#pragma unroll
            for (int m = 0; m < 4; ++m) { const int rl = ai * 128 + wr * 64 + m * 16 + fr; const int slot = u.e * SLOTCAP + u.mt * 256 + (rl < u.nrows ? rl : 0); gts[ai][m] = sgate[slot]; dsts[ai][m] = sdest[slot]; }
#pragma unroll
        for (int ai = 0; ai < 2; ++ai)
#pragma unroll
            for (int m = 0; m < 4; ++m) { const int rl = ai * 128 + wr * 64 + m * 16 + fr;
                if (rl < u.nrows) { const float gt = gts[ai][m]; const int dest = dsts[ai][m];
#pragma unroll
                    for (int bj = 0; bj < 2; ++bj) { const float ds_ = (FP8_MOE && FP8_DIAG) ? (1.f / 64.f) : 1.f; const f32x4 v0 = (acc[ai][bj][m][0] * ds_ + bv[bj][0]) * gt, v1 = (acc[ai][bj][m][1] * ds_ + bv[bj][1]) * gt;
#if YSLOT_FP8
                        v2u w; w.x = pk4_fp8(v0[0], v0[1], v0[2], v0[3]); w.y = pk4_fp8(v1[0], v1[1], v1[2], v1[3]);
                        *(v2u*)((unsigned char*)ys + (size_t)dest * DM + col0 + bj * 128) = w; } } }
#else
                        v4u w; w.x = pk2(v0[0], v0[1]); w.y = pk2(v0[2], v0[3]); w.z = pk2(v1[0], v1[1]); w.w = pk2(v1[2], v1[3]);
                        *(v4u*)(ys + (size_t)dest * DM + col0 + bj * 128) = w; } } }
#endif
    }
};

__device__ __forceinline__ void unpack8(const v4u w, float (&f)[8]) { f[0] = bflo(w.x); f[1] = bfhi(w.x); f[2] = bflo(w.y); f[3] = bfhi(w.y); f[4] = bflo(w.z); f[5] = bfhi(w.z); f[6] = bflo(w.w); f[7] = bfhi(w.w); }
__device__ __forceinline__ v4u pack8f(const float (&f)[8]) { v4u w; w.x = pk2(f[0], f[1]); w.y = pk2(f[2], f[3]); w.z = pk2(f[4], f[5]); w.w = pk2(f[6], f[7]); return w; }
__device__ __forceinline__ void p2_post(Frame& F) {
    const int gw = F.vcu * NWAVES + F.wave, NGW = F.G * NWAVES, lane = TLANE();
    const bf16* proj = WSP(bf16, WS_PROJ);
    {
        const int d0 = (16 * lane) & 127, h = lane >> 3;
        float gqv[16], gkv[16];
#pragma unroll
        for (int j = 0; j < 16; ++j) { gqv[j] = F.gq[d0 + j] * QSCALE; gkv[j] = F.gk[d0 + j]; }
        const float dtb = F.dt_bias[lane & 15], An = -__expf(F.a_log[lane & 15]);
        for (int t0 = 4 * gw; t0 < NTOK; t0 += 4 * NGW) {
            v4u raw[4][2][2];
#pragma unroll
            for (int ti = 0; ti < 4; ++ti)
#pragma unroll
                for (int qk = 0; qk < 2; ++qk) { const v4u* src = (const v4u*)(proj + (size_t)(t0 + ti) * NP + (qk ? O_K : O_Q) + 16 * lane); raw[ti][qk][0] = src[0]; raw[ti][qk][1] = src[1]; }
            float dtraw[4];
#pragma unroll
            for (int ti = 0; ti < 4; ++ti) dtraw[ti] = bf2f(proj[(size_t)(t0 + ti) * NP + O_DT + (lane & 15)]);
#pragma unroll
            for (int ti = 0; ti < 4; ++ti) { const int t = t0 + ti, b = t >> 11, s = t & 2047;
#pragma unroll
                for (int qk = 0; qk < 2; ++qk) {
                    float f[16]; { float a[8], c[8]; unpack8(raw[ti][qk][0], a); unpack8(raw[ti][qk][1], c);
#pragma unroll
                        for (int j = 0; j < 8; ++j) { f[j] = a[j]; f[8 + j] = c[j]; } }
                    float ss = 0.f;
#pragma unroll
                    for (int j = 0; j < 16; ++j) ss += f[j] * f[j];
                    ss += __shfl_xor(ss, 1); ss += __shfl_xor(ss, 2); ss += __shfl_xor(ss, 4);
                    const float rstd = 1.f / sqrtf(ss * (1.f / 128.f) + EPS);
                    float o0[8], o1[8];
#pragma unroll
                    for (int j = 0; j < 8; ++j) { o0[j] = f[j] * rstd * (qk ? gkv[j] : gqv[j]); o1[j] = f[8 + j] * rstd * (qk ? gkv[8 + j] : gqv[8 + j]); }
                    v4u* dst = (v4u*)(WSP(bf16, qk ? WS_KN : WS_QN) + ((size_t)((b * AH + h) * SEQ + s)) * AHD + d0);
                    dst[0] = pack8f(o0); dst[1] = pack8f(o1);
                }
                if (lane < 16) { const float dt = softplusf_(dtraw[ti] + dtb);
                    WSP(float, WS_DTV)[t * 16 + lane] = dt; WSP(float, WS_DAV)[t * 16 + lane] = dt * An; } }
        }
    }
#pragma unroll 1
    for (int j8 = 0; j8 < 3; ++j8) {
        const int c0 = 512 * j8 + 8 * lane;
        float cw[4][8], cb[8];
#pragma unroll
        for (int tap = 0; tap < 4; ++tap)
#pragma unroll
            for (int j = 0; j < 8; ++j) cw[tap][j] = F.conv_w[tap * CONVCH + c0 + j];
#pragma unroll
        for (int j = 0; j < 8; ++j) cb[j] = F.conv_b[c0 + j];
        for (int t0 = 4 * gw; t0 < NTOK; t0 += 4 * NGW) {
            const int s0 = t0 & 2047; v4u xr[7];
#pragma unroll
            for (int i = 0; i < 7; ++i) { xr[i] = (v4u){0u, 0u, 0u, 0u}; if (s0 + i - 3 >= 0) xr[i] = *(const v4u*)(proj + (size_t)(t0 + i - 3) * NP + O_XBC + c0); }
#pragma unroll
            for (int ti = 0; ti < 4; ++ti) { float a[8];
#pragma unroll
                for (int j = 0; j < 8; ++j) a[j] = cb[j];
#pragma unroll
                for (int tap = 0; tap < 4; ++tap) { float xv[8]; unpack8(xr[ti + tap], xv);
#pragma unroll
                    for (int j = 0; j < 8; ++j) a[j] += cw[tap][j] * xv[j]; }
#pragma unroll
                for (int j = 0; j < 8; ++j) a[j] = siluf_(a[j]);
                *(v4u*)(WSP(bf16, WS_XCONV) + (size_t)(t0 + ti) * CONVCH + c0) = pack8f(a); }
        }
    }
    if (F.wave == 0 && F.vcu < BATCH * AH) {
        const int bh = F.vcu, b = bh >> 3, h = bh & 7; const float fb = F.fbias[h];
        float lf[32]; float tot = 0.f;
#pragma unroll
        for (int i = 0; i < 32; ++i) { const float xv = bf2f(proj[(size_t)(b * SEQ + 32 * lane + i) * NP + O_F + h]) + fb;
            lf[i] = fminf(xv, 0.f) - log1pf(__expf(-fabsf(xv))); tot += lf[i]; }
        float inc = tot;
#pragma unroll
        for (int o = 1; o < 64; o <<= 1) { const float v = __shfl_up(inc, o); if (lane >= o) inc += v; }
        float run = inc - tot;
        float* dst = WSP(float, WS_ACUM) + (size_t)bh * SEQ + 32 * lane;
#pragma unroll
        for (int i = 0; i < 32; ++i) { run += lf[i]; dst[i] = run * LOG2E; }
    }
}

__device__ __forceinline__ void p3_attn_naive(Frame& F) {
    const int gw = F.vcu * NWAVES + F.wave, NGW = F.G * NWAVES, lane = TLANE();
    LAS float* qs = (LAS float*)(F.lds + RING_OFF + F.wave * 1024);
    const bf16* QN = WSP(bf16, WS_QN); const bf16* KN = WSP(bf16, WS_KN); const bf16* proj = WSP(bf16, WS_PROJ); const float* AC = WSP(float, WS_ACUM);
    for (int idx = gw; idx < BATCH * AH * SEQ; idx += NGW) {
        const int bh = idx >> 11, q = ((idx & 2047) + bh * 1031) & 2047, b = bh >> 3, h = bh & 7;
        { const unsigned w = *(const unsigned*)(QN + ((size_t)bh * SEQ + q) * AHD + 2 * lane); qs[2 * lane] = bflo(w); qs[2 * lane + 1] = bfhi(w); }
        LDS_WAIT();
        const float Aq = AC[(size_t)bh * SEQ + q];
        float m = -1e30f, l = 0.f, o0 = 0.f, o1 = 0.f;
        for (int kt = 0; kt * 64 <= q; ++kt) {
            const int key = kt * 64 + lane;
            const v4u* kp = (const v4u*)(KN + ((size_t)bh * SEQ + key) * AHD);
            float s = 0.f;
#pragma unroll
            for (int c = 0; c < 16; ++c) { float kf[8]; unpack8(kp[c], kf); const f32x4 q0 = ((const LAS f32x4*)qs)[2 * c], q1 = ((const LAS f32x4*)qs)[2 * c + 1];
                s += kf[0] * q0.x + kf[1] * q0.y + kf[2] * q0.z + kf[3] * q0.w + kf[4] * q1.x + kf[5] * q1.y + kf[6] * q1.z + kf[7] * q1.w; }
            s += Aq - AC[(size_t)bh * SEQ + key];
            if (key > q) s = -__builtin_inff();
            const float mt = wave_max(s), mn = fmaxf(m, mt), alpha = __builtin_amdgcn_exp2f(m - mn), p = __builtin_amdgcn_exp2f(s - mn);
            l = l * alpha + wave_sum(p); o0 *= alpha; o1 *= alpha; m = mn;
            const int nk = (q - kt * 64 + 1) < 64 ? (q - kt * 64 + 1) : 64;
            for (int kk = 0; kk < nk; ++kk) { const float pk = __shfl(p, kk);
                const unsigned w = *(const unsigned*)(proj + (size_t)(b * SEQ + kt * 64 + kk) * NP + O_V + h * AHD + 2 * lane);
                o0 += pk * bflo(w); o1 += pk * bfhi(w); }
        }
        const float il = 1.f / l;
        *(unsigned*)(WSP(bf16, WS_MIX) + (size_t)(b * SEQ + q) * DM + h * AHD + 2 * lane) = pk2(o0 * il, o1 * il);
        LDS_WAIT();
    }
}
__device__ __forceinline__ void p3_ssd_naive(Frame& F) {
    const int gw = F.vcu * NWAVES + F.wave, lane = TLANE();
    if (gw >= BATCH * SH) return;
    const int b = gw >> 4, h = gw & 15, g = h >> 3;
    LAS float* LB = (LAS float*)(F.lds + RING_OFF + 8192 + F.wave * 1024); LAS float* LC = LB + 128;
    const bf16* xc = WSP(bf16, WS_XCONV); const bf16* proj = WSP(bf16, WS_PROJ);
    const float dsk = F.d_skip[h];
    float hst[128];
#pragma unroll
    for (int n = 0; n < 128; ++n) hst[n] = 0.f;
    for (int t = 0; t < SEQ; ++t) {
        const int tok = b * SEQ + t;
        const float dt = WSP(float, WS_DTV)[tok * 16 + h], dec = __expf(WSP(float, WS_DAV)[tok * 16 + h]);
        const float xs = bf2f(xc[(size_t)tok * CONVCH + h * SHD + lane]), xdt = xs * dt;
        const unsigned bw = *(const unsigned*)(xc + (size_t)tok * CONVCH + SW + g * SN + 2 * lane), cw = *(const unsigned*)(xc + (size_t)tok * CONVCH + SW + SG * SN + g * SN + 2 * lane);
        LB[2 * lane] = bflo(bw); LB[2 * lane + 1] = bfhi(bw); LC[2 * lane] = bflo(cw); LC[2 * lane + 1] = bfhi(cw);
        LDS_WAIT();
        float y = 0.f;
#pragma unroll
        for (int n4 = 0; n4 < 32; ++n4) { const f32x4 bv = ((const LAS f32x4*)LB)[n4], cv = ((const LAS f32x4*)LC)[n4];
#pragma unroll
            for (int j = 0; j < 4; ++j) { hst[4 * n4 + j] = hst[4 * n4 + j] * dec + xdt * bv[j]; y += cv[j] * hst[4 * n4 + j]; } }
        LDS_WAIT();
        y += xs * dsk;
        const float z = bf2f(proj[(size_t)tok * NP + O_Z + h * SHD + lane]);
        const float yg = y * siluf_(z);
        const float ss = wave_sum(yg * yg);
        if (lane == 0) atomicAdd((float*)(F.ctl + CW_SSQ) + tok, ss);
        WSP(bf16, WS_MIX)[(size_t)tok * DM + AW + h * SHD + lane] = (bf16)f2bf(yg);
    }
}

__device__ __forceinline__ void p4_ssdnorm(Frame& F) {
    const int gw = F.vcu * NWAVES + F.wave, NGW = F.G * NWAVES, lane = TLANE();
    float gv[16];
#pragma unroll
    for (int j = 0; j < 16; ++j) gv[j] = F.ssd_g[16 * lane + j];
    for (int t0 = 4 * gw; t0 < NTOK; t0 += 4 * NGW) {
        float ssq[4]; v4u r0[4], r1[4];
#pragma unroll
        for (int ti = 0; ti < 4; ++ti) { ssq[ti] = __builtin_bit_cast(float, __hip_atomic_load(F.ctl + CW_SSQ + t0 + ti, RLX_AGENT));
            const v4u* p = (const v4u*)(WSP(bf16, WS_MIX) + (size_t)(t0 + ti) * DM + AW + 16 * lane); r0[ti] = p[0]; r1[ti] = p[1]; }
#pragma unroll
        for (int ti = 0; ti < 4; ++ti) { const float rs = 1.f / sqrtf(ssq[ti] * (1.f / 1024.f) + EPS);
            float a[8], c[8]; unpack8(r0[ti], a); unpack8(r1[ti], c);
#pragma unroll
            for (int j = 0; j < 8; ++j) { a[j] *= rs * gv[j]; c[j] *= rs * gv[8 + j]; }
            v4u* p = (v4u*)(WSP(bf16, WS_MIX) + (size_t)(t0 + ti) * DM + AW + 16 * lane); p[0] = pack8f(a); p[1] = pack8f(c); }
    }
}

__device__ __forceinline__ void p6_router(Frame& F) {
    const int tid = TTID(), lane = tid & 63, wave = F.wave, r16 = lane & 15, q4 = lane >> 4;
    LAS float* RED = (LAS float*)(F.lds + RING_OFF);
    LAS float* LOGI = (LAS float*)(F.lds + RING_OFF + 8 * 32 * 33 * 4);
    LAS float* RS = LOGI + 32 * 33;
    const bf16* WRH = WSP(bf16, WS_WR); const bf16* WRL = WRH + NE * 2048;
    gu32* cnt = F.ctl + CW_CNT;
    for (int unit = F.vcu; unit < NTOK / 32; unit += F.G) {
        const int T0 = unit * 32;
#pragma unroll 1
        for (int jp = 0; jp < 2; ++jp) { const int tok = T0 + 4 * wave + 2 * jp;
            const f32x4* xr0 = (const f32x4*)(F.out + (size_t)tok * DM) + lane; const f32x4* xr1 = xr0 + DM / 4; const f32x4* gr = (const f32x4*)F.g2 + lane;
            f32x4 v[2][8]; float s0 = 0.f, s1 = 0.f;
#pragma unroll
            for (int j = 0; j < 8; ++j) { v[0][j] = xr0[64 * j]; v[1][j] = xr1[64 * j]; }
#pragma unroll
            for (int j = 0; j < 8; ++j) { s0 += (v[0][j].x * v[0][j].x + v[0][j].y * v[0][j].y) + (v[0][j].z * v[0][j].z + v[0][j].w * v[0][j].w); s1 += (v[1][j].x * v[1][j].x + v[1][j].y * v[1][j].y) + (v[1][j].z * v[1][j].z + v[1][j].w * v[1][j].w); }
            const float rs[2] = {1.f / sqrtf(wave_sum(s0) * (1.f / 2048.f) + EPS), 1.f / sqrtf(wave_sum(s1) * (1.f / 2048.f) + EPS)};
            if (lane == 0) { RS[4 * wave + 2 * jp] = rs[0]; RS[4 * wave + 2 * jp + 1] = rs[1]; }
#pragma unroll
            for (int q = 0; q < 2; ++q)
#pragma unroll
                for (int j = 0; j < 8; ++j) { const f32x4 gg = gr[64 * j]; const float rstd = rs[q];
                    f32x4 t = {v[q][j].x * rstd * gg.x, v[q][j].y * rstd * gg.y, v[q][j].z * rstd * gg.z, v[q][j].w * rstd * gg.w};
                    if (EMU_FP8) { t.x = q8(t.x); t.y = q8(t.y); t.z = q8(t.z); t.w = q8(t.w); }
#if FP8_MOE
                    ((unsigned*)(WSP(unsigned char, WS_XN) + (size_t)(tok + q) * DM))[lane + 64 * j] = pk4_fp8(t.x, t.y, t.z, t.w); }
#else
                    v2u w; w.x = pk2(t.x, t.y); w.y = pk2(t.z, t.w); ((v2u*)(WSP(bf16, WS_XN) + (size_t)(tok + q) * DM) + lane)[64 * j] = w; }
#endif
        }
        f32x4 acc[2][2];
#pragma unroll
        for (int a = 0; a < 2; ++a)
#pragma unroll
            for (int c = 0; c < 2; ++c) acc[a][c] = (f32x4){0.f, 0.f, 0.f, 0.f};
#pragma unroll 2
        for (int ks = 0; ks < 8; ++ks) { const int k = 256 * wave + 32 * ks + 8 * q4;
            bf16x8 bh[2], bl[2];
#pragma unroll
            for (int n = 0; n < 2; ++n) { bh[n] = *(const bf16x8*)(WRH + (size_t)(16 * n + r16) * 2048 + k); bl[n] = *(const bf16x8*)(WRL + (size_t)(16 * n + r16) * 2048 + k); }
#pragma unroll
            for (int mt = 0; mt < 2; ++mt) { const float* xp = F.out + (size_t)(T0 + 16 * mt + r16) * DM + k;
                const f32x4 x0 = *(const f32x4*)xp, x1 = *(const f32x4*)(xp + 4);
                float xv[8] = {x0.x, x0.y, x0.z, x0.w, x1.x, x1.y, x1.z, x1.w}; float hv[8], lv[8];
#pragma unroll
                for (int j = 0; j < 8; ++j) { hv[j] = bf2f(f2bf(xv[j])); lv[j] = xv[j] - hv[j]; }
                const v4u ahw = pack8f(hv), alw = pack8f(lv);
                const bf16x8 ah = __builtin_bit_cast(bf16x8, ahw), al = __builtin_bit_cast(bf16x8, alw);
#pragma unroll
                for (int n = 0; n < 2; ++n) { acc[mt][n] = __builtin_amdgcn_mfma_f32_16x16x32_bf16(ah, bh[n], acc[mt][n], 0, 0, 0);
                    acc[mt][n] = __builtin_amdgcn_mfma_f32_16x16x32_bf16(ah, bl[n], acc[mt][n], 0, 0, 0);
                    acc[mt][n] = __builtin_amdgcn_mfma_f32_16x16x32_bf16(al, bh[n], acc[mt][n], 0, 0, 0); } } }
#pragma unroll
        for (int mt = 0; mt < 2; ++mt)
#pragma unroll
            for (int n = 0; n < 2; ++n)
#pragma unroll
                for (int rg = 0; rg < 4; ++rg) RED[(wave * 32 + 16 * mt + 4 * q4 + rg) * 33 + 16 * n + r16] = acc[mt][n][rg];
        __syncthreads();
        { const int tok = tid >> 4, e2 = (tid & 15) * 2;
#pragma unroll
          for (int ee = 0; ee < 2; ++ee) { const int e = e2 + ee; float s = 0.f;
#pragma unroll
              for (int w = 0; w < 8; ++w) s += RED[(w * 32 + tok) * 33 + e];
              LOGI[tok * 33 + e] = s * RS[tok] + F.b_router[e]; } }
        __syncthreads();
        if (tid < 32) { const int tok = T0 + tid; int idx[4]; float val[4];
#pragma unroll
            for (int k = 0; k < 4; ++k) { float best = -__builtin_inff(); int bi = 0;
                for (int e = 0; e < NE; ++e) { const float v = LOGI[tid * 33 + e]; bool used = false;
#pragma unroll
                    for (int kk = 0; kk < 4; ++kk) if (kk < k && idx[kk] == e) used = true;
                    if (!used && v > best) { best = v; bi = e; } }
                idx[k] = bi; val[k] = best; }
            float ex[4], sum = 0.f;
#pragma unroll
            for (int k = 0; k < 4; ++k) { ex[k] = __expf(val[k] - val[0]); sum += ex[k]; }
            const float inv = 1.f / sum;
#pragma unroll
            for (int k = 0; k < 4; ++k) { const int e = idx[k]; const unsigned pos = __hip_atomic_fetch_add(cnt + 64 * e, 1u, RLX_AGENT);
                const size_t sl = (size_t)e * SLOTCAP + pos; WSP(int, WS_STOK)[sl] = tok; WSP(float, WS_SGATE)[sl] = ex[k] * inv; WSP(int, WS_SDEST)[sl] = tok * 4 + k; } }
        __syncthreads();
    }
}
__device__ __forceinline__ void moe_tables(Frame& F) {
    LAS int* TB = (LAS int*)(F.lds + TB_OFF); LAS int* CN = TB + 64; LAS int* MT = CN + 32; LAS int* TBF = MT + 32; LAS int* TBH = TBF + 64;
    const int tid = TTID();
    if (tid < NE) { const int c = (int)__hip_atomic_load(F.ctl + CW_CNT + 64 * tid, RLX_AGENT); CN[tid] = c; MT[tid] = (c + 255) >> 8; }
    __syncthreads();
    if (tid == 0) { int run = 0, rf = 0, rh = 0;
        for (int e = 0; e < NE; ++e) { const int mt = MT[e], rem = CN[e] - (mt - 1) * 256, hf = (HALF_UNITS_CFG && mt > 0 && rem <= 128) ? 1 : 0;
            TB[e] = run; TBF[e] = rf; TBH[e] = rh; run += mt; rf += mt - hf; rh += hf; }
        TB[NE] = run; TBF[NE] = rf; TBH[NE] = rh; }
    __syncthreads();
}
__device__ __forceinline__ void p9_combine(Frame& F) {
    const int gw = F.vcu * NWAVES + F.wave, NGW = F.G * NWAVES, lane = TLANE();
#if YSLOT_FP8
    const unsigned char* ys = WSP(unsigned char, WS_YSLOT);
    for (int t = gw; t < NTOK; t += NGW) {
#pragma unroll
        for (int j = 0; j < 2; ++j) { const int col = 16 * lane + 1024 * j; float* op = F.out + (size_t)t * DM + col;
            f32x4 a[4];
#pragma unroll
            for (int q = 0; q < 4; ++q) a[q] = *(const f32x4*)(op + 4 * q);
#pragma unroll
            for (int k = 0; k < 4; ++k) { const v4u y = *(const v4u*)(ys + (size_t)(4 * t + k) * DM + col); const unsigned yw[4] = {y.x, y.y, y.z, y.w};
#pragma unroll
                for (int q = 0; q < 4; ++q) { a[q].x += __builtin_amdgcn_cvt_f32_fp8((int)yw[q], 0); a[q].y += __builtin_amdgcn_cvt_f32_fp8((int)yw[q], 1); a[q].z += __builtin_amdgcn_cvt_f32_fp8((int)yw[q], 2); a[q].w += __builtin_amdgcn_cvt_f32_fp8((int)yw[q], 3); } }
#pragma unroll
            for (int q = 0; q < 4; ++q) *(f32x4*)(op + 4 * q) = a[q]; }
    }
#else
    const bf16* ys = WSP(bf16, WS_YSLOT);
    for (int t = gw; t < NTOK; t += NGW) {
        float* op = F.out + (size_t)t * DM + 8 * lane;
        f32x4 a0[4], a1[4]; v4u y[4][4];
#pragma unroll
        for (int j = 0; j < 4; ++j) { a0[j] = *(const f32x4*)(op + 512 * j); a1[j] = *(const f32x4*)(op + 512 * j + 4);
#pragma unroll
            for (int k = 0; k < 4; ++k) y[j][k] = __builtin_nontemporal_load((const GAS v4u*)(ys + (size_t)(4 * t + k) * DM + 8 * lane + 512 * j)); }
#pragma unroll
        for (int j = 0; j < 4; ++j) {
#pragma unroll
            for (int k = 0; k < 4; ++k) { float yv[8]; unpack8(y[j][k], yv);
                a0[j].x += yv[0]; a0[j].y += yv[1]; a0[j].z += yv[2]; a0[j].w += yv[3]; a1[j].x += yv[4]; a1[j].y += yv[5]; a1[j].z += yv[6]; a1[j].w += yv[7]; }
            __builtin_nontemporal_store(a0[j], (GAS f32x4*)(op + 512 * j)); __builtin_nontemporal_store(a1[j], (GAS f32x4*)(op + 512 * j + 4)); }
    }
#endif
}
namespace attn {
constexpr int D = 128, NW = 8, QBLK = 32, KVBLK = 64, QB = NW * QBLK;
constexpr int SHM_V = KVBLK * D * 2, SHM_K = KVBLK * D * 2;
constexpr int ATT_LDS_BYTES = 2 * SHM_V + 2 * SHM_K + NW * 64 * 4;
constexpr int KPITCH = 128, VPITCH = NP, OPITCH = DM;
constexpr float THR2 = 11.5416f;
typedef short s16x4 __attribute__((ext_vector_type(4)));
typedef float f32x16 __attribute__((ext_vector_type(16)));
typedef unsigned u32x4 __attribute__((ext_vector_type(4)));

#define KSWZ(row, colB) ((row) * 256 + ((colB) ^ (((row) & 7) << 4)))
#define SBAR() __builtin_amdgcn_sched_barrier(0)
__device__ __forceinline__ int v_st(int k, int c) { const int kk = (k & ~0xC) | ((k & 4) << 1) | ((k & 8) >> 1); return ((kk >> 3) * 4 + (c >> 5)) * 512 + ((kk & 7) * 32 + (c & 31)) * 2; }
__device__ __forceinline__ int v_rd_base(int lane) { return ((lane & 3) << 3) | (((lane >> 2) & 3) << 6) | (((lane >> 4) & 1) << 5) | (((lane >> 5) & 1) << 8); }
constexpr int v_rd_off(int d0, int ks, int half) { return d0 * 512 + ks * 4096 + half * 2048; }
__device__ __forceinline__ int crow(int r, int hi) { return (r & 3) + 8 * (r >> 2) + 4 * hi; }
__device__ __forceinline__ unsigned cvtpk(float lo, float hi) { unsigned r; asm volatile("v_cvt_pk_bf16_f32 %0, %1, %2" : "=v"(r) : "v"(lo), "v"(hi)); return r; }
__device__ __forceinline__ void mask_tile(f32x16& p0, f32x16& p1, int dq) {
    const float NEG = -__builtin_inff();
#pragma unroll
    for (int r = 0; r < 16; ++r) {
        const int c = (r & 3) + 8 * (r >> 2);
        if (dq - c < 0) p0[r] = NEG;
        if (dq - c - 32 < 0) p1[r] = NEG;
    }
}
__device__ __forceinline__ void partialSM(f32x16& p0, f32x16& p1, float& m_reg, float& mn, float& alpha) {
    float pmax = p0[0]; for (int r = 1; r < 16; ++r) pmax = fmaxf(pmax, p0[r]); for (int r = 0; r < 16; ++r) pmax = fmaxf(pmax, p1[r]);
    { auto rr = __builtin_amdgcn_permlane32_swap(__float_as_uint(pmax), __float_as_uint(pmax), false, false);
      pmax = fmaxf(__uint_as_float(rr[0]), __uint_as_float(rr[1])); }
    if (__builtin_expect(__all((pmax - m_reg) <= THR2), 1)) { mn = m_reg; alpha = 1.f; }
    else { mn = fmaxf(m_reg, pmax); alpha = __builtin_amdgcn_exp2f(m_reg - mn); m_reg = mn; }
    for (int r = 0; r < 16; ++r) p0[r] = p0[r] - mn; for (int r = 0; r < 16; ++r) p1[r] = p1[r] - mn;
    for (int r = 0; r < 16; ++r) p0[r] = __builtin_amdgcn_exp2f(p0[r]);
}
__device__ __forceinline__ void finishSM(f32x16& p0, f32x16& p1, float alpha, float& l_reg, bf16x8& pa0, bf16x8& pa1, bf16x8& pa2, bf16x8& pa3) {
    for (int r = 0; r < 16; ++r) p1[r] = __builtin_amdgcn_exp2f(p1[r]);
    float ps = 0; for (int r = 0; r < 16; ++r) ps += p0[r]; for (int r = 0; r < 16; ++r) ps += p1[r];
    { auto rr = __builtin_amdgcn_permlane32_swap(__float_as_uint(ps), __float_as_uint(ps), false, false);
      ps = __uint_as_float(rr[0]) + __uint_as_float(rr[1]); }
    l_reg = l_reg * alpha + ps;
#define PK4(P, B_, OUT) do { unsigned a0 = cvtpk(P[B_+0], P[B_+1]), a1 = cvtpk(P[B_+2], P[B_+3]);                          \
        unsigned b0 = cvtpk(P[B_+4], P[B_+5]), b1 = cvtpk(P[B_+6], P[B_+7]);                                             \
        auto r0 = __builtin_amdgcn_permlane32_swap(a0, b0, false, false); auto r1 = __builtin_amdgcn_permlane32_swap(a1, b1, false, false); \
        u32x4 w = {r0[0], r1[0], r0[1], r1[1]}; OUT = *reinterpret_cast<bf16x8*>(&w); } while (0)
    PK4(p0, 0, pa0); PK4(p0, 8, pa1); PK4(p1, 0, pa2); PK4(p1, 8, pa3);
#undef PK4
}
__device__ __forceinline__ unsigned split2(float a) { const unsigned h = cvtpk(a, 0.f) & 0xffffu; const float r1 = a - __uint_as_float(h << 16); return h | (cvtpk(r1, 0.f) << 16); }
__device__ __forceinline__ bf16x8 q_aug(unsigned w) { u32x4 v = {w, 0x3f803f80u, 0u, 0u}; return *reinterpret_cast<bf16x8*>(&v); }
__device__ __forceinline__ bf16x8 k_aug(float nk, int hi) { u32x4 v = {0x3f803f80u, split2(nk), 0u, 0u}; if (hi) v = (u32x4){0u, 0u, 0u, 0u}; return *reinterpret_cast<bf16x8*>(&v); }
template <int KB>
__device__ __forceinline__ void qkt(f32x16& p0, f32x16& p1, const char* K_lds, int r32, int hi, const bf16x8* qr, unsigned qa, float ak0, float ak1, float aref) {
    p0 = f32x16{}; p1 = f32x16{};
    const char* kb[4];
#pragma unroll
    for (int dd = 0; dd < 4; ++dd) kb[dd] = K_lds + KB * SHM_K + KSWZ(r32, (dd * 16 + hi * 8) * 2);
#pragma unroll
    for (int d0 = 0; d0 < 8; ++d0) { const char* a = kb[d0 & 3] + (d0 >> 2) * 128;
        bf16x8 b0 = *reinterpret_cast<const bf16x8*>(a);
        bf16x8 b1 = *reinterpret_cast<const bf16x8*>(a + 32 * 256);
        p0 = __builtin_amdgcn_mfma_f32_32x32x16_bf16(b0, qr[d0], p0, 0, 0, 0);
        p1 = __builtin_amdgcn_mfma_f32_32x32x16_bf16(b1, qr[d0], p1, 0, 0, 0); }
    p0 = __builtin_amdgcn_mfma_f32_32x32x16_bf16(k_aug(aref - ak0, hi), q_aug(qa), p0, 0, 0, 0);
    p1 = __builtin_amdgcn_mfma_f32_32x32x16_bf16(k_aug(aref - ak1, hi), q_aug(qa), p1, 0, 0, 0);
}
template <int VB>
__device__ __forceinline__ void pv_tile(f32x16* o, int vb0, bf16x8 pa0, bf16x8 pa1, bf16x8 pa2, bf16x8 pa3) {
#define TRRD(dst, off) asm volatile("ds_read_b64_tr_b16 %0, %1 offset:%2" : "=&v"(dst) : "v"(vb0), "i"(off) : "memory")
#define PV_D0(d0) do { s16x4 l0, l1, l2, l3, h0, h1, h2, h3; constexpr int b_ = VB * SHM_V + v_rd_off(d0, 0, 0);   \
        TRRD(l0, b_); TRRD(h0, b_ + 2048); TRRD(l1, b_ + 4096); TRRD(h1, b_ + 6144); TRRD(l2, b_ + 8192); TRRD(h2, b_ + 10240); TRRD(l3, b_ + 12288); TRRD(h3, b_ + 14336); \
        asm volatile("s_waitcnt lgkmcnt(0)" ::: "memory"); SBAR();                                                                    \
        o[d0] = __builtin_amdgcn_mfma_f32_32x32x16_bf16(pa0, (bf16x8){l0[0], l0[1], l0[2], l0[3], h0[0], h0[1], h0[2], h0[3]}, o[d0], 0, 0, 0);   \
        o[d0] = __builtin_amdgcn_mfma_f32_32x32x16_bf16(pa1, (bf16x8){l1[0], l1[1], l1[2], l1[3], h1[0], h1[1], h1[2], h1[3]}, o[d0], 0, 0, 0);   \
        o[d0] = __builtin_amdgcn_mfma_f32_32x32x16_bf16(pa2, (bf16x8){l2[0], l2[1], l2[2], l2[3], h2[0], h2[1], h2[2], h2[3]}, o[d0], 0, 0, 0);   \
        o[d0] = __builtin_amdgcn_mfma_f32_32x32x16_bf16(pa3, (bf16x8){l3[0], l3[1], l3[2], l3[3], h3[0], h3[1], h3[2], h3[3]}, o[d0], 0, 0, 0); } while (0)
    PV_D0(0); PV_D0(1); PV_D0(2); PV_D0(3);
#undef PV_D0
#undef TRRD
}
struct BlockRef { const bf16* Q; const bf16* K; const bf16* V; bf16* O; const float* A; int P0; };
struct Seam { bf16x8 qr[8]; unsigned qa; bf16x8 st_v0, st_v1, st_k0, st_k1; float ak[2][2]; };
#define VMW() asm volatile("s_waitcnt vmcnt(0)" ::: "memory")
#define VMWN(n) asm volatile("s_waitcnt vmcnt(%0)" :: "i"(n) : "memory")
#define LD8(p) (*reinterpret_cast<const bf16x8*>(p))
#define SLOAD_H(Kp, Vp, Ap, k0, AB) do { S.st_v0 = LD8((Vp) + (size_t)((k0) + sr) * VPITCH + sc); S.st_v1 = LD8((Vp) + (size_t)((k0) + 32 + sr) * VPITCH + sc);   \
                         S.st_k0 = LD8((Kp) + (size_t)((k0) + sr) * KPITCH + sc); S.st_k1 = LD8((Kp) + (size_t)((k0) + 32 + sr) * KPITCH + sc);                      \
                         S.ak[AB][0] = (Ap)[(k0) + r32]; S.ak[AB][1] = (Ap)[(k0) + 32 + r32]; } while (0)
#define SWRITE_HK(bf) do { *(bf16x8*)(K_lds + (bf) * SHM_K + kws) = S.st_k0; *(bf16x8*)(K_lds + (bf) * SHM_K + kws + 32 * 256) = S.st_k1; } while (0)
#define SWRITE_HV(bf) do { *(bf16x8*)(V_lds + (bf) * SHM_V + vst0) = S.st_v0; *(bf16x8*)(V_lds + (bf) * SHM_V + vst1) = S.st_v1; } while (0)
#define SWRITE_H(bf) do { SWRITE_HV(bf); SWRITE_HK(bf); } while (0)
#define QLOAD(R) do { _Pragma("unroll") for (int d0 = 0; d0 < 8; ++d0) S.qr[d0] = LD8((R).Q + (size_t)(wid * QBLK + r32) * KPITCH + d0 * 16 + hi * 8);   \
                      S.qa = split2((R).A[(R).P0 + wid * QBLK + r32] - (R).A[(R).P0]); } while (0)
__device__ __forceinline__ void block_prime(const BlockRef& cur, char* lds, Seam& S) {
    int tid = threadIdx.x; asm volatile("" : "+v"(tid));
    const int wid = __builtin_amdgcn_readfirstlane(tid >> 6), lane = tid & 63, r32 = lane & 31, hi = lane >> 5;
    const int sr = tid >> 4, sc = (tid & 15) * 8, kws = KSWZ(sr, sc * 2); char* K_lds = lds + 2 * SHM_V;
    QLOAD(cur);
    SLOAD_H(cur.K, cur.V, cur.A, 0, 0); VMW(); SWRITE_HK(0);
    __syncthreads();
}
__device__ __forceinline__ void block_run(const BlockRef& cur, char* lds, Seam& S) {
    int tid = threadIdx.x; asm volatile("" : "+v"(tid));
    const int wid = __builtin_amdgcn_readfirstlane(tid >> 6), lane = tid & 63, r32 = lane & 31, hi = lane >> 5;
    const int NT = (cur.P0 + QB - 1) / KVBLK + 1;
    const int qlo = cur.P0 + wid * QBLK, qm = qlo + r32 - 4 * hi;
    char* V_lds = lds; char* K_lds = lds + 2 * SHM_V;
    float* ws = (float*)(lds + 2 * SHM_V + 2 * SHM_K) + wid * 64; float* li_l = ws, * al_l = ws + 32;
    float m_reg = -1e30f, l_reg = 0; f32x16 o[4] = {};
    const int sr = tid >> 4, sc = (tid & 15) * 8, vst0 = v_st(sr, sc), vst1 = v_st(32 + sr, sc), kws = KSWZ(sr, sc * 2);
    const int vb0 = (int)(uintptr_t)V_lds + v_rd_base(lane);
    const bf16* Kh = cur.K; const bf16* Vh = cur.V; const float* Ah = cur.A; const float aref = cur.A[cur.P0];
#define RESC(a) do { if (__any((a) < 1.f)) { if (hi == 0) al_l[r32] = (a); asm volatile("s_waitcnt lgkmcnt(0)" ::: "memory");              \
                     for (int d_ = 0; d_ < 4; ++d_) for (int r = 0; r < 16; ++r) o[d_][r] *= al_l[crow(r, hi)]; } } while (0)
#define KBASE(t) ((t) * KVBLK)
#define MASKT(P0_, P1_, t) do { const int kb_ = KBASE(t); if (kb_ + KVBLK - 1 > qlo) mask_tile(P0_, P1_, qm - kb_); } while (0)
    f32x16 pA0, pA1, pB0, pB1; float mnA, mnB, alA, alB; bf16x8 pa0, pa1, pa2, pa3;
    SWRITE_HV(0); SBAR();
    const float a00 = S.ak[0][0], a01 = S.ak[0][1];
    if (NT > 1) SLOAD_H(Kh, Vh, Ah, KBASE(1), 1);
    SBAR(); qkt<0>(pA0, pA1, K_lds, r32, hi, S.qr, S.qa, a00, a01, aref);
    MASKT(pA0, pA1, 0); partialSM(pA0, pA1, m_reg, mnA, alA);
    if (NT > 1) { VMW(); SWRITE_H(1); }
    __syncthreads();
#define HALF_STEP(PX0, PX1, mnX, alX, PY0, PY1, alY, t, KB, VB, SB) do {                                                      \
        SBAR(); qkt<KB>(PX0, PX1, K_lds, r32, hi, S.qr, S.qa, S.ak[KB][0], S.ak[KB][1], aref);                                             \
        finishSM(PY0, PY1, alY, l_reg, pa0, pa1, pa2, pa3); SBAR();                                                           \
        if ((t) + 1 < NT) { SLOAD_H(Kh, Vh, Ah, KBASE((t) + 1), SB); SBAR(); }                                                \
        pv_tile<VB>(o, vb0, pa0, pa1, pa2, pa3); MASKT(PX0, PX1, (t)); partialSM(PX0, PX1, m_reg, mnX, alX);                  \
        __syncthreads();                                                                                                      \
        if ((t) + 1 < NT) { VMW(); SWRITE_H(SB); }                                                                            \
        RESC(alX); __syncthreads(); } while (0)
    for (int t = 1; t + 1 < NT; t += 2) {
        HALF_STEP(pB0, pB1, mnB, alB, pA0, pA1, alA, t, 1, 0, 0);
        HALF_STEP(pA0, pA1, mnA, alA, pB0, pB1, alB, t + 1, 0, 1, 1);
    }
    const bool even = (NT & 1) == 0;
    if (even) { SBAR(); qkt<1>(pB0, pB1, K_lds, r32, hi, S.qr, S.qa, S.ak[1][0], S.ak[1][1], aref); SBAR(); }
    finishSM(pA0, pA1, alA, l_reg, pa0, pa1, pa2, pa3); SBAR();
    pv_tile<0>(o, vb0, pa0, pa1, pa2, pa3);
    if (even) { MASKT(pB0, pB1, NT - 1); partialSM(pB0, pB1, m_reg, mnB, alB); __syncthreads(); RESC(alB);
        finishSM(pB0, pB1, alB, l_reg, pa0, pa1, pa2, pa3); SBAR(); pv_tile<1>(o, vb0, pa0, pa1, pa2, pa3); }
    if (hi == 0) li_l[r32] = l_reg; asm volatile("s_waitcnt lgkmcnt(0)" ::: "memory");
    float rli[16];
#pragma unroll
    for (int r = 0; r < 16; ++r) rli[r] = __builtin_amdgcn_rcpf(li_l[crow(r, hi)]);
    bf16* Ow = cur.O + (size_t)(wid * QBLK) * OPITCH;
#pragma unroll
    for (int r = 0; r < 16; ++r) { const int orow = crow(r, hi);
#pragma unroll
        for (int d0 = 0; d0 < 4; ++d0) { const float v = o[d0][r] * rli[r];
            const float vn = __shfl_xor(v, 1);
            if ((r32 & 1) == 0) *(unsigned*)(Ow + (size_t)orow * OPITCH + d0 * 32 + r32) = cvtpk(v, vn); } }
    __syncthreads();
#undef RESC
#undef KBASE
#undef MASKT
#undef HALF_STEP
}
#undef VMW
#undef VMWN
#undef LD8
#undef SLOAD_H
#undef SWRITE_HK
#undef SWRITE_HV
#undef SWRITE_H
#undef QLOAD
#undef KSWZ
#undef SBAR
}

__device__ __forceinline__ attn::BlockRef attn_ref(Frame& F, int a) {
    const int x = a >> 5, j = a & 31, bh = 4 * x + (j & 3), qb = j >> 2, b = bh >> 3, h = bh & 7;
    attn::BlockRef r;
    r.Q = WSP(bf16, WS_QN) + ((size_t)bh * SEQ + qb * 256) * AHD; r.K = WSP(bf16, WS_KN) + (size_t)bh * SEQ * AHD;
    r.V = WSP(bf16, WS_PROJ) + (size_t)(b * SEQ) * NP + O_V + h * AHD; r.O = WSP(bf16, WS_MIX) + (size_t)(b * SEQ + qb * 256) * DM + h * AHD;
    r.A = WSP(float, WS_ACUM) + (size_t)bh * SEQ; r.P0 = qb * 256; return r;
}
__device__ __forceinline__ void p3_attn(Frame& F) {
    char* lds = (char*)(F.lds + RING_OFF);
    for (int a = F.vcu; a < BATCH * AH * (SEQ / 256); a += F.G) {
        const attn::BlockRef cur = attn_ref(F, a);
        attn::Seam S;
        attn::block_prime(cur, lds, S);
        attn::block_run(cur, lds, S);
    }
}
namespace ssd {
constexpr int CP = 136, TP = 72, YP = 68;
constexpr int L_CM = 0, L_BM = L_CM + 64 * CP * 2, L_BT = L_BM + 64 * CP * 2, L_XT = L_BT + 128 * TP * 2, L_XD = L_XT + 64 * TP * 2, L_H = L_XD + 64 * TP * 2,
              L_Y = L_H + 64 * CP * 2, L_ACS = L_Y + 64 * YP * 4, L_SS = L_ACS + 256, L_END = L_SS + 8 * 64 * 4;
static_assert(L_END <= RING_BYTES, "ssd lds");
typedef LAS unsigned char* lptr;
__device__ __forceinline__ bf16x8 ld16(lptr p) { return *(const LAS bf16x8*)p; }
__device__ __forceinline__ void unit(Frame& F, int un, float* ssq_all) {
    const int b = un >> 4, h = un & 15, g = h >> 3;
    const int tid = TTID();
    const int lane = tid & 63, w = F.wave, r16 = lane & 15, q4 = lane >> 4, Lt = w >> 1;
    lptr L = F.lds + RING_OFF;
    const bf16* xc = WSP(bf16, WS_XCONV) + (size_t)(b * SEQ) * CONVCH;
    const bf16* pz = WSP(bf16, WS_PROJ) + (size_t)(b * SEQ) * NP + O_Z + h * SHD;
    const float* dtp = WSP(float, WS_DTV) + (size_t)(b * SEQ) * 16 + h; const float* dap = WSP(float, WS_DAV) + (size_t)(b * SEQ) * 16 + h;
    bf16* mixp = WSP(bf16, WS_MIX) + (size_t)(b * SEQ) * DM + AW + h * SHD;
    float* ssq = ssq_all + b * SEQ;
    const float dsk = F.d_skip[h];
    f32x4 Hacc[4];
#pragma unroll
    for (int i = 0; i < 4; ++i) Hacc[i] = (f32x4){0.f, 0.f, 0.f, 0.f};
    v4u cmr[2], bmr[2], xsr, zr, xsn, zn; float dtr, dar, dtn, dan;
#define SSD_LOAD(c, XS, ZR, DT, DA) do { const size_t row_ = (size_t)((c) * 64 + lane); \
        _Pragma("unroll") for (int i_ = 0; i_ < 2; ++i_) { cmr[i_] = *(const v4u*)(xc + row_ * CONVCH + SW + SG * SN + g * SN + 8 * (w + 8 * i_)); bmr[i_] = *(const v4u*)(xc + row_ * CONVCH + SW + g * SN + 8 * (w + 8 * i_)); } \
        XS = *(const v4u*)(xc + row_ * CONVCH + h * SHD + 8 * w); ZR = *(const v4u*)(pz + row_ * NP + 8 * w); DT = dtp[row_ * 16]; DA = dap[row_ * 16]; } while (0)
    SSD_LOAD(0, xsr, zr, dtr, dar);
    for (int c = 0; c < SEQ / 64; ++c) {
        __syncthreads();
        if (c > 0 && w == 0) { float s = 0.f;
#pragma unroll
            for (int i = 0; i < 8; ++i) s += *(const LAS float*)(L + L_SS + (i * 64 + lane) * 4);
            atomicAdd(ssq + (c - 1) * 64 + lane, s); }
        float acs = dar;
#pragma unroll
        for (int o = 1; o < 64; o <<= 1) { const float v = __shfl_up(acs, o); if (lane >= o) acs += v; }
        const float alast = __shfl(acs, 63);
#pragma unroll
        for (int i = 0; i < 2; ++i) { const int c8 = 8 * (w + 8 * i);
            *(LAS v4u*)(L + L_CM + (lane * CP + c8) * 2) = cmr[i]; *(LAS v4u*)(L + L_BM + (lane * CP + c8) * 2) = bmr[i];
            const unsigned ww[4] = {bmr[i].x, bmr[i].y, bmr[i].z, bmr[i].w};
#pragma unroll
            for (int j = 0; j < 4; ++j) { *(LAS bf16*)(L + L_BT + ((c8 + 2 * j) * TP + lane) * 2) = (bf16)(ww[j] & 0xffffu); *(LAS bf16*)(L + L_BT + ((c8 + 2 * j + 1) * TP + lane) * 2) = (bf16)(ww[j] >> 16); } }
        { float xv[8]; unpack8(xsr, xv); const float dl = __expf(alast - acs);
#pragma unroll
          for (int j = 0; j < 8; ++j) { const float X = xv[j] * dtr; *(LAS bf16*)(L + L_XT + ((8 * w + j) * TP + lane) * 2) = (bf16)f2bf(X); *(LAS bf16*)(L + L_XD + ((8 * w + j) * TP + lane) * 2) = (bf16)f2bf(X * dl); } }
        if (w == 0) *(LAS float*)(L + L_ACS + lane * 4) = acs;
        if (c + 1 < SEQ / 64) SSD_LOAD(c + 1, xsn, zn, dtn, dan);
        __syncthreads();
        bf16x8 cf[4];
#pragma unroll
        for (int ks = 0; ks < 4; ++ks) cf[ks] = ld16(L + L_CM + ((16 * Lt + r16) * CP + 32 * ks + 8 * q4) * 2);
        const float acs_l = *(const LAS float*)(L + L_ACS + (16 * Lt + r16) * 4);
        float Wv[4][4];
#pragma unroll
        for (int T = 0; T < 4; ++T) {
            f32x4 st = (f32x4){0.f, 0.f, 0.f, 0.f};
            if (T <= Lt) {
#pragma unroll
                for (int ks = 0; ks < 4; ++ks) st = __builtin_amdgcn_mfma_f32_16x16x32_bf16(ld16(L + L_BM + ((16 * T + r16) * CP + 32 * ks + 8 * q4) * 2), cf[ks], st, 0, 0, 0);
            }
            const f32x4 as4 = *(const LAS f32x4*)(L + L_ACS + (16 * T + 4 * q4) * 4);
#pragma unroll
            for (int r = 0; r < 4; ++r) { const int s = 16 * T + 4 * q4 + r, l = 16 * Lt + r16; Wv[T][r] = (T <= Lt && s <= l) ? st[r] * __expf(acs_l - as4[r]) : 0.f; }
        }
        bf16x8 Wf[2];
#pragma unroll
        for (int kp = 0; kp < 2; ++kp) { v4u t; t.x = pk2(Wv[2 * kp][0], Wv[2 * kp][1]); t.y = pk2(Wv[2 * kp][2], Wv[2 * kp][3]); t.z = pk2(Wv[2 * kp + 1][0], Wv[2 * kp + 1][1]); t.w = pk2(Wv[2 * kp + 1][2], Wv[2 * kp + 1][3]);
            Wf[kp] = __builtin_bit_cast(bf16x8, t); }
        const f32x4 al4 = *(const LAS f32x4*)(L + L_ACS + (16 * Lt + 4 * q4) * 4);
#pragma unroll
        for (int pp = 0; pp < 2; ++pp) { const int Pt = 2 * (w & 1) + pp;
            f32x4 yd = (f32x4){0.f, 0.f, 0.f, 0.f}, yo = (f32x4){0.f, 0.f, 0.f, 0.f};
#pragma unroll
            for (int kp = 0; kp < 2; ++kp) if (2 * kp <= Lt) {
                const v2u x0 = *(const LAS v2u*)(L + L_XT + ((16 * Pt + r16) * TP + 32 * kp + 4 * q4) * 2), x1 = *(const LAS v2u*)(L + L_XT + ((16 * Pt + r16) * TP + 32 * kp + 16 + 4 * q4) * 2);
                const v4u xb = {x0.x, x0.y, x1.x, x1.y};
                yd = __builtin_amdgcn_mfma_f32_16x16x32_bf16(Wf[kp], __builtin_bit_cast(bf16x8, xb), yd, 0, 0, 0); }
            if (c > 0) {
#pragma unroll
                for (int ks = 0; ks < 4; ++ks) yo = __builtin_amdgcn_mfma_f32_16x16x32_bf16(cf[ks], ld16(L + L_H + ((16 * Pt + r16) * CP + 32 * ks + 8 * q4) * 2), yo, 0, 0, 0); }
#pragma unroll
            for (int r = 0; r < 4; ++r) *(LAS float*)(L + L_Y + ((16 * Lt + 4 * q4 + r) * YP + 16 * Pt + r16) * 4) = yd[r] + __expf(al4[r]) * yo[r];
        }
        { const float dl = __expf(alast);
#pragma unroll
          for (int pt = 0; pt < 4; ++pt) Hacc[pt] = Hacc[pt] * dl;
#pragma unroll
          for (int ks = 0; ks < 2; ++ks) { const bf16x8 af = ld16(L + L_BT + ((16 * w + r16) * TP + 32 * ks + 8 * q4) * 2);
#pragma unroll
              for (int pt = 0; pt < 4; ++pt) Hacc[pt] = __builtin_amdgcn_mfma_f32_16x16x32_bf16(af, ld16(L + L_XD + ((16 * pt + r16) * TP + 32 * ks + 8 * q4) * 2), Hacc[pt], 0, 0, 0); } }
        __syncthreads();
#pragma unroll
        for (int pt = 0; pt < 4; ++pt) { v2u t; t.x = pk2(Hacc[pt][0], Hacc[pt][1]); t.y = pk2(Hacc[pt][2], Hacc[pt][3]); *(LAS v2u*)(L + L_H + ((16 * pt + r16) * CP + 16 * w + 4 * q4) * 2) = t; }
        { const f32x4 y0 = *(const LAS f32x4*)(L + L_Y + (lane * YP + 8 * w) * 4), y1 = *(const LAS f32x4*)(L + L_Y + (lane * YP + 8 * w + 4) * 4);
          float xv[8], zv[8], o[8]; unpack8(xsr, xv); unpack8(zr, zv); const float yv[8] = {y0.x, y0.y, y0.z, y0.w, y1.x, y1.y, y1.z, y1.w}; float ss = 0.f;
#pragma unroll
          for (int j = 0; j < 8; ++j) { o[j] = (yv[j] + xv[j] * dsk) * siluf_(zv[j]); ss += o[j] * o[j]; }
          *(v4u*)(mixp + (size_t)(c * 64 + lane) * DM + 8 * w) = pack8f(o);
          *(LAS float*)(L + L_SS + (w * 64 + lane) * 4) = ss; }
        xsr = xsn; zr = zn; dtr = dtn; dar = dan;
    }
    __syncthreads();
    if (w == 0) { float s = 0.f;
#pragma unroll
        for (int i = 0; i < 8; ++i) s += *(const LAS float*)(L + L_SS + (i * 64 + lane) * 4);
        atomicAdd(ssq + (SEQ / 64 - 1) * 64 + lane, s); }
    __syncthreads();
#undef SSD_LOAD
}
}
__device__ __forceinline__ void p3_ssd(Frame& F, float* ssq_all) {
    for (int a = F.vcu; a < 256; a += F.G) { const int j = a & 31; if (j < 8) ssd::unit(F, (a >> 5) * 8 + j, ssq_all); }
}
constexpr int NPH = 10;
struct Args { const float* in[22]; float* out; unsigned char* ws; int ph_lo, ph_hi; };
__global__ void __launch_bounds__(NTHR, 2) mk_fwd(Args args) {
    extern __shared__ __attribute__((aligned(16))) unsigned char lds[];
    Frame F;
    F.lds = (LAS unsigned char*)lds;
    F.MISC = (volatile LAS unsigned*)(F.lds + MISC_OFF);
    F.wave = __builtin_amdgcn_readfirstlane(threadIdx.x >> 6);
    F.G = gridDim.x; { const int bx = blockIdx.x; F.vcu = (F.G % 8 == 0) ? (bx % 8) * (F.G / 8) + bx / 8 : bx; }
    F.ws = args.ws; F.ctl = (gu32*)(args.ws + WS_CTL); F.out = args.out;
    F.x = args.in[0]; F.g1 = args.in[1]; F.w_in = args.in[2]; F.fbias = args.in[3]; F.gq = args.in[4]; F.gk = args.in[5]; F.conv_w = args.in[6]; F.conv_b = args.in[7];
    F.dt_bias = args.in[8]; F.a_log = args.in[9]; F.d_skip = args.in[10]; F.ssd_g = args.in[11]; F.w_out = args.in[12]; F.g2 = args.in[13]; F.w_router = args.in[14]; F.b_router = args.in[15];
    F.w_gate = args.in[16]; F.b_gate = args.in[17]; F.w_up = args.in[18]; F.b_up = args.in[19]; F.w_down = args.in[20]; F.b_down = args.in[21];
    for (int u = threadIdx.x; u < (LDS_BYTES - LDSCTL_OFF) / 4; u += NTHR) ((LAS unsigned*)(F.lds + LDSCTL_OFF))[u] = 0u;
    __syncthreads();
    const int lo = args.ph_lo, hi = args.ph_hi;
    XcdBarrier bar; bar.bar = (unsigned*)(F.ctl + CW_BAR); bar.x = 0; bar.st = nullptr;
    if (hi - lo > 1) bar = xcd_barrier_post((unsigned*)(F.ctl + CW_BAR), F.MISC);
#define IN(k) (lo <= (k) && (k) < hi)
#ifndef PROBE_REPEAT
#define PROBE_REPEAT 0
#endif
#define REP(k) for (int rep_ = 0; rep_ < (((PROBE_REPEAT >> (k)) & 1) ? 2 : 1); ++rep_)
#define SEAM(k) do { if (IN(k) && IN((k) + 1)) xcd_barrier(bar); } while (0)

    const bool roles = BG_POOL && F.G == 256;
    const int xc = F.vcu >> 5, jr = F.vcu & 31;
    constexpr int NC1 = NC1_CFG, NC5 = NC5_CFG, NC7 = NC7_CFG;
    const bool conv1 = roles && jr >= 32 - NC1, conv5 = roles && jr >= 32 - NC5, conv7 = roles && jr >= 32 - NC7;
    const int G5 = roles ? 8 * (32 - NC5) : F.G, c5s = roles ? jr * 8 + xc : (int)blockIdx.x;
    const int G1 = roles ? 8 * (32 - NC1) : F.G, c1s = roles ? jr * 8 + xc : (int)blockIdx.x;
    const int G7 = roles ? 8 * (32 - NC7) : F.G, c7m = roles ? xc * (32 - NC7) + jr : F.vcu;
#define BG_FILL(k, lim) do { if (BG_POOL && IN((k) + 1)) bg_fill(F, (k), (lim)); } while (0)

    if (IN(0)) REP(0) { p0_prologue(F); SEAM(0); }

    if (IN(1)) REP(1) {
        if (!conv1) {
        OrderStatic S; S.init(NTOK, NP, G1, c1s, WSP(bf16, WS_XN), WSP(bf16, WS_WIN));
        EpiProj E{WSP(bf16, WS_PROJ), NP};
        pg8::gemm_phase<EpiProj, OrderStatic, false, true>(F.lds + RING_OFF, S, E);
        }
        BG_FILL(1, POOL_ALL);
        SEAM(1);
    }
    if (IN(2)) REP(2) { p2_post(F); SEAM(2); }
    if (IN(3)) {
#if NAIVE_ATTN
        p3_attn_naive(F);
#else
        p3_attn(F);
#endif
        __syncthreads();
#if NAIVE_SSD
        p3_ssd_naive(F);
#else
        p3_ssd(F, (float*)(F.ctl + CW_SSQ));
#endif
        BG_FILL(3, POOL_ALL);
        SEAM(3);
    }
    if (IN(4)) { p4_ssdnorm(F); SEAM(4); }
    if (IN(5)) REP(5) {
        if (!conv5) {
        OrderStatic S; S.init(NTOK, DM, G5, c5s, WSP(bf16, WS_MIX), WSP(bf16, WS_WOUT));
        EpiRes E{F.x, F.out};
        pg8::gemm_phase<EpiRes, OrderStatic, false, false>(F.lds + RING_OFF, S, E);
        }
        BG_FILL(5, POOL_ALL);
        SEAM(5);
    }
    if (IN(6)) { p6_router(F); if (BG_POOL) (void)bg_finish(F, POOL_GU); SEAM(6); }
    constexpr int MOE_RB = FP8_MOE ? 2048 : 4096;
    if (IN(7)) REP(7) {
        if (!conv7) {
        moe_tables(F);
        const LAS int* TB = (const LAS int*)(F.lds + TB_OFF);
        typedef OrderMoe<16, true, MOE_RB> Ord;
        Ord S; S.init(G7, c7m, TB, TB + 64, TLANE(), WSP(char, WS_XN), WSP(char, WS_WGU), (size_t)4096 * MOE_RB, WSP(int, WS_STOK), F.ctl + CW_MOEQ, (volatile LAS int*)(F.lds + BGW_OFF) + 4, DYN_MOE && G7 == 256);
        EpiGlu E{WSP(void, WS_ACT), F.b_gate, F.b_up};
        pg8::gemm_phase<EpiGlu, Ord, true, true, FP8_MOE != 0>(F.lds + RING_OFF, S, E);
        }
        BG_FILL(7, POOL_ALL);
        if (BG_POOL) (void)bg_finish(F, POOL_ALL);
        SEAM(7);
    }
    if (IN(8)) REP(8) {
        moe_tables(F);
        const LAS int* TB = (const LAS int*)(F.lds + TB_OFF);
        typedef OrderMoe<8, false, MOE_RB> Ord;
        Ord S; S.init(F.G, F.vcu, TB, TB + 64, TLANE(), WSP(char, WS_ACT), WSP(char, WS_WD), (size_t)2048 * MOE_RB, WSP(int, WS_STOK), F.ctl + CW_MOEQ + 64 * 8, (volatile LAS int*)(F.lds + BGW_OFF) + 4, DYN_MOE && F.G == 256);
        EpiDown E{WSP(bf16, WS_YSLOT), F.b_down, WSP(float, WS_SGATE), WSP(int, WS_SDEST)};
        pg8::gemm_phase<EpiDown, Ord, false, true, FP8_MOE != 0>(F.lds + RING_OFF, S, E);
        SEAM(8);
    }
    if (IN(9)) { p9_combine(F); }
#undef IN
#undef SEAM
}

extern "C" void kernel_launch(void* const* d_in, const int* in_sizes, int n_in, void* d_out, int out_size, void* d_ws, size_t ws_size, hipStream_t stream) {
    static int grid = 0;
    if (grid == 0) {
        if (n_in != 22 || in_sizes[0] != NTOK * DM || out_size != NTOK * DM || ws_size < WS_END) { fprintf(stderr, "kernel_launch: unexpected shapes (n_in %d, in0 %d, out %d, ws %zu)\n", n_in, n_in > 0 ? in_sizes[0] : -1, out_size, ws_size); grid = -1; return; }
        int dev = 0, cus = 0, per_cu = 0;
        if (hipGetDevice(&dev) != hipSuccess || hipDeviceGetAttribute(&cus, hipDeviceAttributeMultiprocessorCount, dev) != hipSuccess) { grid = -1; return; }
        if (hipFuncSetAttribute((const void*)mk_fwd, hipFuncAttributeMaxDynamicSharedMemorySize, LDS_BYTES) != hipSuccess) { fprintf(stderr, "kernel_launch: hipFuncSetAttribute failed\n"); grid = -1; return; }
        if (hipOccupancyMaxActiveBlocksPerMultiprocessor(&per_cu, (const void*)mk_fwd, NTHR, LDS_BYTES) != hipSuccess || per_cu < 1) { fprintf(stderr, "kernel_launch: occupancy query says %d blocks per CU\n", per_cu); }
        (void)hipGetLastError();
        grid = cus;
    }
    if (grid < 0) return;
    (void)hipMemsetAsync((char*)d_ws + WS_CTL, 0, CTL_ZERO_BYTES, stream);
    Args a{};
    for (int i = 0; i < 22; ++i) a.in[i] = (const float*)d_in[i];
    a.out = (float*)d_out; a.ws = (unsigned char*)d_ws;
#if MK_N_LAUNCHES == 1
    a.ph_lo = 0; a.ph_hi = NPH;
    hipLaunchKernelGGL(mk_fwd, dim3(grid), dim3(NTHR), LDS_BYTES, stream, a);
#else
    for (int p = 0; p < NPH; ++p) { a.ph_lo = p; a.ph_hi = p + 1; hipLaunchKernelGGL(mk_fwd, dim3(grid), dim3(NTHR), LDS_BYTES, stream, a); }
#endif
}
```

```cpp
#include <hip/hip_runtime.h>
#define MK_N_LAUNCHES 1
#define NAIVE_ATTN 0
#define NAIVE_SSD 0
#define FP8_MOE 1
#define NC1_CFG 18
#define NC5_CFG 0
#define NC7_CFG 0
#define SSD_WPX 8
#define YSLOT_FP8 1
#include <cstdio>
#include <cstdint>

#ifndef MK_N_LAUNCHES
#define MK_N_LAUNCHES 1
#endif
#ifndef NAIVE_ATTN
#define NAIVE_ATTN 1
#endif
#ifndef NAIVE_SSD
#define NAIVE_SSD 1
#endif

#define GAS __attribute__((address_space(1)))
#define LAS __attribute__((address_space(3)))
typedef unsigned short bf16;
typedef unsigned v4u __attribute__((ext_vector_type(4)));
typedef unsigned v2u __attribute__((ext_vector_type(2)));
typedef float f32x4 __attribute__((ext_vector_type(4)));
typedef float f32x2 __attribute__((ext_vector_type(2)));
typedef short bf16x8 __attribute__((ext_vector_type(8)));
typedef GAS unsigned gu32;
#define RLX_AGENT __ATOMIC_RELAXED, __HIP_MEMORY_SCOPE_AGENT
#define LDS_WAIT() asm volatile("s_waitcnt lgkmcnt(0)" ::: "memory")
#define VM_WAIT() asm volatile("s_waitcnt vmcnt(0)" ::: "memory")

constexpr int BATCH = 4, SEQ = 2048, DM = 2048, NTOK = BATCH * SEQ;
constexpr int AH = 8, AHD = 128, AW = AH * AHD;
constexpr int SW = 1024, SHD = 64, SH = 16, SG = 2, SN = 128, CONVCH = SW + 2 * SG * SN;
constexpr int NE = 32, TOPK = 4, DFF = 2048;
constexpr int INCOLS = 5656, NP = 5888;
constexpr int O_Q = 0, O_K = 1024, O_V = 2048, O_F = 3072, O_Z = 3080, O_XBC = 4104, O_DT = 5640;
constexpr float EPS = 1e-6f, SW_ALPHA = 1.702f, SW_LIMIT = 7.0f;
constexpr float LOG2E = 1.4426950408889634f;
constexpr float QSCALE = 0.08838834764831845f * LOG2E;
constexpr int SLOTCAP = NTOK;
constexpr int MAXMT = (NTOK * TOPK) / 256 + NE;

constexpr size_t MiB = 1u << 20;
constexpr size_t WS_CTL = 0, CTL_ZERO_BYTES = 1 * MiB;
constexpr size_t WS_WIN = 1 * MiB;
constexpr size_t WS_WOUT = 24 * MiB;
constexpr size_t WS_WR = 32 * MiB;
constexpr size_t WS_ACUM = 33 * MiB;
constexpr size_t WS_DTV = 34 * MiB, WS_DAV = 35 * MiB;
constexpr size_t WS_STOK = 36 * MiB, WS_SGATE = 37 * MiB, WS_SDEST = 38 * MiB;
constexpr size_t WS_XN = 40 * MiB;
constexpr size_t WS_PROJ = 72 * MiB;
constexpr size_t WS_H = WS_PROJ;
constexpr size_t WS_QN = 164 * MiB, WS_KN = 180 * MiB;
constexpr size_t WS_XCONV = 196 * MiB;
constexpr size_t WS_MIX = 220 * MiB;
constexpr size_t WS_ACT = 252 * MiB;
constexpr size_t WS_YSLOT = 412 * MiB;
constexpr size_t WS_WGU = 540 * MiB;
constexpr size_t WS_WD = 1052 * MiB;
constexpr size_t WS_END = 1308 * MiB;
constexpr int CW_BAR = 4096;
constexpr int CW_HEAD = 8192;
constexpr int CW_DONE = 8192 + 64;
constexpr int CW_PROBE = 12288;
constexpr int CW_MOEQ = 10240;
constexpr int CW_CNT = 16384;
constexpr int CW_SSQ = 32768;
static_assert((CW_SSQ + NTOK) * 4 <= (int)CTL_ZERO_BYTES, "ctl");

constexpr int RING_OFF = 0, RING_BYTES = 131072;
constexpr int LDSCTL_OFF = RING_BYTES;
constexpr int MISC_OFF = LDSCTL_OFF;
constexpr int BGW_OFF = LDSCTL_OFF + 64;
constexpr int TB_OFF = LDSCTL_OFF + 256;
constexpr int DMA_T_OFF = LDSCTL_OFF + 1024;
constexpr int LDS_BYTES = 163840 - 8192;
constexpr int NWAVES = 8, NTHR = 512;

__device__ __forceinline__ unsigned f2bf(float f) { unsigned u = __builtin_bit_cast(unsigned, f); return (u + 0x7fffu + ((u >> 16) & 1u)) >> 16; }
__device__ __forceinline__ unsigned pk2(float lo, float hi) { unsigned r; asm volatile("v_cvt_pk_bf16_f32 %0, %1, %2" : "=v"(r) : "v"(lo), "v"(hi)); return r; }
__device__ __forceinline__ float bf2f(unsigned h) { return __builtin_bit_cast(float, h << 16); }
__device__ __forceinline__ float bflo(unsigned w) { return __builtin_bit_cast(float, w << 16); }
__device__ __forceinline__ float bfhi(unsigned w) { return __builtin_bit_cast(float, w & 0xffff0000u); }
__device__ __forceinline__ float wave_sum(float v) {
#pragma unroll
    for (int o = 1; o < 64; o <<= 1) v += __shfl_xor(v, o);
    return v;
}
__device__ __forceinline__ float wave_max(float v) {
#pragma unroll
    for (int o = 1; o < 64; o <<= 1) v = fmaxf(v, __shfl_xor(v, o));
    return v;
}
#ifndef NC1_CFG
#define NC1_CFG 9
#endif
#ifndef NC5_CFG
#define NC5_CFG 16
#endif
#ifndef NC7_CFG
#define NC7_CFG 3
#endif
#ifndef SSD_WPX
#define SSD_WPX 4
#endif
#ifndef PROBE_P3
#define PROBE_P3 0
#endif
#ifndef CONV_IN_P0
#define CONV_IN_P0 0
#endif
#ifndef PROBE_T
#define PROBE_T 0
#endif
#ifndef PROBE_KA
#define PROBE_KA 0
#endif
#ifndef PROBE_KB
#define PROBE_KB 1
#endif
#ifndef PROBE_GA
#define PROBE_GA 0.001f
#endif
#ifndef HALF_LAST
#define HALF_LAST 0
#endif
#ifndef CONV_NTS
#define CONV_NTS 1
#endif
#ifndef CONV_NT
#define CONV_NT 1
#endif
#ifndef DYN_MOE
#define DYN_MOE 0
#endif
#ifndef HALF_UNITS_CFG
#define HALF_UNITS_CFG 1
#endif
#ifndef YSLOT_FP8
#define YSLOT_FP8 0
#endif
#ifndef CONV_DMA
#define CONV_DMA 0
#endif
#ifndef BGB_CFG
#define BGB_CFG 4
#endif
#ifndef CONV_WG
#define CONV_WG 1
#endif
#ifndef CONV_PIPE
#define CONV_PIPE 0
#endif
#ifndef BG_POOL
#define BG_POOL 1
#endif
#ifndef FP8_MOE
#define FP8_MOE 1
#endif
#ifndef H_BF16
#define H_BF16 1
#endif
#ifndef PEEK_CFG
#define PEEK_CFG 1
#endif
#ifndef NSPLIT_CFG
#define NSPLIT_CFG 1
#endif
#ifndef ALIGN_EPI_CFG
#define ALIGN_EPI_CFG 7
#endif
#ifndef P9_NTS
#define P9_NTS 0
#endif
#ifndef SPLIT_P3
#define SPLIT_P3 0
#endif
#ifndef FUSE_P4
#define FUSE_P4 1
#endif
#ifndef PROBE_EPI2
#define PROBE_EPI2 0
#endif
#ifndef LOOSE_EPI_WAIT
#define LOOSE_EPI_WAIT 0
#endif
#ifndef FIN2_CFG
#define FIN2_CFG 0
#endif
#ifndef PROBE_KLD
#define PROBE_KLD 0
#endif
#ifndef EMU_IN8
#define EMU_IN8 0
#endif
#ifndef EMU_OUT8
#define EMU_OUT8 0
#endif
#ifndef EMU_FP8
#define EMU_FP8 0
#endif
__device__ __forceinline__ unsigned pk4_fp8(float a, float b, float c, float d) { int p = __builtin_amdgcn_cvt_pk_fp8_f32(a, b, 0, false); p = __builtin_amdgcn_cvt_pk_fp8_f32(c, d, p, true); return (unsigned)p; }
typedef short v2s_ __attribute__((ext_vector_type(2)));
#ifndef CVT_SCALE
#define CVT_SCALE 0.015625f
#endif
__device__ __forceinline__ unsigned pk4_fp8_x64(float a, float b, float c, float d) { v2s_ o = {0, 0}; o = __builtin_amdgcn_cvt_scalef32_pk_fp8_f32(o, a, b, CVT_SCALE, false); o = __builtin_amdgcn_cvt_scalef32_pk_fp8_f32(o, c, d, CVT_SCALE, true); return __builtin_bit_cast(unsigned, o); }
__device__ __forceinline__ float q8(float x) { return __builtin_amdgcn_cvt_f32_fp8(__builtin_amdgcn_cvt_pk_fp8_f32(x, x, 0, false), 0); }
__device__ __forceinline__ float sigmoidf_(float x) { return 1.f / (1.f + __expf(-x)); }
template <int CTRL> __device__ __forceinline__ float dpp_f(float v) { return __builtin_bit_cast(float, __builtin_amdgcn_update_dpp(0, __builtin_bit_cast(int, v), CTRL, 0xf, 0xf, true)); }
template <int CTRL> __device__ __forceinline__ int dpp_i(int v) { return __builtin_amdgcn_update_dpp(0, v, CTRL, 0xf, 0xf, true); }
__device__ __forceinline__ float siluf_(float x) { return x * __builtin_amdgcn_rcpf(1.f + __expf(-x)); }
__device__ __forceinline__ float softplusf_(float x) { return fmaxf(x, 0.f) + log1pf(__expf(-fabsf(x))); }

#define XB_TMO      128
#define XB_XCNT(j)  (256  + 64 * (j))
#define XB_XSUB(j)  (1280 + 64 * (j))
#define XB_XGEN(j)  (2304 + 64 * (j))
#define XB_TOP      3328
#define XB_TOPGEN   3392
#define XCD_BAR_WORDS 3456
#define XB_SPIN_CAP (1u << 18)

__device__ __forceinline__ unsigned xb_ld(unsigned* p)              { return __hip_atomic_load(p, __ATOMIC_RELAXED, __HIP_MEMORY_SCOPE_AGENT); }
__device__ __forceinline__ unsigned xb_add(unsigned* p, unsigned v) { return __hip_atomic_fetch_add(p, v, __ATOMIC_RELAXED, __HIP_MEMORY_SCOPE_AGENT); }
__device__ __forceinline__ unsigned xb_xcc_id() { return (unsigned)__builtin_amdgcn_s_getreg((3 << 11) | 20) & 0xFu; }
#define XB_SPIN(cond, bar) do { unsigned _sp = 0; while (cond) { __builtin_amdgcn_s_sleep(1); \
    if ((++_sp & 255u) == 0u) { if (xb_ld(&(bar)[XB_TMO])) break; if (_sp > XB_SPIN_CAP) { atomicAdd(&(bar)[XB_TMO], 1u); break; } } } } while (0)

struct XcdBarrier {
    unsigned* bar; unsigned x;
    volatile LAS unsigned* st;
};
__device__ __forceinline__ XcdBarrier xcd_barrier_post(unsigned* bar, volatile LAS unsigned* st) {
    XcdBarrier b; b.bar = bar; b.x = xb_xcc_id(); b.st = st;
    if (threadIdx.x == 0) (void)xb_add(&bar[XB_XCNT(b.x)], 1u);
    return b;
}
__device__ __forceinline__ void xcd_barrier_complete(unsigned* bar, unsigned x, unsigned& nloc, unsigned& nx) {
    const unsigned G = gridDim.x * gridDim.y * gridDim.z;
    unsigned sum, cnt, mine, sp = 0u;
    for (;;) {
        sum = 0u; cnt = 0u; mine = 0u;
#pragma unroll
        for (unsigned j = 0; j < 16; ++j) { const unsigned c = xb_ld(&bar[XB_XCNT(j)]); sum += c; cnt += (c > 0u) ? 1u : 0u; mine = (j == x) ? c : mine; }
        if (sum == G) break;
        __builtin_amdgcn_s_sleep(1);
        if ((++sp & 255u) == 0u) { if (xb_ld(&bar[XB_TMO])) break; if (sp > XB_SPIN_CAP) { atomicAdd(&bar[XB_TMO], 1u); break; } }
    }
    nloc = mine > 0u ? mine : 1u; nx = cnt > 0u ? cnt : 1u;
}
__device__ __forceinline__ void xcd_barrier(const XcdBarrier& b) {
    asm volatile("s_waitcnt vmcnt(0)" ::: "memory");
    __syncthreads();
    if (threadIdx.x == 0) {
        unsigned* bar = b.bar;
        __builtin_amdgcn_s_waitcnt(0);
        unsigned nloc = b.st[0], nx = b.st[1];
        if (nloc == 0u) { xcd_barrier_complete(bar, b.x, nloc, nx); b.st[0] = nloc; b.st[1] = nx; }
        const unsigned old = xb_add(&bar[XB_XSUB(b.x)], 1u);
        const unsigned gen = old / nloc;
        if (old + 1u == (gen + 1u) * nloc) {
            __builtin_amdgcn_fence(__ATOMIC_RELEASE, "agent");
            asm volatile("s_waitcnt vmcnt(0)" ::: "memory");
            const unsigned og = xb_add(&bar[XB_TOP], 1u);
            const unsigned tg = og / nx;
            if (og + 1u == (tg + 1u) * nx) xb_add(&bar[XB_TOPGEN], 1u);
            else XB_SPIN(xb_ld(&bar[XB_TOPGEN]) == tg, bar);
            __builtin_amdgcn_fence(__ATOMIC_ACQUIRE, "agent");
            xb_add(&bar[XB_XGEN(b.x)], 1u);
            asm volatile("s_waitcnt vmcnt(0)" ::: "memory");
        } else {
            XB_SPIN(xb_ld(&bar[XB_XGEN(b.x)]) == gen, bar);
            __builtin_amdgcn_fence(__ATOMIC_ACQUIRE, "agent");
            asm volatile("s_waitcnt vmcnt(0)" ::: "memory");
        }
    }
    __syncthreads();
}
#ifndef B_NT_CFG
#define B_NT_CFG 0
#endif
#ifndef FP8_DIAG
#define FP8_DIAG 0
#endif
#ifndef FP8_NOSCALE
#define FP8_NOSCALE 0
#endif
namespace pg8 {
#define PG8_LAS __attribute__((address_space(3)))
typedef unsigned short bf16_t;
typedef short bf16x8 __attribute__((ext_vector_type(8)));
typedef float f32x4 __attribute__((ext_vector_type(4)));
typedef unsigned u32x4 __attribute__((ext_vector_type(4)));
constexpr int BM = 256, BK = 64, HALF = 128, HTB = HALF * BK * 2  , STAGE_BYTES = 8 * HTB, NXCD = 8, WGM = 8;
constexpr int GK = 2048;
typedef int i32x8 __attribute__((ext_vector_type(8)));
typedef int i32x4_ __attribute__((ext_vector_type(4)));

__host__ __device__ __forceinline__ int lds_byte(int r, int c) { const int st = (r >> 4) * 2 + (c >> 5), rr = r & 15, cc = c & 31, ob = rr * 64 + cc * 2; return st * 1024 + (ob ^ (((ob >> 9) & 1) << 5)); }
__host__ __device__ __forceinline__ void stage_rc(int b, int& R, int& C) { const int st = b / 1024, sb = b % 1024, swz = sb ^ (((sb >> 9) & 1) << 5); R = (st >> 1) * 16 + swz / 64; C = (st & 1) * 32 + (swz % 64) / 2; }
__host__ __device__ __forceinline__ int perm32(int rho) { const int n = rho >> 4, i = rho & 15; return 8 * (i >> 2) + 4 * n + (i & 3); }

struct Unit { int pm, pn, e, mt, nrows, nh, rh, roff; };

__device__ __forceinline__ unsigned cvt_pk_bf16(float lo, float hi) { unsigned r; asm volatile("v_cvt_pk_bf16_f32 %0, %1, %2" : "=v"(r) : "v"(lo), "v"(hi)); return r; }

template <class Epi, class Sched, bool GATHER, bool ALIGN_EPI, bool FP8 = false>
__device__ __forceinline__ void gemm_phase(PG8_LAS unsigned char* lds, const Sched& S, const Epi& E) {
    const int tid = threadIdx.x, wid = __builtin_amdgcn_readfirstlane(tid >> 6), lane = tid & 63, wr = wid >> 2, wc = wid & 3, fr = lane & 15, fq = lane >> 4;
    constexpr int K = FP8 ? GK / 2 : GK, nt = K / BK;
    unsigned vB[2]; int Ri[2], Ci[2];
#pragma unroll
    for (int i = 0; i < 2; ++i) { int R, C; stage_rc(tid * 16 + i * 8192, R, C); const int Rb = Epi::PERM ? ((R & ~31) + perm32(R & 31)) : R;
        vB[i] = Sched::B_BLOCKED ? (unsigned)(Rb * BK + C) * 2u : (unsigned)(Rb * K + C) * 2u; Ri[i] = R; Ci[i] = C; }
    constexpr unsigned kstep = (unsigned)(BK * 2);
    constexpr unsigned hstepB = Sched::B_BLOCKED ? (unsigned)HALF * BK * 2 : (unsigned)HALF * K * 2;
    const unsigned kstepB = Sched::B_BLOCKED ? S.b_kstep() : kstep;
    const char* const rA = (const char*)S.a_base(); const char* const rB = (const char*)S.b_base();
    const unsigned ldsw = (unsigned)wid * 1024u;
    const int aoff = lds_byte(wr * 64 + fr, fq * 8), boff = lds_byte(wc * 32 + fr, fq * 8);
#define PG8_SA(b, h) (((b) * 2 + (h)) * HTB)
#define PG8_SB(b, h) ((4 + (b) * 2 + (h)) * HTB)
#define PG8_STAGE(bufoff, gbase, soff, voff) do { _Pragma("unroll") for (int _i = 0; _i < 2; ++_i) { \
        if (FP8 && B_NT_CFG && (bufoff) >= 4 * HTB) __builtin_amdgcn_global_load_lds((const unsigned*)((gbase) + (size_t)(soff) + (voff)[_i]), (PG8_LAS unsigned*)(lds + (bufoff) + ldsw + _i * 8192), 16, 0, 2); \
        else __builtin_amdgcn_global_load_lds((const unsigned*)((gbase) + (size_t)(soff) + (voff)[_i]), (PG8_LAS unsigned*)(lds + (bufoff) + ldsw + _i * 8192), 16, 0, 0); } } while (0)
#define PG8_LDA(dst, b, h) do { _Pragma("unroll") for (int m = 0; m < 4; ++m) { dst[m].lo = *(const PG8_LAS i32x4_*)(lds + PG8_SA(b, h) + aoff + m * 2048); dst[m].hi = *(const PG8_LAS i32x4_*)(lds + PG8_SA(b, h) + aoff + m * 2048 + 1024); } } while (0)
#define PG8_LDB(dst, b, h) do { _Pragma("unroll") for (int n = 0; n < 2; ++n) { dst[n].lo = *(const PG8_LAS i32x4_*)(lds + PG8_SB(b, h) + boff + n * 2048); dst[n].hi = *(const PG8_LAS i32x4_*)(lds + PG8_SB(b, h) + boff + n * 2048 + 1024); } } while (0)
#define PG8_MMA(ai, bj, At, Bt) do { __builtin_amdgcn_s_setprio(1); _Pragma("unroll") for (int m = 0; m < 4; ++m) _Pragma("unroll") for (int n = 0; n < 2; ++n) { \
        if constexpr (FP8) { if (FP8_DIAG) { _Pragma("unroll") for (int q_ = 0; q_ < 4; ++q_) { \
                const long b_ = (long)(unsigned)Bt[n][2 * q_] | ((long)Bt[n][2 * q_ + 1] << 32), a_ = (long)(unsigned)At[m][2 * q_] | ((long)At[m][2 * q_ + 1] << 32); \
                acc[ai][bj][m][n] = __builtin_amdgcn_mfma_f32_16x16x32_fp8_fp8(b_, a_, acc[ai][bj][m][n], 0, 0, 0); } } \
            else if (FP8_NOSCALE) asm volatile("v_mfma_f32_16x16x128_f8f6f4 %0, %1, %2, %0" : "+v"(acc[ai][bj][m][n]) : "v"(Bt[n]), "v"(At[m])); \
            else asm volatile("v_mfma_scale_f32_16x16x128_f8f6f4 %0, %1, %2, %0, %3, %3 op_sel_hi:[0,0,0]" : "+v"(acc[ai][bj][m][n]) : "v"(Bt[n]), "v"(At[m]), "v"(sc8)); } \
        else { const i32x4_ bl_ = __builtin_shufflevector(Bt[n], Bt[n], 0, 1, 2, 3), bh_ = __builtin_shufflevector(Bt[n], Bt[n], 4, 5, 6, 7), al_ = __builtin_shufflevector(At[m], At[m], 0, 1, 2, 3), ah_ = __builtin_shufflevector(At[m], At[m], 4, 5, 6, 7); \
               acc[ai][bj][m][n] = __builtin_amdgcn_mfma_f32_16x16x32_bf16(__builtin_bit_cast(bf16x8, bl_), __builtin_bit_cast(bf16x8, al_), acc[ai][bj][m][n], 0, 0, 0); \
               acc[ai][bj][m][n] = __builtin_amdgcn_mfma_f32_16x16x32_bf16(__builtin_bit_cast(bf16x8, bh_), __builtin_bit_cast(bf16x8, ah_), acc[ai][bj][m][n], 0, 0, 0); } } \
        __builtin_amdgcn_s_setprio(0); } while (0)
#define PG8_WAIT_V(n) asm volatile("s_waitcnt vmcnt(" #n ")" ::: "memory")
#define PG8_WAIT_L(n) asm volatile("s_waitcnt lgkmcnt(" #n ")" ::: "memory")
#define PG8_BAR __builtin_amdgcn_s_barrier()
#define PG8_SCHED __builtin_amdgcn_sched_barrier(0)
#define PG8_VOFF(v, u) do { _Pragma("unroll") for (int h_ = 0; h_ < 2; ++h_) _Pragma("unroll") for (int i_ = 0; i_ < 2; ++i_) { \
        const int r_ = h_ * HALF + Ri[i_]; const int src_ = GATHER ? S.a_row(u, r_) : r_; v[h_][i_] = (unsigned)(src_ * K + Ci[i_]) * 2u; } } while (0)
#define PG8_WAIT_SEL(loose, NL) asm volatile("s_cmp_lg_u32 %0, 0\n\ts_cbranch_scc0 .Lw8_%=\n\ts_waitcnt vmcnt(%1)\n\ts_branch .Lwe_%=\n.Lw8_%=:\n\ts_waitcnt vmcnt(8)\n.Lwe_%=:" :: "s"(loose), "n"(NL) : "memory", "scc")
#define PG8_ITER(W1, W2, W3, W4) do { \
            if (nh != 2) PG8_LDB(B0, 0, 0); if (nh != 1) PG8_LDB(B1, 0, 1); PG8_SCHED; PG8_LDA(At, 0, 0); PG8_STAGE(PG8_SA(1, 1), rA, a1, vAc[1]); \
            W1; PG8_WAIT_L(0); PG8_BAR; if (nh != 2) PG8_MMA(0, 0, At, B0); if (nh != 1) PG8_MMA(0, 1, At, B1); PG8_BAR; PG8_SCHED; \
            if (!halfu) PG8_LDA(At, 0, 1); PG8_STAGE(PG8_SB(0, 0), rB, b2, vB); PG8_STAGE(PG8_SB(0, 1), rB, b2 + hstepB, vB); PG8_STAGE(PG8_SA(0, 0), rA, a2, v2[0]); \
            W2; PG8_WAIT_L(0); PG8_BAR; if (!halfu) { if (nh != 2) PG8_MMA(1, 0, At, B0); if (nh != 1) PG8_MMA(1, 1, At, B1); } PG8_BAR; PG8_SCHED; \
            if (nh != 2) PG8_LDB(B0, 1, 0); if (nh != 1) PG8_LDB(B1, 1, 1); PG8_SCHED; PG8_LDA(At, 1, 0); PG8_STAGE(PG8_SA(0, 1), rA, a2, v2[1]); \
            W3; PG8_WAIT_L(0); PG8_BAR; if (nh != 2) PG8_MMA(0, 0, At, B0); if (nh != 1) PG8_MMA(0, 1, At, B1); PG8_BAR; PG8_SCHED; \
            if (!halfu) PG8_LDA(At, 1, 1); PG8_STAGE(PG8_SB(1, 0), rB, b3, vB); PG8_STAGE(PG8_SB(1, 1), rB, b3 + hstepB, vB); PG8_STAGE(PG8_SA(1, 0), rA, a3, v2[0]); \
            W4; PG8_WAIT_L(0); PG8_BAR; if (!halfu) { if (nh != 2) PG8_MMA(1, 0, At, B0); if (nh != 1) PG8_MMA(1, 1, At, B1); } PG8_BAR; PG8_SCHED; } while (0)
    Unit cur, nxt; int ui = 0;
    if (!S.next(0, cur)) return;
    f32x4 acc[2][2][4][2];
#pragma unroll
    for (int a = 0; a < 2; ++a)
#pragma unroll
        for (int b = 0; b < 2; ++b)
#pragma unroll
            for (int m = 0; m < 4; ++m)
#pragma unroll
                for (int n = 0; n < 2; ++n) acc[a][b][m][n] = (f32x4){0.f, 0.f, 0.f, 0.f};
    const int sc8 = 0x7c7c7c7c;
    i32x8 At[4], B0[2], B1[2];
    unsigned vAc[2][2], vAn[2][2];
    PG8_VOFF(vAc, cur);
    constexpr int KROT = Epi::MIDSCALE ? nt / 2 : 0;
    float mraw = 0.f;
#define PG8_KA(t_) ((unsigned)(((t_) + KROT) & (nt - 1)) * kstep)
#define PG8_KB(t_) ((unsigned)(((t_) + KROT) & (nt - 1)) * kstepB)
    unsigned cA = S.a_off(cur), cB = S.b_off(cur);
    PG8_STAGE(PG8_SB(0, 0), rB, cB + PG8_KB(0), vB); PG8_STAGE(PG8_SB(0, 1), rB, cB + PG8_KB(0) + hstepB, vB); PG8_STAGE(PG8_SA(0, 0), rA, cA + PG8_KA(0), vAc[0]); PG8_STAGE(PG8_SA(0, 1), rA, cA + PG8_KA(0), vAc[1]);
    if (wr == 1) PG8_BAR;
    PG8_WAIT_V(2); PG8_BAR;
    PG8_STAGE(PG8_SB(1, 0), rB, cB + PG8_KB(1), vB); PG8_STAGE(PG8_SA(1, 0), rA, cA + PG8_KA(1), vAc[0]); PG8_STAGE(PG8_SB(1, 1), rB, cB + hstepB + PG8_KB(1), vB);
    PG8_WAIT_V(6); PG8_BAR;
    for (;;) {
        const bool has_next = S.next(ui + 1, nxt);
        unsigned nA = cA, nB = cB;
        if (has_next) { nA = S.a_off(nxt); nB = S.b_off(nxt); PG8_VOFF(vAn, nxt); }
        else {
#pragma unroll
            for (int h = 0; h < 2; ++h)
#pragma unroll
                for (int i = 0; i < 2; ++i) vAn[h][i] = vAc[h][i]; }
        if constexpr (Epi::MIDSCALE) mraw = E.mid_load(cur);
        const int nh = Sched::NSPLIT ? __builtin_amdgcn_readfirstlane(cur.nh) : 0;
        const bool halfu = Sched::HALF_UNITS && cur.nrows <= HALF;
        for (int t = 0; t < nt; t += 2) {
            const bool last = (t == nt - 2);
            const unsigned a1 = cA + PG8_KA(t + 1);
            const unsigned a2 = last ? nA + PG8_KA(0) : cA + PG8_KA(t + 2), b2 = last ? nB + PG8_KB(0) : cB + PG8_KB(t + 2);
            const unsigned a3 = a2 + kstep, b3 = b2 + kstepB;
            if constexpr (Epi::MIDSCALE) { if (t == nt / 2 - 2) { if (tid < 256) ((PG8_LAS float*)(lds + (LDSCTL_OFF - RING_OFF) + 4096))[tid] = E.mid_factor(mraw); } }
            if constexpr (Epi::MIDSCALE) { if (t == nt / 2) {
#pragma unroll
                for (int a = 0; a < 2; ++a)
#pragma unroll
                    for (int m = 0; m < 4; ++m) { const float f_ = ((const PG8_LAS float*)(lds + (LDSCTL_OFF - RING_OFF) + 4096))[a * 128 + wr * 64 + m * 16 + fr];
#pragma unroll
                        for (int b = 0; b < 2; ++b)
#pragma unroll
                            for (int n = 0; n < 2; ++n) acc[a][b][m][n] = acc[a][b][m][n] * f_; } } }
            unsigned v2[2][2];
#pragma unroll
            for (int h = 0; h < 2; ++h)
#pragma unroll
                for (int i = 0; i < 2; ++i) v2[h][i] = last ? vAn[h][i] : vAc[h][i];
            const int loose = __builtin_amdgcn_readfirstlane((LOOSE_EPI_WAIT && t == 0 && ui > 0) ? 1 : 0);
            PG8_ITER(PG8_WAIT_SEL(loose, 8 + Epi::NVM), PG8_WAIT_SEL(loose, 8 + Epi::NVM), PG8_WAIT_SEL(loose, 8 + Epi::NVM), PG8_WAIT_V(8));
        }
        if constexpr (FP8) asm volatile("s_nop 15\n\ts_nop 15" ::: "memory");
        if constexpr (ALIGN_EPI) { if (wr == 0) PG8_BAR; }
        E(acc, cur, wr, wc, fr, fq);
        if (PROBE_EPI2) { asm volatile("" ::: "memory"); E(acc, cur, wr, wc, fr, fq); }
        if (!has_next) break;
#pragma unroll
        for (int a = 0; a < 2; ++a)
#pragma unroll
            for (int b = 0; b < 2; ++b)
#pragma unroll
                for (int m = 0; m < 4; ++m)
#pragma unroll
                    for (int n = 0; n < 2; ++n) acc[a][b][m][n] = (f32x4){0.f, 0.f, 0.f, 0.f};
        cur = nxt; cA = nA; cB = nB; ++ui;
#pragma unroll
        for (int h = 0; h < 2; ++h)
#pragma unroll
            for (int i = 0; i < 2; ++i) vAc[h][i] = vAn[h][i];
        if constexpr (ALIGN_EPI) { if (wr == 1) PG8_BAR; }
    }
    PG8_WAIT_V(0);
    if constexpr (!ALIGN_EPI) { if (wr == 0) PG8_BAR; }
    PG8_BAR;
#undef PG8_KA
#undef PG8_KB
#undef PG8_ITER
#undef PG8_WAIT_SEL
#undef PG8_SA
#undef PG8_SB
#undef PG8_STAGE
#undef PG8_LDA
#undef PG8_LDB
#undef PG8_MMA
#undef PG8_WAIT_V
#undef PG8_WAIT_L
#undef PG8_BAR
#undef PG8_SCHED
#undef PG8_VOFF
}
}
struct Frame {
    LAS unsigned char* lds;
    volatile LAS unsigned* MISC;
    gu32* ctl;
    int wave, vcu, G;
    const float *x, *g1, *w_in, *fbias, *gq, *gk, *conv_w, *conv_b, *dt_bias, *a_log, *d_skip, *ssd_g, *w_out, *g2, *w_router, *b_router, *w_gate, *b_gate, *w_up, *b_up, *w_down, *b_down;
    float* out; unsigned char* ws;
};
#define WSP(T, off) ((T*)(F.ws + (off)))
__device__ __forceinline__ int TTID() { int t = threadIdx.x; asm volatile("" : "+v"(t)); return t; }
__device__ __forceinline__ int TLANE() { return TTID() & 63; }

template <bool Q8>
__device__ __forceinline__ void conv_item(const float* W, int ldn, int nvalid, int k0, int n0, bf16* dst, LAS unsigned* T, int lane, const float* rowgain = nullptr) {
    const int kq = lane >> 4, nq = lane & 15, col = n0 + 4 * nq;
    const bool ok = col < nvalid;
    f32x4 a[8], b[8];
#pragma unroll
    for (int i = 0; i < 8; ++i) { const float* p = W + (size_t)(k0 + 8 * i + 2 * kq) * ldn + col;
        a[i] = ok ? *(const f32x4*)p : (f32x4){0.f, 0.f, 0.f, 0.f}; b[i] = ok ? *(const f32x4*)(p + ldn) : (f32x4){0.f, 0.f, 0.f, 0.f}; }
    if (rowgain) {
#pragma unroll
        for (int i = 0; i < 8; ++i) { const float ga = rowgain[8 * i + 2 * kq], gb = rowgain[8 * i + 2 * kq + 1]; a[i] = a[i] * ga; b[i] = b[i] * gb; } }
#pragma unroll
    for (int i = 0; i < 8; ++i)
#pragma unroll
        for (int j = 0; j < 4; ++j) T[(4 * nq + j) * 33 + 4 * i + kq] = (Q8 && (EMU_FP8 || EMU_IN8 || EMU_OUT8)) ? pk2(q8(a[i][j] * 64.f) * (1.f / 64.f), q8(b[i][j] * 64.f) * (1.f / 64.f)) : pk2(a[i][j], b[i][j]);
    LDS_WAIT();
    const int c = lane & 7;
#pragma unroll
    for (int r = 0; r < 8; ++r) { const int n = 8 * r + (lane >> 3); const LAS unsigned* s = T + n * 33 + 4 * c;
        v4u o; o.x = s[0]; o.y = s[1]; o.z = s[2]; o.w = s[3];
        *(v4u*)(dst + (size_t)n * 2048 + k0 + 8 * c) = o; }
    LDS_WAIT();
}
__device__ __forceinline__ void conv_item8(const float* W, int k0, int n0, unsigned char* dst, LAS unsigned* T, int lane) {
    const int kq = lane >> 4, nq = lane & 15, col = n0 + 4 * nq;
    f32x4 a[8][4];
#pragma unroll
    for (int i = 0; i < 8; ++i)
#pragma unroll
        for (int r = 0; r < 4; ++r) a[i][r] = __builtin_nontemporal_load((const GAS f32x4*)(W + (size_t)(k0 + 16 * i + 4 * kq + r) * 2048 + col));
#pragma unroll
    for (int i = 0; i < 8; ++i)
#pragma unroll
        for (int j = 0; j < 4; ++j) T[(4 * nq + j) * 33 + 4 * i + kq] = pk4_fp8_x64(a[i][0][j], a[i][1][j], a[i][2][j], a[i][3][j]);
    LDS_WAIT();
    const int c = lane & 7;
#pragma unroll
    for (int r = 0; r < 8; ++r) { const int n = 8 * r + (lane >> 3); const LAS unsigned* s = T + n * 33 + 4 * c;
        v4u o; o.x = s[0]; o.y = s[1]; o.z = s[2]; o.w = s[3];
        *(GAS v4u*)(dst + (size_t)n * 128 + 16 * c) = o; }
    LDS_WAIT();
}
struct Conv8Regs { f32x4 a[4][4]; };
__device__ __forceinline__ void conv8_load(Conv8Regs& R, const float* W, int k0, int n0, int lane) {
    const int kq = lane >> 4, nq = lane & 15, col = n0 + 4 * nq;
#pragma unroll
    for (int i = 0; i < 4; ++i)
#pragma unroll
        for (int r = 0; r < 4; ++r) R.a[i][r] = __builtin_nontemporal_load((const GAS f32x4*)(W + (size_t)(k0 + 16 * i + 4 * kq + r) * 2048 + col));
}
__device__ __forceinline__ void conv8_pack(const Conv8Regs& R, int k0, unsigned char* dst, LAS unsigned* T, int lane) {
    const int kq = lane >> 4, nq = lane & 15;
#pragma unroll
    for (int i = 0; i < 4; ++i)
#pragma unroll
        for (int j = 0; j < 4; ++j) T[(4 * nq + j) * 17 + 4 * i + kq] = pk4_fp8_x64(R.a[i][0][j], R.a[i][1][j], R.a[i][2][j], R.a[i][3][j]);
    LDS_WAIT();
    const int c = lane & 3;
#pragma unroll
    for (int r = 0; r < 4; ++r) { const int n = 16 * r + (lane >> 2); const LAS unsigned* s = T + n * 17 + 4 * c;
        v4u o; o.x = s[0]; o.y = s[1]; o.z = s[2]; o.w = s[3];
        *(GAS v4u*)(dst + (size_t)n * 2048 + k0 + 16 * c) = o; }
    LDS_WAIT();
}
constexpr int MKB = (FP8_MOE && !CONV_PIPE) ? 16 : 32;
constexpr int IT_IN = 32 * (NP / 64), IT_OUT = 32 * 32, IT_EXP = MKB * 32, IT_MOE = 3 * NE * IT_EXP, IT_TOTAL = IT_IN + IT_OUT + IT_MOE;
constexpr int IT_GU = 2 * NE * IT_EXP;
struct MoeItem { const float* src; unsigned char* dst; int k0, n0; };
__device__ __forceinline__ MoeItem moe_item(Frame& F, int r) {
    const int m = r / (NE * IT_EXP); r -= m * (NE * IT_EXP);
    const int e = r / IT_EXP; r -= e * IT_EXP; const int kb = r >> 5, nb = r & 31;
    const size_t eo = (size_t)e * 2048 * 2048; const int es = FP8_MOE ? 1 : 2;
    MoeItem it; it.k0 = kb * ((FP8_MOE && !CONV_PIPE) ? 128 : 64); it.n0 = nb * 64;
    const int rgu = (nb >> 1) * 256 + (nb & 1) * 64;
#if FP8_MOE && !CONV_PIPE
    unsigned char* dgu = WSP(unsigned char, WS_WGU) + (size_t)e * (4096 * 2048) + ((size_t)kb * 4096 + rgu) * 128;
    unsigned char* ddn = WSP(unsigned char, WS_WD) + (size_t)e * (2048 * 2048) + ((size_t)kb * 2048 + nb * 64) * 128;
    constexpr size_t up_off = (size_t)128 * 128;
#else
    unsigned char* dgu = WSP(unsigned char, WS_WGU) + ((size_t)e * 4096 + rgu) * (2048 * es);
    unsigned char* ddn = WSP(unsigned char, WS_WD) + ((size_t)e * 2048 + nb * 64) * (2048 * es);
    constexpr size_t up_off = (size_t)128 * (2048 * es);
#endif
    const float* pg = F.w_gate; const float* pu = F.w_up; const float* pd = F.w_down; asm volatile("" : "+s"(pg), "+s"(pu), "+s"(pd));
    const float* base = pg; it.dst = dgu;
    if (m == 1) { base = pu; it.dst = dgu + up_off; }
    if (m == 2) { base = pd; it.dst = ddn; }
    it.src = base + eo; return it;
}
__device__ __forceinline__ void conv_moe_item(Frame& F, int r, LAS unsigned* T, int lane0) {
    const MoeItem it = moe_item(F, r);
#if FP8_MOE && CONV_PIPE
    { Conv8Regs R; conv8_load(R, it.src, it.k0, it.n0, lane0); conv8_pack(R, it.k0, it.dst, T, lane0); }
#elif FP8_MOE
    conv_item8(it.src, it.k0, it.n0, it.dst, T, lane0);
#else
    conv_item<true>(it.src, 2048, 2048, it.k0, it.n0, (bf16*)it.dst, T, lane0);
#endif
}
__device__ __forceinline__ void conv_dispatch(Frame& F, int it, LAS unsigned* T, int lane0) {
    int r = it;
    if (r < IT_IN) { const int kb = r / (NP / 64), nb = r % (NP / 64); conv_item<(EMU_IN8 != 0)>(F.w_in, INCOLS, INCOLS, kb * 64, nb * 64, WSP(bf16, WS_WIN) + (size_t)(nb * 64) * 2048, T, lane0); return; }
    r -= IT_IN;
    if (r < IT_OUT) { const int kb = r >> 5, nb = r & 31; conv_item<(EMU_OUT8 != 0)>(F.w_out, DM, DM, kb * 64, nb * 64, WSP(bf16, WS_WOUT) + (size_t)(nb * 64) * 2048, T, lane0, (FUSE_P4 && kb >= 16) ? F.ssd_g + (kb * 64 - 1024) : nullptr); return; }
    r -= IT_OUT;
    conv_moe_item(F, r, T, lane0);
}
constexpr int WNB = CONV_DMA ? 16 : 8;
constexpr int WIT_EXP = 16 * WNB, WIT_GU = 2 * NE * WIT_EXP, WIT_MOE = 3 * NE * WIT_EXP;
struct WgItem { const float* src; unsigned char* blk; int m, nb; };
__device__ __forceinline__ WgItem wg_item(Frame& F, int r) {
    const int m = r / (NE * WIT_EXP); r -= m * (NE * WIT_EXP);
    const int e = r / WIT_EXP; r -= e * WIT_EXP; const int kb = r / WNB, nb = r % WNB;
    const float* pg = F.w_gate; const float* pu = F.w_up; const float* pd = F.w_down; asm volatile("" : "+s"(pg), "+s"(pu), "+s"(pd));
    WgItem it; it.m = m; it.nb = nb;
    const float* base = pg; if (m == 1) base = pu; if (m == 2) base = pd;
    it.src = base + (size_t)e * 2048 * 2048 + (size_t)(kb * 128) * 2048 + nb * (CONV_DMA ? 128 : 256);
    it.blk = (m == 2) ? WSP(unsigned char, WS_WD) + (size_t)e * (2048 * 2048) + (size_t)kb * (2048 * 128)
                      : WSP(unsigned char, WS_WGU) + (size_t)e * (4096 * 2048) + (size_t)kb * (4096 * 128);
    return it;
}
__device__ __forceinline__ void wg_load(f32x4 (&a)[16], const WgItem& it, int wave, int lane) {
#pragma unroll
    for (int i = 0; i < 16; ++i) a[i] = CONV_NT ? __builtin_nontemporal_load((const GAS f32x4*)(it.src + (size_t)(16 * wave + i) * 2048 + 4 * lane)) : *(const GAS f32x4*)(it.src + (size_t)(16 * wave + i) * 2048 + 4 * lane);
}
__device__ __forceinline__ void wg_pack(const f32x4 (&a)[16], LAS unsigned char* T, int wave, int lane) {
#pragma unroll
    for (int j = 0; j < 4; ++j) { v4u d;
        d.x = pk4_fp8_x64(a[0][j], a[1][j], a[2][j], a[3][j]); d.y = pk4_fp8_x64(a[4][j], a[5][j], a[6][j], a[7][j]);
        d.z = pk4_fp8_x64(a[8][j], a[9][j], a[10][j], a[11][j]); d.w = pk4_fp8_x64(a[12][j], a[13][j], a[14][j], a[15][j]);
        *(LAS v4u*)(T + (4 * lane + j) * 128 + ((wave ^ (lane & 7)) << 4)) = d; }
}
__device__ __forceinline__ void wg_store(const LAS unsigned char* T, const WgItem& it, int wave, int lane) {
    const int rb = (it.m == 2) ? it.nb * 256 : (2 * it.nb + (wave >> 2)) * 256 + (it.m == 1 ? 128 : 0);
#pragma unroll
    for (int s = 0; s < 4; ++s) { const int n = 32 * wave + 8 * s + (lane >> 3), c = lane & 7;
        const v4u v = *(const LAS v4u*)(T + n * 128 + ((c ^ ((n >> 2) & 7)) << 4));
        const int row = (it.m == 2) ? rb + n : rb + (n & 127);
        if (CONV_NTS) __builtin_nontemporal_store(v, (GAS v4u*)(it.blk + (size_t)row * 128 + 16 * c)); else *(GAS v4u*)(it.blk + (size_t)row * 128 + 16 * c) = v; }
}
__device__ __forceinline__ void dma_issue(const WgItem& it, unsigned sbase, int wave, int lane) {
#pragma unroll
    for (int i2 = 0; i2 < 8; ++i2) { const float* g = it.src + (size_t)(16 * wave + 2 * i2 + (lane >> 5)) * 2048 + 4 * (lane & 31); unsigned keep;
        asm volatile("s_mov_b32 %0, m0\n\ts_mov_b32 m0, %2\n\ts_nop 0\n\tglobal_load_lds_dwordx4 %1, off nt\n\ts_mov_b32 m0, %0" : "=&s"(keep) : "v"(g), "s"(sbase + 1024u * i2) : "memory"); }
}
__device__ __forceinline__ void dma_pack(const LAS unsigned char* Sw, LAS unsigned char* T, int wave, int lane) {
    const int n4 = lane & 31, kh = lane >> 5;
    f32x4 a[8];
#pragma unroll
    for (int r = 0; r < 8; ++r) { const int k = 8 * kh + r; a[r] = *(const LAS f32x4*)(Sw + (k >> 1) * 1024 + (k & 1) * 512 + n4 * 16); }
#pragma unroll
    for (int j = 0; j < 4; ++j) { v2u d; d.x = pk4_fp8_x64(a[0][j], a[1][j], a[2][j], a[3][j]); d.y = pk4_fp8_x64(a[4][j], a[5][j], a[6][j], a[7][j]);
        const int n = 4 * n4 + j; *(LAS v2u*)(T + n * 128 + ((wave ^ (n4 & 7)) << 4) + 8 * kh) = d; }
}
__device__ __forceinline__ void dma_store(const LAS unsigned char* T, const WgItem& it, int wave, int lane) {
    const int rb = (it.m == 2) ? it.nb * 128 : it.nb * 256 + (it.m == 1 ? 128 : 0);
#pragma unroll
    for (int s = 0; s < 2; ++s) { const int n = 16 * wave + 8 * s + (lane >> 3), c = lane & 7;
        const v4u v = *(const LAS v4u*)(T + n * 128 + ((c ^ ((n >> 2) & 7)) << 4));
        *(GAS v4u*)(it.blk + (size_t)(rb + n) * 128 + 16 * c) = v; }
}
constexpr int BG_BATCH = CONV_WG ? BGB_CFG : 32;
constexpr int POOL_GU = CONV_WG ? WIT_GU : IT_GU, POOL_ALL = CONV_WG ? WIT_MOE : IT_MOE;
__device__ __forceinline__ bool bg_batch(Frame& F, int limit) {
    LAS unsigned* T = (LAS unsigned*)(F.lds + RING_OFF + F.wave * 16384); volatile LAS int* BW = (volatile LAS int*)(F.lds + BGW_OFF);
    const int lane = TLANE();
    if (F.wave == 0) { int v = (int)__hip_atomic_load(F.ctl + CW_HEAD, RLX_AGENT);
        if (v < limit) v = (int)__hip_atomic_fetch_add(F.ctl + CW_HEAD, lane == 0 ? (unsigned)BG_BATCH : 0u, RLX_AGENT); else v = POOL_ALL;
        BW[0] = __builtin_amdgcn_readfirstlane(v); }
    __syncthreads();
    const int it0 = __builtin_amdgcn_readfirstlane(BW[0]);
    __syncthreads();
    if (it0 >= POOL_ALL) return false;
#if CONV_WG && CONV_DMA
    { LAS unsigned char* S0 = F.lds + RING_OFF; LAS unsigned char* T = F.lds + DMA_T_OFF; const int w = F.wave;
      const unsigned sb0 = (unsigned)(uintptr_t)(S0 + 8192 * w), sb1 = sb0 + 65536u;
      const WgItem i0 = wg_item(F, it0), i1 = wg_item(F, it0 + 1), i2 = wg_item(F, it0 + 2), i3 = wg_item(F, it0 + 3);
#define DMA_STEP(cur, sbc, NEXT_ISSUE, NWAIT) do { NEXT_ISSUE; asm volatile("s_waitcnt vmcnt(" #NWAIT ")" ::: "memory"); \
        dma_pack(S0 + ((sbc) - sb0) + 8192 * w, T, w, lane); LDS_WAIT(); __syncthreads(); dma_store(T, cur, w, lane); LDS_WAIT(); __syncthreads(); } while (0)
      dma_issue(i0, sb0, w, lane);
      DMA_STEP(i0, sb0, dma_issue(i1, sb1, w, lane), 8);
      DMA_STEP(i1, sb1, dma_issue(i2, sb0, w, lane), 8);
      DMA_STEP(i2, sb0, dma_issue(i3, sb1, w, lane), 8);
      DMA_STEP(i3, sb1, (void)0, 0);
#undef DMA_STEP
    }
#elif CONV_WG
    { LAS unsigned char* T0 = F.lds + RING_OFF; LAS unsigned char* T1 = T0 + 32768; const int w = F.wave;
      f32x4 A[16], B[16];
#if BGB_CFG == 6
      f32x4 C[16];
      const WgItem i0 = wg_item(F, it0), i1 = wg_item(F, it0 + 1), i2 = wg_item(F, it0 + 2), i3 = wg_item(F, it0 + 3), i4 = wg_item(F, it0 + 4), i5 = wg_item(F, it0 + 5);
      wg_load(A, i0, w, lane); wg_load(B, i1, w, lane); wg_load(C, i2, w, lane);
      wg_pack(A, T0, w, lane); LDS_WAIT(); __syncthreads(); wg_store(T0, i0, w, lane); wg_load(A, i3, w, lane);
      wg_pack(B, T1, w, lane); LDS_WAIT(); __syncthreads(); wg_store(T1, i1, w, lane); wg_load(B, i4, w, lane);
      wg_pack(C, T0, w, lane); LDS_WAIT(); __syncthreads(); wg_store(T0, i2, w, lane); wg_load(C, i5, w, lane);
      wg_pack(A, T1, w, lane); LDS_WAIT(); __syncthreads(); wg_store(T1, i3, w, lane);
      wg_pack(B, T0, w, lane); LDS_WAIT(); __syncthreads(); wg_store(T0, i4, w, lane);
      wg_pack(C, T1, w, lane); LDS_WAIT(); __syncthreads(); wg_store(T1, i5, w, lane);
#elif BGB_CFG == 4
      const WgItem i0 = wg_item(F, it0), i1 = wg_item(F, it0 + 1), i2 = wg_item(F, it0 + 2), i3 = wg_item(F, it0 + 3);
      wg_load(A, i0, w, lane);
      wg_load(B, i1, w, lane); wg_pack(A, T0, w, lane); LDS_WAIT(); __syncthreads(); wg_store(T0, i0, w, lane);
      wg_load(A, i2, w, lane); wg_pack(B, T1, w, lane); LDS_WAIT(); __syncthreads(); wg_store(T1, i1, w, lane);
      wg_load(B, i3, w, lane); wg_pack(A, T0, w, lane); LDS_WAIT(); __syncthreads(); wg_store(T0, i2, w, lane);
      wg_pack(B, T1, w, lane); LDS_WAIT(); __syncthreads(); wg_store(T1, i3, w, lane);
#elif BGB_CFG == 2
      const WgItem i0 = wg_item(F, it0), i1 = wg_item(F, it0 + 1);
      wg_load(A, i0, w, lane);
      wg_load(B, i1, w, lane); wg_pack(A, T0, w, lane); LDS_WAIT(); __syncthreads(); wg_store(T0, i0, w, lane);
      wg_pack(B, T1, w, lane); LDS_WAIT(); __syncthreads(); wg_store(T1, i1, w, lane);
#else
      const WgItem i0 = wg_item(F, it0);
      wg_load(A, i0, w, lane); wg_pack(A, T0, w, lane); LDS_WAIT(); __syncthreads(); wg_store(T0, i0, w, lane);
#endif
      LDS_WAIT(); __syncthreads(); }
#else
#pragma unroll 1
    for (int j = 0; j < BG_BATCH / NWAVES; ++j) conv_moe_item(F, it0 + j * NWAVES + F.wave, T, lane);
#endif
    return true;
}
__device__ __forceinline__ void bg_fill(Frame& F, int k, int limit) {
    volatile LAS int* BW = (volatile LAS int*)(F.lds + BGW_OFF);
    const int lane = TLANE();
    VM_WAIT(); __syncthreads();
    if (F.wave == 0) (void)__hip_atomic_fetch_add(F.ctl + CW_DONE + 64 * k, lane == 0 ? 1u : 0u, RLX_AGENT);
    bool more = true;
    while (more) {
        if (F.wave == 0) BW[1] = ((int)__hip_atomic_load(F.ctl + CW_DONE + 64 * k, RLX_AGENT) >= F.G) ? 1 : 0;
        __syncthreads();
        const int stop = __builtin_amdgcn_readfirstlane(BW[1]);
        __syncthreads();
        more = !stop;
        if (more) more = bg_batch(F, limit);
    }
}
__device__ __forceinline__ bool bg_finish(Frame& F, int limit) {
    bool any = false;
    while (bg_batch(F, limit)) any = true;
    return any;
}
__device__ __forceinline__ bool bg_peek_open(Frame& F) {
    volatile LAS int* BW = (volatile LAS int*)(F.lds + BGW_OFF);
    if (F.wave == 0) BW[2] = ((int)__hip_atomic_load(F.ctl + CW_HEAD, RLX_AGENT) < POOL_ALL) ? 1 : 0;
    __syncthreads();
    const int v = __builtin_amdgcn_readfirstlane(BW[2]);
    __syncthreads();
    return v != 0;
}
__device__ __forceinline__ bool bg_open(Frame& F, int limit) {
    return (int)__hip_atomic_load(F.ctl + CW_HEAD, RLX_AGENT) < limit;
}
__device__ __forceinline__ void rms_row_to_bf16(const float* xrow, const float* g, bf16* orow, int lane) {
    const f32x4* xr = (const f32x4*)xrow + lane; const f32x4* gr = (const f32x4*)g + lane;
    f32x4 v[8]; float s = 0.f;
#pragma unroll
    for (int j = 0; j < 8; ++j) { v[j] = xr[64 * j]; s += (v[j].x * v[j].x + v[j].y * v[j].y) + (v[j].z * v[j].z + v[j].w * v[j].w); }
    const float rstd = 1.f / sqrtf(wave_sum(s) * (1.f / 2048.f) + EPS);
    v2u* o8 = (v2u*)orow + lane;
#pragma unroll
    for (int j = 0; j < 8; ++j) { const f32x4 gg = gr[64 * j]; v2u w; w.x = pk2(v[j].x * rstd * gg.x, v[j].y * rstd * gg.y); w.y = pk2(v[j].z * rstd * gg.z, v[j].w * rstd * gg.w); o8[64 * j] = w; }
}
__device__ __forceinline__ void p0_prologue(Frame& F) {
    LAS unsigned* T = (LAS unsigned*)(F.lds + RING_OFF + F.wave * 16384); const int lane0 = TLANE();
    const int gw = F.vcu * NWAVES + F.wave, NGW = F.G * NWAVES;
    for (int it = gw; it < (BG_POOL ? IT_IN + IT_OUT : IT_TOTAL); it += NGW) conv_dispatch(F, it, T, lane0);
    for (int i = gw * 64 + lane0; i < NE * 2048; i += NGW * 64) { const int e = i >> 11, k = i & 2047; const float w = F.g2[k] * F.w_router[k * NE + e];
        const unsigned hi = f2bf(w); const float lo = w - bf2f(hi); WSP(bf16, WS_WR)[i] = (bf16)hi; WSP(bf16, WS_WR)[NE * 2048 + i] = (bf16)f2bf(lo); }
    for (int m0 = 2 * gw; m0 < NTOK; m0 += 2 * NGW) {
        const f32x4* x0 = (const f32x4*)(F.x + (size_t)m0 * DM) + lane0; const f32x4* x1 = x0 + DM / 4; const f32x4* gr = (const f32x4*)F.g1 + lane0;
        f32x4 v0[8], v1[8]; float s0 = 0.f, s1 = 0.f;
#pragma unroll
        for (int j = 0; j < 8; ++j) { v0[j] = x0[64 * j]; v1[j] = x1[64 * j]; }
#pragma unroll
        for (int j = 0; j < 8; ++j) { s0 += (v0[j].x * v0[j].x + v0[j].y * v0[j].y) + (v0[j].z * v0[j].z + v0[j].w * v0[j].w); s1 += (v1[j].x * v1[j].x + v1[j].y * v1[j].y) + (v1[j].z * v1[j].z + v1[j].w * v1[j].w); }
        const float r0 = 1.f / sqrtf(wave_sum(s0) * (1.f / 2048.f) + EPS), r1 = 1.f / sqrtf(wave_sum(s1) * (1.f / 2048.f) + EPS);
        v2u* o0 = (v2u*)(WSP(bf16, WS_XN) + (size_t)m0 * DM) + lane0; v2u* o1 = o0 + DM / 4;
#pragma unroll
        for (int j = 0; j < 8; ++j) { const f32x4 gg = gr[64 * j]; v2u w;
#if EMU_IN8
            w.x = pk2(q8(v0[j].x * r0 * gg.x), q8(v0[j].y * r0 * gg.y)); w.y = pk2(q8(v0[j].z * r0 * gg.z), q8(v0[j].w * r0 * gg.w)); o0[64 * j] = w;
            w.x = pk2(q8(v1[j].x * r1 * gg.x), q8(v1[j].y * r1 * gg.y)); w.y = pk2(q8(v1[j].z * r1 * gg.z), q8(v1[j].w * r1 * gg.w)); o1[64 * j] = w; }
#else
            w.x = pk2(v0[j].x * r0 * gg.x, v0[j].y * r0 * gg.y); w.y = pk2(v0[j].z * r0 * gg.z, v0[j].w * r0 * gg.w); o0[64 * j] = w;
            w.x = pk2(v1[j].x * r1 * gg.x, v1[j].y * r1 * gg.y); w.y = pk2(v1[j].z * r1 * gg.z, v1[j].w * r1 * gg.w); o1[64 * j] = w; }
#endif
    }
}

template <bool NS> struct OrderStaticT {
    static constexpr bool B_BLOCKED = false, HALF_UNITS = false, NSPLIT = NS, RSPLIT = false; __device__ __forceinline__ unsigned b_kstep() const { return 128u; }
    int nM, nN, nwg, G, c; const char* A; const char* Bt; const char* xprobe;
    __device__ __forceinline__ void init(int M, int N, int G_, int c_, const void* A_, const void* Bt_) { nM = M / 256; nN = N / 256; nwg = nM * nN; G = G_; c = c_; A = (const char*)A_; Bt = (const char*)Bt_; }
    __device__ __forceinline__ bool next(int i, pg8::Unit& u) const {
        long L = (long)i * G + c; u.nh = 0; u.rh = 0; u.roff = 0;
        if (NS) { const int R = nwg / G, T = nwg - R * G;
            if (T > 0 && 2 * T <= G && L >= (long)R * G) { const int Lp = (int)(L - (long)R * G); if (Lp >= 2 * T) return false; L = (long)R * G + (Lp >> 1); u.nh = 1 + (Lp & 1); } }
        if (L >= nwg) return false;
        int wgid = (int)L; { const int q = nwg / 8, r = nwg % 8, xcd = wgid % 8, off = wgid / 8; wgid = (xcd < r ? xcd * (q + 1) : r * (q + 1) + (xcd - r) * q) + off; }
        const int nig = 8 * nN, gid = wgid / nig, fm = gid * 8, gsz = (nM - fm) < 8 ? (nM - fm) : 8;
        u.pm = fm + ((wgid % nig) % gsz); u.pn = (wgid % nig) / gsz; u.e = 0; u.mt = 0; u.nrows = 256; return true;
    }
    __device__ __forceinline__ const void* a_base() const { return A; }
    __device__ __forceinline__ const void* b_base() const { return Bt; }
    __device__ __forceinline__ unsigned a_off(const pg8::Unit& u) const { return (unsigned)u.pm * (256u * 2048 * 2); }
    __device__ __forceinline__ unsigned b_off(const pg8::Unit& u) const { return (unsigned)u.pn * (256u * 2048 * 2); }
    __device__ __forceinline__ int a_row(const pg8::Unit&, int r) const { return r; }
};
typedef OrderStaticT<false> OrderStatic;
template <int NT, bool GATHER_A, int RB  > struct OrderMoe {
    static constexpr bool HALF_UNITS = HALF_UNITS_CFG != 0;
    static constexpr bool RSPLIT = NSPLIT_CFG != 0 && NT == 16;
    static constexpr bool NSPLIT = NSPLIT_CFG != 0 && NT == 8;
    static constexpr bool B_BLOCKED = FP8_MOE != 0;
    __device__ __forceinline__ unsigned b_kstep() const { return (unsigned)(bstride / 16); }
    int G, c, tb_lane, cn_lane, tbf_lane, tbh_lane; const char* A; const char* Bt; const int* stok; size_t bstride;
    const char* xprobe; gu32* qcnt; volatile LAS int* bw; int xc; bool dyn;
    __device__ __forceinline__ void init(int G_, int c_, const LAS int* TB, const LAS int* CN, int lane, const void* A_, const void* Bt_, size_t bstride_, const int* stok_, gu32* qcnt_, volatile LAS int* bw_, bool dyn_) {
        G = G_; c = c_; tb_lane = TB[lane < 32 ? lane : 32]; cn_lane = CN[lane & 31]; tbf_lane = TB[128 + (lane < 32 ? lane : 32)]; tbh_lane = TB[192 + (lane < 32 ? lane : 32)]; A = (const char*)A_; Bt = (const char*)Bt_; bstride = bstride_; stok = stok_;
        dyn = dyn_; xc = c_ >> 5; qcnt = qcnt_ + 64 * xc; bw = bw_; }
    __device__ __forceinline__ bool next(int i, pg8::Unit& u) const {
        int L = i * G + c;
        if (dyn) {
            if (__builtin_amdgcn_readfirstlane((int)(threadIdx.x >> 6)) == 0) { const unsigned v = __hip_atomic_fetch_add(qcnt, (threadIdx.x & 63) == 0 ? 1u : 0u, RLX_AGENT); bw[0] = __builtin_amdgcn_readfirstlane((int)v); }
            asm volatile("s_waitcnt lgkmcnt(0)" ::: "memory"); __builtin_amdgcn_s_barrier(); asm volatile("" ::: "memory");
            const int j = __builtin_amdgcn_readfirstlane(bw[0]);
            L = ((j >> 5) * 8 + xc) * 32 + (j & 31);
        }
        const int tfl = HALF_LAST ? tbf_lane : tb_lane;
        const int nfull = __builtin_amdgcn_readlane(tfl, 32) * NT, total = nfull + (HALF_LAST ? __builtin_amdgcn_readlane(tbh_lane, 32) * NT : 0);
        u.nh = 0; u.rh = 0; u.roff = 0;
        if ((NSPLIT || RSPLIT) && !dyn) { const int R = total / G, T = total - R * G;
            if (T > 0 && 2 * T <= G && L >= R * G) { const int Lp = L - R * G; if (Lp >= 2 * T) return false; L = R * G + (Lp >> 1); if (NSPLIT) u.nh = 1 + (Lp & 1); else u.rh = 1 + (Lp & 1); } }
        if (L >= total) return false;
        const int lane = threadIdx.x & 63;
        if (L < nfull) {
            const unsigned long long mk = __ballot(lane < 32 && tfl * NT <= L);
            const int e = __builtin_popcountll(mk) - 1;
            const int tfe = __builtin_amdgcn_readlane(tfl, e), tfe1 = __builtin_amdgcn_readlane(tfl, e + 1), tbe = __builtin_amdgcn_readlane(tb_lane, e), cne = __builtin_amdgcn_readlane(cn_lane, e);
            const int r = L - tfe * NT, mtiles = tfe1 - tfe, grp = mtiles * 8, ng = r / grp, r2 = r - ng * grp, mt = r2 >> 3, n8 = r2 & 7;
            u.e = e; u.mt = mt; u.pm = tbe + mt; u.pn = ng * 8 + n8; const int left = cne - mt * 256; u.nrows = left < 256 ? left : 256;
        } else {
            const int Lh = L - nfull;
            const unsigned long long mk = __ballot(lane < 32 && tbh_lane * NT <= Lh);
            const int e = __builtin_popcountll(mk) - 1;
            const int the = __builtin_amdgcn_readlane(tbh_lane, e), tbe = __builtin_amdgcn_readlane(tb_lane, e), tbe1 = __builtin_amdgcn_readlane(tb_lane, e + 1), cne = __builtin_amdgcn_readlane(cn_lane, e);
            const int mt = tbe1 - tbe - 1;
            u.e = e; u.mt = mt; u.pm = tbe + mt; u.pn = Lh - the * NT; u.nrows = cne - mt * 256;
        }
        if (RSPLIT && u.rh) {
            if (u.rh == 1) u.nrows = u.nrows < 128 ? u.nrows : 128;
            else if (u.nrows > 128) { u.roff = 128; u.nrows -= 128; }
            else { u.rh = 3; }
        }
        return true;
    }
    __device__ __forceinline__ const void* a_base() const { return A; }
    __device__ __forceinline__ const void* b_base() const { return Bt; }
    __device__ __forceinline__ unsigned a_off(const pg8::Unit& u) const { return GATHER_A ? 0u : (unsigned)u.pm * (256u * RB); }
    __device__ __forceinline__ unsigned b_off(const pg8::Unit& u) const { return (unsigned)u.e * (unsigned)bstride + (unsigned)u.pn * (256u * (B_BLOCKED ? 128 : RB)); }
    __device__ __forceinline__ int a_row(const pg8::Unit& u, int r) const { return stok[u.e * SLOTCAP + u.mt * 256 + u.roff + (r < u.nrows ? r : 0)]; }
};

struct EpiProj {
    static constexpr bool MIDSCALE = false; static constexpr int NVM = 16;
    static constexpr bool PERM = true; bf16* O; int ldc;
    __device__ __forceinline__ void operator()(const f32x4 (&acc)[2][2][4][2], const pg8::Unit& u, int wr, int wc, int fr, int fq) const {
        const int row0 = u.pm * 256 + wr * 64 + fr, col0 = u.pn * 256 + wc * 32 + 8 * fq;
#pragma unroll
        for (int ai = 0; ai < 2; ++ai)
#pragma unroll
            for (int m = 0; m < 4; ++m) { bf16* rowp = O + (size_t)(row0 + ai * 128 + m * 16) * ldc + col0;
#pragma unroll
                for (int bj = 0; bj < 2; ++bj) { if (u.nh == 2 - bj) continue; const f32x4 v0 = acc[ai][bj][m][0], v1 = acc[ai][bj][m][1];
                    v4u w; w.x = pk2(v0[0], v0[1]); w.y = pk2(v0[2], v0[3]); w.z = pk2(v1[0], v1[1]); w.w = pk2(v1[2], v1[3]);
                    *(v4u*)(rowp + bj * 128) = w; } }
    }
};
struct EpiRes {
    static constexpr int NVM = 48; static constexpr bool PERM = H_BF16 != 0; const float* base; float* out;
    static constexpr bool MIDSCALE = FUSE_P4 != 0; gu32* ssq;
    __device__ __forceinline__ float mid_load(const pg8::Unit& u) const { const int t = threadIdx.x; return t < 256 ? __builtin_bit_cast(float, __hip_atomic_load(ssq + u.pm * 256 + t, RLX_AGENT)) : 0.f; }
    __device__ __forceinline__ float mid_factor(float raw) const { return 1.f / sqrtf(raw * (1.f / 1024.f) + EPS); }
    __device__ __forceinline__ void operator()(const f32x4 (&acc)[2][2][4][2], const pg8::Unit& u, int wr, int wc, int fr, int fq) const {
#if H_BF16
        const int row0 = u.pm * 256 + wr * 64 + fr, col0 = u.pn * 256 + wc * 32 + 8 * fq;
#pragma unroll
        for (int ai = 0; ai < 2; ++ai)
#pragma unroll
            for (int m = 0; m < 4; ++m) { const size_t off = (size_t)(row0 + ai * 128 + m * 16) * DM + col0;
#pragma unroll
                for (int bj = 0; bj < 2; ++bj) { const f32x4 x0 = *(const f32x4*)(base + off + bj * 128), x1 = *(const f32x4*)(base + off + bj * 128 + 4); const f32x4 v0 = x0 + acc[ai][bj][m][0], v1 = x1 + acc[ai][bj][m][1];
                    v4u w; w.x = pk2(v0[0], v0[1]); w.y = pk2(v0[2], v0[3]); w.z = pk2(v1[0], v1[1]); w.w = pk2(v1[2], v1[3]);
                    *(v4u*)((bf16*)out + off + bj * 128) = w; } }
#else
        const int row0 = u.pm * 256 + wr * 64 + fr, col0 = u.pn * 256 + wc * 32 + 4 * fq;
#pragma unroll
        for (int ai = 0; ai < 2; ++ai)
#pragma unroll
            for (int m = 0; m < 4; ++m) { const size_t off = (size_t)(row0 + ai * 128 + m * 16) * DM + col0;
                f32x4 xb[2][2];
#pragma unroll
                for (int bj = 0; bj < 2; ++bj)
#pragma unroll
                    for (int n = 0; n < 2; ++n) xb[bj][n] = *(const f32x4*)(base + off + bj * 128 + n * 16);
#pragma unroll
                for (int bj = 0; bj < 2; ++bj)
#pragma unroll
                    for (int n = 0; n < 2; ++n) *(f32x4*)(out + off + bj * 128 + n * 16) = xb[bj][n] + acc[ai][bj][m][n]; }
#endif
    }
};
__device__ __forceinline__ float swiglu1(float g, float u) {
    g = fminf(g, SW_LIMIT); u = fminf(fmaxf(u, -SW_LIMIT), SW_LIMIT);
    const float glu = g * __builtin_amdgcn_rcpf(1.f + __expf(-SW_ALPHA * g));
    return (u + 1.f) * glu;
}
__device__ __forceinline__ f32x2 swiglu2(f32x2 g, f32x2 u) {
    g.x = fminf(g.x, SW_LIMIT); g.y = fminf(g.y, SW_LIMIT);
    u.x = fminf(fmaxf(u.x, -SW_LIMIT), SW_LIMIT); u.y = fminf(fmaxf(u.y, -SW_LIMIT), SW_LIMIT);
    const f32x2 t = g * (f32x2){-SW_ALPHA * LOG2E, -SW_ALPHA * LOG2E};
    f32x2 e; e.x = __builtin_amdgcn_exp2f(t.x); e.y = __builtin_amdgcn_exp2f(t.y);
    e = e + (f32x2){1.f, 1.f};
    f32x2 r; r.x = __builtin_amdgcn_rcpf(e.x); r.y = __builtin_amdgcn_rcpf(e.y);
    const f32x2 glu = g * r;
    return __builtin_elementwise_fma(u, glu, glu);
}
struct EpiGlu {
    static constexpr bool MIDSCALE = false; static constexpr int NVM = 8; static constexpr bool PERM = true; void* act; const float* bg; const float* bu;
    __device__ __forceinline__ void operator()(const f32x4 (&acc)[2][2][4][2], const pg8::Unit& u, int wr, int wc, int fr, int fq) const {
        if (u.rh == 3) return;
        const int row0 = u.pm * 256 + u.roff + wr * 64 + fr, colf = u.pn * 128 + wc * 32 + 8 * fq;
        f32x4 g_b[2], u_b[2];
#pragma unroll
        for (int n = 0; n < 2; ++n) { g_b[n] = *(const f32x4*)(bg + (size_t)u.e * DFF + colf + 4 * n); u_b[n] = *(const f32x4*)(bu + (size_t)u.e * DFF + colf + 4 * n); }
#pragma unroll
        for (int ai = 0; ai < 2; ++ai) { if (u.rh != 0 && ai == 1) continue;
#pragma unroll
            for (int m = 0; m < 4; ++m) { float r[8];
#pragma unroll
                for (int n = 0; n < 2; ++n) { const float ds_ = (FP8_MOE && (FP8_DIAG || FP8_NOSCALE)) ? (1.f / 64.f) : 1.f; const f32x4 g = acc[ai][0][m][n] * ds_ + g_b[n], uu = acc[ai][1][m][n] * ds_ + u_b[n];
#pragma unroll
                    for (int j = 0; j < 4; j += 2) { const f32x2 r2 = swiglu2((f32x2){g[j], g[j + 1]}, (f32x2){uu[j], uu[j + 1]}); r[4 * n + j] = r2.x; r[4 * n + j + 1] = r2.y;
                        if (EMU_FP8) { r[4 * n + j] = q8(r[4 * n + j]); r[4 * n + j + 1] = q8(r[4 * n + j + 1]); } } }
#if FP8_MOE
                v2u w; w.x = pk4_fp8(r[0], r[1], r[2], r[3]); w.y = pk4_fp8(r[4], r[5], r[6], r[7]);
                *(v2u*)((unsigned char*)act + (size_t)(row0 + ai * 128 + m * 16) * DFF + colf) = w; }
#else
                v4u w; w.x = pk2(r[0], r[1]); w.y = pk2(r[2], r[3]); w.z = pk2(r[4], r[5]); w.w = pk2(r[6], r[7]);
                *(v4u*)((bf16*)act + (size_t)(row0 + ai * 128 + m * 16) * DFF + colf) = w; }
#endif
        }
    }
};
struct EpiDown {
    static constexpr bool MIDSCALE = false; static constexpr int NVM = 16; static constexpr bool PERM = true; bf16* ys; const float* bd; const float* sgate; const int* sdest;
    __device__ __forceinline__ void operator()(const f32x4 (&acc)[2][2][4][2], const pg8::Unit& u, int wr, int wc, int fr, int fq) const {
        const int col0 = u.pn * 256 + wc * 32 + 8 * fq;
        f32x4 bv[2][2];
#pragma unroll
        for (int bj = 0; bj < 2; ++bj)
#pragma unroll
            for (int n = 0; n < 2; ++n) bv[bj][n] = *(const f32x4*)(bd + (size_t)u.e * DM + col0 + bj * 128 + 4 * n);
        float gts[2][4]; int dsts[2][4];
#pragma unroll
        for (int ai = 0; ai < 2; ++ai)
#pragma unroll
            for (int m = 0; m < 4; ++m) { const int rl = ai * 128 + wr * 64 + m * 16 + fr; const int slot = u.e * SLOTCAP + u.mt * 256 + (rl < u.nrows ? rl : 0); gts[ai][m] = sgate[slot]; dsts[ai][m] = sdest[slot]; }
#pragma unroll
        for (int ai = 0; ai < 2; ++ai)
#pragma unroll
            for (int m = 0; m < 4; ++m) { const int rl = ai * 128 + wr * 64 + m * 16 + fr;
                if (rl < u.nrows) { const float gt = gts[ai][m]; const int dest = dsts[ai][m];
#pragma unroll
                    for (int bj = 0; bj < 2; ++bj) { if (u.nh == 2 - bj) continue; const float ds_ = (FP8_MOE && (FP8_DIAG || FP8_NOSCALE)) ? (1.f / 64.f) : 1.f; const f32x4 v0 = (acc[ai][bj][m][0] * ds_ + bv[bj][0]) * gt, v1 = (acc[ai][bj][m][1] * ds_ + bv[bj][1]) * gt;
#if YSLOT_FP8
                        v2u w; w.x = pk4_fp8(v0[0], v0[1], v0[2], v0[3]); w.y = pk4_fp8(v1[0], v1[1], v1[2], v1[3]);
                        *(v2u*)((unsigned char*)ys + (size_t)dest * DM + col0 + bj * 128) = w; } } }
#else
                        v4u w; w.x = pk2(v0[0], v0[1]); w.y = pk2(v0[2], v0[3]); w.z = pk2(v1[0], v1[1]); w.w = pk2(v1[2], v1[3]);
                        *(v4u*)(ys + (size_t)dest * DM + col0 + bj * 128) = w; } } }
#endif
    }
};

__device__ __forceinline__ void unpack8(const v4u w, float (&f)[8]) { f[0] = bflo(w.x); f[1] = bfhi(w.x); f[2] = bflo(w.y); f[3] = bfhi(w.y); f[4] = bflo(w.z); f[5] = bfhi(w.z); f[6] = bflo(w.w); f[7] = bfhi(w.w); }
__device__ __forceinline__ v4u pack8f(const float (&f)[8]) { v4u w; w.x = pk2(f[0], f[1]); w.y = pk2(f[2], f[3]); w.z = pk2(f[4], f[5]); w.w = pk2(f[6], f[7]); return w; }
__device__ __forceinline__ void p2_post(Frame& F) {
    const int gw = F.vcu * NWAVES + F.wave, NGW = F.G * NWAVES, lane = TLANE();
    const bf16* proj = WSP(bf16, WS_PROJ);
    const bool scan = F.vcu < BATCH * AH;
    float fraw[4] = {0.f, 0.f, 0.f, 0.f};
    if (scan) { const int b = F.vcu >> 3, h = F.vcu & 7;
#pragma unroll
        for (int i = 0; i < 4; ++i) fraw[i] = bf2f(proj[(size_t)(b * SEQ + 256 * F.wave + 4 * lane + i) * NP + O_F + h]); }
    for (int t0 = 4 * gw; t0 < NTOK; t0 += 4 * NGW) {
        const int s0 = t0 & 2047;
        v4u xr[3][7];
#pragma unroll
        for (int j8 = 0; j8 < 2; ++j8)
#pragma unroll
            for (int i = 0; i < 7; ++i) { xr[j8][i] = (v4u){0u, 0u, 0u, 0u}; if (s0 + i - 3 >= 0) xr[j8][i] = *(const v4u*)(proj + (size_t)(t0 + i - 3) * NP + O_XBC + 512 * j8 + 8 * lane); }
        v4u raw[4][2][2];
#pragma unroll
        for (int ti = 0; ti < 4; ++ti)
#pragma unroll
            for (int qk = 0; qk < 2; ++qk) { const v4u* src = (const v4u*)(proj + (size_t)(t0 + ti) * NP + (qk ? O_K : O_Q) + 16 * lane); raw[ti][qk][0] = src[0]; raw[ti][qk][1] = src[1]; }
        float dtraw[4];
#pragma unroll
        for (int ti = 0; ti < 4; ++ti) dtraw[ti] = bf2f(proj[(size_t)(t0 + ti) * NP + O_DT + (lane & 15)]);
        {
            const int d0 = (16 * lane) & 127, h = lane >> 3;
            float gqv[16], gkv[16];
#pragma unroll
            for (int j = 0; j < 16; ++j) { gqv[j] = F.gq[d0 + j] * QSCALE; gkv[j] = F.gk[d0 + j]; }
            const float dtb = F.dt_bias[lane & 15], An = -__expf(F.a_log[lane & 15]);
#pragma unroll
            for (int ti = 0; ti < 4; ++ti) { const int t = t0 + ti, b = t >> 11, s = t & 2047;
#pragma unroll
                for (int qk = 0; qk < 2; ++qk) {
                    float f[16]; { float a[8], c[8]; unpack8(raw[ti][qk][0], a); unpack8(raw[ti][qk][1], c);
#pragma unroll
                        for (int j = 0; j < 8; ++j) { f[j] = a[j]; f[8 + j] = c[j]; } }
                    float ss = 0.f;
#pragma unroll
                    for (int j = 0; j < 16; ++j) ss += f[j] * f[j];
                    ss += __shfl_xor(ss, 1); ss += __shfl_xor(ss, 2); ss += __shfl_xor(ss, 4);
                    const float rstd = 1.f / sqrtf(ss * (1.f / 128.f) + EPS);
                    float o0[8], o1[8];
#pragma unroll
                    for (int j = 0; j < 8; ++j) { o0[j] = f[j] * rstd * (qk ? gkv[j] : gqv[j]); o1[j] = f[8 + j] * rstd * (qk ? gkv[8 + j] : gqv[8 + j]); }
                    v4u* dst = (v4u*)(WSP(bf16, qk ? WS_KN : WS_QN) + ((size_t)((b * AH + h) * SEQ + s)) * AHD + d0);
                    dst[0] = pack8f(o0); dst[1] = pack8f(o1);
                }
                if (lane < 16) { const float dt = softplusf_(dtraw[ti] + dtb);
                    WSP(float, WS_DTV)[t * 16 + lane] = dt; WSP(float, WS_DAV)[t * 16 + lane] = dt * An; } }
        }
#pragma unroll
        for (int i = 0; i < 7; ++i) { xr[2][i] = (v4u){0u, 0u, 0u, 0u}; if (s0 + i - 3 >= 0) xr[2][i] = *(const v4u*)(proj + (size_t)(t0 + i - 3) * NP + O_XBC + 1024 + 8 * lane); }
#pragma unroll
        for (int j8 = 0; j8 < 3; ++j8) {
            const int c0 = 512 * j8 + 8 * lane;
            float cw[4][8], cb[8];
#pragma unroll
            for (int tap = 0; tap < 4; ++tap)
#pragma unroll
                for (int j = 0; j < 8; ++j) cw[tap][j] = F.conv_w[tap * CONVCH + c0 + j];
#pragma unroll
            for (int j = 0; j < 8; ++j) cb[j] = F.conv_b[c0 + j];
#pragma unroll
            for (int ti = 0; ti < 4; ++ti) { float a[8];
#pragma unroll
                for (int j = 0; j < 8; ++j) a[j] = cb[j];
#pragma unroll
                for (int tap = 0; tap < 4; ++tap) { float xv[8]; unpack8(xr[j8][ti + tap], xv);
#pragma unroll
                    for (int j = 0; j < 8; ++j) a[j] += cw[tap][j] * xv[j]; }
#pragma unroll
                for (int j = 0; j < 8; ++j) a[j] = siluf_(a[j]);
                *(v4u*)(WSP(bf16, WS_XCONV) + (size_t)(t0 + ti) * CONVCH + c0) = pack8f(a); }
        }
    }
    if (scan) {
        LAS float* WT = (LAS float*)(F.lds + RING_OFF);
        const int bh = F.vcu, h = bh & 7; const float fb = F.fbias[h];
        float lf[4]; float tot = 0.f;
#pragma unroll
        for (int i = 0; i < 4; ++i) { const float xv = fraw[i] + fb; lf[i] = fminf(xv, 0.f) - log1pf(__expf(-fabsf(xv))); tot += lf[i]; }
        float inc = tot;
#pragma unroll
        for (int o = 1; o < 64; o <<= 1) { const float v = __shfl_up(inc, o); if (lane >= o) inc += v; }
        if (lane == 63) WT[F.wave] = inc;
        LDS_WAIT(); __syncthreads();
        float run = inc - tot;
        for (int w = 0; w < F.wave; ++w) run += WT[w];
        f32x4 o;
        run += lf[0]; o.x = run * LOG2E; run += lf[1]; o.y = run * LOG2E; run += lf[2]; o.z = run * LOG2E; run += lf[3]; o.w = run * LOG2E;
        *(f32x4*)(WSP(float, WS_ACUM) + (size_t)bh * SEQ + 256 * F.wave + 4 * lane) = o;
        __syncthreads();
    }
}

__device__ __forceinline__ void p3_attn_naive(Frame& F) {
    const int gw = F.vcu * NWAVES + F.wave, NGW = F.G * NWAVES, lane = TLANE();
    LAS float* qs = (LAS float*)(F.lds + RING_OFF + F.wave * 1024);
    const bf16* QN = WSP(bf16, WS_QN); const bf16* KN = WSP(bf16, WS_KN); const bf16* proj = WSP(bf16, WS_PROJ); const float* AC = WSP(float, WS_ACUM);
    for (int idx = gw; idx < BATCH * AH * SEQ; idx += NGW) {
        const int bh = idx >> 11, q = ((idx & 2047) + bh * 1031) & 2047, b = bh >> 3, h = bh & 7;
        { const unsigned w = *(const unsigned*)(QN + ((size_t)bh * SEQ + q) * AHD + 2 * lane); qs[2 * lane] = bflo(w); qs[2 * lane + 1] = bfhi(w); }
        LDS_WAIT();
        const float Aq = AC[(size_t)bh * SEQ + q];
        float m = -1e30f, l = 0.f, o0 = 0.f, o1 = 0.f;
        for (int kt = 0; kt * 64 <= q; ++kt) {
            const int key = kt * 64 + lane;
            const v4u* kp = (const v4u*)(KN + ((size_t)bh * SEQ + key) * AHD);
            float s = 0.f;
#pragma unroll
            for (int c = 0; c < 16; ++c) { float kf[8]; unpack8(kp[c], kf); const f32x4 q0 = ((const LAS f32x4*)qs)[2 * c], q1 = ((const LAS f32x4*)qs)[2 * c + 1];
                s += kf[0] * q0.x + kf[1] * q0.y + kf[2] * q0.z + kf[3] * q0.w + kf[4] * q1.x + kf[5] * q1.y + kf[6] * q1.z + kf[7] * q1.w; }
            s += Aq - AC[(size_t)bh * SEQ + key];
            if (key > q) s = -__builtin_inff();
            const float mt = wave_max(s), mn = fmaxf(m, mt), alpha = __builtin_amdgcn_exp2f(m - mn), p = __builtin_amdgcn_exp2f(s - mn);
            l = l * alpha + wave_sum(p); o0 *= alpha; o1 *= alpha; m = mn;
            const int nk = (q - kt * 64 + 1) < 64 ? (q - kt * 64 + 1) : 64;
            for (int kk = 0; kk < nk; ++kk) { const float pk = __shfl(p, kk);
                const unsigned w = *(const unsigned*)(proj + (size_t)(b * SEQ + kt * 64 + kk) * NP + O_V + h * AHD + 2 * lane);
                o0 += pk * bflo(w); o1 += pk * bfhi(w); }
        }
        const float il = 1.f / l;
        *(unsigned*)(WSP(bf16, WS_MIX) + (size_t)(b * SEQ + q) * DM + h * AHD + 2 * lane) = pk2(o0 * il, o1 * il);
        LDS_WAIT();
    }
}
__device__ __forceinline__ void p3_ssd_naive(Frame& F) {
    const int gw = F.vcu * NWAVES + F.wave, lane = TLANE();
    if (gw >= BATCH * SH) return;
    const int b = gw >> 4, h = gw & 15, g = h >> 3;
    LAS float* LB = (LAS float*)(F.lds + RING_OFF + 8192 + F.wave * 1024); LAS float* LC = LB + 128;
    const bf16* xc = WSP(bf16, WS_XCONV); const bf16* proj = WSP(bf16, WS_PROJ);
    const float dsk = F.d_skip[h];
    float hst[128];
#pragma unroll
    for (int n = 0; n < 128; ++n) hst[n] = 0.f;
    for (int t = 0; t < SEQ; ++t) {
        const int tok = b * SEQ + t;
        const float dt = WSP(float, WS_DTV)[tok * 16 + h], dec = __expf(WSP(float, WS_DAV)[tok * 16 + h]);
        const float xs = bf2f(xc[(size_t)tok * CONVCH + h * SHD + lane]), xdt = xs * dt;
        const unsigned bw = *(const unsigned*)(xc + (size_t)tok * CONVCH + SW + g * SN + 2 * lane), cw = *(const unsigned*)(xc + (size_t)tok * CONVCH + SW + SG * SN + g * SN + 2 * lane);
        LB[2 * lane] = bflo(bw); LB[2 * lane + 1] = bfhi(bw); LC[2 * lane] = bflo(cw); LC[2 * lane + 1] = bfhi(cw);
        LDS_WAIT();
        float y = 0.f;
#pragma unroll
        for (int n4 = 0; n4 < 32; ++n4) { const f32x4 bv = ((const LAS f32x4*)LB)[n4], cv = ((const LAS f32x4*)LC)[n4];
#pragma unroll
            for (int j = 0; j < 4; ++j) { hst[4 * n4 + j] = hst[4 * n4 + j] * dec + xdt * bv[j]; y += cv[j] * hst[4 * n4 + j]; } }
        LDS_WAIT();
        y += xs * dsk;
        const float z = bf2f(proj[(size_t)tok * NP + O_Z + h * SHD + lane]);
        const float yg = y * siluf_(z);
        const float ss = wave_sum(yg * yg);
        if (lane == 0) atomicAdd((float*)(F.ctl + CW_SSQ) + tok, ss);
        WSP(bf16, WS_MIX)[(size_t)tok * DM + AW + h * SHD + lane] = (bf16)f2bf(yg);
    }
}

__device__ __forceinline__ void p4_ssdnorm(Frame& F) {
    const int gw = F.vcu * NWAVES + F.wave, NGW = F.G * NWAVES, lane = TLANE();
    float gv[16];
#pragma unroll
    for (int j = 0; j < 16; ++j) gv[j] = F.ssd_g[16 * lane + j];
    for (int t0 = 4 * gw; t0 < NTOK; t0 += 4 * NGW) {
        float ssq[4]; v4u r0[4], r1[4];
#pragma unroll
        for (int ti = 0; ti < 4; ++ti) { ssq[ti] = __builtin_bit_cast(float, __hip_atomic_load(F.ctl + CW_SSQ + t0 + ti, RLX_AGENT));
            const v4u* p = (const v4u*)(WSP(bf16, WS_MIX) + (size_t)(t0 + ti) * DM + AW + 16 * lane); r0[ti] = p[0]; r1[ti] = p[1]; }
#pragma unroll
        for (int ti = 0; ti < 4; ++ti) { const float rs = 1.f / sqrtf(ssq[ti] * (1.f / 1024.f) + EPS);
            float a[8], c[8]; unpack8(r0[ti], a); unpack8(r1[ti], c);
#pragma unroll
            for (int j = 0; j < 8; ++j) { a[j] *= rs * gv[j]; c[j] *= rs * gv[8 + j]; if (EMU_OUT8) { a[j] = q8(a[j]); c[j] = q8(c[j]); } }
            v4u* p = (v4u*)(WSP(bf16, WS_MIX) + (size_t)(t0 + ti) * DM + AW + 16 * lane); p[0] = pack8f(a); p[1] = pack8f(c); }
    }
#if EMU_OUT8
    for (int t0 = gw; t0 < NTOK; t0 += NGW) { v4u* p = (v4u*)(WSP(bf16, WS_MIX) + (size_t)t0 * DM + 16 * lane); v4u r0 = p[0], r1 = p[1]; float a[8], c[8]; unpack8(r0, a); unpack8(r1, c);
        for (int j = 0; j < 8; ++j) { a[j] = q8(a[j]); c[j] = q8(c[j]); } p[0] = pack8f(a); p[1] = pack8f(c); }
#endif
}

__device__ __forceinline__ void p6_router(Frame& F) {
    const int tid = TTID(), lane = tid & 63, wave = F.wave, r16 = lane & 15, q4 = lane >> 4;
    LAS float* RED = (LAS float*)(F.lds + RING_OFF);
    LAS int* LC = (LAS int*)(F.lds + RING_OFF + 8 * 32 * 33 * 4); LAS int* LB = LC + 32;
    const bf16* WRH = WSP(bf16, WS_WR); const bf16* WRL = WRH + NE * 2048;
    gu32* cnt = F.ctl + CW_CNT;
    for (int unit = F.vcu; unit < NTOK / 32; unit += F.G) {
        const int T0 = unit * 32;
        float rs[4];
#if H_BF16 && FP8_MOE
        { const int tok = T0 + 4 * wave; const bf16* hr = WSP(bf16, WS_H) + (size_t)tok * DM + 8 * lane;
            v4u v[4][4];
#pragma unroll
            for (int q = 0; q < 4; ++q)
#pragma unroll
                for (int j = 0; j < 4; ++j) v[q][j] = *(const v4u*)(hr + (size_t)q * DM + 512 * j);
#pragma unroll
            for (int q = 0; q < 4; ++q) { float s0 = 0.f;
#pragma unroll
                for (int j = 0; j < 4; ++j) { float f[8]; unpack8(v[q][j], f);
#pragma unroll
                    for (int i = 0; i < 8; ++i) s0 += f[i] * f[i]; }
                rs[q] = 1.f / sqrtf(wave_sum(s0) * (1.f / 2048.f) + EPS); }
#pragma unroll
            for (int j = 0; j < 4; ++j) { const f32x4 g0 = *(const f32x4*)(F.g2 + 8 * lane + 512 * j), g1 = *(const f32x4*)(F.g2 + 8 * lane + 512 * j + 4);
#pragma unroll
                for (int q = 0; q < 4; ++q) { const float rstd = rs[q]; float f[8]; unpack8(v[q][j], f);
                    v2u w; w.x = pk4_fp8(f[0] * rstd * g0.x, f[1] * rstd * g0.y, f[2] * rstd * g0.z, f[3] * rstd * g0.w); w.y = pk4_fp8(f[4] * rstd * g1.x, f[5] * rstd * g1.y, f[6] * rstd * g1.z, f[7] * rstd * g1.w);
                    *(v2u*)(WSP(unsigned char, WS_XN) + (size_t)(tok + q) * DM + 8 * lane + 512 * j) = w; } }
        }
#else
        { const int tok = T0 + 4 * wave; const f32x4* xr = (const f32x4*)(F.out + (size_t)tok * DM) + lane; const f32x4* gr = (const f32x4*)F.g2 + lane;
            f32x4 v[4][8];
#pragma unroll
            for (int q = 0; q < 4; ++q)
#pragma unroll
                for (int j = 0; j < 8; ++j) v[q][j] = xr[q * (DM / 4) + 64 * j];
#pragma unroll
            for (int q = 0; q < 4; ++q) { float s0 = 0.f;
#pragma unroll
                for (int j = 0; j < 8; ++j) s0 += (v[q][j].x * v[q][j].x + v[q][j].y * v[q][j].y) + (v[q][j].z * v[q][j].z + v[q][j].w * v[q][j].w);
                rs[q] = 1.f / sqrtf(wave_sum(s0) * (1.f / 2048.f) + EPS); }
#pragma unroll
            for (int j = 0; j < 8; ++j) { const f32x4 gg = gr[64 * j];
#pragma unroll
                for (int q = 0; q < 4; ++q) { const float rstd = rs[q];
                    f32x4 t = {v[q][j].x * rstd * gg.x, v[q][j].y * rstd * gg.y, v[q][j].z * rstd * gg.z, v[q][j].w * rstd * gg.w};
                    if (EMU_FP8) { t.x = q8(t.x); t.y = q8(t.y); t.z = q8(t.z); t.w = q8(t.w); }
#if FP8_MOE
                    ((unsigned*)(WSP(unsigned char, WS_XN) + (size_t)(tok + q) * DM))[lane + 64 * j] = pk4_fp8(t.x, t.y, t.z, t.w); }
#else
                    v2u w; w.x = pk2(t.x, t.y); w.y = pk2(t.z, t.w); ((v2u*)(WSP(bf16, WS_XN) + (size_t)(tok + q) * DM) + lane)[64 * j] = w; }
#endif
            }
        }
#endif
        f32x4 acc[2][2];
#pragma unroll
        for (int a = 0; a < 2; ++a)
#pragma unroll
            for (int c = 0; c < 2; ++c) acc[a][c] = (f32x4){0.f, 0.f, 0.f, 0.f};
#pragma unroll 4
        for (int ks = 0; ks < 8; ++ks) { const int k = 256 * wave + 32 * ks + 8 * q4;
            bf16x8 bh[2], bl[2];
#pragma unroll
            for (int n = 0; n < 2; ++n) { bh[n] = *(const bf16x8*)(WRH + (size_t)(16 * n + r16) * 2048 + k); bl[n] = *(const bf16x8*)(WRL + (size_t)(16 * n + r16) * 2048 + k); }
#pragma unroll
#if H_BF16
            for (int mt = 0; mt < 2; ++mt) { const bf16x8 ah = *(const bf16x8*)(WSP(bf16, WS_H) + (size_t)(T0 + 16 * mt + r16) * DM + k);
#pragma unroll
                for (int n = 0; n < 2; ++n) { acc[mt][n] = __builtin_amdgcn_mfma_f32_16x16x32_bf16(ah, bh[n], acc[mt][n], 0, 0, 0); acc[mt][n] = __builtin_amdgcn_mfma_f32_16x16x32_bf16(ah, bl[n], acc[mt][n], 0, 0, 0); } }
#else
            for (int mt = 0; mt < 2; ++mt) { const float* xp = F.out + (size_t)(T0 + 16 * mt + r16) * DM + k;
                const f32x4 x0 = *(const f32x4*)xp, x1 = *(const f32x4*)(xp + 4);
                float xv[8] = {x0.x, x0.y, x0.z, x0.w, x1.x, x1.y, x1.z, x1.w}; float hv[8], lv[8];
#pragma unroll
                for (int j = 0; j < 8; ++j) { hv[j] = bf2f(f2bf(xv[j])); lv[j] = xv[j] - hv[j]; }
                const v4u ahw = pack8f(hv), alw = pack8f(lv);
                const bf16x8 ah = __builtin_bit_cast(bf16x8, ahw), al = __builtin_bit_cast(bf16x8, alw);
#pragma unroll
                for (int n = 0; n < 2; ++n) { acc[mt][n] = __builtin_amdgcn_mfma_f32_16x16x32_bf16(ah, bh[n], acc[mt][n], 0, 0, 0);
                    acc[mt][n] = __builtin_amdgcn_mfma_f32_16x16x32_bf16(ah, bl[n], acc[mt][n], 0, 0, 0);
                    acc[mt][n] = __builtin_amdgcn_mfma_f32_16x16x32_bf16(al, bh[n], acc[mt][n], 0, 0, 0); } }
#endif
        }
#pragma unroll
        for (int mt = 0; mt < 2; ++mt)
#pragma unroll
            for (int n = 0; n < 2; ++n)
#pragma unroll
                for (int rg = 0; rg < 4; ++rg) RED[(wave * 32 + 16 * mt + 4 * q4 + rg) * 33 + 16 * n + r16] = acc[mt][n][rg];
        if (tid < 32) LC[tid] = 0;
        __syncthreads();
        { const int tokl = tid >> 4, e2 = r16 * 2;
          const float rsel = q4 == 0 ? rs[0] : q4 == 1 ? rs[1] : q4 == 2 ? rs[2] : rs[3];
          float l0 = 0.f, l1 = 0.f;
#pragma unroll
          for (int w = 0; w < 8; ++w) { l0 += RED[(w * 32 + tokl) * 33 + e2]; l1 += RED[(w * 32 + tokl) * 33 + e2 + 1]; }
          l0 = l0 * rsel + F.b_router[e2]; l1 = l1 * rsel + F.b_router[e2 + 1];
          float val[4]; int idx[4];
#pragma unroll
          for (int k = 0; k < 4; ++k) { float bv = l0; int bi = e2; if (l1 > l0) { bv = l1; bi = e2 + 1; }
#pragma unroll
              for (int st = 0; st < 4; ++st) {
                  float ov; int oi;
                  if (st == 0) { ov = dpp_f<0x128>(bv); oi = dpp_i<0x128>(bi); } else if (st == 1) { ov = dpp_f<0x124>(bv); oi = dpp_i<0x124>(bi); } else if (st == 2) { ov = dpp_f<0x122>(bv); oi = dpp_i<0x122>(bi); } else { ov = dpp_f<0x121>(bv); oi = dpp_i<0x121>(bi); }
                  if (ov > bv || (ov == bv && oi < bi)) { bv = ov; bi = oi; } }
              val[k] = bv; idx[k] = bi;
              if (bi == e2) l0 = -__builtin_inff(); if (bi == e2 + 1) l1 = -__builtin_inff(); }
          float ex[4], sum = 0.f;
#pragma unroll
          for (int k = 0; k < 4; ++k) { ex[k] = __expf(val[k] - val[0]); sum += ex[k]; }
          const float inv = 1.f / sum;
          int esel = 0, loc = 0; float gsel = 0.f;
          if (r16 < 4) { const int k = r16;
              const int e = k == 0 ? idx[0] : k == 1 ? idx[1] : k == 2 ? idx[2] : idx[3]; const float g = (k == 0 ? ex[0] : k == 1 ? ex[1] : k == 2 ? ex[2] : ex[3]) * inv;
              esel = e; gsel = g; loc = __hip_atomic_fetch_add(LC + e, 1, __ATOMIC_RELAXED, __HIP_MEMORY_SCOPE_WORKGROUP); }
          __syncthreads();
          if (tid < 32) { const int c = LC[tid]; LB[tid] = c > 0 ? (int)__hip_atomic_fetch_add(cnt + 64 * tid, (unsigned)c, RLX_AGENT) : 0; }
#ifdef PROBE_AT2
          __syncthreads();
          if (tid < 32) { const int c = LC[tid]; const int d = c > 0 ? (int)__hip_atomic_fetch_add(cnt + 64 * tid + 32, (unsigned)c, RLX_AGENT) : 0; if (d < 0) LB[tid] = d; }
#endif
          __syncthreads();
          if (r16 < 4) { const int tok = T0 + tokl; const size_t sl = (size_t)esel * SLOTCAP + (LB[esel] + loc); WSP(int, WS_STOK)[sl] = tok; WSP(float, WS_SGATE)[sl] = gsel; WSP(int, WS_SDEST)[sl] = tok * 4 + r16; } }
        __syncthreads();
    }
}
__device__ __forceinline__ void moe_tables(Frame& F) {
    LAS int* TB = (LAS int*)(F.lds + TB_OFF); LAS int* CN = TB + 64; LAS int* MT = CN + 32; LAS int* TBF = MT + 32; LAS int* TBH = TBF + 64;
    const int tid = TTID();
    if (tid < NE) { const int c = (int)__hip_atomic_load(F.ctl + CW_CNT + 64 * tid, RLX_AGENT); CN[tid] = c; MT[tid] = (c + 255) >> 8; }
    __syncthreads();
    if (tid == 0) { int run = 0, rf = 0, rh = 0;
        for (int e = 0; e < NE; ++e) { const int mt = MT[e], rem = CN[e] - (mt - 1) * 256, hf = (HALF_UNITS_CFG && mt > 0 && rem <= 128) ? 1 : 0;
            TB[e] = run; TBF[e] = rf; TBH[e] = rh; run += mt; rf += mt - hf; rh += hf; }
        TB[NE] = run; TBF[NE] = rf; TBH[NE] = rh; }
    __syncthreads();
}
__device__ __forceinline__ void p9_combine(Frame& F) {
    const int gw = F.vcu * NWAVES + F.wave, NGW = F.G * NWAVES, lane = TLANE();
#if PROBE_T
    const float probe_s = 1.f + __builtin_bit_cast(float, __hip_atomic_load(F.ctl + CW_PROBE, RLX_AGENT)), probe_a = __builtin_bit_cast(float, __hip_atomic_load(F.ctl + CW_PROBE + 1, RLX_AGENT));
#endif
#if YSLOT_FP8 && H_BF16
    const unsigned char* ys = WSP(unsigned char, WS_YSLOT); const bf16* hb = WSP(bf16, WS_H);
    for (int t = gw; t < NTOK; t += NGW) {
        v4u hh[2][2], yy[2][4];
#pragma unroll
        for (int j = 0; j < 2; ++j) { const int col = 16 * lane + 1024 * j;
            hh[j][0] = *(const v4u*)(hb + (size_t)t * DM + col); hh[j][1] = *(const v4u*)(hb + (size_t)t * DM + col + 8);
#pragma unroll
            for (int k = 0; k < 4; ++k) yy[j][k] = *(const v4u*)(ys + (size_t)(4 * t + k) * DM + col); }
#pragma unroll
        for (int j = 0; j < 2; ++j) { float* op = F.out + (size_t)t * DM + 16 * lane + 1024 * j;
            float a[16]; { float f0[8], f1[8]; unpack8(hh[j][0], f0); unpack8(hh[j][1], f1);
#pragma unroll
                for (int i = 0; i < 8; ++i) { a[i] = f0[i]; a[8 + i] = f1[i]; } }
#pragma unroll
            for (int k = 0; k < 4; ++k) { const unsigned yw[4] = {yy[j][k].x, yy[j][k].y, yy[j][k].z, yy[j][k].w};
#pragma unroll
                for (int q = 0; q < 4; ++q) { a[4 * q] += __builtin_amdgcn_cvt_f32_fp8((int)yw[q], 0); a[4 * q + 1] += __builtin_amdgcn_cvt_f32_fp8((int)yw[q], 1); a[4 * q + 2] += __builtin_amdgcn_cvt_f32_fp8((int)yw[q], 2); a[4 * q + 3] += __builtin_amdgcn_cvt_f32_fp8((int)yw[q], 3); } }
#pragma unroll
            for (int q = 0; q < 4; ++q) { f32x4 o = {a[4 * q], a[4 * q + 1], a[4 * q + 2], a[4 * q + 3]};
#if PROBE_T
                o = o * probe_s; if (t == 0 && lane == 0 && j == 0 && q == 0) o.x += probe_a;
#endif
                *(f32x4*)(op + 4 * q) = o; } }
    }
#elif YSLOT_FP8
    const unsigned char* ys = WSP(unsigned char, WS_YSLOT);
    for (int t = gw; t < NTOK; t += NGW) {
#pragma unroll
        for (int j = 0; j < 2; ++j) { const int col = 16 * lane + 1024 * j; float* op = F.out + (size_t)t * DM + col;
            f32x4 a[4];
#pragma unroll
            for (int q = 0; q < 4; ++q) a[q] = *(const f32x4*)(op + 4 * q);
#pragma unroll
            for (int k = 0; k < 4; ++k) { const v4u y = *(const v4u*)(ys + (size_t)(4 * t + k) * DM + col); const unsigned yw[4] = {y.x, y.y, y.z, y.w};
#pragma unroll
                for (int q = 0; q < 4; ++q) { a[q].x += __builtin_amdgcn_cvt_f32_fp8((int)yw[q], 0); a[q].y += __builtin_amdgcn_cvt_f32_fp8((int)yw[q], 1); a[q].z += __builtin_amdgcn_cvt_f32_fp8((int)yw[q], 2); a[q].w += __builtin_amdgcn_cvt_f32_fp8((int)yw[q], 3); } }
#pragma unroll
            for (int q = 0; q < 4; ++q) *(f32x4*)(op + 4 * q) = a[q]; }
    }
#else
    const bf16* ys = WSP(bf16, WS_YSLOT);
    for (int t = gw; t < NTOK; t += NGW) {
        float* op = F.out + (size_t)t * DM + 8 * lane;
        f32x4 a0[4], a1[4]; v4u y[4][4];
#pragma unroll
        for (int j = 0; j < 4; ++j) { a0[j] = *(const f32x4*)(op + 512 * j); a1[j] = *(const f32x4*)(op + 512 * j + 4);
#pragma unroll
            for (int k = 0; k < 4; ++k) y[j][k] = __builtin_nontemporal_load((const GAS v4u*)(ys + (size_t)(4 * t + k) * DM + 8 * lane + 512 * j)); }
#pragma unroll
        for (int j = 0; j < 4; ++j) {
#pragma unroll
            for (int k = 0; k < 4; ++k) { float yv[8]; unpack8(y[j][k], yv);
                a0[j].x += yv[0]; a0[j].y += yv[1]; a0[j].z += yv[2]; a0[j].w += yv[3]; a1[j].x += yv[4]; a1[j].y += yv[5]; a1[j].z += yv[6]; a1[j].w += yv[7]; }
#if PROBE_T
            a0[j] = a0[j] * probe_s; a1[j] = a1[j] * probe_s; if (t == 0 && lane == 0 && j == 0) a0[j].x = probe_a;
#endif
            __builtin_nontemporal_store(a0[j], (GAS f32x4*)(op + 512 * j)); __builtin_nontemporal_store(a1[j], (GAS f32x4*)(op + 512 * j + 4)); }
    }
#endif
}
namespace attn {
constexpr int D = 128, NW = 8, QBLK = 32, KVBLK = 64, QB = NW * QBLK;
constexpr int SHM_V = KVBLK * D * 2, SHM_K = KVBLK * D * 2;
constexpr int ATT_LDS_BYTES = 2 * SHM_V + 2 * SHM_K + NW * 64 * 4;
constexpr int KPITCH = 128, VPITCH = NP, OPITCH = DM;
constexpr float THR2 = 11.5416f;
typedef short s16x4 __attribute__((ext_vector_type(4)));
typedef float f32x16 __attribute__((ext_vector_type(16)));
typedef unsigned u32x4 __attribute__((ext_vector_type(4)));

#define KSWZ(row, colB) ((row) * 256 + ((colB) ^ (((row) & 7) << 4)))
#define SBAR() __builtin_amdgcn_sched_barrier(0)
__device__ __forceinline__ int v_st(int k, int c) { const int kk = (k & ~0xC) | ((k & 4) << 1) | ((k & 8) >> 1); return ((kk >> 3) * 4 + (c >> 5)) * 512 + ((kk & 7) * 32 + (c & 31)) * 2; }
__device__ __forceinline__ int v_rd_base(int lane) { return ((lane & 3) << 3) | (((lane >> 2) & 3) << 6) | (((lane >> 4) & 1) << 5) | (((lane >> 5) & 1) << 8); }
constexpr int v_rd_off(int d0, int ks, int half) { return d0 * 512 + ks * 4096 + half * 2048; }
__device__ __forceinline__ int crow(int r, int hi) { return (r & 3) + 8 * (r >> 2) + 4 * hi; }
__device__ __forceinline__ unsigned cvtpk(float lo, float hi) { unsigned r; asm volatile("v_cvt_pk_bf16_f32 %0, %1, %2" : "=v"(r) : "v"(lo), "v"(hi)); return r; }
__device__ __forceinline__ void mask_tile(f32x16& p0, f32x16& p1, int dq) {
    const float NEG = -__builtin_inff();
#pragma unroll
    for (int r = 0; r < 16; ++r) {
        const int c = (r & 3) + 8 * (r >> 2);
        if (dq - c < 0) p0[r] = NEG;
        if (dq - c - 32 < 0) p1[r] = NEG;
    }
}
__device__ __forceinline__ void partialSM(f32x16& p0, f32x16& p1, float& m_reg, float& mn, float& alpha) {
    float pmax = p0[0]; for (int r = 1; r < 16; ++r) pmax = fmaxf(pmax, p0[r]); for (int r = 0; r < 16; ++r) pmax = fmaxf(pmax, p1[r]);
    { auto rr = __builtin_amdgcn_permlane32_swap(__float_as_uint(pmax), __float_as_uint(pmax), false, false);
      pmax = fmaxf(__uint_as_float(rr[0]), __uint_as_float(rr[1])); }
    if (__builtin_expect(__all((pmax - m_reg) <= THR2), 1)) { mn = m_reg; alpha = 1.f; }
    else { mn = fmaxf(m_reg, pmax); alpha = __builtin_amdgcn_exp2f(m_reg - mn); m_reg = mn; }
    for (int r = 0; r < 16; ++r) p0[r] = p0[r] - mn; for (int r = 0; r < 16; ++r) p1[r] = p1[r] - mn;
    for (int r = 0; r < 16; ++r) p0[r] = __builtin_amdgcn_exp2f(p0[r]);
}
__device__ __forceinline__ void finishSM(f32x16& p0, f32x16& p1, float alpha, float& l_reg, bf16x8& pa0, bf16x8& pa1, bf16x8& pa2, bf16x8& pa3) {
    for (int r = 0; r < 16; ++r) p1[r] = __builtin_amdgcn_exp2f(p1[r]);
    float ps = 0; for (int r = 0; r < 16; ++r) ps += p0[r]; for (int r = 0; r < 16; ++r) ps += p1[r];
    { auto rr = __builtin_amdgcn_permlane32_swap(__float_as_uint(ps), __float_as_uint(ps), false, false);
      ps = __uint_as_float(rr[0]) + __uint_as_float(rr[1]); }
    l_reg = l_reg * alpha + ps;
#define PK4(P, B_, OUT) do { unsigned a0 = cvtpk(P[B_+0], P[B_+1]), a1 = cvtpk(P[B_+2], P[B_+3]);                          \
        unsigned b0 = cvtpk(P[B_+4], P[B_+5]), b1 = cvtpk(P[B_+6], P[B_+7]);                                             \
        auto r0 = __builtin_amdgcn_permlane32_swap(a0, b0, false, false); auto r1 = __builtin_amdgcn_permlane32_swap(a1, b1, false, false); \
        u32x4 w = {r0[0], r1[0], r0[1], r1[1]}; OUT = *reinterpret_cast<bf16x8*>(&w); } while (0)
    PK4(p0, 0, pa0); PK4(p0, 8, pa1); PK4(p1, 0, pa2); PK4(p1, 8, pa3);
#undef PK4
}
__device__ __forceinline__ unsigned split2(float a) { const unsigned h = cvtpk(a, 0.f) & 0xffffu; const float r1 = a - __uint_as_float(h << 16); return h | (cvtpk(r1, 0.f) << 16); }
__device__ __forceinline__ bf16x8 q_aug(unsigned w) { u32x4 v = {w, 0x3f803f80u, 0u, 0u}; return *reinterpret_cast<bf16x8*>(&v); }
__device__ __forceinline__ bf16x8 k_aug(float nk, int hi) { u32x4 v = {0x3f803f80u, split2(nk), 0u, 0u}; if (hi) v = (u32x4){0u, 0u, 0u, 0u}; return *reinterpret_cast<bf16x8*>(&v); }
template <int KB>
__device__ __forceinline__ void qkt(f32x16& p0, f32x16& p1, const char* K_lds, int r32, int hi, const bf16x8* qr, unsigned qa, float ak0, float ak1, float aref) {
    p0 = f32x16{}; p1 = f32x16{};
    const char* kb[4];
#pragma unroll
    for (int dd = 0; dd < 4; ++dd) kb[dd] = K_lds + KB * SHM_K + KSWZ(r32, (dd * 16 + hi * 8) * 2);
#pragma unroll
    for (int d0 = 0; d0 < 8; ++d0) { const char* a = kb[d0 & 3] + (d0 >> 2) * 128;
        bf16x8 b0 = *reinterpret_cast<const bf16x8*>(a);
        bf16x8 b1 = *reinterpret_cast<const bf16x8*>(a + 32 * 256);
        p0 = __builtin_amdgcn_mfma_f32_32x32x16_bf16(b0, qr[d0], p0, 0, 0, 0);
        p1 = __builtin_amdgcn_mfma_f32_32x32x16_bf16(b1, qr[d0], p1, 0, 0, 0); }
    p0 = __builtin_amdgcn_mfma_f32_32x32x16_bf16(k_aug(aref - ak0, hi), q_aug(qa), p0, 0, 0, 0);
    p1 = __builtin_amdgcn_mfma_f32_32x32x16_bf16(k_aug(aref - ak1, hi), q_aug(qa), p1, 0, 0, 0);
}
template <int VB>
__device__ __forceinline__ void pv_tile(f32x16* o, int vb0, bf16x8 pa0, bf16x8 pa1, bf16x8 pa2, bf16x8 pa3) {
#define TRRD(dst, off) asm volatile("ds_read_b64_tr_b16 %0, %1 offset:%2" : "=&v"(dst) : "v"(vb0), "i"(off) : "memory")
#define PV_D0(d0) do { s16x4 l0, l1, l2, l3, h0, h1, h2, h3; constexpr int b_ = VB * SHM_V + v_rd_off(d0, 0, 0);   \
        TRRD(l0, b_); TRRD(h0, b_ + 2048); TRRD(l1, b_ + 4096); TRRD(h1, b_ + 6144); TRRD(l2, b_ + 8192); TRRD(h2, b_ + 10240); TRRD(l3, b_ + 12288); TRRD(h3, b_ + 14336); \
        asm volatile("s_waitcnt lgkmcnt(0)" ::: "memory"); SBAR();                                                                    \
        o[d0] = __builtin_amdgcn_mfma_f32_32x32x16_bf16(pa0, (bf16x8){l0[0], l0[1], l0[2], l0[3], h0[0], h0[1], h0[2], h0[3]}, o[d0], 0, 0, 0);   \
        o[d0] = __builtin_amdgcn_mfma_f32_32x32x16_bf16(pa1, (bf16x8){l1[0], l1[1], l1[2], l1[3], h1[0], h1[1], h1[2], h1[3]}, o[d0], 0, 0, 0);   \
        o[d0] = __builtin_amdgcn_mfma_f32_32x32x16_bf16(pa2, (bf16x8){l2[0], l2[1], l2[2], l2[3], h2[0], h2[1], h2[2], h2[3]}, o[d0], 0, 0, 0);   \
        o[d0] = __builtin_amdgcn_mfma_f32_32x32x16_bf16(pa3, (bf16x8){l3[0], l3[1], l3[2], l3[3], h3[0], h3[1], h3[2], h3[3]}, o[d0], 0, 0, 0); } while (0)
    PV_D0(0); PV_D0(1); PV_D0(2); PV_D0(3);
#undef PV_D0
#undef TRRD
}
struct BlockRef { const bf16* Q; const bf16* K; const bf16* V; bf16* O; const float* A; int P0; };
struct Seam { bf16x8 qr[8]; unsigned qa; bf16x8 st_v0, st_v1, st_k0, st_k1; float ak[2][2]; };
#define VMW() asm volatile("s_waitcnt vmcnt(0)" ::: "memory")
#define VMWN(n) asm volatile("s_waitcnt vmcnt(%0)" :: "i"(n) : "memory")
#define LD8(p) (*reinterpret_cast<const bf16x8*>(p))
#define SLOAD_H(Kp, Vp, Ap, k0, AB) do { S.st_v0 = LD8((Vp) + (size_t)((k0) + sr) * VPITCH + sc); S.st_v1 = LD8((Vp) + (size_t)((k0) + 32 + sr) * VPITCH + sc);   \
                         S.st_k0 = LD8((Kp) + (size_t)((k0) + sr) * KPITCH + sc); S.st_k1 = LD8((Kp) + (size_t)((k0) + 32 + sr) * KPITCH + sc);                      \
                         S.ak[AB][0] = (Ap)[(k0) + r32]; S.ak[AB][1] = (Ap)[(k0) + 32 + r32]; } while (0)
#define SWRITE_HK(bf) do { *(bf16x8*)(K_lds + (bf) * SHM_K + kws) = S.st_k0; *(bf16x8*)(K_lds + (bf) * SHM_K + kws + 32 * 256) = S.st_k1; } while (0)
#define SWRITE_HV(bf) do { *(bf16x8*)(V_lds + (bf) * SHM_V + vst0) = S.st_v0; *(bf16x8*)(V_lds + (bf) * SHM_V + vst1) = S.st_v1; } while (0)
#define SWRITE_H(bf) do { SWRITE_HV(bf); SWRITE_HK(bf); } while (0)
#define QLOAD(R) do { _Pragma("unroll") for (int d0 = 0; d0 < 8; ++d0) S.qr[d0] = LD8((R).Q + (size_t)(wid * QBLK + r32) * KPITCH + d0 * 16 + hi * 8);   \
                      S.qa = split2((R).A[(R).P0 + wid * QBLK + r32] - (R).A[(R).P0]); } while (0)
__device__ __forceinline__ void block_prime(const BlockRef& cur, char* lds, Seam& S) {
    int tid = threadIdx.x; asm volatile("" : "+v"(tid));
    const int wid = __builtin_amdgcn_readfirstlane(tid >> 6), lane = tid & 63, r32 = lane & 31, hi = lane >> 5;
    const int sr = tid >> 4, sc = (tid & 15) * 8, kws = KSWZ(sr, sc * 2); char* K_lds = lds + 2 * SHM_V;
    QLOAD(cur);
    SLOAD_H(cur.K, cur.V, cur.A, 0, 0); VMW(); SWRITE_HK(0);
    __syncthreads();
}
__device__ __forceinline__ void block_run(const BlockRef& cur, char* lds, Seam& S) {
    int tid = threadIdx.x; asm volatile("" : "+v"(tid));
    const int wid = __builtin_amdgcn_readfirstlane(tid >> 6), lane = tid & 63, r32 = lane & 31, hi = lane >> 5;
    const int NT = (cur.P0 + QB - 1) / KVBLK + 1;
    const int qlo = cur.P0 + wid * QBLK, qm = qlo + r32 - 4 * hi;
    char* V_lds = lds; char* K_lds = lds + 2 * SHM_V;
    float* ws = (float*)(lds + 2 * SHM_V + 2 * SHM_K) + wid * 64; float* li_l = ws, * al_l = ws + 32;
    float m_reg = -1e30f, l_reg = 0; f32x16 o[4] = {};
    const int sr = tid >> 4, sc = (tid & 15) * 8, vst0 = v_st(sr, sc), vst1 = v_st(32 + sr, sc), kws = KSWZ(sr, sc * 2);
    const int vb0 = (int)(uintptr_t)V_lds + v_rd_base(lane);
    const bf16* Kh = cur.K; const bf16* Vh = cur.V; const float* Ah = cur.A; const float aref = cur.A[cur.P0];
#define RESC(a) do { if (__any((a) < 1.f)) { if (hi == 0) al_l[r32] = (a); asm volatile("s_waitcnt lgkmcnt(0)" ::: "memory");              \
                     for (int d_ = 0; d_ < 4; ++d_) for (int r = 0; r < 16; ++r) o[d_][r] *= al_l[crow(r, hi)]; } } while (0)
#define KBASE(t) ((t) * KVBLK)
#define MASKT(P0_, P1_, t) do { const int kb_ = KBASE(t); if (kb_ + KVBLK - 1 > qlo) mask_tile(P0_, P1_, qm - kb_); } while (0)
    f32x16 pA0, pA1, pB0, pB1; float mnA, mnB, alA, alB; bf16x8 pa0, pa1, pa2, pa3;
    SWRITE_HV(0); SBAR();
    const float a00 = S.ak[0][0], a01 = S.ak[0][1];
    if (NT > 1) SLOAD_H(Kh, Vh, Ah, KBASE(1), 1);
    SBAR(); qkt<0>(pA0, pA1, K_lds, r32, hi, S.qr, S.qa, a00, a01, aref);
    MASKT(pA0, pA1, 0); partialSM(pA0, pA1, m_reg, mnA, alA);
    if (NT > 1) { VMW(); SWRITE_H(1); }
    __syncthreads();
#define HALF_STEP(PX0, PX1, mnX, alX, PY0, PY1, alY, t, KB, VB, SB) do {                                                      \
        SBAR(); qkt<KB>(PX0, PX1, K_lds, r32, hi, S.qr, S.qa, S.ak[KB][0], S.ak[KB][1], aref);                                             \
        finishSM(PY0, PY1, alY, l_reg, pa0, pa1, pa2, pa3); SBAR();                                                           \
        if ((t) + 1 < NT) { SLOAD_H(Kh, Vh, Ah, KBASE((t) + 1), SB); SBAR(); }                                                \
        pv_tile<VB>(o, vb0, pa0, pa1, pa2, pa3); MASKT(PX0, PX1, (t)); partialSM(PX0, PX1, m_reg, mnX, alX);                  \
        __syncthreads();                                                                                                      \
        if ((t) + 1 < NT) { VMW(); SWRITE_H(SB); }                                                                            \
        RESC(alX); __syncthreads(); } while (0)
    for (int t = 1; t + 1 < NT; t += 2) {
        HALF_STEP(pB0, pB1, mnB, alB, pA0, pA1, alA, t, 1, 0, 0);
        HALF_STEP(pA0, pA1, mnA, alA, pB0, pB1, alB, t + 1, 0, 1, 1);
    }
    const bool even = (NT & 1) == 0;
    if (even) { SBAR(); qkt<1>(pB0, pB1, K_lds, r32, hi, S.qr, S.qa, S.ak[1][0], S.ak[1][1], aref); SBAR(); }
    finishSM(pA0, pA1, alA, l_reg, pa0, pa1, pa2, pa3); SBAR();
    pv_tile<0>(o, vb0, pa0, pa1, pa2, pa3);
    if (even) { MASKT(pB0, pB1, NT - 1); partialSM(pB0, pB1, m_reg, mnB, alB); __syncthreads(); RESC(alB);
        finishSM(pB0, pB1, alB, l_reg, pa0, pa1, pa2, pa3); SBAR(); pv_tile<1>(o, vb0, pa0, pa1, pa2, pa3); }
    if (hi == 0) li_l[r32] = l_reg; asm volatile("s_waitcnt lgkmcnt(0)" ::: "memory");
    float rli[16];
#pragma unroll
    for (int r = 0; r < 16; ++r) rli[r] = __builtin_amdgcn_rcpf(li_l[crow(r, hi)]);
    bf16* Ow = cur.O + (size_t)(wid * QBLK) * OPITCH;
#pragma unroll
    for (int r = 0; r < 16; ++r) { const int orow = crow(r, hi);
#pragma unroll
        for (int d0 = 0; d0 < 4; ++d0) { const float v = o[d0][r] * rli[r];
            const float vn = __shfl_xor(v, 1);
            if ((r32 & 1) == 0) *(unsigned*)(Ow + (size_t)orow * OPITCH + d0 * 32 + r32) = cvtpk(v, vn); } }
    __syncthreads();
#undef RESC
#undef KBASE
#undef MASKT
#undef HALF_STEP
}
#undef VMW
#undef VMWN
#undef LD8
#undef SLOAD_H
#undef SWRITE_HK
#undef SWRITE_HV
#undef SWRITE_H
#undef QLOAD
#undef KSWZ
#undef SBAR
}

__device__ __forceinline__ attn::BlockRef attn_ref(Frame& F, int a) {
    const int x = a >> 5, j = a & 31, bh = 4 * x + (j & 3), qb = j >> 2, b = bh >> 3, h = bh & 7;
    attn::BlockRef r;
    r.Q = WSP(bf16, WS_QN) + ((size_t)bh * SEQ + qb * 256) * AHD; r.K = WSP(bf16, WS_KN) + (size_t)bh * SEQ * AHD;
    r.V = WSP(bf16, WS_PROJ) + (size_t)(b * SEQ) * NP + O_V + h * AHD; r.O = WSP(bf16, WS_MIX) + (size_t)(b * SEQ + qb * 256) * DM + h * AHD;
    r.A = WSP(float, WS_ACUM) + (size_t)bh * SEQ; r.P0 = qb * 256; return r;
}
__device__ __forceinline__ void p3_attn(Frame& F) {
    char* lds = (char*)(F.lds + RING_OFF);
    if (F.G == 256) {
        const int j = F.vcu & 31;
        if (j < SSD_WPX) return;
        { const attn::BlockRef cur = attn_ref(F, F.vcu); attn::Seam S; attn::block_prime(cur, lds, S); attn::block_run(cur, lds, S); }
        if (j >= 8 && j < 8 + SSD_WPX) { const attn::BlockRef cur = attn_ref(F, F.vcu - 8); attn::Seam S; attn::block_prime(cur, lds, S); attn::block_run(cur, lds, S); }
        return;
    }
    for (int a = F.vcu; a < BATCH * AH * (SEQ / 256); a += F.G) {
        const attn::BlockRef cur = attn_ref(F, a);
        attn::Seam S;
        attn::block_prime(cur, lds, S);
        attn::block_run(cur, lds, S);
    }
}
namespace ssd {
__device__ __forceinline__ float dpp_scan64(float x) {
    float v = x;
#define SSD_DPP_ADD(ctrl, rowmask) do { const int t_ = __builtin_amdgcn_update_dpp(0, __builtin_bit_cast(int, v), (ctrl), (rowmask), 0xf, true); v += __builtin_bit_cast(float, t_); } while (0)
    SSD_DPP_ADD(0x111, 0xf); SSD_DPP_ADD(0x112, 0xf); SSD_DPP_ADD(0x114, 0xf); SSD_DPP_ADD(0x118, 0xf);
    SSD_DPP_ADD(0x142, 0xa); SSD_DPP_ADD(0x143, 0xc);
#undef SSD_DPP_ADD
    return v;
}
constexpr int CP = 136, TP = 72, YP = 68;
constexpr int L_CM = 0, L_BM = L_CM + 64 * CP * 2, L_BT = L_BM + 64 * CP * 2, L_XT = L_BT + 128 * TP * 2, L_XD = L_XT + 64 * TP * 2, L_H = L_XD + 64 * TP * 2,
              L_Y = L_H + 64 * CP * 2, L_XS = L_Y + 64 * YP * 4, L_ACS = L_XS + 64 * TP * 2, L_DT = L_ACS + 512  , L_DEC = L_DT + 512, L_SS = L_DEC + 512, L_Z = L_SS + 256, L_END = L_Z + 64 * TP * 2;
static_assert(L_END <= RING_BYTES, "ssd lds");
typedef LAS unsigned char* lptr;
__device__ __forceinline__ bf16x8 ld16(lptr p) { return *(const LAS bf16x8*)p; }
__device__ __forceinline__ void unit(Frame& F, int un, float* ssq_all) {
    const int b = un >> 4, h = un & 15, g = h >> 3;
    const int tid = TTID();
    const int lane = tid & 63, w = F.wave, r16 = lane & 15, q4 = lane >> 4, Lt = w >> 1;
    const int nrow = tid >> 3, np8 = (tid & 7) * 8;
    const int crow = tid >> 4, cc8 = (tid & 15) * 8;
    lptr L = F.lds + RING_OFF;
    const bf16* xc = WSP(bf16, WS_XCONV) + (size_t)(b * SEQ) * CONVCH;
    const bf16* pz = WSP(bf16, WS_PROJ) + (size_t)(b * SEQ) * NP + O_Z + h * SHD;
    const float* dtp = WSP(float, WS_DTV) + (size_t)(b * SEQ) * 16 + h; const float* dap = WSP(float, WS_DAV) + (size_t)(b * SEQ) * 16 + h;
    bf16* mixp = WSP(bf16, WS_MIX) + (size_t)(b * SEQ) * DM + AW + h * SHD;
    float* ssq = ssq_all + b * SEQ;
    const float dsk = F.d_skip[h];
    f32x4 Hacc[4];
#pragma unroll
    for (int i = 0; i < 4; ++i) Hacc[i] = (f32x4){0.f, 0.f, 0.f, 0.f};
    v4u cmA[2], bmA[2], xsA, zA, cmB[2], bmB[2], xsB, zB; float dtw = 0.f, daw = 0.f;
#define SSD_LOAD(c, CM, BM, XS, ZR) do { const size_t t0_ = (size_t)(c) * 64; \
        _Pragma("unroll") for (int i_ = 0; i_ < 2; ++i_) { CM[i_] = *(const v4u*)(xc + (t0_ + crow + 32 * i_) * CONVCH + SW + SG * SN + g * SN + cc8); BM[i_] = *(const v4u*)(xc + (t0_ + crow + 32 * i_) * CONVCH + SW + g * SN + cc8); } \
        XS = *(const v4u*)(xc + (t0_ + nrow) * CONVCH + h * SHD + np8); ZR = *(const v4u*)(pz + (t0_ + nrow) * NP + np8); } while (0)
#define SSD_SCAN(c) do { if (w == 0) { const float acs_ = dpp_scan64(daw);     \
        const float al_ = __builtin_bit_cast(float, __builtin_amdgcn_readlane(__builtin_bit_cast(int, acs_), 63)); \
        *(LAS float*)(L + L_ACS + (((c) & 1) * 64 + lane) * 4) = acs_; *(LAS float*)(L + L_DT + lane * 4) = dtw; *(LAS float*)(L + L_DEC + lane * 4) = __expf(al_ - acs_); \
        if ((c) + 1 < SEQ / 64) { dtw = dtp[(size_t)(((c) + 1) * 64 + lane) * 16]; daw = dap[(size_t)(((c) + 1) * 64 + lane) * 16]; } } } while (0)
    if (w == 0) { dtw = dtp[(size_t)lane * 16]; daw = dap[(size_t)lane * 16]; }
    SSD_LOAD(0, cmA, bmA, xsA, zA);
    SSD_LOAD(1, cmB, bmB, xsB, zB);
    SSD_SCAN(0);
    auto nat_store = [&](const v4u (&cm)[2], const v4u (&bm)[2], const v4u& xs, const v4u& zs) __attribute__((always_inline)) {
#pragma unroll
        for (int i = 0; i < 2; ++i) { *(LAS v4u*)(L + L_CM + ((crow + 32 * i) * CP + cc8) * 2) = cm[i]; *(LAS v4u*)(L + L_BM + ((crow + 32 * i) * CP + cc8) * 2) = bm[i]; }
        *(LAS v4u*)(L + L_XS + (nrow * TP + np8) * 2) = xs; *(LAS v4u*)(L + L_Z + (nrow * TP + np8) * 2) = zs; };
    nat_store(cmA, bmA, xsA, zA);
    SSD_LOAD(2, cmA, bmA, xsA, zA);
    auto chunk = [&](const int c, v4u (&cmX)[2], v4u (&bmX)[2], v4u& xsX, v4u& zsX) __attribute__((always_inline)) {
        lptr ACS = L + L_ACS + (c & 1) * 256;
        __syncthreads();
        if (c > 0 && w == 0) atomicAdd(ssq + (c - 1) * 64 + lane, *(const LAS float*)(L + L_SS + lane * 4));
        { const float dtl = *(const LAS float*)(L + L_DT + lane * 4), decl = *(const LAS float*)(L + L_DEC + lane * 4);
#pragma unroll
          for (int i = 0; i < 2; ++i) { const int c8 = 8 * (w + 8 * i); const v4u bm = *(const LAS v4u*)(L + L_BM + (lane * CP + c8) * 2);
              const unsigned ww[4] = {bm.x, bm.y, bm.z, bm.w};
#pragma unroll
              for (int j = 0; j < 4; ++j) { *(LAS bf16*)(L + L_BT + ((c8 + 2 * j) * TP + lane) * 2) = (bf16)(ww[j] & 0xffffu); *(LAS bf16*)(L + L_BT + ((c8 + 2 * j + 1) * TP + lane) * 2) = (bf16)(ww[j] >> 16); } }
          float xv[8]; unpack8(*(const LAS v4u*)(L + L_XS + (lane * TP + 8 * w) * 2), xv);
#pragma unroll
          for (int j = 0; j < 8; j += 2) { const float X0 = xv[j] * dtl, X1 = xv[j + 1] * dtl; const unsigned a = pk2(X0, X1), d = pk2(X0 * decl, X1 * decl);
              *(LAS bf16*)(L + L_XT + ((8 * w + j) * TP + lane) * 2) = (bf16)(a & 0xffffu); *(LAS bf16*)(L + L_XT + ((8 * w + j + 1) * TP + lane) * 2) = (bf16)(a >> 16);
              *(LAS bf16*)(L + L_XD + ((8 * w + j) * TP + lane) * 2) = (bf16)(d & 0xffffu); *(LAS bf16*)(L + L_XD + ((8 * w + j + 1) * TP + lane) * 2) = (bf16)(d >> 16); } }
        __syncthreads();
        bf16x8 cf[4];
#pragma unroll
        for (int ks = 0; ks < 4; ++ks) cf[ks] = ld16(L + L_CM + ((16 * Lt + r16) * CP + 32 * ks + 8 * q4) * 2);
        const float acs_l = *(const LAS float*)(ACS + (16 * Lt + r16) * 4);
        float Wv[4][4];
#pragma unroll
        for (int T = 0; T < 4; ++T) {
            f32x4 st = (f32x4){0.f, 0.f, 0.f, 0.f};
            if (T <= Lt) {
#pragma unroll
                for (int ks = 0; ks < 4; ++ks) st = __builtin_amdgcn_mfma_f32_16x16x32_bf16(ld16(L + L_BM + ((16 * T + r16) * CP + 32 * ks + 8 * q4) * 2), cf[ks], st, 0, 0, 0);
            }
            const f32x4 as4 = *(const LAS f32x4*)(ACS + (16 * T + 4 * q4) * 4);
#pragma unroll
            for (int r = 0; r < 4; ++r) { const int s = 16 * T + 4 * q4 + r, l = 16 * Lt + r16; Wv[T][r] = (T <= Lt && s <= l) ? st[r] * __expf(acs_l - as4[r]) : 0.f; }
        }
        bf16x8 Wf[2];
#pragma unroll
        for (int kp = 0; kp < 2; ++kp) { v4u t; t.x = pk2(Wv[2 * kp][0], Wv[2 * kp][1]); t.y = pk2(Wv[2 * kp][2], Wv[2 * kp][3]); t.z = pk2(Wv[2 * kp + 1][0], Wv[2 * kp + 1][1]); t.w = pk2(Wv[2 * kp + 1][2], Wv[2 * kp + 1][3]);
            Wf[kp] = __builtin_bit_cast(bf16x8, t); }
        const f32x4 al4 = *(const LAS f32x4*)(ACS + (16 * Lt + 4 * q4) * 4);
        const float alast = *(const LAS float*)(ACS + 63 * 4);
#pragma unroll
        for (int pp = 0; pp < 2; ++pp) { const int Pt = 2 * (w & 1) + pp;
            f32x4 yd = (f32x4){0.f, 0.f, 0.f, 0.f}, yo = (f32x4){0.f, 0.f, 0.f, 0.f};
#pragma unroll
            for (int kp = 0; kp < 2; ++kp) if (2 * kp <= Lt) {
                const v2u x0 = *(const LAS v2u*)(L + L_XT + ((16 * Pt + r16) * TP + 32 * kp + 4 * q4) * 2), x1 = *(const LAS v2u*)(L + L_XT + ((16 * Pt + r16) * TP + 32 * kp + 16 + 4 * q4) * 2);
                const v4u xb = {x0.x, x0.y, x1.x, x1.y};
                yd = __builtin_amdgcn_mfma_f32_16x16x32_bf16(Wf[kp], __builtin_bit_cast(bf16x8, xb), yd, 0, 0, 0); }
            if (c > 0) {
#pragma unroll
                for (int ks = 0; ks < 4; ++ks) yo = __builtin_amdgcn_mfma_f32_16x16x32_bf16(cf[ks], ld16(L + L_H + ((16 * Pt + r16) * CP + 32 * ks + 8 * q4) * 2), yo, 0, 0, 0); }
#pragma unroll
            for (int r = 0; r < 4; ++r) *(LAS float*)(L + L_Y + ((16 * Lt + 4 * q4 + r) * YP + 16 * Pt + r16) * 4) = yd[r] + __expf(al4[r]) * yo[r];
        }
        { const float dl = __expf(alast);
#pragma unroll
          for (int pt = 0; pt < 4; ++pt) Hacc[pt] = Hacc[pt] * dl;
#pragma unroll
          for (int ks = 0; ks < 2; ++ks) { const bf16x8 af = ld16(L + L_BT + ((16 * w + r16) * TP + 32 * ks + 8 * q4) * 2);
#pragma unroll
              for (int pt = 0; pt < 4; ++pt) Hacc[pt] = __builtin_amdgcn_mfma_f32_16x16x32_bf16(af, ld16(L + L_XD + ((16 * pt + r16) * TP + 32 * ks + 8 * q4) * 2), Hacc[pt], 0, 0, 0); } }
        __syncthreads();
#pragma unroll
        for (int pt = 0; pt < 4; ++pt) { v2u t; t.x = pk2(Hacc[pt][0], Hacc[pt][1]); t.y = pk2(Hacc[pt][2], Hacc[pt][3]); *(LAS v2u*)(L + L_H + ((16 * pt + r16) * CP + 16 * w + 4 * q4) * 2) = t; }
        SSD_SCAN(c + 1);
        { const f32x4 y0 = *(const LAS f32x4*)(L + L_Y + (nrow * YP + np8) * 4), y1 = *(const LAS f32x4*)(L + L_Y + (nrow * YP + np8 + 4) * 4);
          const v4u xs_ = *(const LAS v4u*)(L + L_XS + (nrow * TP + np8) * 2), zs_ = *(const LAS v4u*)(L + L_Z + (nrow * TP + np8) * 2);
          if (c + 1 < SEQ / 64) nat_store(cmX, bmX, xsX, zsX);
          if (c + 3 < SEQ / 64) SSD_LOAD(c + 3, cmX, bmX, xsX, zsX);
          float xv[8], zv[8], o[8]; unpack8(xs_, xv); unpack8(zs_, zv); const float yv[8] = {y0.x, y0.y, y0.z, y0.w, y1.x, y1.y, y1.z, y1.w}; float ss = 0.f;
#pragma unroll
          for (int j = 0; j < 8; ++j) { o[j] = (yv[j] + xv[j] * dsk) * siluf_(zv[j]); ss += o[j] * o[j]; }
          *(v4u*)(mixp + (size_t)(c * 64 + nrow) * DM + np8) = pack8f(o);
          ss += __shfl_xor(ss, 1); ss += __shfl_xor(ss, 2); ss += __shfl_xor(ss, 4);
          if ((tid & 7) == 0) *(LAS float*)(L + L_SS + nrow * 4) = ss; }
    };
    for (int c = 0; c < SEQ / 64; c += 2) { chunk(c, cmB, bmB, xsB, zB); chunk(c + 1, cmA, bmA, xsA, zA); }
    __syncthreads();
    if (w == 0) atomicAdd(ssq + (SEQ / 64 - 1) * 64 + lane, *(const LAS float*)(L + L_SS + lane * 4));
    __syncthreads();
#undef SSD_LOAD
#undef SSD_SCAN
}
}
__device__ __forceinline__ void p3_ssd(Frame& F, float* ssq_all) {
    if (F.G == 256) {
        const int j = F.vcu & 31, x = F.vcu >> 5;
        if (j < SSD_WPX) for (int u = j; u < 8; u += SSD_WPX) ssd::unit(F, x * 8 + u, ssq_all);
        return;
    }
    for (int a = F.vcu; a < 256; a += F.G) { const int j = a & 31; if (j < 8) ssd::unit(F, (a >> 5) * 8 + j, ssq_all); }
}
constexpr int NPH = 10;
struct Args { const float* in[22]; float* out; unsigned char* ws; int ph_lo, ph_hi; };
__global__ void __launch_bounds__(NTHR, 2) mk_fwd(Args args) {
    extern __shared__ __attribute__((aligned(16))) unsigned char lds[];
    Frame F;
    F.lds = (LAS unsigned char*)lds;
    F.MISC = (volatile LAS unsigned*)(F.lds + MISC_OFF);
    F.wave = __builtin_amdgcn_readfirstlane(threadIdx.x >> 6);
    F.G = gridDim.x; { const int bx = blockIdx.x; F.vcu = (F.G % 8 == 0) ? (bx % 8) * (F.G / 8) + bx / 8 : bx; }
    F.ws = args.ws; F.ctl = (gu32*)(args.ws + WS_CTL); F.out = args.out;
    F.x = args.in[0]; F.g1 = args.in[1]; F.w_in = args.in[2]; F.fbias = args.in[3]; F.gq = args.in[4]; F.gk = args.in[5]; F.conv_w = args.in[6]; F.conv_b = args.in[7];
    F.dt_bias = args.in[8]; F.a_log = args.in[9]; F.d_skip = args.in[10]; F.ssd_g = args.in[11]; F.w_out = args.in[12]; F.g2 = args.in[13]; F.w_router = args.in[14]; F.b_router = args.in[15];
    F.w_gate = args.in[16]; F.b_gate = args.in[17]; F.w_up = args.in[18]; F.b_up = args.in[19]; F.w_down = args.in[20]; F.b_down = args.in[21];
    for (int u = threadIdx.x; u < (LDS_BYTES - LDSCTL_OFF) / 4; u += NTHR) ((LAS unsigned*)(F.lds + LDSCTL_OFF))[u] = 0u;
    __syncthreads();
    const int lo = args.ph_lo, hi = args.ph_hi;
    XcdBarrier bar; bar.bar = (unsigned*)(F.ctl + CW_BAR); bar.x = 0; bar.st = nullptr;
    if (hi - lo > 1) bar = xcd_barrier_post((unsigned*)(F.ctl + CW_BAR), F.MISC);
#define IN(k) (lo <= (k) && (k) < hi)
#ifndef PROBE_REPEAT
#define PROBE_REPEAT 0
#endif
#define REP(k) for (int rep_ = 0; rep_ < (((PROBE_REPEAT >> (k)) & 1) ? 2 : 1); ++rep_)
#if PROBE_T
#define STAMP(i) do { if (blockIdx.x == 0 && threadIdx.x == 0) { const unsigned long long t_ = __builtin_amdgcn_s_memrealtime(); __hip_atomic_store(F.ctl + CW_PROBE + 16 + 2 * (i), (unsigned)t_, RLX_AGENT); __hip_atomic_store(F.ctl + CW_PROBE + 17 + 2 * (i), (unsigned)(t_ >> 32), RLX_AGENT); } } while (0)
#else
#define STAMP(i) do { } while (0)
#endif
#define SEAM(k) do { if (IN(k) && IN((k) + 1)) xcd_barrier(bar); STAMP((k) + 1); } while (0)

    const bool roles = BG_POOL && F.G == 256;
    const int xc = F.vcu >> 5, jr = F.vcu & 31;
    constexpr int NC1 = NC1_CFG, NC5 = NC5_CFG, NC7 = NC7_CFG;
    const bool conv1 = roles && jr >= 32 - NC1, conv5 = roles && jr >= 32 - NC5, conv7 = roles && jr >= 32 - NC7;
    const int G5 = roles ? 8 * (32 - NC5) : F.G, c5s = roles ? jr * 8 + xc : (int)blockIdx.x;
    const int G1 = roles ? 8 * (32 - NC1) : F.G, c1s = roles ? jr * 8 + xc : (int)blockIdx.x;
    const int G7 = roles ? 8 * (32 - NC7) : F.G, c7m = roles ? xc * (32 - NC7) + jr : F.vcu;
    bool pool_open = BG_POOL && !CONV_IN_P0 && PEEK_CFG;
#define BG_PEEK() do { if (PEEK_CFG && pool_open) pool_open = bg_peek_open(F); } while (0)
#define BG_FILL(k, lim) do { if (BG_POOL && !CONV_IN_P0 && IN((k) + 1) && ((k) == 1 || !PEEK_CFG || pool_open)) bg_fill(F, (k), (lim)); } while (0)

    STAMP(0);
    if (IN(0)) REP(0) { p0_prologue(F); if (CONV_IN_P0) (void)bg_finish(F, POOL_ALL); SEAM(0); }

    if (IN(1)) REP(1) {
        if (!conv1) {
        typedef OrderStaticT<(NSPLIT_CFG != 0)> Ord1;
        Ord1 S; S.init(NTOK, NP, G1, c1s, WSP(bf16, WS_XN), WSP(bf16, WS_WIN));
        EpiProj E{WSP(bf16, WS_PROJ), NP};
        pg8::gemm_phase<EpiProj, Ord1, false, (ALIGN_EPI_CFG & 1) != 0>(F.lds + RING_OFF, S, E);
        }
        BG_FILL(1, POOL_ALL);
        SEAM(1);
    }
    if (IN(2)) REP(2) { BG_PEEK(); p2_post(F); if (FIN2_CFG && BG_POOL) (void)bg_finish(F, POOL_ALL); SEAM(2); }
    if (IN(3)) {
#if NAIVE_ATTN
        p3_attn_naive(F);
#else
        p3_attn(F);
#endif
        __syncthreads();
#if NAIVE_SSD
        p3_ssd_naive(F);
#elif !SPLIT_P3
        p3_ssd(F, (float*)(F.ctl + CW_SSQ));
#endif
#if PROBE_P3
        __syncthreads(); p3_attn(F); __syncthreads(); p3_ssd(F, WSP(float, WS_YSLOT));
#endif
        BG_FILL(3, POOL_ALL);
        SEAM(3);
    }
#if SPLIT_P3
    if (IN(4)) { p3_ssd(F, (float*)(F.ctl + CW_SSQ)); SEAM(4); }
#endif
    if (!FUSE_P4 && IN(4)) { p4_ssdnorm(F); SEAM(4); }
    if (IN(5)) BG_PEEK();
    if (IN(5)) REP(5) {
        if (!conv5) {
        OrderStatic S; S.init(NTOK, DM, G5, c5s, WSP(bf16, WS_MIX), WSP(bf16, WS_WOUT));
        EpiRes E{F.x, H_BF16 ? WSP(float, WS_H) : F.out, F.ctl + CW_SSQ};
        pg8::gemm_phase<EpiRes, OrderStatic, false, false>(F.lds + RING_OFF, S, E);
        }
        BG_FILL(5, POOL_ALL);
        SEAM(5);
    }
    if (IN(6)) { BG_PEEK(); p6_router(F); if (BG_POOL && (!PEEK_CFG || pool_open)) (void)bg_finish(F, POOL_GU); SEAM(6); }
    constexpr int MOE_RB = FP8_MOE ? 2048 : 4096;
    if (IN(7)) BG_PEEK();
    if (IN(7)) REP(7) {
        if (!conv7) {
        moe_tables(F);
        const LAS int* TB = (const LAS int*)(F.lds + TB_OFF);
        typedef OrderMoe<16, true, MOE_RB> Ord;
        Ord S; S.init(G7, c7m, TB, TB + 64, TLANE(), WSP(char, WS_XN), WSP(char, WS_WGU), (size_t)4096 * MOE_RB, WSP(int, WS_STOK), F.ctl + CW_MOEQ, (volatile LAS int*)(F.lds + BGW_OFF) + 4, DYN_MOE && G7 == 256);
        S.xprobe = (const char*)F.w_down;
        EpiGlu E{WSP(void, WS_ACT), F.b_gate, F.b_up};
        pg8::gemm_phase<EpiGlu, Ord, true, (ALIGN_EPI_CFG & 2) != 0, FP8_MOE != 0>(F.lds + RING_OFF, S, E);
        }
        BG_FILL(7, POOL_ALL);
        if (BG_POOL && (!PEEK_CFG || pool_open)) (void)bg_finish(F, POOL_ALL);
        SEAM(7);
    }
    if (IN(8)) REP(8) {
        moe_tables(F);
        const LAS int* TB = (const LAS int*)(F.lds + TB_OFF);
        typedef OrderMoe<8, false, MOE_RB> Ord;
        Ord S; S.init(F.G, F.vcu, TB, TB + 64, TLANE(), WSP(char, WS_ACT), WSP(char, WS_WD), (size_t)2048 * MOE_RB, WSP(int, WS_STOK), F.ctl + CW_MOEQ + 64 * 8, (volatile LAS int*)(F.lds + BGW_OFF) + 4, DYN_MOE && F.G == 256);
        S.xprobe = nullptr;
        EpiDown E{WSP(bf16, WS_YSLOT), F.b_down, WSP(float, WS_SGATE), WSP(int, WS_SDEST)};
        pg8::gemm_phase<EpiDown, Ord, false, (ALIGN_EPI_CFG & 4) != 0, FP8_MOE != 0>(F.lds + RING_OFF, S, E);
        SEAM(8);
    }
#if PROBE_T
    if (blockIdx.x == 0 && threadIdx.x == 0) {
        const unsigned a0_ = __hip_atomic_load(F.ctl + CW_PROBE + 16 + 2 * PROBE_KA, RLX_AGENT), a1_ = __hip_atomic_load(F.ctl + CW_PROBE + 16 + 2 * (PROBE_KA + 1), RLX_AGENT);
        const unsigned b0_ = __hip_atomic_load(F.ctl + CW_PROBE + 16 + 2 * PROBE_KB, RLX_AGENT), b1_ = __hip_atomic_load(F.ctl + CW_PROBE + 16 + 2 * (PROBE_KB + 1), RLX_AGENT);
        const float ua = (float)(a1_ - a0_) * 0.01f, ub = (float)(b1_ - b0_) * 0.01f;
        __hip_atomic_store(F.ctl + CW_PROBE, __builtin_bit_cast(unsigned, ua * PROBE_GA), RLX_AGENT); __hip_atomic_store(F.ctl + CW_PROBE + 1, __builtin_bit_cast(unsigned, 100.f + ub), RLX_AGENT); }
    xcd_barrier(bar);
#endif
    if (IN(9)) { p9_combine(F); }
#undef IN
#undef SEAM
}

extern "C" void kernel_launch(void* const* d_in, const int* in_sizes, int n_in, void* d_out, int out_size, void* d_ws, size_t ws_size, hipStream_t stream) {
    static int grid = 0;
    if (grid == 0) {
        if (n_in != 22 || in_sizes[0] != NTOK * DM || out_size != NTOK * DM || ws_size < WS_END) { fprintf(stderr, "kernel_launch: unexpected shapes (n_in %d, in0 %d, out %d, ws %zu)\n", n_in, n_in > 0 ? in_sizes[0] : -1, out_size, ws_size); grid = -1; return; }
        int dev = 0, cus = 0, per_cu = 0;
        if (hipGetDevice(&dev) != hipSuccess || hipDeviceGetAttribute(&cus, hipDeviceAttributeMultiprocessorCount, dev) != hipSuccess) { grid = -1; return; }
        if (hipFuncSetAttribute((const void*)mk_fwd, hipFuncAttributeMaxDynamicSharedMemorySize, LDS_BYTES) != hipSuccess) { fprintf(stderr, "kernel_launch: hipFuncSetAttribute failed\n"); grid = -1; return; }
        if (hipOccupancyMaxActiveBlocksPerMultiprocessor(&per_cu, (const void*)mk_fwd, NTHR, LDS_BYTES) != hipSuccess || per_cu < 1) { fprintf(stderr, "kernel_launch: occupancy query says %d blocks per CU\n", per_cu); }
        (void)hipGetLastError();
        grid = cus;
    }
    if (grid < 0) return;
    (void)hipMemsetAsync((char*)d_ws + WS_CTL, 0, CTL_ZERO_BYTES, stream);
    Args a{};
    for (int i = 0; i < 22; ++i) a.in[i] = (const float*)d_in[i];
    a.out = (float*)d_out; a.ws = (unsigned char*)d_ws;
#if MK_N_LAUNCHES == 1
    a.ph_lo = 0; a.ph_hi = NPH;
    hipLaunchKernelGGL(mk_fwd, dim3(grid), dim3(NTHR), LDS_BYTES, stream, a);
#else
    for (int p = 0; p < NPH; ++p) { a.ph_lo = p; a.ph_hi = p + 1; hipLaunchKernelGGL(mk_fwd, dim3(grid), dim3(NTHR), LDS_BYTES, stream, a); }
#endif
}
```

```cpp
#include <hip/hip_runtime.h>
#define MK_N_LAUNCHES 1
#define NAIVE_ATTN 0
#define NAIVE_SSD 0
#define FP8_MOE 1
#define NC1_CFG 18
#define NC5_CFG 0
#define NC7_CFG 0
#define SSD_WPX 8
#define YSLOT_FP8 1
#include <cstdio>
#include <cstdint>

#ifndef MK_N_LAUNCHES
#define MK_N_LAUNCHES 1
#endif
#ifndef NAIVE_ATTN
#define NAIVE_ATTN 1
#endif
#ifndef NAIVE_SSD
#define NAIVE_SSD 1
#endif

#define GAS __attribute__((address_space(1)))
#define LAS __attribute__((address_space(3)))
typedef unsigned short bf16;
typedef unsigned v4u __attribute__((ext_vector_type(4)));
typedef unsigned v2u __attribute__((ext_vector_type(2)));
typedef float f32x4 __attribute__((ext_vector_type(4)));
typedef float f32x2 __attribute__((ext_vector_type(2)));
typedef short bf16x8 __attribute__((ext_vector_type(8)));
typedef GAS unsigned gu32;
#define RLX_AGENT __ATOMIC_RELAXED, __HIP_MEMORY_SCOPE_AGENT
#define LDS_WAIT() asm volatile("s_waitcnt lgkmcnt(0)" ::: "memory")
#define VM_WAIT() asm volatile("s_waitcnt vmcnt(0)" ::: "memory")

constexpr int BATCH = 4, SEQ = 2048, DM = 2048, NTOK = BATCH * SEQ;
constexpr int AH = 8, AHD = 128, AW = AH * AHD;
constexpr int SW = 1024, SHD = 64, SH = 16, SG = 2, SN = 128, CONVCH = SW + 2 * SG * SN;
constexpr int NE = 32, TOPK = 4, DFF = 2048;
constexpr int INCOLS = 5656, NP = 5888;
constexpr int O_Q = 0, O_K = 1024, O_V = 2048, O_F = 3072, O_Z = 3080, O_XBC = 4104, O_DT = 5640;
constexpr float EPS = 1e-6f, SW_ALPHA = 1.702f, SW_LIMIT = 7.0f;
constexpr float LOG2E = 1.4426950408889634f;
constexpr float QSCALE = 0.08838834764831845f * LOG2E;
constexpr int SLOTCAP = NTOK;
constexpr int MAXMT = (NTOK * TOPK) / 256 + NE;

constexpr size_t MiB = 1u << 20;
constexpr size_t WS_CTL = 0, CTL_ZERO_BYTES = 1 * MiB;
constexpr size_t WS_WIN = 1 * MiB;
constexpr size_t WS_WOUT = 24 * MiB;
constexpr size_t WS_WR = 32 * MiB;
constexpr size_t WS_ACUM = 33 * MiB;
constexpr size_t WS_DTV = 34 * MiB, WS_DAV = 35 * MiB;
constexpr size_t WS_STOK = 36 * MiB, WS_SGATE = 37 * MiB, WS_SDEST = 38 * MiB;
constexpr size_t WS_XN = 40 * MiB;
constexpr size_t WS_PROJ = 72 * MiB;
constexpr size_t WS_H = WS_PROJ;
constexpr size_t WS_QN = 164 * MiB, WS_KN = 180 * MiB;
constexpr size_t WS_XCONV = 196 * MiB;
constexpr size_t WS_MIX = 220 * MiB;
constexpr size_t WS_ACT = 252 * MiB;
constexpr size_t WS_YSLOT = 412 * MiB;
constexpr size_t WS_WGU = 540 * MiB;
constexpr size_t WS_WD = 1052 * MiB;
constexpr size_t WS_END = 1308 * MiB;
constexpr int CW_BAR = 4096;
constexpr int CW_HEAD = 8192;
constexpr int CW_DONE = 8192 + 64;
constexpr int CW_PROBE = 12288;
constexpr int CW_MOEQ = 10240;
constexpr int CW_CNT = 16384;
constexpr int CW_SSQ = 32768;
static_assert((CW_SSQ + NTOK) * 4 <= (int)CTL_ZERO_BYTES, "ctl");

constexpr int RING_OFF = 0, RING_BYTES = 131072;
constexpr int LDSCTL_OFF = RING_BYTES;
constexpr int MISC_OFF = LDSCTL_OFF;
constexpr int BGW_OFF = LDSCTL_OFF + 64;
constexpr int TB_OFF = LDSCTL_OFF + 256;
constexpr int DMA_T_OFF = LDSCTL_OFF + 1024;
constexpr int LDS_BYTES = 163840 - 8192;
constexpr int NWAVES = 8, NTHR = 512;

__device__ __forceinline__ unsigned f2bf(float f) { unsigned u = __builtin_bit_cast(unsigned, f); return (u + 0x7fffu + ((u >> 16) & 1u)) >> 16; }
__device__ __forceinline__ unsigned pk2(float lo, float hi) { unsigned r; asm volatile("v_cvt_pk_bf16_f32 %0, %1, %2" : "=v"(r) : "v"(lo), "v"(hi)); return r; }
__device__ __forceinline__ float bf2f(unsigned h) { return __builtin_bit_cast(float, h << 16); }
__device__ __forceinline__ float bflo(unsigned w) { return __builtin_bit_cast(float, w << 16); }
__device__ __forceinline__ float bfhi(unsigned w) { return __builtin_bit_cast(float, w & 0xffff0000u); }
__device__ __forceinline__ float wave_sum(float v) {
#pragma unroll
    for (int o = 1; o < 64; o <<= 1) v += __shfl_xor(v, o);
    return v;
}
__device__ __forceinline__ float wave_max(float v) {
#pragma unroll
    for (int o = 1; o < 64; o <<= 1) v = fmaxf(v, __shfl_xor(v, o));
    return v;
}
#ifndef NC1_CFG
#define NC1_CFG 9
#endif
#ifndef NC5_CFG
#define NC5_CFG 16
#endif
#ifndef NC7_CFG
#define NC7_CFG 3
#endif
#ifndef SSD_WPX
#define SSD_WPX 4
#endif
#ifndef PROBE_P3
#define PROBE_P3 0
#endif
#ifndef CONV_IN_P0
#define CONV_IN_P0 0
#endif
#ifndef PROBE_T
#define PROBE_T 0
#endif
#ifndef PROBE_KA
#define PROBE_KA 0
#endif
#ifndef PROBE_KB
#define PROBE_KB 1
#endif
#ifndef PROBE_GA
#define PROBE_GA 0.001f
#endif
#ifndef HALF_LAST
#define HALF_LAST 0
#endif
#ifndef CONV_NTS
#define CONV_NTS 1
#endif
#ifndef CONV_NT
#define CONV_NT 1
#endif
#ifndef DYN_MOE
#define DYN_MOE 0
#endif
#ifndef HALF_UNITS_CFG
#define HALF_UNITS_CFG 1
#endif
#ifndef YSLOT_FP8
#define YSLOT_FP8 0
#endif
#ifndef CONV_DMA
#define CONV_DMA 0
#endif
#ifndef BGB_CFG
#define BGB_CFG 4
#endif
#ifndef CONV_WG
#define CONV_WG 1
#endif
#ifndef CONV_PIPE
#define CONV_PIPE 0
#endif
#ifndef BG_POOL
#define BG_POOL 1
#endif
#ifndef FP8_MOE
#define FP8_MOE 1
#endif
#ifndef H_BF16
#define H_BF16 1
#endif
#ifndef PEEK_CFG
#define PEEK_CFG 1
#endif
#ifndef NSPLIT_CFG
#define NSPLIT_CFG 1
#endif
#ifndef ALIGN_EPI_CFG
#define ALIGN_EPI_CFG 7
#endif
#ifndef P9_NTS
#define P9_NTS 0
#endif
#ifndef SPLIT_P3
#define SPLIT_P3 0
#endif
#ifndef FUSE_P4
#define FUSE_P4 1
#endif
#ifndef PROBE_EPI2
#define PROBE_EPI2 0
#endif
#ifndef LOOSE_EPI_WAIT
#define LOOSE_EPI_WAIT 0
#endif
#ifndef FIN2_CFG
#define FIN2_CFG 0
#endif
#ifndef PROBE_KLD
#define PROBE_KLD 0
#endif
#ifndef EMU_IN8
#define EMU_IN8 0
#endif
#ifndef EMU_OUT8
#define EMU_OUT8 0
#endif
#ifndef EMU_FP8
#define EMU_FP8 0
#endif
__device__ __forceinline__ unsigned pk4_fp8(float a, float b, float c, float d) { int p = __builtin_amdgcn_cvt_pk_fp8_f32(a, b, 0, false); p = __builtin_amdgcn_cvt_pk_fp8_f32(c, d, p, true); return (unsigned)p; }
typedef short v2s_ __attribute__((ext_vector_type(2)));
#ifndef CVT_SCALE
#define CVT_SCALE 0.015625f
#endif
__device__ __forceinline__ unsigned pk4_fp8_x64(float a, float b, float c, float d) { v2s_ o = {0, 0}; o = __builtin_amdgcn_cvt_scalef32_pk_fp8_f32(o, a, b, CVT_SCALE, false); o = __builtin_amdgcn_cvt_scalef32_pk_fp8_f32(o, c, d, CVT_SCALE, true); return __builtin_bit_cast(unsigned, o); }
__device__ __forceinline__ float q8(float x) { return __builtin_amdgcn_cvt_f32_fp8(__builtin_amdgcn_cvt_pk_fp8_f32(x, x, 0, false), 0); }
__device__ __forceinline__ float sigmoidf_(float x) { return 1.f / (1.f + __expf(-x)); }
template <int CTRL> __device__ __forceinline__ float dpp_f(float v) { return __builtin_bit_cast(float, __builtin_amdgcn_update_dpp(0, __builtin_bit_cast(int, v), CTRL, 0xf, 0xf, true)); }
template <int CTRL> __device__ __forceinline__ int dpp_i(int v) { return __builtin_amdgcn_update_dpp(0, v, CTRL, 0xf, 0xf, true); }
__device__ __forceinline__ float siluf_(float x) { return x * __builtin_amdgcn_rcpf(1.f + __expf(-x)); }
__device__ __forceinline__ float softplusf_(float x) { return fmaxf(x, 0.f) + log1pf(__expf(-fabsf(x))); }

#define XB_TMO      128
#define XB_XCNT(j)  (256  + 64 * (j))
#define XB_XSUB(j)  (1280 + 64 * (j))
#define XB_XGEN(j)  (2304 + 64 * (j))
#define XB_TOP      3328
#define XB_TOPGEN   3392
#define XCD_BAR_WORDS 3456
#define XB_SPIN_CAP (1u << 18)

__device__ __forceinline__ unsigned xb_ld(unsigned* p)              { return __hip_atomic_load(p, __ATOMIC_RELAXED, __HIP_MEMORY_SCOPE_AGENT); }
__device__ __forceinline__ unsigned xb_add(unsigned* p, unsigned v) { return __hip_atomic_fetch_add(p, v, __ATOMIC_RELAXED, __HIP_MEMORY_SCOPE_AGENT); }
__device__ __forceinline__ unsigned xb_xcc_id() { return (unsigned)__builtin_amdgcn_s_getreg((3 << 11) | 20) & 0xFu; }
#define XB_SPIN(cond, bar) do { unsigned _sp = 0; while (cond) { __builtin_amdgcn_s_sleep(1); \
    if ((++_sp & 255u) == 0u) { if (xb_ld(&(bar)[XB_TMO])) break; if (_sp > XB_SPIN_CAP) { atomicAdd(&(bar)[XB_TMO], 1u); break; } } } } while (0)

struct XcdBarrier {
    unsigned* bar; unsigned x;
    volatile LAS unsigned* st;
};
__device__ __forceinline__ XcdBarrier xcd_barrier_post(unsigned* bar, volatile LAS unsigned* st) {
    XcdBarrier b; b.bar = bar; b.x = xb_xcc_id(); b.st = st;
    if (threadIdx.x == 0) (void)xb_add(&bar[XB_XCNT(b.x)], 1u);
    return b;
}
__device__ __forceinline__ void xcd_barrier_complete(unsigned* bar, unsigned x, unsigned& nloc, unsigned& nx) {
    const unsigned G = gridDim.x * gridDim.y * gridDim.z;
    unsigned sum, cnt, mine, sp = 0u;
    for (;;) {
        sum = 0u; cnt = 0u; mine = 0u;
#pragma unroll
        for (unsigned j = 0; j < 16; ++j) { const unsigned c = xb_ld(&bar[XB_XCNT(j)]); sum += c; cnt += (c > 0u) ? 1u : 0u; mine = (j == x) ? c : mine; }
        if (sum == G) break;
        __builtin_amdgcn_s_sleep(1);
        if ((++sp & 255u) == 0u) { if (xb_ld(&bar[XB_TMO])) break; if (sp > XB_SPIN_CAP) { atomicAdd(&bar[XB_TMO], 1u); break; } }
    }
    nloc = mine > 0u ? mine : 1u; nx = cnt > 0u ? cnt : 1u;
}
__device__ __forceinline__ void xcd_barrier(const XcdBarrier& b) {
    asm volatile("s_waitcnt vmcnt(0)" ::: "memory");
    __syncthreads();
    if (threadIdx.x == 0) {
        unsigned* bar = b.bar;
        __builtin_amdgcn_s_waitcnt(0);
        unsigned nloc = b.st[0], nx = b.st[1];
        if (nloc == 0u) { xcd_barrier_complete(bar, b.x, nloc, nx); b.st[0] = nloc; b.st[1] = nx; }
        const unsigned old = xb_add(&bar[XB_XSUB(b.x)], 1u);
        const unsigned gen = old / nloc;
        if (old + 1u == (gen + 1u) * nloc) {
            __builtin_amdgcn_fence(__ATOMIC_RELEASE, "agent");
            asm volatile("s_waitcnt vmcnt(0)" ::: "memory");
            const unsigned og = xb_add(&bar[XB_TOP], 1u);
            const unsigned tg = og / nx;
            if (og + 1u == (tg + 1u) * nx) xb_add(&bar[XB_TOPGEN], 1u);
            else XB_SPIN(xb_ld(&bar[XB_TOPGEN]) == tg, bar);
            __builtin_amdgcn_fence(__ATOMIC_ACQUIRE, "agent");
            xb_add(&bar[XB_XGEN(b.x)], 1u);
            asm volatile("s_waitcnt vmcnt(0)" ::: "memory");
        } else {
            XB_SPIN(xb_ld(&bar[XB_XGEN(b.x)]) == gen, bar);
            __builtin_amdgcn_fence(__ATOMIC_ACQUIRE, "agent");
            asm volatile("s_waitcnt vmcnt(0)" ::: "memory");
        }
    }
    __syncthreads();
}
#ifndef B_NT_CFG
#define B_NT_CFG 0
#endif
#ifndef FP8_DIAG
#define FP8_DIAG 0
#endif
#ifndef FP8_NOSCALE
#define FP8_NOSCALE 0
#endif
namespace pg8 {
#define PG8_LAS __attribute__((address_space(3)))
typedef unsigned short bf16_t;
typedef short bf16x8 __attribute__((ext_vector_type(8)));
typedef float f32x4 __attribute__((ext_vector_type(4)));
typedef unsigned u32x4 __attribute__((ext_vector_type(4)));
constexpr int BM = 256, BK = 64, HALF = 128, HTB = HALF * BK * 2  , STAGE_BYTES = 8 * HTB, NXCD = 8, WGM = 8;
constexpr int GK = 2048;
typedef int i32x8 __attribute__((ext_vector_type(8)));
typedef int i32x4_ __attribute__((ext_vector_type(4)));

__host__ __device__ __forceinline__ int lds_byte(int r, int c) { const int st = (r >> 4) * 2 + (c >> 5), rr = r & 15, cc = c & 31, ob = rr * 64 + cc * 2; return st * 1024 + (ob ^ (((ob >> 9) & 1) << 5)); }
__host__ __device__ __forceinline__ void stage_rc(int b, int& R, int& C) { const int st = b / 1024, sb = b % 1024, swz = sb ^ (((sb >> 9) & 1) << 5); R = (st >> 1) * 16 + swz / 64; C = (st & 1) * 32 + (swz % 64) / 2; }
__host__ __device__ __forceinline__ int perm32(int rho) { const int n = rho >> 4, i = rho & 15; return 8 * (i >> 2) + 4 * n + (i & 3); }

struct Unit { int pm, pn, e, mt, nrows, nh, rh, roff; };

__device__ __forceinline__ unsigned cvt_pk_bf16(float lo, float hi) { unsigned r; asm volatile("v_cvt_pk_bf16_f32 %0, %1, %2" : "=v"(r) : "v"(lo), "v"(hi)); return r; }

template <class Epi, class Sched, bool GATHER, bool ALIGN_EPI, bool FP8 = false>
__device__ __forceinline__ void gemm_phase(PG8_LAS unsigned char* lds, const Sched& S, const Epi& E) {
    const int tid = threadIdx.x, wid = __builtin_amdgcn_readfirstlane(tid >> 6), lane = tid & 63, wr = wid >> 2, wc = wid & 3, fr = lane & 15, fq = lane >> 4;
    constexpr int K = FP8 ? GK / 2 : GK, nt = K / BK;
    unsigned vB[2]; int Ri[2], Ci[2];
#pragma unroll
    for (int i = 0; i < 2; ++i) { int R, C; stage_rc(tid * 16 + i * 8192, R, C); const int Rb = Epi::PERM ? ((R & ~31) + perm32(R & 31)) : R;
        vB[i] = Sched::B_BLOCKED ? (unsigned)(Rb * BK + C) * 2u : (unsigned)(Rb * K + C) * 2u; Ri[i] = R; Ci[i] = C; }
    constexpr unsigned kstep = (unsigned)(BK * 2);
    constexpr unsigned hstepB = Sched::B_BLOCKED ? (unsigned)HALF * BK * 2 : (unsigned)HALF * K * 2;
    const unsigned kstepB = Sched::B_BLOCKED ? S.b_kstep() : kstep;
    const char* const rA = (const char*)S.a_base(); const char* const rB = (const char*)S.b_base();
    const unsigned ldsw = (unsigned)wid * 1024u;
    const int aoff = lds_byte(wr * 64 + fr, fq * 8), boff = lds_byte(wc * 32 + fr, fq * 8);
#define PG8_SA(b, h) (((b) * 2 + (h)) * HTB)
#define PG8_SB(b, h) ((4 + (b) * 2 + (h)) * HTB)
#define PG8_STAGE(bufoff, gbase, soff, voff) do { _Pragma("unroll") for (int _i = 0; _i < 2; ++_i) { \
        if (FP8 && B_NT_CFG && (bufoff) >= 4 * HTB) __builtin_amdgcn_global_load_lds((const unsigned*)((gbase) + (size_t)(soff) + (voff)[_i]), (PG8_LAS unsigned*)(lds + (bufoff) + ldsw + _i * 8192), 16, 0, 2); \
        else __builtin_amdgcn_global_load_lds((const unsigned*)((gbase) + (size_t)(soff) + (voff)[_i]), (PG8_LAS unsigned*)(lds + (bufoff) + ldsw + _i * 8192), 16, 0, 0); } } while (0)
#define PG8_LDA(dst, b, h) do { _Pragma("unroll") for (int m = 0; m < 4; ++m) { dst[m].lo = *(const PG8_LAS i32x4_*)(lds + PG8_SA(b, h) + aoff + m * 2048); dst[m].hi = *(const PG8_LAS i32x4_*)(lds + PG8_SA(b, h) + aoff + m * 2048 + 1024); } } while (0)
#define PG8_LDB(dst, b, h) do { _Pragma("unroll") for (int n = 0; n < 2; ++n) { dst[n].lo = *(const PG8_LAS i32x4_*)(lds + PG8_SB(b, h) + boff + n * 2048); dst[n].hi = *(const PG8_LAS i32x4_*)(lds + PG8_SB(b, h) + boff + n * 2048 + 1024); } } while (0)
#define PG8_MMA(ai, bj, At, Bt) do { __builtin_amdgcn_s_setprio(1); _Pragma("unroll") for (int m = 0; m < 4; ++m) _Pragma("unroll") for (int n = 0; n < 2; ++n) { \
        if constexpr (FP8) { if (FP8_DIAG) { _Pragma("unroll") for (int q_ = 0; q_ < 4; ++q_) { \
                const long b_ = (long)(unsigned)Bt[n][2 * q_] | ((long)Bt[n][2 * q_ + 1] << 32), a_ = (long)(unsigned)At[m][2 * q_] | ((long)At[m][2 * q_ + 1] << 32); \
                acc[ai][bj][m][n] = __builtin_amdgcn_mfma_f32_16x16x32_fp8_fp8(b_, a_, acc[ai][bj][m][n], 0, 0, 0); } } \
            else if (FP8_NOSCALE) asm volatile("v_mfma_f32_16x16x128_f8f6f4 %0, %1, %2, %0" : "+v"(acc[ai][bj][m][n]) : "v"(Bt[n]), "v"(At[m])); \
            else asm volatile("v_mfma_scale_f32_16x16x128_f8f6f4 %0, %1, %2, %0, %3, %3 op_sel_hi:[0,0,0]" : "+v"(acc[ai][bj][m][n]) : "v"(Bt[n]), "v"(At[m]), "v"(sc8)); } \
        else { const i32x4_ bl_ = __builtin_shufflevector(Bt[n], Bt[n], 0, 1, 2, 3), bh_ = __builtin_shufflevector(Bt[n], Bt[n], 4, 5, 6, 7), al_ = __builtin_shufflevector(At[m], At[m], 0, 1, 2, 3), ah_ = __builtin_shufflevector(At[m], At[m], 4, 5, 6, 7); \
               acc[ai][bj][m][n] = __builtin_amdgcn_mfma_f32_16x16x32_bf16(__builtin_bit_cast(bf16x8, bl_), __builtin_bit_cast(bf16x8, al_), acc[ai][bj][m][n], 0, 0, 0); \
               acc[ai][bj][m][n] = __builtin_amdgcn_mfma_f32_16x16x32_bf16(__builtin_bit_cast(bf16x8, bh_), __builtin_bit_cast(bf16x8, ah_), acc[ai][bj][m][n], 0, 0, 0); } } \
        __builtin_amdgcn_s_setprio(0); } while (0)
#define PG8_WAIT_V(n) asm volatile("s_waitcnt vmcnt(" #n ")" ::: "memory")
#define PG8_WAIT_L(n) asm volatile("s_waitcnt lgkmcnt(" #n ")" ::: "memory")
#define PG8_BAR __builtin_amdgcn_s_barrier()
#define PG8_SCHED __builtin_amdgcn_sched_barrier(0)
#define PG8_VOFF(v, u) do { _Pragma("unroll") for (int h_ = 0; h_ < 2; ++h_) _Pragma("unroll") for (int i_ = 0; i_ < 2; ++i_) { \
        const int r_ = h_ * HALF + Ri[i_]; const int src_ = GATHER ? S.a_row(u, r_) : r_; v[h_][i_] = (unsigned)(src_ * K + Ci[i_]) * 2u; } } while (0)
#define PG8_WAIT_SEL(loose, NL) asm volatile("s_cmp_lg_u32 %0, 0\n\ts_cbranch_scc0 .Lw8_%=\n\ts_waitcnt vmcnt(%1)\n\ts_branch .Lwe_%=\n.Lw8_%=:\n\ts_waitcnt vmcnt(8)\n.Lwe_%=:" :: "s"(loose), "n"(NL) : "memory", "scc")
#define PG8_ITER(W1, W2, W3, W4) do { \
            if (nh != 2) PG8_LDB(B0, 0, 0); if (nh != 1) PG8_LDB(B1, 0, 1); PG8_SCHED; PG8_LDA(At, 0, 0); PG8_STAGE(PG8_SA(1, 1), rA, a1, vAc[1]); \
            W1; PG8_WAIT_L(0); PG8_BAR; if (nh != 2) PG8_MMA(0, 0, At, B0); if (nh != 1) PG8_MMA(0, 1, At, B1); PG8_BAR; PG8_SCHED; \
            if (!halfu) PG8_LDA(At, 0, 1); PG8_STAGE(PG8_SB(0, 0), rB, b2, vB); PG8_STAGE(PG8_SB(0, 1), rB, b2 + hstepB, vB); PG8_STAGE(PG8_SA(0, 0), rA, a2, v2[0]); \
            W2; PG8_WAIT_L(0); PG8_BAR; if (!halfu) { if (nh != 2) PG8_MMA(1, 0, At, B0); if (nh != 1) PG8_MMA(1, 1, At, B1); } PG8_BAR; PG8_SCHED; \
            if (nh != 2) PG8_LDB(B0, 1, 0); if (nh != 1) PG8_LDB(B1, 1, 1); PG8_SCHED; PG8_LDA(At, 1, 0); PG8_STAGE(PG8_SA(0, 1), rA, a2, v2[1]); \
            W3; PG8_WAIT_L(0); PG8_BAR; if (nh != 2) PG8_MMA(0, 0, At, B0); if (nh != 1) PG8_MMA(0, 1, At, B1); PG8_BAR; PG8_SCHED; \
            if (!halfu) PG8_LDA(At, 1, 1); PG8_STAGE(PG8_SB(1, 0), rB, b3, vB); PG8_STAGE(PG8_SB(1, 1), rB, b3 + hstepB, vB); PG8_STAGE(PG8_SA(1, 0), rA, a3, v2[0]); \
            W4; PG8_WAIT_L(0); PG8_BAR; if (!halfu) { if (nh != 2) PG8_MMA(1, 0, At, B0); if (nh != 1) PG8_MMA(1, 1, At, B1); } PG8_BAR; PG8_SCHED; } while (0)
    Unit cur, nxt; int ui = 0;
    if (!S.next(0, cur)) return;
    f32x4 acc[2][2][4][2];
#pragma unroll
    for (int a = 0; a < 2; ++a)
#pragma unroll
        for (int b = 0; b < 2; ++b)
#pragma unroll
            for (int m = 0; m < 4; ++m)
#pragma unroll
                for (int n = 0; n < 2; ++n) acc[a][b][m][n] = (f32x4){0.f, 0.f, 0.f, 0.f};
    const int sc8 = 0x7c7c7c7c;
    i32x8 At[4], B0[2], B1[2];
    unsigned vAc[2][2], vAn[2][2];
    PG8_VOFF(vAc, cur);
    constexpr int KROT = Epi::MIDSCALE ? nt / 2 : 0;
    float mraw = 0.f;
#define PG8_KA(t_) ((unsigned)(((t_) + KROT) & (nt - 1)) * kstep)
#define PG8_KB(t_) ((unsigned)(((t_) + KROT) & (nt - 1)) * kstepB)
    unsigned cA = S.a_off(cur), cB = S.b_off(cur);
    PG8_STAGE(PG8_SB(0, 0), rB, cB + PG8_KB(0), vB); PG8_STAGE(PG8_SB(0, 1), rB, cB + PG8_KB(0) + hstepB, vB); PG8_STAGE(PG8_SA(0, 0), rA, cA + PG8_KA(0), vAc[0]); PG8_STAGE(PG8_SA(0, 1), rA, cA + PG8_KA(0), vAc[1]);
    if (wr == 1) PG8_BAR;
    PG8_WAIT_V(2); PG8_BAR;
    PG8_STAGE(PG8_SB(1, 0), rB, cB + PG8_KB(1), vB); PG8_STAGE(PG8_SA(1, 0), rA, cA + PG8_KA(1), vAc[0]); PG8_STAGE(PG8_SB(1, 1), rB, cB + hstepB + PG8_KB(1), vB);
    PG8_WAIT_V(6); PG8_BAR;
    for (;;) {
        const bool has_next = S.next(ui + 1, nxt);
        unsigned nA = cA, nB = cB;
        if (has_next) { nA = S.a_off(nxt); nB = S.b_off(nxt); PG8_VOFF(vAn, nxt); }
        else {
#pragma unroll
            for (int h = 0; h < 2; ++h)
#pragma unroll
                for (int i = 0; i < 2; ++i) vAn[h][i] = vAc[h][i]; }
        if constexpr (Epi::MIDSCALE) mraw = E.mid_load(cur);
        const int nh = Sched::NSPLIT ? __builtin_amdgcn_readfirstlane(cur.nh) : 0;
        const bool halfu = Sched::HALF_UNITS && cur.nrows <= HALF;
        for (int t = 0; t < nt; t += 2) {
            const bool last = (t == nt - 2);
            const unsigned a1 = cA + PG8_KA(t + 1);
            const unsigned a2 = last ? nA + PG8_KA(0) : cA + PG8_KA(t + 2), b2 = last ? nB + PG8_KB(0) : cB + PG8_KB(t + 2);
            const unsigned a3 = a2 + kstep, b3 = b2 + kstepB;
            if constexpr (Epi::MIDSCALE) { if (t == nt / 2 - 2) { if (tid < 256) ((PG8_LAS float*)(lds + (LDSCTL_OFF - RING_OFF) + 4096))[tid] = E.mid_factor(mraw); } }
            if constexpr (Epi::MIDSCALE) { if (t == nt / 2) {
#pragma unroll
                for (int a = 0; a < 2; ++a)
#pragma unroll
                    for (int m = 0; m < 4; ++m) { const float f_ = ((const PG8_LAS float*)(lds + (LDSCTL_OFF - RING_OFF) + 4096))[a * 128 + wr * 64 + m * 16 + fr];
#pragma unroll
                        for (int b = 0; b < 2; ++b)
#pragma unroll
                            for (int n = 0; n < 2; ++n) acc[a][b][m][n] = acc[a][b][m][n] * f_; } } }
            unsigned v2[2][2];
#pragma unroll
            for (int h = 0; h < 2; ++h)
#pragma unroll
                for (int i = 0; i < 2; ++i) v2[h][i] = last ? vAn[h][i] : vAc[h][i];
            const int loose = __builtin_amdgcn_readfirstlane((LOOSE_EPI_WAIT && t == 0 && ui > 0) ? 1 : 0);
            PG8_ITER(PG8_WAIT_SEL(loose, 8 + Epi::NVM), PG8_WAIT_SEL(loose, 8 + Epi::NVM), PG8_WAIT_SEL(loose, 8 + Epi::NVM), PG8_WAIT_V(8));
        }
        if constexpr (FP8) asm volatile("s_nop 15\n\ts_nop 15" ::: "memory");
        if constexpr (ALIGN_EPI) { if (wr == 0) PG8_BAR; }
        E(acc, cur, wr, wc, fr, fq);
        if (PROBE_EPI2) { asm volatile("" ::: "memory"); E(acc, cur, wr, wc, fr, fq); }
        if (!has_next) break;
#pragma unroll
        for (int a = 0; a < 2; ++a)
#pragma unroll
            for (int b = 0; b < 2; ++b)
#pragma unroll
                for (int m = 0; m < 4; ++m)
#pragma unroll
                    for (int n = 0; n < 2; ++n) acc[a][b][m][n] = (f32x4){0.f, 0.f, 0.f, 0.f};
        cur = nxt; cA = nA; cB = nB; ++ui;
#pragma unroll
        for (int h = 0; h < 2; ++h)
#pragma unroll
            for (int i = 0; i < 2; ++i) vAc[h][i] = vAn[h][i];
        if constexpr (ALIGN_EPI) { if (wr == 1) PG8_BAR; }
    }
    PG8_WAIT_V(0);
    if constexpr (!ALIGN_EPI) { if (wr == 0) PG8_BAR; }
    PG8_BAR;
#undef PG8_KA
#undef PG8_KB
#undef PG8_ITER
#undef PG8_WAIT_SEL
#undef PG8_SA
#undef PG8_SB
#undef PG8_STAGE
#undef PG8_LDA
#undef PG8_LDB
#undef PG8_MMA
#undef PG8_WAIT_V
#undef PG8_WAIT_L
#undef PG8_BAR
#undef PG8_SCHED
#undef PG8_VOFF
}
}
struct Frame {
    LAS unsigned char* lds;
    volatile LAS unsigned* MISC;
    gu32* ctl;
    int wave, vcu, G;
    const float *x, *g1, *w_in, *fbias, *gq, *gk, *conv_w, *conv_b, *dt_bias, *a_log, *d_skip, *ssd_g, *w_out, *g2, *w_router, *b_router, *w_gate, *b_gate, *w_up, *b_up, *w_down, *b_down;
    float* out; unsigned char* ws;
};
#define WSP(T, off) ((T*)(F.ws + (off)))
__device__ __forceinline__ int TTID() { int t = threadIdx.x; asm volatile("" : "+v"(t)); return t; }
__device__ __forceinline__ int TLANE() { return TTID() & 63; }

template <bool Q8>
__device__ __forceinline__ void conv_item(const float* W, int ldn, int nvalid, int k0, int n0, bf16* dst, LAS unsigned* T, int lane, const float* rowgain = nullptr) {
    const int kq = lane >> 4, nq = lane & 15, col = n0 + 4 * nq;
    const bool ok = col < nvalid;
    f32x4 a[8], b[8];
#pragma unroll
    for (int i = 0; i < 8; ++i) { const float* p = W + (size_t)(k0 + 8 * i + 2 * kq) * ldn + col;
        a[i] = ok ? *(const f32x4*)p : (f32x4){0.f, 0.f, 0.f, 0.f}; b[i] = ok ? *(const f32x4*)(p + ldn) : (f32x4){0.f, 0.f, 0.f, 0.f}; }
    if (rowgain) {
#pragma unroll
        for (int i = 0; i < 8; ++i) { const float ga = rowgain[8 * i + 2 * kq], gb = rowgain[8 * i + 2 * kq + 1]; a[i] = a[i] * ga; b[i] = b[i] * gb; } }
#pragma unroll
    for (int i = 0; i < 8; ++i)
#pragma unroll
        for (int j = 0; j < 4; ++j) T[(4 * nq + j) * 33 + 4 * i + kq] = (Q8 && (EMU_FP8 || EMU_IN8 || EMU_OUT8)) ? pk2(q8(a[i][j] * 64.f) * (1.f / 64.f), q8(b[i][j] * 64.f) * (1.f / 64.f)) : pk2(a[i][j], b[i][j]);
    LDS_WAIT();
    const int c = lane & 7;
#pragma unroll
    for (int r = 0; r < 8; ++r) { const int n = 8 * r + (lane >> 3); const LAS unsigned* s = T + n * 33 + 4 * c;
        v4u o; o.x = s[0]; o.y = s[1]; o.z = s[2]; o.w = s[3];
        *(v4u*)(dst + (size_t)n * 2048 + k0 + 8 * c) = o; }
    LDS_WAIT();
}
__device__ __forceinline__ void conv_item8(const float* W, int k0, int n0, unsigned char* dst, LAS unsigned* T, int lane) {
    const int kq = lane >> 4, nq = lane & 15, col = n0 + 4 * nq;
    f32x4 a[8][4];
#pragma unroll
    for (int i = 0; i < 8; ++i)
#pragma unroll
        for (int r = 0; r < 4; ++r) a[i][r] = __builtin_nontemporal_load((const GAS f32x4*)(W + (size_t)(k0 + 16 * i + 4 * kq + r) * 2048 + col));
#pragma unroll
    for (int i = 0; i < 8; ++i)
#pragma unroll
        for (int j = 0; j < 4; ++j) T[(4 * nq + j) * 33 + 4 * i + kq] = pk4_fp8_x64(a[i][0][j], a[i][1][j], a[i][2][j], a[i][3][j]);
    LDS_WAIT();
    const int c = lane & 7;
#pragma unroll
    for (int r = 0; r < 8; ++r) { const int n = 8 * r + (lane >> 3); const LAS unsigned* s = T + n * 33 + 4 * c;
        v4u o; o.x = s[0]; o.y = s[1]; o.z = s[2]; o.w = s[3];
        *(GAS v4u*)(dst + (size_t)n * 128 + 16 * c) = o; }
    LDS_WAIT();
}
struct Conv8Regs { f32x4 a[4][4]; };
__device__ __forceinline__ void conv8_load(Conv8Regs& R, const float* W, int k0, int n0, int lane) {
    const int kq = lane >> 4, nq = lane & 15, col = n0 + 4 * nq;
#pragma unroll
    for (int i = 0; i < 4; ++i)
#pragma unroll
        for (int r = 0; r < 4; ++r) R.a[i][r] = __builtin_nontemporal_load((const GAS f32x4*)(W + (size_t)(k0 + 16 * i + 4 * kq + r) * 2048 + col));
}
__device__ __forceinline__ void conv8_pack(const Conv8Regs& R, int k0, unsigned char* dst, LAS unsigned* T, int lane) {
    const int kq = lane >> 4, nq = lane & 15;
#pragma unroll
    for (int i = 0; i < 4; ++i)
#pragma unroll
        for (int j = 0; j < 4; ++j) T[(4 * nq + j) * 17 + 4 * i + kq] = pk4_fp8_x64(R.a[i][0][j], R.a[i][1][j], R.a[i][2][j], R.a[i][3][j]);
    LDS_WAIT();
    const int c = lane & 3;
#pragma unroll
    for (int r = 0; r < 4; ++r) { const int n = 16 * r + (lane >> 2); const LAS unsigned* s = T + n * 17 + 4 * c;
        v4u o; o.x = s[0]; o.y = s[1]; o.z = s[2]; o.w = s[3];
        *(GAS v4u*)(dst + (size_t)n * 2048 + k0 + 16 * c) = o; }
    LDS_WAIT();
}
constexpr int MKB = (FP8_MOE && !CONV_PIPE) ? 16 : 32;
constexpr int IT_IN = 32 * (NP / 64), IT_OUT = 32 * 32, IT_EXP = MKB * 32, IT_MOE = 3 * NE * IT_EXP, IT_TOTAL = IT_IN + IT_OUT + IT_MOE;
constexpr int IT_GU = 2 * NE * IT_EXP;
struct MoeItem { const float* src; unsigned char* dst; int k0, n0; };
__device__ __forceinline__ MoeItem moe_item(Frame& F, int r) {
    const int m = r / (NE * IT_EXP); r -= m * (NE * IT_EXP);
    const int e = r / IT_EXP; r -= e * IT_EXP; const int kb = r >> 5, nb = r & 31;
    const size_t eo = (size_t)e * 2048 * 2048; const int es = FP8_MOE ? 1 : 2;
    MoeItem it; it.k0 = kb * ((FP8_MOE && !CONV_PIPE) ? 128 : 64); it.n0 = nb * 64;
    const int rgu = (nb >> 1) * 256 + (nb & 1) * 64;
#if FP8_MOE && !CONV_PIPE
    unsigned char* dgu = WSP(unsigned char, WS_WGU) + (size_t)e * (4096 * 2048) + ((size_t)kb * 4096 + rgu) * 128;
    unsigned char* ddn = WSP(unsigned char, WS_WD) + (size_t)e * (2048 * 2048) + ((size_t)kb * 2048 + nb * 64) * 128;
    constexpr size_t up_off = (size_t)128 * 128;
#else
    unsigned char* dgu = WSP(unsigned char, WS_WGU) + ((size_t)e * 4096 + rgu) * (2048 * es);
    unsigned char* ddn = WSP(unsigned char, WS_WD) + ((size_t)e * 2048 + nb * 64) * (2048 * es);
    constexpr size_t up_off = (size_t)128 * (2048 * es);
#endif
    const float* pg = F.w_gate; const float* pu = F.w_up; const float* pd = F.w_down; asm volatile("" : "+s"(pg), "+s"(pu), "+s"(pd));
    const float* base = pg; it.dst = dgu;
    if (m == 1) { base = pu; it.dst = dgu + up_off; }
    if (m == 2) { base = pd; it.dst = ddn; }
    it.src = base + eo; return it;
}
__device__ __forceinline__ void conv_moe_item(Frame& F, int r, LAS unsigned* T, int lane0) {
    const MoeItem it = moe_item(F, r);
#if FP8_MOE && CONV_PIPE
    { Conv8Regs R; conv8_load(R, it.src, it.k0, it.n0, lane0); conv8_pack(R, it.k0, it.dst, T, lane0); }
#elif FP8_MOE
    conv_item8(it.src, it.k0, it.n0, it.dst, T, lane0);
#else
    conv_item<true>(it.src, 2048, 2048, it.k0, it.n0, (bf16*)it.dst, T, lane0);
#endif
}
__device__ __forceinline__ void conv_dispatch(Frame& F, int it, LAS unsigned* T, int lane0) {
    int r = it;
    if (r < IT_IN) { const int kb = r / (NP / 64), nb = r % (NP / 64); conv_item<(EMU_IN8 != 0)>(F.w_in, INCOLS, INCOLS, kb * 64, nb * 64, WSP(bf16, WS_WIN) + (size_t)(nb * 64) * 2048, T, lane0); return; }
    r -= IT_IN;
    if (r < IT_OUT) { const int kb = r >> 5, nb = r & 31; conv_item<(EMU_OUT8 != 0)>(F.w_out, DM, DM, kb * 64, nb * 64, WSP(bf16, WS_WOUT) + (size_t)(nb * 64) * 2048, T, lane0, (FUSE_P4 && kb >= 16) ? F.ssd_g + (kb * 64 - 1024) : nullptr); return; }
    r -= IT_OUT;
    conv_moe_item(F, r, T, lane0);
}
constexpr int WNB = CONV_DMA ? 16 : 8;
constexpr int WIT_EXP = 16 * WNB, WIT_GU = 2 * NE * WIT_EXP, WIT_MOE = 3 * NE * WIT_EXP;
struct WgItem { const float* src; unsigned char* blk; int m, nb; };
__device__ __forceinline__ WgItem wg_item(Frame& F, int r) {
    const int m = r / (NE * WIT_EXP); r -= m * (NE * WIT_EXP);
    const int e = r / WIT_EXP; r -= e * WIT_EXP; const int kb = r / WNB, nb = r % WNB;
    const float* pg = F.w_gate; const float* pu = F.w_up; const float* pd = F.w_down; asm volatile("" : "+s"(pg), "+s"(pu), "+s"(pd));
    WgItem it; it.m = m; it.nb = nb;
    const float* base = pg; if (m == 1) base = pu; if (m == 2) base = pd;
    it.src = base + (size_t)e * 2048 * 2048 + (size_t)(kb * 128) * 2048 + nb * (CONV_DMA ? 128 : 256);
    it.blk = (m == 2) ? WSP(unsigned char, WS_WD) + (size_t)e * (2048 * 2048) + (size_t)kb * (2048 * 128)
                      : WSP(unsigned char, WS_WGU) + (size_t)e * (4096 * 2048) + (size_t)kb * (4096 * 128);
    return it;
}
__device__ __forceinline__ void wg_load(f32x4 (&a)[16], const WgItem& it, int wave, int lane) {
#pragma unroll
    for (int i = 0; i < 16; ++i) a[i] = CONV_NT ? __builtin_nontemporal_load((const GAS f32x4*)(it.src + (size_t)(16 * wave + i) * 2048 + 4 * lane)) : *(const GAS f32x4*)(it.src + (size_t)(16 * wave + i) * 2048 + 4 * lane);
}
__device__ __forceinline__ void wg_pack(const f32x4 (&a)[16], LAS unsigned char* T, int wave, int lane) {
#pragma unroll
    for (int j = 0; j < 4; ++j) { v4u d;
        d.x = pk4_fp8_x64(a[0][j], a[1][j], a[2][j], a[3][j]); d.y = pk4_fp8_x64(a[4][j], a[5][j], a[6][j], a[7][j]);
        d.z = pk4_fp8_x64(a[8][j], a[9][j], a[10][j], a[11][j]); d.w = pk4_fp8_x64(a[12][j], a[13][j], a[14][j], a[15][j]);
        *(LAS v4u*)(T + (4 * lane + j) * 128 + ((wave ^ (lane & 7)) << 4)) = d; }
}
__device__ __forceinline__ void wg_store(const LAS unsigned char* T, const WgItem& it, int wave, int lane) {
    const int rb = (it.m == 2) ? it.nb * 256 : (2 * it.nb + (wave >> 2)) * 256 + (it.m == 1 ? 128 : 0);
#pragma unroll
    for (int s = 0; s < 4; ++s) { const int n = 32 * wave + 8 * s + (lane >> 3), c = lane & 7;
        const v4u v = *(const LAS v4u*)(T + n * 128 + ((c ^ ((n >> 2) & 7)) << 4));
        const int row = (it.m == 2) ? rb + n : rb + (n & 127);
        if (CONV_NTS) __builtin_nontemporal_store(v, (GAS v4u*)(it.blk + (size_t)row * 128 + 16 * c)); else *(GAS v4u*)(it.blk + (size_t)row * 128 + 16 * c) = v; }
}
__device__ __forceinline__ void dma_issue(const WgItem& it, unsigned sbase, int wave, int lane) {
#pragma unroll
    for (int i2 = 0; i2 < 8; ++i2) { const float* g = it.src + (size_t)(16 * wave + 2 * i2 + (lane >> 5)) * 2048 + 4 * (lane & 31); unsigned keep;
        asm volatile("s_mov_b32 %0, m0\n\ts_mov_b32 m0, %2\n\ts_nop 0\n\tglobal_load_lds_dwordx4 %1, off nt\n\ts_mov_b32 m0, %0" : "=&s"(keep) : "v"(g), "s"(sbase + 1024u * i2) : "memory"); }
}
__device__ __forceinline__ void dma_pack(const LAS unsigned char* Sw, LAS unsigned char* T, int wave, int lane) {
    const int n4 = lane & 31, kh = lane >> 5;
    f32x4 a[8];
#pragma unroll
    for (int r = 0; r < 8; ++r) { const int k = 8 * kh + r; a[r] = *(const LAS f32x4*)(Sw + (k >> 1) * 1024 + (k & 1) * 512 + n4 * 16); }
#pragma unroll
    for (int j = 0; j < 4; ++j) { v2u d; d.x = pk4_fp8_x64(a[0][j], a[1][j], a[2][j], a[3][j]); d.y = pk4_fp8_x64(a[4][j], a[5][j], a[6][j], a[7][j]);
        const int n = 4 * n4 + j; *(LAS v2u*)(T + n * 128 + ((wave ^ (n4 & 7)) << 4) + 8 * kh) = d; }
}
__device__ __forceinline__ void dma_store(const LAS unsigned char* T, const WgItem& it, int wave, int lane) {
    const int rb = (it.m == 2) ? it.nb * 128 : it.nb * 256 + (it.m == 1 ? 128 : 0);
#pragma unroll
    for (int s = 0; s < 2; ++s) { const int n = 16 * wave + 8 * s + (lane >> 3), c = lane & 7;
        const v4u v = *(const LAS v4u*)(T + n * 128 + ((c ^ ((n >> 2) & 7)) << 4));
        *(GAS v4u*)(it.blk + (size_t)(rb + n) * 128 + 16 * c) = v; }
}
constexpr int BG_BATCH = CONV_WG ? BGB_CFG : 32;
constexpr int POOL_GU = CONV_WG ? WIT_GU : IT_GU, POOL_ALL = CONV_WG ? WIT_MOE : IT_MOE;
__device__ __forceinline__ bool bg_batch(Frame& F, int limit) {
    LAS unsigned* T = (LAS unsigned*)(F.lds + RING_OFF + F.wave * 16384); volatile LAS int* BW = (volatile LAS int*)(F.lds + BGW_OFF);
    const int lane = TLANE();
    if (F.wave == 0) { int v = (int)__hip_atomic_load(F.ctl + CW_HEAD, RLX_AGENT);
        if (v < limit) v = (int)__hip_atomic_fetch_add(F.ctl + CW_HEAD, lane == 0 ? (unsigned)BG_BATCH : 0u, RLX_AGENT); else v = POOL_ALL;
        BW[0] = __builtin_amdgcn_readfirstlane(v); }
    __syncthreads();
    const int it0 = __builtin_amdgcn_readfirstlane(BW[0]);
    __syncthreads();
    if (it0 >= POOL_ALL) return false;
#if CONV_WG && CONV_DMA
    { LAS unsigned char* S0 = F.lds + RING_OFF; LAS unsigned char* T = F.lds + DMA_T_OFF; const int w = F.wave;
      const unsigned sb0 = (unsigned)(uintptr_t)(S0 + 8192 * w), sb1 = sb0 + 65536u;
      const WgItem i0 = wg_item(F, it0), i1 = wg_item(F, it0 + 1), i2 = wg_item(F, it0 + 2), i3 = wg_item(F, it0 + 3);
#define DMA_STEP(cur, sbc, NEXT_ISSUE, NWAIT) do { NEXT_ISSUE; asm volatile("s_waitcnt vmcnt(" #NWAIT ")" ::: "memory"); \
        dma_pack(S0 + ((sbc) - sb0) + 8192 * w, T, w, lane); LDS_WAIT(); __syncthreads(); dma_store(T, cur, w, lane); LDS_WAIT(); __syncthreads(); } while (0)
      dma_issue(i0, sb0, w, lane);
      DMA_STEP(i0, sb0, dma_issue(i1, sb1, w, lane), 8);
      DMA_STEP(i1, sb1, dma_issue(i2, sb0, w, lane), 8);
      DMA_STEP(i2, sb0, dma_issue(i3, sb1, w, lane), 8);
      DMA_STEP(i3, sb1, (void)0, 0);
#undef DMA_STEP
    }
#elif CONV_WG
    { LAS unsigned char* T0 = F.lds + RING_OFF; LAS unsigned char* T1 = T0 + 32768; const int w = F.wave;
      f32x4 A[16], B[16];
#if BGB_CFG == 6
      f32x4 C[16];
      const WgItem i0 = wg_item(F, it0), i1 = wg_item(F, it0 + 1), i2 = wg_item(F, it0 + 2), i3 = wg_item(F, it0 + 3), i4 = wg_item(F, it0 + 4), i5 = wg_item(F, it0 + 5);
      wg_load(A, i0, w, lane); wg_load(B, i1, w, lane); wg_load(C, i2, w, lane);
      wg_pack(A, T0, w, lane); LDS_WAIT(); __syncthreads(); wg_store(T0, i0, w, lane); wg_load(A, i3, w, lane);
      wg_pack(B, T1, w, lane); LDS_WAIT(); __syncthreads(); wg_store(T1, i1, w, lane); wg_load(B, i4, w, lane);
      wg_pack(C, T0, w, lane); LDS_WAIT(); __syncthreads(); wg_store(T0, i2, w, lane); wg_load(C, i5, w, lane);
      wg_pack(A, T1, w, lane); LDS_WAIT(); __syncthreads(); wg_store(T1, i3, w, lane);
      wg_pack(B, T0, w, lane); LDS_WAIT(); __syncthreads(); wg_store(T0, i4, w, lane);
      wg_pack(C, T1, w, lane); LDS_WAIT(); __syncthreads(); wg_store(T1, i5, w, lane);
#elif BGB_CFG == 4
      const WgItem i0 = wg_item(F, it0), i1 = wg_item(F, it0 + 1), i2 = wg_item(F, it0 + 2), i3 = wg_item(F, it0 + 3);
      wg_load(A, i0, w, lane);
      wg_load(B, i1, w, lane); wg_pack(A, T0, w, lane); LDS_WAIT(); __syncthreads(); wg_store(T0, i0, w, lane);
      wg_load(A, i2, w, lane); wg_pack(B, T1, w, lane); LDS_WAIT(); __syncthreads(); wg_store(T1, i1, w, lane);
      wg_load(B, i3, w, lane); wg_pack(A, T0, w, lane); LDS_WAIT(); __syncthreads(); wg_store(T0, i2, w, lane);
      wg_pack(B, T1, w, lane); LDS_WAIT(); __syncthreads(); wg_store(T1, i3, w, lane);
#elif BGB_CFG == 2
      const WgItem i0 = wg_item(F, it0), i1 = wg_item(F, it0 + 1);
      wg_load(A, i0, w, lane);
      wg_load(B, i1, w, lane); wg_pack(A, T0, w, lane); LDS_WAIT(); __syncthreads(); wg_store(T0, i0, w, lane);
      wg_pack(B, T1, w, lane); LDS_WAIT(); __syncthreads(); wg_store(T1, i1, w, lane);
#else
      const WgItem i0 = wg_item(F, it0);
      wg_load(A, i0, w, lane); wg_pack(A, T0, w, lane); LDS_WAIT(); __syncthreads(); wg_store(T0, i0, w, lane);
#endif
      LDS_WAIT(); __syncthreads(); }
#else
#pragma unroll 1
    for (int j = 0; j < BG_BATCH / NWAVES; ++j) conv_moe_item(F, it0 + j * NWAVES + F.wave, T, lane);
#endif
    return true;
}
__device__ __forceinline__ void bg_fill(Frame& F, int k, int limit) {
    volatile LAS int* BW = (volatile LAS int*)(F.lds + BGW_OFF);
    const int lane = TLANE();
    VM_WAIT(); __syncthreads();
    if (F.wave == 0) (void)__hip_atomic_fetch_add(F.ctl + CW_DONE + 64 * k, lane == 0 ? 1u : 0u, RLX_AGENT);
    bool more = true;
    while (more) {
        if (F.wave == 0) BW[1] = ((int)__hip_atomic_load(F.ctl + CW_DONE + 64 * k, RLX_AGENT) >= F.G) ? 1 : 0;
        __syncthreads();
        const int stop = __builtin_amdgcn_readfirstlane(BW[1]);
        __syncthreads();
        more = !stop;
        if (more) more = bg_batch(F, limit);
    }
}
__device__ __forceinline__ bool bg_finish(Frame& F, int limit) {
    bool any = false;
    while (bg_batch(F, limit)) any = true;
    return any;
}
__device__ __forceinline__ bool bg_peek_open(Frame& F) {
    volatile LAS int* BW = (volatile LAS int*)(F.lds + BGW_OFF);
    if (F.wave == 0) BW[2] = ((int)__hip_atomic_load(F.ctl + CW_HEAD, RLX_AGENT) < POOL_ALL) ? 1 : 0;
    __syncthreads();
    const int v = __builtin_amdgcn_readfirstlane(BW[2]);
    __syncthreads();
    return v != 0;
}
__device__ __forceinline__ bool bg_open(Frame& F, int limit) {
    return (int)__hip_atomic_load(F.ctl + CW_HEAD, RLX_AGENT) < limit;
}
__device__ __forceinline__ void rms_row_to_bf16(const float* xrow, const float* g, bf16* orow, int lane) {
    const f32x4* xr = (const f32x4*)xrow + lane; const f32x4* gr = (const f32x4*)g + lane;
    f32x4 v[8]; float s = 0.f;
#pragma unroll
    for (int j = 0; j < 8; ++j) { v[j] = xr[64 * j]; s += (v[j].x * v[j].x + v[j].y * v[j].y) + (v[j].z * v[j].z + v[j].w * v[j].w); }
    const float rstd = 1.f / sqrtf(wave_sum(s) * (1.f / 2048.f) + EPS);
    v2u* o8 = (v2u*)orow + lane;
#pragma unroll
    for (int j = 0; j < 8; ++j) { const f32x4 gg = gr[64 * j]; v2u w; w.x = pk2(v[j].x * rstd * gg.x, v[j].y * rstd * gg.y); w.y = pk2(v[j].z * rstd * gg.z, v[j].w * rstd * gg.w); o8[64 * j] = w; }
}
__device__ __forceinline__ void p0_prologue(Frame& F) {
    LAS unsigned* T = (LAS unsigned*)(F.lds + RING_OFF + F.wave * 16384); const int lane0 = TLANE();
    const int gw = F.vcu * NWAVES + F.wave, NGW = F.G * NWAVES;
    for (int it = gw; it < (BG_POOL ? IT_IN + IT_OUT : IT_TOTAL); it += NGW) conv_dispatch(F, it, T, lane0);
    for (int i = gw * 64 + lane0; i < NE * 2048; i += NGW * 64) { const int e = i >> 11, k = i & 2047; const float w = F.g2[k] * F.w_router[k * NE + e];
        const unsigned hi = f2bf(w); const float lo = w - bf2f(hi); WSP(bf16, WS_WR)[i] = (bf16)hi; WSP(bf16, WS_WR)[NE * 2048 + i] = (bf16)f2bf(lo); }
    for (int m0 = 2 * gw; m0 < NTOK; m0 += 2 * NGW) {
        const f32x4* x0 = (const f32x4*)(F.x + (size_t)m0 * DM) + lane0; const f32x4* x1 = x0 + DM / 4; const f32x4* gr = (const f32x4*)F.g1 + lane0;
        f32x4 v0[8], v1[8]; float s0 = 0.f, s1 = 0.f;
#pragma unroll
        for (int j = 0; j < 8; ++j) { v0[j] = x0[64 * j]; v1[j] = x1[64 * j]; }
#pragma unroll
        for (int j = 0; j < 8; ++j) { s0 += (v0[j].x * v0[j].x + v0[j].y * v0[j].y) + (v0[j].z * v0[j].z + v0[j].w * v0[j].w); s1 += (v1[j].x * v1[j].x + v1[j].y * v1[j].y) + (v1[j].z * v1[j].z + v1[j].w * v1[j].w); }
        const float r0 = 1.f / sqrtf(wave_sum(s0) * (1.f / 2048.f) + EPS), r1 = 1.f / sqrtf(wave_sum(s1) * (1.f / 2048.f) + EPS);
        v2u* o0 = (v2u*)(WSP(bf16, WS_XN) + (size_t)m0 * DM) + lane0; v2u* o1 = o0 + DM / 4;
#pragma unroll
        for (int j = 0; j < 8; ++j) { const f32x4 gg = gr[64 * j]; v2u w;
#if EMU_IN8
            w.x = pk2(q8(v0[j].x * r0 * gg.x), q8(v0[j].y * r0 * gg.y)); w.y = pk2(q8(v0[j].z * r0 * gg.z), q8(v0[j].w * r0 * gg.w)); o0[64 * j] = w;
            w.x = pk2(q8(v1[j].x * r1 * gg.x), q8(v1[j].y * r1 * gg.y)); w.y = pk2(q8(v1[j].z * r1 * gg.z), q8(v1[j].w * r1 * gg.w)); o1[64 * j] = w; }
#else
            w.x = pk2(v0[j].x * r0 * gg.x, v0[j].y * r0 * gg.y); w.y = pk2(v0[j].z * r0 * gg.z, v0[j].w * r0 * gg.w); o0[64 * j] = w;
            w.x = pk2(v1[j].x * r1 * gg.x, v1[j].y * r1 * gg.y); w.y = pk2(v1[j].z * r1 * gg.z, v1[j].w * r1 * gg.w); o1[64 * j] = w; }
#endif
    }
}

template <bool NS> struct OrderStaticT {
    static constexpr bool B_BLOCKED = false, HALF_UNITS = false, NSPLIT = NS, RSPLIT = false; __device__ __forceinline__ unsigned b_kstep() const { return 128u; }
    int nM, nN, nwg, G, c; const char* A; const char* Bt; const char* xprobe;
    __device__ __forceinline__ void init(int M, int N, int G_, int c_, const void* A_, const void* Bt_) { nM = M / 256; nN = N / 256; nwg = nM * nN; G = G_; c = c_; A = (const char*)A_; Bt = (const char*)Bt_; }
    __device__ __forceinline__ bool next(int i, pg8::Unit& u) const {
        long L = (long)i * G + c; u.nh = 0; u.rh = 0; u.roff = 0;
        if (NS) { const int R = nwg / G, T = nwg - R * G;
            if (T > 0 && 2 * T <= G && L >= (long)R * G) { const int Lp = (int)(L - (long)R * G); if (Lp >= 2 * T) return false; L = (long)R * G + (Lp >> 1); u.nh = 1 + (Lp & 1); } }
        if (L >= nwg) return false;
        int wgid = (int)L; { const int q = nwg / 8, r = nwg % 8, xcd = wgid % 8, off = wgid / 8; wgid = (xcd < r ? xcd * (q + 1) : r * (q + 1) + (xcd - r) * q) + off; }
        const int nig = 8 * nN, gid = wgid / nig, fm = gid * 8, gsz = (nM - fm) < 8 ? (nM - fm) : 8;
        u.pm = fm + ((wgid % nig) % gsz); u.pn = (wgid % nig) / gsz; u.e = 0; u.mt = 0; u.nrows = 256; return true;
    }
    __device__ __forceinline__ const void* a_base() const { return A; }
    __device__ __forceinline__ const void* b_base() const { return Bt; }
    __device__ __forceinline__ unsigned a_off(const pg8::Unit& u) const { return (unsigned)u.pm * (256u * 2048 * 2); }
    __device__ __forceinline__ unsigned b_off(const pg8::Unit& u) const { return (unsigned)u.pn * (256u * 2048 * 2); }
    __device__ __forceinline__ int a_row(const pg8::Unit&, int r) const { return r; }
};
typedef OrderStaticT<false> OrderStatic;
template <int NT, bool GATHER_A, int RB  > struct OrderMoe {
    static constexpr bool HALF_UNITS = HALF_UNITS_CFG != 0;
    static constexpr bool RSPLIT = NSPLIT_CFG != 0 && NT == 16;
    static constexpr bool NSPLIT = NSPLIT_CFG != 0 && NT == 8;
    static constexpr bool B_BLOCKED = FP8_MOE != 0;
    __device__ __forceinline__ unsigned b_kstep() const { return (unsigned)(bstride / 16); }
    int G, c, tb_lane, cn_lane, tbf_lane, tbh_lane; const char* A; const char* Bt; const int* stok; size_t bstride;
    const char* xprobe; gu32* qcnt; volatile LAS int* bw; int xc; bool dyn;
    __device__ __forceinline__ void init(int G_, int c_, const LAS int* TB, const LAS int* CN, int lane, const void* A_, const void* Bt_, size_t bstride_, const int* stok_, gu32* qcnt_, volatile LAS int* bw_, bool dyn_) {
        G = G_; c = c_; tb_lane = TB[lane < 32 ? lane : 32]; cn_lane = CN[lane & 31]; tbf_lane = TB[128 + (lane < 32 ? lane : 32)]; tbh_lane = TB[192 + (lane < 32 ? lane : 32)]; A = (const char*)A_; Bt = (const char*)Bt_; bstride = bstride_; stok = stok_;
        dyn = dyn_; xc = c_ >> 5; qcnt = qcnt_ + 64 * xc; bw = bw_; }
    __device__ __forceinline__ bool next(int i, pg8::Unit& u) const {
        int L = i * G + c;
        if (dyn) {
            if (__builtin_amdgcn_readfirstlane((int)(threadIdx.x >> 6)) == 0) { const unsigned v = __hip_atomic_fetch_add(qcnt, (threadIdx.x & 63) == 0 ? 1u : 0u, RLX_AGENT); bw[0] = __builtin_amdgcn_readfirstlane((int)v); }
            asm volatile("s_waitcnt lgkmcnt(0)" ::: "memory"); __builtin_amdgcn_s_barrier(); asm volatile("" ::: "memory");
            const int j = __builtin_amdgcn_readfirstlane(bw[0]);
            L = ((j >> 5) * 8 + xc) * 32 + (j & 31);
        }
        const int tfl = HALF_LAST ? tbf_lane : tb_lane;
        const int nfull = __builtin_amdgcn_readlane(tfl, 32) * NT, total = nfull + (HALF_LAST ? __builtin_amdgcn_readlane(tbh_lane, 32) * NT : 0);
        u.nh = 0; u.rh = 0; u.roff = 0;
        if ((NSPLIT || RSPLIT) && !dyn) { const int R = total / G, T = total - R * G;
            if (T > 0 && 2 * T <= G && L >= R * G) { const int Lp = L - R * G; if (Lp >= 2 * T) return false; L = R * G + (Lp >> 1); if (NSPLIT) u.nh = 1 + (Lp & 1); else u.rh = 1 + (Lp & 1); } }
        if (L >= total) return false;
        const int lane = threadIdx.x & 63;
        if (L < nfull) {
            const unsigned long long mk = __ballot(lane < 32 && tfl * NT <= L);
            const int e = __builtin_popcountll(mk) - 1;
            const int tfe = __builtin_amdgcn_readlane(tfl, e), tfe1 = __builtin_amdgcn_readlane(tfl, e + 1), tbe = __builtin_amdgcn_readlane(tb_lane, e), cne = __builtin_amdgcn_readlane(cn_lane, e);
            const int r = L - tfe * NT, mtiles = tfe1 - tfe, grp = mtiles * 8, ng = r / grp, r2 = r - ng * grp, mt = r2 >> 3, n8 = r2 & 7;
            u.e = e; u.mt = mt; u.pm = tbe + mt; u.pn = ng * 8 + n8; const int left = cne - mt * 256; u.nrows = left < 256 ? left : 256;
        } else {
            const int Lh = L - nfull;
            const unsigned long long mk = __ballot(lane < 32 && tbh_lane * NT <= Lh);
            const int e = __builtin_popcountll(mk) - 1;
            const int the = __builtin_amdgcn_readlane(tbh_lane, e), tbe = __builtin_amdgcn_readlane(tb_lane, e), tbe1 = __builtin_amdgcn_readlane(tb_lane, e + 1), cne = __builtin_amdgcn_readlane(cn_lane, e);
            const int mt = tbe1 - tbe - 1;
            u.e = e; u.mt = mt; u.pm = tbe + mt; u.pn = Lh - the * NT; u.nrows = cne - mt * 256;
        }
        if (RSPLIT && u.rh) {
            if (u.rh == 1) u.nrows = u.nrows < 128 ? u.nrows : 128;
            else if (u.nrows > 128) { u.roff = 128; u.nrows -= 128; }
            else { u.rh = 3; }
        }
        return true;
    }
    __device__ __forceinline__ const void* a_base() const { return A; }
    __device__ __forceinline__ const void* b_base() const { return Bt; }
    __device__ __forceinline__ unsigned a_off(const pg8::Unit& u) const { return GATHER_A ? 0u : (unsigned)u.pm * (256u * RB); }
    __device__ __forceinline__ unsigned b_off(const pg8::Unit& u) const { return (unsigned)u.e * (unsigned)bstride + (unsigned)u.pn * (256u * (B_BLOCKED ? 128 : RB)); }
    __device__ __forceinline__ int a_row(const pg8::Unit& u, int r) const { return stok[u.e * SLOTCAP + u.mt * 256 + u.roff + (r < u.nrows ? r : 0)]; }
};

struct EpiProj {
    static constexpr bool MIDSCALE = false; static constexpr int NVM = 16;
    static constexpr bool PERM = true; bf16* O; int ldc;
    __device__ __forceinline__ void operator()(const f32x4 (&acc)[2][2][4][2], const pg8::Unit& u, int wr, int wc, int fr, int fq) const {
        const int row0 = u.pm * 256 + wr * 64 + fr, col0 = u.pn * 256 + wc * 32 + 8 * fq;
#pragma unroll
        for (int ai = 0; ai < 2; ++ai)
#pragma unroll
            for (int m = 0; m < 4; ++m) { bf16* rowp = O + (size_t)(row0 + ai * 128 + m * 16) * ldc + col0;
#pragma unroll
                for (int bj = 0; bj < 2; ++bj) { if (u.nh == 2 - bj) continue; const f32x4 v0 = acc[ai][bj][m][0], v1 = acc[ai][bj][m][1];
                    v4u w; w.x = pk2(v0[0], v0[1]); w.y = pk2(v0[2], v0[3]); w.z = pk2(v1[0], v1[1]); w.w = pk2(v1[2], v1[3]);
                    *(v4u*)(rowp + bj * 128) = w; } }
    }
};
struct EpiRes {
    static constexpr int NVM = 48; static constexpr bool PERM = H_BF16 != 0; const float* base; float* out;
    static constexpr bool MIDSCALE = FUSE_P4 != 0; gu32* ssq;
    __device__ __forceinline__ float mid_load(const pg8::Unit& u) const { const int t = threadIdx.x; return t < 256 ? __builtin_bit_cast(float, __hip_atomic_load(ssq + u.pm * 256 + t, RLX_AGENT)) : 0.f; }
    __device__ __forceinline__ float mid_factor(float raw) const { return 1.f / sqrtf(raw * (1.f / 1024.f) + EPS); }
    __device__ __forceinline__ void operator()(const f32x4 (&acc)[2][2][4][2], const pg8::Unit& u, int wr, int wc, int fr, int fq) const {
#if H_BF16
        const int row0 = u.pm * 256 + wr * 64 + fr, col0 = u.pn * 256 + wc * 32 + 8 * fq;
#pragma unroll
        for (int ai = 0; ai < 2; ++ai)
#pragma unroll
            for (int m = 0; m < 4; ++m) { const size_t off = (size_t)(row0 + ai * 128 + m * 16) * DM + col0;
#pragma unroll
                for (int bj = 0; bj < 2; ++bj) { const f32x4 x0 = *(const f32x4*)(base + off + bj * 128), x1 = *(const f32x4*)(base + off + bj * 128 + 4); const f32x4 v0 = x0 + acc[ai][bj][m][0], v1 = x1 + acc[ai][bj][m][1];
                    v4u w; w.x = pk2(v0[0], v0[1]); w.y = pk2(v0[2], v0[3]); w.z = pk2(v1[0], v1[1]); w.w = pk2(v1[2], v1[3]);
                    *(v4u*)((bf16*)out + off + bj * 128) = w; } }
#else
        const int row0 = u.pm * 256 + wr * 64 + fr, col0 = u.pn * 256 + wc * 32 + 4 * fq;
#pragma unroll
        for (int ai = 0; ai < 2; ++ai)
#pragma unroll
            for (int m = 0; m < 4; ++m) { const size_t off = (size_t)(row0 + ai * 128 + m * 16) * DM + col0;
                f32x4 xb[2][2];
#pragma unroll
                for (int bj = 0; bj < 2; ++bj)
#pragma unroll
                    for (int n = 0; n < 2; ++n) xb[bj][n] = *(const f32x4*)(base + off + bj * 128 + n * 16);
#pragma unroll
                for (int bj = 0; bj < 2; ++bj)
#pragma unroll
                    for (int n = 0; n < 2; ++n) *(f32x4*)(out + off + bj * 128 + n * 16) = xb[bj][n] + acc[ai][bj][m][n]; }
#endif
    }
};
__device__ __forceinline__ float swiglu1(float g, float u) {
    g = fminf(g, SW_LIMIT); u = fminf(fmaxf(u, -SW_LIMIT), SW_LIMIT);
    const float glu = g * __builtin_amdgcn_rcpf(1.f + __expf(-SW_ALPHA * g));
    return (u + 1.f) * glu;
}
__device__ __forceinline__ f32x2 swiglu2(f32x2 g, f32x2 u) {
    g.x = fminf(g.x, SW_LIMIT); g.y = fminf(g.y, SW_LIMIT);
    u.x = fminf(fmaxf(u.x, -SW_LIMIT), SW_LIMIT); u.y = fminf(fmaxf(u.y, -SW_LIMIT), SW_LIMIT);
    const f32x2 t = g * (f32x2){-SW_ALPHA * LOG2E, -SW_ALPHA * LOG2E};
    f32x2 e; e.x = __builtin_amdgcn_exp2f(t.x); e.y = __builtin_amdgcn_exp2f(t.y);
    e = e + (f32x2){1.f, 1.f};
    f32x2 r; r.x = __builtin_amdgcn_rcpf(e.x); r.y = __builtin_amdgcn_rcpf(e.y);
    const f32x2 glu = g * r;
    return __builtin_elementwise_fma(u, glu, glu);
}
struct EpiGlu {
    static constexpr bool MIDSCALE = false; static constexpr int NVM = 8; static constexpr bool PERM = true; void* act; const float* bg; const float* bu;
    __device__ __forceinline__ void operator()(const f32x4 (&acc)[2][2][4][2], const pg8::Unit& u, int wr, int wc, int fr, int fq) const {
        if (u.rh == 3) return;
        const int row0 = u.pm * 256 + u.roff + wr * 64 + fr, colf = u.pn * 128 + wc * 32 + 8 * fq;
        f32x4 g_b[2], u_b[2];
#pragma unroll
        for (int n = 0; n < 2; ++n) { g_b[n] = *(const f32x4*)(bg + (size_t)u.e * DFF + colf + 4 * n); u_b[n] = *(const f32x4*)(bu + (size_t)u.e * DFF + colf + 4 * n); }
#pragma unroll
        for (int ai = 0; ai < 2; ++ai) { if (u.rh != 0 && ai == 1) continue;
#pragma unroll
            for (int m = 0; m < 4; ++m) { float r[8];
#pragma unroll
                for (int n = 0; n < 2; ++n) { const float ds_ = (FP8_MOE && (FP8_DIAG || FP8_NOSCALE)) ? (1.f / 64.f) : 1.f; const f32x4 g = acc[ai][0][m][n] * ds_ + g_b[n], uu = acc[ai][1][m][n] * ds_ + u_b[n];
#pragma unroll
                    for (int j = 0; j < 4; j += 2) { const f32x2 r2 = swiglu2((f32x2){g[j], g[j + 1]}, (f32x2){uu[j], uu[j + 1]}); r[4 * n + j] = r2.x; r[4 * n + j + 1] = r2.y;
                        if (EMU_FP8) { r[4 * n + j] = q8(r[4 * n + j]); r[4 * n + j + 1] = q8(r[4 * n + j + 1]); } } }
#if FP8_MOE
                v2u w; w.x = pk4_fp8(r[0], r[1], r[2], r[3]); w.y = pk4_fp8(r[4], r[5], r[6], r[7]);
                *(v2u*)((unsigned char*)act + (size_t)(row0 + ai * 128 + m * 16) * DFF + colf) = w; }
#else
                v4u w; w.x = pk2(r[0], r[1]); w.y = pk2(r[2], r[3]); w.z = pk2(r[4], r[5]); w.w = pk2(r[6], r[7]);
                *(v4u*)((bf16*)act + (size_t)(row0 + ai * 128 + m * 16) * DFF + colf) = w; }
#endif
        }
    }
};
struct EpiDown {
    static constexpr bool MIDSCALE = false; static constexpr int NVM = 16; static constexpr bool PERM = true; bf16* ys; const float* bd; const float* sgate; const int* sdest;
    __device__ __forceinline__ void operator()(const f32x4 (&acc)[2][2][4][2], const pg8::Unit& u, int wr, int wc, int fr, int fq) const {
        const int col0 = u.pn * 256 + wc * 32 + 8 * fq;
        f32x4 bv[2][2];
#pragma unroll
        for (int bj = 0; bj < 2; ++bj)
#pragma unroll
            for (int n = 0; n < 2; ++n) bv[bj][n] = *(const f32x4*)(bd + (size_t)u.e * DM + col0 + bj * 128 + 4 * n);
        float gts[2][4]; int dsts[2][4];
#pragma unroll
        for (int ai = 0; ai < 2; ++ai)
#pragma unroll
            for (int m = 0; m < 4; ++m) { const int rl = ai * 128 + wr * 64 + m * 16 + fr; const int slot = u.e * SLOTCAP + u.mt * 256 + (rl < u.nrows ? rl : 0); gts[ai][m] = sgate[slot]; dsts[ai][m] = sdest[slot]; }
#pragma unroll
        for (int ai = 0; ai < 2; ++ai)
#pragma unroll
            for (int m = 0; m < 4; ++m) { const int rl = ai * 128 + wr * 64 + m * 16 + fr;
                if (rl < u.nrows) { const float gt = gts[ai][m]; const int dest = dsts[ai][m];
#pragma unroll
                    for (int bj = 0; bj < 2; ++bj) { if (u.nh == 2 - bj) continue; const float ds_ = (FP8_MOE && (FP8_DIAG || FP8_NOSCALE)) ? (1.f / 64.f) : 1.f; const f32x4 v0 = (acc[ai][bj][m][0] * ds_ + bv[bj][0]) * gt, v1 = (acc[ai][bj][m][1] * ds_ + bv[bj][1]) * gt;
#if YSLOT_FP8
                        v2u w; w.x = pk4_fp8(v0[0], v0[1], v0[2], v0[3]); w.y = pk4_fp8(v1[0], v1[1], v1[2], v1[3]);
                        *(v2u*)((unsigned char*)ys + (size_t)dest * DM + col0 + bj * 128) = w; } } }
#else
                        v4u w; w.x = pk2(v0[0], v0[1]); w.y = pk2(v0[2], v0[3]); w.z = pk2(v1[0], v1[1]); w.w = pk2(v1[2], v1[3]);
                        *(v4u*)(ys + (size_t)dest * DM + col0 + bj * 128) = w; } } }
#endif
    }
};

__device__ __forceinline__ void unpack8(const v4u w, float (&f)[8]) { f[0] = bflo(w.x); f[1] = bfhi(w.x); f[2] = bflo(w.y); f[3] = bfhi(w.y); f[4] = bflo(w.z); f[5] = bfhi(w.z); f[6] = bflo(w.w); f[7] = bfhi(w.w); }
__device__ __forceinline__ v4u pack8f(const float (&f)[8]) { v4u w; w.x = pk2(f[0], f[1]); w.y = pk2(f[2], f[3]); w.z = pk2(f[4], f[5]); w.w = pk2(f[6], f[7]); return w; }
__device__ __forceinline__ void p2_post(Frame& F) {
    const int gw = F.vcu * NWAVES + F.wave, NGW = F.G * NWAVES, lane = TLANE();
    const bf16* proj = WSP(bf16, WS_PROJ);
    const bool scan = F.vcu < BATCH * AH;
    float fraw[4] = {0.f, 0.f, 0.f, 0.f};
    if (scan) { const int b = F.vcu >> 3, h = F.vcu & 7;
#pragma unroll
        for (int i = 0; i < 4; ++i) fraw[i] = bf2f(proj[(size_t)(b * SEQ + 256 * F.wave + 4 * lane + i) * NP + O_F + h]); }
    for (int t0 = 4 * gw; t0 < NTOK; t0 += 4 * NGW) {
        const int s0 = t0 & 2047;
        v4u xr[3][7];
#pragma unroll
        for (int j8 = 0; j8 < 2; ++j8)
#pragma unroll
            for (int i = 0; i < 7; ++i) { xr[j8][i] = (v4u){0u, 0u, 0u, 0u}; if (s0 + i - 3 >= 0) xr[j8][i] = *(const v4u*)(proj + (size_t)(t0 + i - 3) * NP + O_XBC + 512 * j8 + 8 * lane); }
        v4u raw[4][2][2];
#pragma unroll
        for (int ti = 0; ti < 4; ++ti)
#pragma unroll
            for (int qk = 0; qk < 2; ++qk) { const v4u* src = (const v4u*)(proj + (size_t)(t0 + ti) * NP + (qk ? O_K : O_Q) + 16 * lane); raw[ti][qk][0] = src[0]; raw[ti][qk][1] = src[1]; }
        float dtraw[4];
#pragma unroll
        for (int ti = 0; ti < 4; ++ti) dtraw[ti] = bf2f(proj[(size_t)(t0 + ti) * NP + O_DT + (lane & 15)]);
        {
            const int d0 = (16 * lane) & 127, h = lane >> 3;
            float gqv[16], gkv[16];
#pragma unroll
            for (int j = 0; j < 16; ++j) { gqv[j] = F.gq[d0 + j] * QSCALE; gkv[j] = F.gk[d0 + j]; }
            const float dtb = F.dt_bias[lane & 15], An = -__expf(F.a_log[lane & 15]);
#pragma unroll
            for (int ti = 0; ti < 4; ++ti) { const int t = t0 + ti, b = t >> 11, s = t & 2047;
#pragma unroll
                for (int qk = 0; qk < 2; ++qk) {
                    float f[16]; { float a[8], c[8]; unpack8(raw[ti][qk][0], a); unpack8(raw[ti][qk][1], c);
#pragma unroll
                        for (int j = 0; j < 8; ++j) { f[j] = a[j]; f[8 + j] = c[j]; } }
                    float ss = 0.f;
#pragma unroll
                    for (int j = 0; j < 16; ++j) ss += f[j] * f[j];
                    ss += __shfl_xor(ss, 1); ss += __shfl_xor(ss, 2); ss += __shfl_xor(ss, 4);
                    const float rstd = 1.f / sqrtf(ss * (1.f / 128.f) + EPS);
                    float o0[8], o1[8];
#pragma unroll
                    for (int j = 0; j < 8; ++j) { o0[j] = f[j] * rstd * (qk ? gkv[j] : gqv[j]); o1[j] = f[8 + j] * rstd * (qk ? gkv[8 + j] : gqv[8 + j]); }
                    v4u* dst = (v4u*)(WSP(bf16, qk ? WS_KN : WS_QN) + ((size_t)((b * AH + h) * SEQ + s)) * AHD + d0);
                    dst[0] = pack8f(o0); dst[1] = pack8f(o1);
                }
                if (lane < 16) { const float dt = softplusf_(dtraw[ti] + dtb);
                    WSP(float, WS_DTV)[t * 16 + lane] = dt; WSP(float, WS_DAV)[t * 16 + lane] = dt * An; } }
        }
#pragma unroll
        for (int i = 0; i < 7; ++i) { xr[2][i] = (v4u){0u, 0u, 0u, 0u}; if (s0 + i - 3 >= 0) xr[2][i] = *(const v4u*)(proj + (size_t)(t0 + i - 3) * NP + O_XBC + 1024 + 8 * lane); }
#pragma unroll
        for (int j8 = 0; j8 < 3; ++j8) {
            const int c0 = 512 * j8 + 8 * lane;
            float cw[4][8], cb[8];
#pragma unroll
            for (int tap = 0; tap < 4; ++tap)
#pragma unroll
                for (int j = 0; j < 8; ++j) cw[tap][j] = F.conv_w[tap * CONVCH + c0 + j];
#pragma unroll
            for (int j = 0; j < 8; ++j) cb[j] = F.conv_b[c0 + j];
#pragma unroll
            for (int ti = 0; ti < 4; ++ti) { float a[8];
#pragma unroll
                for (int j = 0; j < 8; ++j) a[j] = cb[j];
#pragma unroll
                for (int tap = 0; tap < 4; ++tap) { float xv[8]; unpack8(xr[j8][ti + tap], xv);
#pragma unroll
                    for (int j = 0; j < 8; ++j) a[j] += cw[tap][j] * xv[j]; }
#pragma unroll
                for (int j = 0; j < 8; ++j) a[j] = siluf_(a[j]);
                *(v4u*)(WSP(bf16, WS_XCONV) + (size_t)(t0 + ti) * CONVCH + c0) = pack8f(a); }
        }
    }
    if (scan) {
        LAS float* WT = (LAS float*)(F.lds + RING_OFF);
        const int bh = F.vcu, h = bh & 7; const float fb = F.fbias[h];
        float lf[4]; float tot = 0.f;
#pragma unroll
        for (int i = 0; i < 4; ++i) { const float xv = fraw[i] + fb; lf[i] = fminf(xv, 0.f) - log1pf(__expf(-fabsf(xv))); tot += lf[i]; }
        float inc = tot;
#pragma unroll
        for (int o = 1; o < 64; o <<= 1) { const float v = __shfl_up(inc, o); if (lane >= o) inc += v; }
        if (lane == 63) WT[F.wave] = inc;
        LDS_WAIT(); __syncthreads();
        float run = inc - tot;
        for (int w = 0; w < F.wave; ++w) run += WT[w];
        f32x4 o;
        run += lf[0]; o.x = run * LOG2E; run += lf[1]; o.y = run * LOG2E; run += lf[2]; o.z = run * LOG2E; run += lf[3]; o.w = run * LOG2E;
        *(f32x4*)(WSP(float, WS_ACUM) + (size_t)bh * SEQ + 256 * F.wave + 4 * lane) = o;
        __syncthreads();
    }
}

__device__ __forceinline__ void p3_attn_naive(Frame& F) {
    const int gw = F.vcu * NWAVES + F.wave, NGW = F.G * NWAVES, lane = TLANE();
    LAS float* qs = (LAS float*)(F.lds + RING_OFF + F.wave * 1024);
    const bf16* QN = WSP(bf16, WS_QN); const bf16* KN = WSP(bf16, WS_KN); const bf16* proj = WSP(bf16, WS_PROJ); const float* AC = WSP(float, WS_ACUM);
    for (int idx = gw; idx < BATCH * AH * SEQ; idx += NGW) {
        const int bh = idx >> 11, q = ((idx & 2047) + bh * 1031) & 2047, b = bh >> 3, h = bh & 7;
        { const unsigned w = *(const unsigned*)(QN + ((size_t)bh * SEQ + q) * AHD + 2 * lane); qs[2 * lane] = bflo(w); qs[2 * lane + 1] = bfhi(w); }
        LDS_WAIT();
        const float Aq = AC[(size_t)bh * SEQ + q];
        float m = -1e30f, l = 0.f, o0 = 0.f, o1 = 0.f;
        for (int kt = 0; kt * 64 <= q; ++kt) {
            const int key = kt * 64 + lane;
            const v4u* kp = (const v4u*)(KN + ((size_t)bh * SEQ + key) * AHD);
            float s = 0.f;
#pragma unroll
            for (int c = 0; c < 16; ++c) { float kf[8]; unpack8(kp[c], kf); const f32x4 q0 = ((const LAS f32x4*)qs)[2 * c], q1 = ((const LAS f32x4*)qs)[2 * c + 1];
                s += kf[0] * q0.x + kf[1] * q0.y + kf[2] * q0.z + kf[3] * q0.w + kf[4] * q1.x + kf[5] * q1.y + kf[6] * q1.z + kf[7] * q1.w; }
            s += Aq - AC[(size_t)bh * SEQ + key];
            if (key > q) s = -__builtin_inff();
            const float mt = wave_max(s), mn = fmaxf(m, mt), alpha = __builtin_amdgcn_exp2f(m - mn), p = __builtin_amdgcn_exp2f(s - mn);
            l = l * alpha + wave_sum(p); o0 *= alpha; o1 *= alpha; m = mn;
            const int nk = (q - kt * 64 + 1) < 64 ? (q - kt * 64 + 1) : 64;
            for (int kk = 0; kk < nk; ++kk) { const float pk = __shfl(p, kk);
                const unsigned w = *(const unsigned*)(proj + (size_t)(b * SEQ + kt * 64 + kk) * NP + O_V + h * AHD + 2 * lane);
                o0 += pk * bflo(w); o1 += pk * bfhi(w); }
        }
        const float il = 1.f / l;
        *(unsigned*)(WSP(bf16, WS_MIX) + (size_t)(b * SEQ + q) * DM + h * AHD + 2 * lane) = pk2(o0 * il, o1 * il);
        LDS_WAIT();
    }
}
__device__ __forceinline__ void p3_ssd_naive(Frame& F) {
    const int gw = F.vcu * NWAVES + F.wave, lane = TLANE();
    if (gw >= BATCH * SH) return;
    const int b = gw >> 4, h = gw & 15, g = h >> 3;
    LAS float* LB = (LAS float*)(F.lds + RING_OFF + 8192 + F.wave * 1024); LAS float* LC = LB + 128;
    const bf16* xc = WSP(bf16, WS_XCONV); const bf16* proj = WSP(bf16, WS_PROJ);
    const float dsk = F.d_skip[h];
    float hst[128];
#pragma unroll
    for (int n = 0; n < 128; ++n) hst[n] = 0.f;
    for (int t = 0; t < SEQ; ++t) {
        const int tok = b * SEQ + t;
        const float dt = WSP(float, WS_DTV)[tok * 16 + h], dec = __expf(WSP(float, WS_DAV)[tok * 16 + h]);
        const float xs = bf2f(xc[(size_t)tok * CONVCH + h * SHD + lane]), xdt = xs * dt;
        const unsigned bw = *(const unsigned*)(xc + (size_t)tok * CONVCH + SW + g * SN + 2 * lane), cw = *(const unsigned*)(xc + (size_t)tok * CONVCH + SW + SG * SN + g * SN + 2 * lane);
        LB[2 * lane] = bflo(bw); LB[2 * lane + 1] = bfhi(bw); LC[2 * lane] = bflo(cw); LC[2 * lane + 1] = bfhi(cw);
        LDS_WAIT();
        float y = 0.f;
#pragma unroll
        for (int n4 = 0; n4 < 32; ++n4) { const f32x4 bv = ((const LAS f32x4*)LB)[n4], cv = ((const LAS f32x4*)LC)[n4];
#pragma unroll
            for (int j = 0; j < 4; ++j) { hst[4 * n4 + j] = hst[4 * n4 + j] * dec + xdt * bv[j]; y += cv[j] * hst[4 * n4 + j]; } }
        LDS_WAIT();
        y += xs * dsk;
        const float z = bf2f(proj[(size_t)tok * NP + O_Z + h * SHD + lane]);
        const float yg = y * siluf_(z);
        const float ss = wave_sum(yg * yg);
        if (lane == 0) atomicAdd((float*)(F.ctl + CW_SSQ) + tok, ss);
        WSP(bf16, WS_MIX)[(size_t)tok * DM + AW + h * SHD + lane] = (bf16)f2bf(yg);
    }
}

__device__ __forceinline__ void p4_ssdnorm(Frame& F) {
    const int gw = F.vcu * NWAVES + F.wave, NGW = F.G * NWAVES, lane = TLANE();
    float gv[16];
#pragma unroll
    for (int j = 0; j < 16; ++j) gv[j] = F.ssd_g[16 * lane + j];
    for (int t0 = 4 * gw; t0 < NTOK; t0 += 4 * NGW) {
        float ssq[4]; v4u r0[4], r1[4];
#pragma unroll
        for (int ti = 0; ti < 4; ++ti) { ssq[ti] = __builtin_bit_cast(float, __hip_atomic_load(F.ctl + CW_SSQ + t0 + ti, RLX_AGENT));
            const v4u* p = (const v4u*)(WSP(bf16, WS_MIX) + (size_t)(t0 + ti) * DM + AW + 16 * lane); r0[ti] = p[0]; r1[ti] = p[1]; }
#pragma unroll
        for (int ti = 0; ti < 4; ++ti) { const float rs = 1.f / sqrtf(ssq[ti] * (1.f / 1024.f) + EPS);
            float a[8], c[8]; unpack8(r0[ti], a); unpack8(r1[ti], c);
#pragma unroll
            for (int j = 0; j < 8; ++j) { a[j] *= rs * gv[j]; c[j] *= rs * gv[8 + j]; if (EMU_OUT8) { a[j] = q8(a[j]); c[j] = q8(c[j]); } }
            v4u* p = (v4u*)(WSP(bf16, WS_MIX) + (size_t)(t0 + ti) * DM + AW + 16 * lane); p[0] = pack8f(a); p[1] = pack8f(c); }
    }
#if EMU_OUT8
    for (int t0 = gw; t0 < NTOK; t0 += NGW) { v4u* p = (v4u*)(WSP(bf16, WS_MIX) + (size_t)t0 * DM + 16 * lane); v4u r0 = p[0], r1 = p[1]; float a[8], c[8]; unpack8(r0, a); unpack8(r1, c);
        for (int j = 0; j < 8; ++j) { a[j] = q8(a[j]); c[j] = q8(c[j]); } p[0] = pack8f(a); p[1] = pack8f(c); }
#endif
}

__device__ __forceinline__ void p6_router(Frame& F) {
    const int tid = TTID(), lane = tid & 63, wave = F.wave, r16 = lane & 15, q4 = lane >> 4;
    LAS float* RED = (LAS float*)(F.lds + RING_OFF);
    LAS int* LC = (LAS int*)(F.lds + RING_OFF + 8 * 32 * 33 * 4); LAS int* LB = LC + 32;
    const bf16* WRH = WSP(bf16, WS_WR); const bf16* WRL = WRH + NE * 2048;
    gu32* cnt = F.ctl + CW_CNT;
    for (int unit = F.vcu; unit < NTOK / 32; unit += F.G) {
        const int T0 = unit * 32;
        float rs[4];
#if H_BF16 && FP8_MOE
        { const int tok = T0 + 4 * wave; const bf16* hr = WSP(bf16, WS_H) + (size_t)tok * DM + 8 * lane;
            v4u v[4][4];
#pragma unroll
            for (int q = 0; q < 4; ++q)
#pragma unroll
                for (int j = 0; j < 4; ++j) v[q][j] = *(const v4u*)(hr + (size_t)q * DM + 512 * j);
#pragma unroll
            for (int q = 0; q < 4; ++q) { float s0 = 0.f;
#pragma unroll
                for (int j = 0; j < 4; ++j) { float f[8]; unpack8(v[q][j], f);
#pragma unroll
                    for (int i = 0; i < 8; ++i) s0 += f[i] * f[i]; }
                rs[q] = 1.f / sqrtf(wave_sum(s0) * (1.f / 2048.f) + EPS); }
#pragma unroll
            for (int j = 0; j < 4; ++j) { const f32x4 g0 = *(const f32x4*)(F.g2 + 8 * lane + 512 * j), g1 = *(const f32x4*)(F.g2 + 8 * lane + 512 * j + 4);
#pragma unroll
                for (int q = 0; q < 4; ++q) { const float rstd = rs[q]; float f[8]; unpack8(v[q][j], f);
                    v2u w; w.x = pk4_fp8(f[0] * rstd * g0.x, f[1] * rstd * g0.y, f[2] * rstd * g0.z, f[3] * rstd * g0.w); w.y = pk4_fp8(f[4] * rstd * g1.x, f[5] * rstd * g1.y, f[6] * rstd * g1.z, f[7] * rstd * g1.w);
                    *(v2u*)(WSP(unsigned char, WS_XN) + (size_t)(tok + q) * DM + 8 * lane + 512 * j) = w; } }
        }
#else
        { const int tok = T0 + 4 * wave; const f32x4* xr = (const f32x4*)(F.out + (size_t)tok * DM) + lane; const f32x4* gr = (const f32x4*)F.g2 + lane;
            f32x4 v[4][8];
#pragma unroll
            for (int q = 0; q < 4; ++q)
#pragma unroll
                for (int j = 0; j < 8; ++j) v[q][j] = xr[q * (DM / 4) + 64 * j];
#pragma unroll
            for (int q = 0; q < 4; ++q) { float s0 = 0.f;
#pragma unroll
                for (int j = 0; j < 8; ++j) s0 += (v[q][j].x * v[q][j].x + v[q][j].y * v[q][j].y) + (v[q][j].z * v[q][j].z + v[q][j].w * v[q][j].w);
                rs[q] = 1.f / sqrtf(wave_sum(s0) * (1.f / 2048.f) + EPS); }
#pragma unroll
            for (int j = 0; j < 8; ++j) { const f32x4 gg = gr[64 * j];
#pragma unroll
                for (int q = 0; q < 4; ++q) { const float rstd = rs[q];
                    f32x4 t = {v[q][j].x * rstd * gg.x, v[q][j].y * rstd * gg.y, v[q][j].z * rstd * gg.z, v[q][j].w * rstd * gg.w};
                    if (EMU_FP8) { t.x = q8(t.x); t.y = q8(t.y); t.z = q8(t.z); t.w = q8(t.w); }
#if FP8_MOE
                    ((unsigned*)(WSP(unsigned char, WS_XN) + (size_t)(tok + q) * DM))[lane + 64 * j] = pk4_fp8(t.x, t.y, t.z, t.w); }
#else
                    v2u w; w.x = pk2(t.x, t.y); w.y = pk2(t.z, t.w); ((v2u*)(WSP(bf16, WS_XN) + (size_t)(tok + q) * DM) + lane)[64 * j] = w; }
#endif
            }
        }
#endif
        f32x4 acc[2][2];
#pragma unroll
        for (int a = 0; a < 2; ++a)
#pragma unroll
            for (int c = 0; c < 2; ++c) acc[a][c] = (f32x4){0.f, 0.f, 0.f, 0.f};
#pragma unroll 4
        for (int ks = 0; ks < 8; ++ks) { const int k = 256 * wave + 32 * ks + 8 * q4;
            bf16x8 bh[2], bl[2];
#pragma unroll
            for (int n = 0; n < 2; ++n) { bh[n] = *(const bf16x8*)(WRH + (size_t)(16 * n + r16) * 2048 + k); bl[n] = *(const bf16x8*)(WRL + (size_t)(16 * n + r16) * 2048 + k); }
#pragma unroll
#if H_BF16
            for (int mt = 0; mt < 2; ++mt) { const bf16x8 ah = *(const bf16x8*)(WSP(bf16, WS_H) + (size_t)(T0 + 16 * mt + r16) * DM + k);
#pragma unroll
                for (int n = 0; n < 2; ++n) { acc[mt][n] = __builtin_amdgcn_mfma_f32_16x16x32_bf16(ah, bh[n], acc[mt][n], 0, 0, 0); acc[mt][n] = __builtin_amdgcn_mfma_f32_16x16x32_bf16(ah, bl[n], acc[mt][n], 0, 0, 0); } }
#else
            for (int mt = 0; mt < 2; ++mt) { const float* xp = F.out + (size_t)(T0 + 16 * mt + r16) * DM + k;
                const f32x4 x0 = *(const f32x4*)xp, x1 = *(const f32x4*)(xp + 4);
                float xv[8] = {x0.x, x0.y, x0.z, x0.w, x1.x, x1.y, x1.z, x1.w}; float hv[8], lv[8];
#pragma unroll
                for (int j = 0; j < 8; ++j) { hv[j] = bf2f(f2bf(xv[j])); lv[j] = xv[j] - hv[j]; }
                const v4u ahw = pack8f(hv), alw = pack8f(lv);
                const bf16x8 ah = __builtin_bit_cast(bf16x8, ahw), al = __builtin_bit_cast(bf16x8, alw);
#pragma unroll
                for (int n = 0; n < 2; ++n) { acc[mt][n] = __builtin_amdgcn_mfma_f32_16x16x32_bf16(ah, bh[n], acc[mt][n], 0, 0, 0);
                    acc[mt][n] = __builtin_amdgcn_mfma_f32_16x16x32_bf16(ah, bl[n], acc[mt][n], 0, 0, 0);
                    acc[mt][n] = __builtin_amdgcn_mfma_f32_16x16x32_bf16(al, bh[n], acc[mt][n], 0, 0, 0); } }
#endif
        }
#pragma unroll
        for (int mt = 0; mt < 2; ++mt)
#pragma unroll
            for (int n = 0; n < 2; ++n)
#pragma unroll
                for (int rg = 0; rg < 4; ++rg) RED[(wave * 32 + 16 * mt + 4 * q4 + rg) * 33 + 16 * n + r16] = acc[mt][n][rg];
        if (tid < 32) LC[tid] = 0;
        __syncthreads();
        { const int tokl = tid >> 4, e2 = r16 * 2;
          const float rsel = q4 == 0 ? rs[0] : q4 == 1 ? rs[1] : q4 == 2 ? rs[2] : rs[3];
          float l0 = 0.f, l1 = 0.f;
#pragma unroll
          for (int w = 0; w < 8; ++w) { l0 += RED[(w * 32 + tokl) * 33 + e2]; l1 += RED[(w * 32 + tokl) * 33 + e2 + 1]; }
          l0 = l0 * rsel + F.b_router[e2]; l1 = l1 * rsel + F.b_router[e2 + 1];
          float val[4]; int idx[4];
#pragma unroll
          for (int k = 0; k < 4; ++k) { float bv = l0; int bi = e2; if (l1 > l0) { bv = l1; bi = e2 + 1; }
#pragma unroll
              for (int m = 1; m < 16; m <<= 1) { const float ov = __shfl_xor(bv, m); const int oi = __shfl_xor(bi, m); if (ov > bv || (ov == bv && oi < bi)) { bv = ov; bi = oi; } }
              val[k] = bv; idx[k] = bi;
              if (bi == e2) l0 = -__builtin_inff(); if (bi == e2 + 1) l1 = -__builtin_inff(); }
          float ex[4], sum = 0.f;
#pragma unroll
          for (int k = 0; k < 4; ++k) { ex[k] = __expf(val[k] - val[0]); sum += ex[k]; }
          const float inv = 1.f / sum;
          int esel = 0, loc = 0; float gsel = 0.f;
          if (r16 < 4) { const int k = r16;
              const int e = k == 0 ? idx[0] : k == 1 ? idx[1] : k == 2 ? idx[2] : idx[3]; const float g = (k == 0 ? ex[0] : k == 1 ? ex[1] : k == 2 ? ex[2] : ex[3]) * inv;
              esel = e; gsel = g; loc = __hip_atomic_fetch_add(LC + e, 1, __ATOMIC_RELAXED, __HIP_MEMORY_SCOPE_WORKGROUP); }
          __syncthreads();
          if (tid < 32) { const int c = LC[tid]; LB[tid] = c > 0 ? (int)__hip_atomic_fetch_add(cnt + 64 * tid, (unsigned)c, RLX_AGENT) : 0; }
#ifdef PROBE_AT2
          __syncthreads();
          if (tid < 32) { const int c = LC[tid]; const int d = c > 0 ? (int)__hip_atomic_fetch_add(cnt + 64 * tid + 32, (unsigned)c, RLX_AGENT) : 0; if (d < 0) LB[tid] = d; }
#endif
          __syncthreads();
          if (r16 < 4) { const int tok = T0 + tokl; const size_t sl = (size_t)esel * SLOTCAP + (LB[esel] + loc); WSP(int, WS_STOK)[sl] = tok; WSP(float, WS_SGATE)[sl] = gsel; WSP(int, WS_SDEST)[sl] = tok * 4 + r16; } }
        __syncthreads();
    }
}
__device__ __forceinline__ void moe_tables(Frame& F) {
    LAS int* TB = (LAS int*)(F.lds + TB_OFF); LAS int* CN = TB + 64; LAS int* MT = CN + 32; LAS int* TBF = MT + 32; LAS int* TBH = TBF + 64;
    const int tid = TTID();
    if (tid < NE) { const int c = (int)__hip_atomic_load(F.ctl + CW_CNT + 64 * tid, RLX_AGENT); CN[tid] = c; MT[tid] = (c + 255) >> 8; }
    __syncthreads();
    if (tid == 0) { int run = 0, rf = 0, rh = 0;
        for (int e = 0; e < NE; ++e) { const int mt = MT[e], rem = CN[e] - (mt - 1) * 256, hf = (HALF_UNITS_CFG && mt > 0 && rem <= 128) ? 1 : 0;
            TB[e] = run; TBF[e] = rf; TBH[e] = rh; run += mt; rf += mt - hf; rh += hf; }
        TB[NE] = run; TBF[NE] = rf; TBH[NE] = rh; }
    __syncthreads();
}
__device__ __forceinline__ void p9_combine(Frame& F) {
    const int gw = F.vcu * NWAVES + F.wave, NGW = F.G * NWAVES, lane = TLANE();
#if PROBE_T
    const float probe_s = 1.f + __builtin_bit_cast(float, __hip_atomic_load(F.ctl + CW_PROBE, RLX_AGENT)), probe_a = __builtin_bit_cast(float, __hip_atomic_load(F.ctl + CW_PROBE + 1, RLX_AGENT));
#endif
#if YSLOT_FP8 && H_BF16
    const unsigned char* ys = WSP(unsigned char, WS_YSLOT); const bf16* hb = WSP(bf16, WS_H);
    for (int t = gw; t < NTOK; t += NGW) {
        v4u hh[2][2], yy[2][4];
#pragma unroll
        for (int j = 0; j < 2; ++j) { const int col = 16 * lane + 1024 * j;
            hh[j][0] = *(const v4u*)(hb + (size_t)t * DM + col); hh[j][1] = *(const v4u*)(hb + (size_t)t * DM + col + 8);
#pragma unroll
            for (int k = 0; k < 4; ++k) yy[j][k] = *(const v4u*)(ys + (size_t)(4 * t + k) * DM + col); }
#pragma unroll
        for (int j = 0; j < 2; ++j) { float* op = F.out + (size_t)t * DM + 16 * lane + 1024 * j;
            float a[16]; { float f0[8], f1[8]; unpack8(hh[j][0], f0); unpack8(hh[j][1], f1);
#pragma unroll
                for (int i = 0; i < 8; ++i) { a[i] = f0[i]; a[8 + i] = f1[i]; } }
#pragma unroll
            for (int k = 0; k < 4; ++k) { const unsigned yw[4] = {yy[j][k].x, yy[j][k].y, yy[j][k].z, yy[j][k].w};
#pragma unroll
                for (int q = 0; q < 4; ++q) { a[4 * q] += __builtin_amdgcn_cvt_f32_fp8((int)yw[q], 0); a[4 * q + 1] += __builtin_amdgcn_cvt_f32_fp8((int)yw[q], 1); a[4 * q + 2] += __builtin_amdgcn_cvt_f32_fp8((int)yw[q], 2); a[4 * q + 3] += __builtin_amdgcn_cvt_f32_fp8((int)yw[q], 3); } }
#pragma unroll
            for (int q = 0; q < 4; ++q) { f32x4 o = {a[4 * q], a[4 * q + 1], a[4 * q + 2], a[4 * q + 3]};
#if PROBE_T
                o = o * probe_s; if (t == 0 && lane == 0 && j == 0 && q == 0) o.x += probe_a;
#endif
                *(f32x4*)(op + 4 * q) = o; } }
    }
#elif YSLOT_FP8
    const unsigned char* ys = WSP(unsigned char, WS_YSLOT);
    for (int t = gw; t < NTOK; t += NGW) {
#pragma unroll
        for (int j = 0; j < 2; ++j) { const int col = 16 * lane + 1024 * j; float* op = F.out + (size_t)t * DM + col;
            f32x4 a[4];
#pragma unroll
            for (int q = 0; q < 4; ++q) a[q] = *(const f32x4*)(op + 4 * q);
#pragma unroll
            for (int k = 0; k < 4; ++k) { const v4u y = *(const v4u*)(ys + (size_t)(4 * t + k) * DM + col); const unsigned yw[4] = {y.x, y.y, y.z, y.w};
#pragma unroll
                for (int q = 0; q < 4; ++q) { a[q].x += __builtin_amdgcn_cvt_f32_fp8((int)yw[q], 0); a[q].y += __builtin_amdgcn_cvt_f32_fp8((int)yw[q], 1); a[q].z += __builtin_amdgcn_cvt_f32_fp8((int)yw[q], 2); a[q].w += __builtin_amdgcn_cvt_f32_fp8((int)yw[q], 3); } }
#pragma unroll
            for (int q = 0; q < 4; ++q) *(f32x4*)(op + 4 * q) = a[q]; }
    }
#else
    const bf16* ys = WSP(bf16, WS_YSLOT);
    for (int t = gw; t < NTOK; t += NGW) {
        float* op = F.out + (size_t)t * DM + 8 * lane;
        f32x4 a0[4], a1[4]; v4u y[4][4];
#pragma unroll
        for (int j = 0; j < 4; ++j) { a0[j] = *(const f32x4*)(op + 512 * j); a1[j] = *(const f32x4*)(op + 512 * j + 4);
#pragma unroll
            for (int k = 0; k < 4; ++k) y[j][k] = __builtin_nontemporal_load((const GAS v4u*)(ys + (size_t)(4 * t + k) * DM + 8 * lane + 512 * j)); }
#pragma unroll
        for (int j = 0; j < 4; ++j) {
#pragma unroll
            for (int k = 0; k < 4; ++k) { float yv[8]; unpack8(y[j][k], yv);
                a0[j].x += yv[0]; a0[j].y += yv[1]; a0[j].z += yv[2]; a0[j].w += yv[3]; a1[j].x += yv[4]; a1[j].y += yv[5]; a1[j].z += yv[6]; a1[j].w += yv[7]; }
#if PROBE_T
            a0[j] = a0[j] * probe_s; a1[j] = a1[j] * probe_s; if (t == 0 && lane == 0 && j == 0) a0[j].x = probe_a;
#endif
            __builtin_nontemporal_store(a0[j], (GAS f32x4*)(op + 512 * j)); __builtin_nontemporal_store(a1[j], (GAS f32x4*)(op + 512 * j + 4)); }
    }
#endif
}
namespace attn {
constexpr int D = 128, NW = 8, QBLK = 32, KVBLK = 64, QB = NW * QBLK;
constexpr int SHM_V = KVBLK * D * 2, SHM_K = KVBLK * D * 2;
constexpr int ATT_LDS_BYTES = 2 * SHM_V + 2 * SHM_K + NW * 64 * 4;
constexpr int KPITCH = 128, VPITCH = NP, OPITCH = DM;
constexpr float THR2 = 11.5416f;
typedef short s16x4 __attribute__((ext_vector_type(4)));
typedef float f32x16 __attribute__((ext_vector_type(16)));
typedef unsigned u32x4 __attribute__((ext_vector_type(4)));

#define KSWZ(row, colB) ((row) * 256 + ((colB) ^ (((row) & 7) << 4)))
#define SBAR() __builtin_amdgcn_sched_barrier(0)
__device__ __forceinline__ int v_st(int k, int c) { const int kk = (k & ~0xC) | ((k & 4) << 1) | ((k & 8) >> 1); return ((kk >> 3) * 4 + (c >> 5)) * 512 + ((kk & 7) * 32 + (c & 31)) * 2; }
__device__ __forceinline__ int v_rd_base(int lane) { return ((lane & 3) << 3) | (((lane >> 2) & 3) << 6) | (((lane >> 4) & 1) << 5) | (((lane >> 5) & 1) << 8); }
constexpr int v_rd_off(int d0, int ks, int half) { return d0 * 512 + ks * 4096 + half * 2048; }
__device__ __forceinline__ int crow(int r, int hi) { return (r & 3) + 8 * (r >> 2) + 4 * hi; }
__device__ __forceinline__ unsigned cvtpk(float lo, float hi) { unsigned r; asm volatile("v_cvt_pk_bf16_f32 %0, %1, %2" : "=v"(r) : "v"(lo), "v"(hi)); return r; }
__device__ __forceinline__ void mask_tile(f32x16& p0, f32x16& p1, int dq) {
    const float NEG = -__builtin_inff();
#pragma unroll
    for (int r = 0; r < 16; ++r) {
        const int c = (r & 3) + 8 * (r >> 2);
        if (dq - c < 0) p0[r] = NEG;
        if (dq - c - 32 < 0) p1[r] = NEG;
    }
}
__device__ __forceinline__ void partialSM(f32x16& p0, f32x16& p1, float& m_reg, float& mn, float& alpha) {
    float pmax = p0[0]; for (int r = 1; r < 16; ++r) pmax = fmaxf(pmax, p0[r]); for (int r = 0; r < 16; ++r) pmax = fmaxf(pmax, p1[r]);
    { auto rr = __builtin_amdgcn_permlane32_swap(__float_as_uint(pmax), __float_as_uint(pmax), false, false);
      pmax = fmaxf(__uint_as_float(rr[0]), __uint_as_float(rr[1])); }
    if (__builtin_expect(__all((pmax - m_reg) <= THR2), 1)) { mn = m_reg; alpha = 1.f; }
    else { mn = fmaxf(m_reg, pmax); alpha = __builtin_amdgcn_exp2f(m_reg - mn); m_reg = mn; }
    for (int r = 0; r < 16; ++r) p0[r] = p0[r] - mn; for (int r = 0; r < 16; ++r) p1[r] = p1[r] - mn;
    for (int r = 0; r < 16; ++r) p0[r] = __builtin_amdgcn_exp2f(p0[r]);
}
__device__ __forceinline__ void finishSM(f32x16& p0, f32x16& p1, float alpha, float& l_reg, bf16x8& pa0, bf16x8& pa1, bf16x8& pa2, bf16x8& pa3) {
    for (int r = 0; r < 16; ++r) p1[r] = __builtin_amdgcn_exp2f(p1[r]);
    float ps = 0; for (int r = 0; r < 16; ++r) ps += p0[r]; for (int r = 0; r < 16; ++r) ps += p1[r];
    { auto rr = __builtin_amdgcn_permlane32_swap(__float_as_uint(ps), __float_as_uint(ps), false, false);
      ps = __uint_as_float(rr[0]) + __uint_as_float(rr[1]); }
    l_reg = l_reg * alpha + ps;
#define PK4(P, B_, OUT) do { unsigned a0 = cvtpk(P[B_+0], P[B_+1]), a1 = cvtpk(P[B_+2], P[B_+3]);                          \
        unsigned b0 = cvtpk(P[B_+4], P[B_+5]), b1 = cvtpk(P[B_+6], P[B_+7]);                                             \
        auto r0 = __builtin_amdgcn_permlane32_swap(a0, b0, false, false); auto r1 = __builtin_amdgcn_permlane32_swap(a1, b1, false, false); \
        u32x4 w = {r0[0], r1[0], r0[1], r1[1]}; OUT = *reinterpret_cast<bf16x8*>(&w); } while (0)
    PK4(p0, 0, pa0); PK4(p0, 8, pa1); PK4(p1, 0, pa2); PK4(p1, 8, pa3);
#undef PK4
}
__device__ __forceinline__ unsigned split2(float a) { const unsigned h = cvtpk(a, 0.f) & 0xffffu; const float r1 = a - __uint_as_float(h << 16); return h | (cvtpk(r1, 0.f) << 16); }
__device__ __forceinline__ bf16x8 q_aug(unsigned w) { u32x4 v = {w, 0x3f803f80u, 0u, 0u}; return *reinterpret_cast<bf16x8*>(&v); }
__device__ __forceinline__ bf16x8 k_aug(float nk, int hi) { u32x4 v = {0x3f803f80u, split2(nk), 0u, 0u}; if (hi) v = (u32x4){0u, 0u, 0u, 0u}; return *reinterpret_cast<bf16x8*>(&v); }
template <int KB>
__device__ __forceinline__ void qkt(f32x16& p0, f32x16& p1, const char* K_lds, int r32, int hi, const bf16x8* qr, unsigned qa, float ak0, float ak1, float aref) {
    p0 = f32x16{}; p1 = f32x16{};
    const char* kb[4];
#pragma unroll
    for (int dd = 0; dd < 4; ++dd) kb[dd] = K_lds + KB * SHM_K + KSWZ(r32, (dd * 16 + hi * 8) * 2);
#pragma unroll
    for (int d0 = 0; d0 < 8; ++d0) { const char* a = kb[d0 & 3] + (d0 >> 2) * 128;
        bf16x8 b0 = *reinterpret_cast<const bf16x8*>(a);
        bf16x8 b1 = *reinterpret_cast<const bf16x8*>(a + 32 * 256);
        p0 = __builtin_amdgcn_mfma_f32_32x32x16_bf16(b0, qr[d0], p0, 0, 0, 0);
        p1 = __builtin_amdgcn_mfma_f32_32x32x16_bf16(b1, qr[d0], p1, 0, 0, 0); }
    p0 = __builtin_amdgcn_mfma_f32_32x32x16_bf16(k_aug(aref - ak0, hi), q_aug(qa), p0, 0, 0, 0);
    p1 = __builtin_amdgcn_mfma_f32_32x32x16_bf16(k_aug(aref - ak1, hi), q_aug(qa), p1, 0, 0, 0);
}
template <int VB>
__device__ __forceinline__ void pv_tile(f32x16* o, int vb0, bf16x8 pa0, bf16x8 pa1, bf16x8 pa2, bf16x8 pa3) {
#define TRRD(dst, off) asm volatile("ds_read_b64_tr_b16 %0, %1 offset:%2" : "=&v"(dst) : "v"(vb0), "i"(off) : "memory")
#define PV_D0(d0) do { s16x4 l0, l1, l2, l3, h0, h1, h2, h3; constexpr int b_ = VB * SHM_V + v_rd_off(d0, 0, 0);   \
        TRRD(l0, b_); TRRD(h0, b_ + 2048); TRRD(l1, b_ + 4096); TRRD(h1, b_ + 6144); TRRD(l2, b_ + 8192); TRRD(h2, b_ + 10240); TRRD(l3, b_ + 12288); TRRD(h3, b_ + 14336); \
        asm volatile("s_waitcnt lgkmcnt(0)" ::: "memory"); SBAR();                                                                    \
        o[d0] = __builtin_amdgcn_mfma_f32_32x32x16_bf16(pa0, (bf16x8){l0[0], l0[1], l0[2], l0[3], h0[0], h0[1], h0[2], h0[3]}, o[d0], 0, 0, 0);   \
        o[d0] = __builtin_amdgcn_mfma_f32_32x32x16_bf16(pa1, (bf16x8){l1[0], l1[1], l1[2], l1[3], h1[0], h1[1], h1[2], h1[3]}, o[d0], 0, 0, 0);   \
        o[d0] = __builtin_amdgcn_mfma_f32_32x32x16_bf16(pa2, (bf16x8){l2[0], l2[1], l2[2], l2[3], h2[0], h2[1], h2[2], h2[3]}, o[d0], 0, 0, 0);   \
        o[d0] = __builtin_amdgcn_mfma_f32_32x32x16_bf16(pa3, (bf16x8){l3[0], l3[1], l3[2], l3[3], h3[0], h3[1], h3[2], h3[3]}, o[d0], 0, 0, 0); } while (0)
    PV_D0(0); PV_D0(1); PV_D0(2); PV_D0(3);
#undef PV_D0
#undef TRRD
}
struct BlockRef { const bf16* Q; const bf16* K; const bf16* V; bf16* O; const float* A; int P0; };
struct Seam { bf16x8 qr[8]; unsigned qa; bf16x8 st_v0, st_v1, st_k0, st_k1; float ak[2][2]; };
#define VMW() asm volatile("s_waitcnt vmcnt(0)" ::: "memory")
#define VMWN(n) asm volatile("s_waitcnt vmcnt(%0)" :: "i"(n) : "memory")
#define LD8(p) (*reinterpret_cast<const bf16x8*>(p))
#define SLOAD_H(Kp, Vp, Ap, k0, AB) do { S.st_v0 = LD8((Vp) + (size_t)((k0) + sr) * VPITCH + sc); S.st_v1 = LD8((Vp) + (size_t)((k0) + 32 + sr) * VPITCH + sc);   \
                         S.st_k0 = LD8((Kp) + (size_t)((k0) + sr) * KPITCH + sc); S.st_k1 = LD8((Kp) + (size_t)((k0) + 32 + sr) * KPITCH + sc);                      \
                         S.ak[AB][0] = (Ap)[(k0) + r32]; S.ak[AB][1] = (Ap)[(k0) + 32 + r32]; } while (0)
#define SWRITE_HK(bf) do { *(bf16x8*)(K_lds + (bf) * SHM_K + kws) = S.st_k0; *(bf16x8*)(K_lds + (bf) * SHM_K + kws + 32 * 256) = S.st_k1; } while (0)
#define SWRITE_HV(bf) do { *(bf16x8*)(V_lds + (bf) * SHM_V + vst0) = S.st_v0; *(bf16x8*)(V_lds + (bf) * SHM_V + vst1) = S.st_v1; } while (0)
#define SWRITE_H(bf) do { SWRITE_HV(bf); SWRITE_HK(bf); } while (0)
#define QLOAD(R) do { _Pragma("unroll") for (int d0 = 0; d0 < 8; ++d0) S.qr[d0] = LD8((R).Q + (size_t)(wid * QBLK + r32) * KPITCH + d0 * 16 + hi * 8);   \
                      S.qa = split2((R).A[(R).P0 + wid * QBLK + r32] - (R).A[(R).P0]); } while (0)
__device__ __forceinline__ void block_prime(const BlockRef& cur, char* lds, Seam& S) {
    int tid = threadIdx.x; asm volatile("" : "+v"(tid));
    const int wid = __builtin_amdgcn_readfirstlane(tid >> 6), lane = tid & 63, r32 = lane & 31, hi = lane >> 5;
    const int sr = tid >> 4, sc = (tid & 15) * 8, kws = KSWZ(sr, sc * 2); char* K_lds = lds + 2 * SHM_V;
    QLOAD(cur);
    SLOAD_H(cur.K, cur.V, cur.A, 0, 0); VMW(); SWRITE_HK(0);
    __syncthreads();
}
__device__ __forceinline__ void block_run(const BlockRef& cur, char* lds, Seam& S) {
    int tid = threadIdx.x; asm volatile("" : "+v"(tid));
    const int wid = __builtin_amdgcn_readfirstlane(tid >> 6), lane = tid & 63, r32 = lane & 31, hi = lane >> 5;
    const int NT = (cur.P0 + QB - 1) / KVBLK + 1;
    const int qlo = cur.P0 + wid * QBLK, qm = qlo + r32 - 4 * hi;
    char* V_lds = lds; char* K_lds = lds + 2 * SHM_V;
    float* ws = (float*)(lds + 2 * SHM_V + 2 * SHM_K) + wid * 64; float* li_l = ws, * al_l = ws + 32;
    float m_reg = -1e30f, l_reg = 0; f32x16 o[4] = {};
    const int sr = tid >> 4, sc = (tid & 15) * 8, vst0 = v_st(sr, sc), vst1 = v_st(32 + sr, sc), kws = KSWZ(sr, sc * 2);
    const int vb0 = (int)(uintptr_t)V_lds + v_rd_base(lane);
    const bf16* Kh = cur.K; const bf16* Vh = cur.V; const float* Ah = cur.A; const float aref = cur.A[cur.P0];
#define RESC(a) do { if (__any((a) < 1.f)) { if (hi == 0) al_l[r32] = (a); asm volatile("s_waitcnt lgkmcnt(0)" ::: "memory");              \
                     for (int d_ = 0; d_ < 4; ++d_) for (int r = 0; r < 16; ++r) o[d_][r] *= al_l[crow(r, hi)]; } } while (0)
#define KBASE(t) ((t) * KVBLK)
#define MASKT(P0_, P1_, t) do { const int kb_ = KBASE(t); if (kb_ + KVBLK - 1 > qlo) mask_tile(P0_, P1_, qm - kb_); } while (0)
    f32x16 pA0, pA1, pB0, pB1; float mnA, mnB, alA, alB; bf16x8 pa0, pa1, pa2, pa3;
    SWRITE_HV(0); SBAR();
    const float a00 = S.ak[0][0], a01 = S.ak[0][1];
    if (NT > 1) SLOAD_H(Kh, Vh, Ah, KBASE(1), 1);
    SBAR(); qkt<0>(pA0, pA1, K_lds, r32, hi, S.qr, S.qa, a00, a01, aref);
    MASKT(pA0, pA1, 0); partialSM(pA0, pA1, m_reg, mnA, alA);
    if (NT > 1) { VMW(); SWRITE_H(1); }
    __syncthreads();
#define HALF_STEP(PX0, PX1, mnX, alX, PY0, PY1, alY, t, KB, VB, SB) do {                                                      \
        SBAR(); qkt<KB>(PX0, PX1, K_lds, r32, hi, S.qr, S.qa, S.ak[KB][0], S.ak[KB][1], aref);                                             \
        finishSM(PY0, PY1, alY, l_reg, pa0, pa1, pa2, pa3); SBAR();                                                           \
        if ((t) + 1 < NT) { SLOAD_H(Kh, Vh, Ah, KBASE((t) + 1), SB); SBAR(); }                                                \
        pv_tile<VB>(o, vb0, pa0, pa1, pa2, pa3); MASKT(PX0, PX1, (t)); partialSM(PX0, PX1, m_reg, mnX, alX);                  \
        __syncthreads();                                                                                                      \
        if ((t) + 1 < NT) { VMW(); SWRITE_H(SB); }                                                                            \
        RESC(alX); __syncthreads(); } while (0)
    for (int t = 1; t + 1 < NT; t += 2) {
        HALF_STEP(pB0, pB1, mnB, alB, pA0, pA1, alA, t, 1, 0, 0);
        HALF_STEP(pA0, pA1, mnA, alA, pB0, pB1, alB, t + 1, 0, 1, 1);
    }
    const bool even = (NT & 1) == 0;
    if (even) { SBAR(); qkt<1>(pB0, pB1, K_lds, r32, hi, S.qr, S.qa, S.ak[1][0], S.ak[1][1], aref); SBAR(); }
    finishSM(pA0, pA1, alA, l_reg, pa0, pa1, pa2, pa3); SBAR();
    pv_tile<0>(o, vb0, pa0, pa1, pa2, pa3);
    if (even) { MASKT(pB0, pB1, NT - 1); partialSM(pB0, pB1, m_reg, mnB, alB); __syncthreads(); RESC(alB);
        finishSM(pB0, pB1, alB, l_reg, pa0, pa1, pa2, pa3); SBAR(); pv_tile<1>(o, vb0, pa0, pa1, pa2, pa3); }
    if (hi == 0) li_l[r32] = l_reg; asm volatile("s_waitcnt lgkmcnt(0)" ::: "memory");
    float rli[16];
#pragma unroll
    for (int r = 0; r < 16; ++r) rli[r] = __builtin_amdgcn_rcpf(li_l[crow(r, hi)]);
    bf16* Ow = cur.O + (size_t)(wid * QBLK) * OPITCH;
#pragma unroll
    for (int r = 0; r < 16; ++r) { const int orow = crow(r, hi);
#pragma unroll
        for (int d0 = 0; d0 < 4; ++d0) { const float v = o[d0][r] * rli[r];
            const float vn = __shfl_xor(v, 1);
            if ((r32 & 1) == 0) *(unsigned*)(Ow + (size_t)orow * OPITCH + d0 * 32 + r32) = cvtpk(v, vn); } }
    __syncthreads();
#undef RESC
#undef KBASE
#undef MASKT
#undef HALF_STEP
}
#undef VMW
#undef VMWN
#undef LD8
#undef SLOAD_H
#undef SWRITE_HK
#undef SWRITE_HV
#undef SWRITE_H
#undef QLOAD
#undef KSWZ
#undef SBAR
}

__device__ __forceinline__ attn::BlockRef attn_ref(Frame& F, int a) {
    const int x = a >> 5, j = a & 31, bh = 4 * x + (j & 3), qb = j >> 2, b = bh >> 3, h = bh & 7;
    attn::BlockRef r;
    r.Q = WSP(bf16, WS_QN) + ((size_t)bh * SEQ + qb * 256) * AHD; r.K = WSP(bf16, WS_KN) + (size_t)bh * SEQ * AHD;
    r.V = WSP(bf16, WS_PROJ) + (size_t)(b * SEQ) * NP + O_V + h * AHD; r.O = WSP(bf16, WS_MIX) + (size_t)(b * SEQ + qb * 256) * DM + h * AHD;
    r.A = WSP(float, WS_ACUM) + (size_t)bh * SEQ; r.P0 = qb * 256; return r;
}
__device__ __forceinline__ void p3_attn(Frame& F) {
    char* lds = (char*)(F.lds + RING_OFF);
    if (F.G == 256) {
        const int j = F.vcu & 31;
        if (j < SSD_WPX) return;
        { const attn::BlockRef cur = attn_ref(F, F.vcu); attn::Seam S; attn::block_prime(cur, lds, S); attn::block_run(cur, lds, S); }
        if (j >= 8 && j < 8 + SSD_WPX) { const attn::BlockRef cur = attn_ref(F, F.vcu - 8); attn::Seam S; attn::block_prime(cur, lds, S); attn::block_run(cur, lds, S); }
        return;
    }
    for (int a = F.vcu; a < BATCH * AH * (SEQ / 256); a += F.G) {
        const attn::BlockRef cur = attn_ref(F, a);
        attn::Seam S;
        attn::block_prime(cur, lds, S);
        attn::block_run(cur, lds, S);
    }
}
namespace ssd {
__device__ __forceinline__ float dpp_scan64(float x) {
    float v = x;
#define SSD_DPP_ADD(ctrl, rowmask) do { const int t_ = __builtin_amdgcn_update_dpp(0, __builtin_bit_cast(int, v), (ctrl), (rowmask), 0xf, true); v += __builtin_bit_cast(float, t_); } while (0)
    SSD_DPP_ADD(0x111, 0xf); SSD_DPP_ADD(0x112, 0xf); SSD_DPP_ADD(0x114, 0xf); SSD_DPP_ADD(0x118, 0xf);
    SSD_DPP_ADD(0x142, 0xa); SSD_DPP_ADD(0x143, 0xc);
#undef SSD_DPP_ADD
    return v;
}
constexpr int CP = 136, TP = 72, YP = 68;
constexpr int L_CM = 0, L_BM = L_CM + 64 * CP * 2, L_BT = L_BM + 64 * CP * 2, L_XT = L_BT + 128 * TP * 2, L_XD = L_XT + 64 * TP * 2, L_H = L_XD + 64 * TP * 2,
              L_Y = L_H + 64 * CP * 2, L_XS = L_Y + 64 * YP * 4, L_ACS = L_XS + 64 * TP * 2, L_DT = L_ACS + 512  , L_DEC = L_DT + 512, L_SS = L_DEC + 512, L_Z = L_SS + 256, L_END = L_Z + 64 * TP * 2;
static_assert(L_END <= RING_BYTES, "ssd lds");
typedef LAS unsigned char* lptr;
__device__ __forceinline__ bf16x8 ld16(lptr p) { return *(const LAS bf16x8*)p; }
__device__ __forceinline__ void unit(Frame& F, int un, float* ssq_all) {
    const int b = un >> 4, h = un & 15, g = h >> 3;
    const int tid = TTID();
    const int lane = tid & 63, w = F.wave, r16 = lane & 15, q4 = lane >> 4, Lt = w >> 1;
    const int nrow = tid >> 3, np8 = (tid & 7) * 8;
    const int crow = tid >> 4, cc8 = (tid & 15) * 8;
    lptr L = F.lds + RING_OFF;
    const bf16* xc = WSP(bf16, WS_XCONV) + (size_t)(b * SEQ) * CONVCH;
    const bf16* pz = WSP(bf16, WS_PROJ) + (size_t)(b * SEQ) * NP + O_Z + h * SHD;
    const float* dtp = WSP(float, WS_DTV) + (size_t)(b * SEQ) * 16 + h; const float* dap = WSP(float, WS_DAV) + (size_t)(b * SEQ) * 16 + h;
    bf16* mixp = WSP(bf16, WS_MIX) + (size_t)(b * SEQ) * DM + AW + h * SHD;
    float* ssq = ssq_all + b * SEQ;
    const float dsk = F.d_skip[h];
    f32x4 Hacc[4];
#pragma unroll
    for (int i = 0; i < 4; ++i) Hacc[i] = (f32x4){0.f, 0.f, 0.f, 0.f};
    v4u cmA[2], bmA[2], xsA, zA, cmB[2], bmB[2], xsB, zB; float dtw = 0.f, daw = 0.f;
#define SSD_LOAD(c, CM, BM, XS, ZR) do { const size_t t0_ = (size_t)(c) * 64; \
        _Pragma("unroll") for (int i_ = 0; i_ < 2; ++i_) { CM[i_] = *(const v4u*)(xc + (t0_ + crow + 32 * i_) * CONVCH + SW + SG * SN + g * SN + cc8); BM[i_] = *(const v4u*)(xc + (t0_ + crow + 32 * i_) * CONVCH + SW + g * SN + cc8); } \
        XS = *(const v4u*)(xc + (t0_ + nrow) * CONVCH + h * SHD + np8); ZR = *(const v4u*)(pz + (t0_ + nrow) * NP + np8); } while (0)
#define SSD_SCAN(c) do { if (w == 0) { const float acs_ = dpp_scan64(daw);     \
        const float al_ = __builtin_bit_cast(float, __builtin_amdgcn_readlane(__builtin_bit_cast(int, acs_), 63)); \
        *(LAS float*)(L + L_ACS + (((c) & 1) * 64 + lane) * 4) = acs_; *(LAS float*)(L + L_DT + lane * 4) = dtw; *(LAS float*)(L + L_DEC + lane * 4) = __expf(al_ - acs_); \
        if ((c) + 1 < SEQ / 64) { dtw = dtp[(size_t)(((c) + 1) * 64 + lane) * 16]; daw = dap[(size_t)(((c) + 1) * 64 + lane) * 16]; } } } while (0)
    if (w == 0) { dtw = dtp[(size_t)lane * 16]; daw = dap[(size_t)lane * 16]; }
    SSD_LOAD(0, cmA, bmA, xsA, zA);
    SSD_LOAD(1, cmB, bmB, xsB, zB);
    SSD_SCAN(0);
    auto nat_store = [&](const v4u (&cm)[2], const v4u (&bm)[2], const v4u& xs, const v4u& zs) __attribute__((always_inline)) {
#pragma unroll
        for (int i = 0; i < 2; ++i) { *(LAS v4u*)(L + L_CM + ((crow + 32 * i) * CP + cc8) * 2) = cm[i]; *(LAS v4u*)(L + L_BM + ((crow + 32 * i) * CP + cc8) * 2) = bm[i]; }
        *(LAS v4u*)(L + L_XS + (nrow * TP + np8) * 2) = xs; *(LAS v4u*)(L + L_Z + (nrow * TP + np8) * 2) = zs; };
    nat_store(cmA, bmA, xsA, zA);
    SSD_LOAD(2, cmA, bmA, xsA, zA);
    auto chunk = [&](const int c, v4u (&cmX)[2], v4u (&bmX)[2], v4u& xsX, v4u& zsX) __attribute__((always_inline)) {
        lptr ACS = L + L_ACS + (c & 1) * 256;
        __syncthreads();
        { const float dtl = *(const LAS float*)(L + L_DT + lane * 4), decl = *(const LAS float*)(L + L_DEC + lane * 4);
#pragma unroll
          for (int i = 0; i < 2; ++i) { const int c8 = 8 * (w + 8 * i); const v4u bm = *(const LAS v4u*)(L + L_BM + (lane * CP + c8) * 2);
              const unsigned ww[4] = {bm.x, bm.y, bm.z, bm.w};
#pragma unroll
              for (int j = 0; j < 4; ++j) { *(LAS bf16*)(L + L_BT + ((c8 + 2 * j) * TP + lane) * 2) = (bf16)(ww[j] & 0xffffu); *(LAS bf16*)(L + L_BT + ((c8 + 2 * j + 1) * TP + lane) * 2) = (bf16)(ww[j] >> 16); } }
          float xv[8]; unpack8(*(const LAS v4u*)(L + L_XS + (lane * TP + 8 * w) * 2), xv);
#pragma unroll
          for (int j = 0; j < 8; j += 2) { const float X0 = xv[j] * dtl, X1 = xv[j + 1] * dtl; const unsigned a = pk2(X0, X1), d = pk2(X0 * decl, X1 * decl);
              *(LAS bf16*)(L + L_XT + ((8 * w + j) * TP + lane) * 2) = (bf16)(a & 0xffffu); *(LAS bf16*)(L + L_XT + ((8 * w + j + 1) * TP + lane) * 2) = (bf16)(a >> 16);
              *(LAS bf16*)(L + L_XD + ((8 * w + j) * TP + lane) * 2) = (bf16)(d & 0xffffu); *(LAS bf16*)(L + L_XD + ((8 * w + j + 1) * TP + lane) * 2) = (bf16)(d >> 16); } }
        __syncthreads();
        bf16x8 cf[4];
#pragma unroll
        for (int ks = 0; ks < 4; ++ks) cf[ks] = ld16(L + L_CM + ((16 * Lt + r16) * CP + 32 * ks + 8 * q4) * 2);
        const float acs_l = *(const LAS float*)(ACS + (16 * Lt + r16) * 4);
        float Wv[4][4];
#pragma unroll
        for (int T = 0; T < 4; ++T) {
            f32x4 st = (f32x4){0.f, 0.f, 0.f, 0.f};
            if (T <= Lt) {
#pragma unroll
                for (int ks = 0; ks < 4; ++ks) st = __builtin_amdgcn_mfma_f32_16x16x32_bf16(ld16(L + L_BM + ((16 * T + r16) * CP + 32 * ks + 8 * q4) * 2), cf[ks], st, 0, 0, 0);
            }
            const f32x4 as4 = *(const LAS f32x4*)(ACS + (16 * T + 4 * q4) * 4);
#pragma unroll
            for (int r = 0; r < 4; ++r) { const int s = 16 * T + 4 * q4 + r, l = 16 * Lt + r16; Wv[T][r] = (T <= Lt && s <= l) ? st[r] * __expf(acs_l - as4[r]) : 0.f; }
        }
        bf16x8 Wf[2];
#pragma unroll
        for (int kp = 0; kp < 2; ++kp) { v4u t; t.x = pk2(Wv[2 * kp][0], Wv[2 * kp][1]); t.y = pk2(Wv[2 * kp][2], Wv[2 * kp][3]); t.z = pk2(Wv[2 * kp + 1][0], Wv[2 * kp + 1][1]); t.w = pk2(Wv[2 * kp + 1][2], Wv[2 * kp + 1][3]);
            Wf[kp] = __builtin_bit_cast(bf16x8, t); }
        const f32x4 al4 = *(const LAS f32x4*)(ACS + (16 * Lt + 4 * q4) * 4);
        const float alast = *(const LAS float*)(ACS + 63 * 4);
#pragma unroll
        for (int pp = 0; pp < 2; ++pp) { const int Pt = 2 * (w & 1) + pp;
            f32x4 yd = (f32x4){0.f, 0.f, 0.f, 0.f}, yo = (f32x4){0.f, 0.f, 0.f, 0.f};
#pragma unroll
            for (int kp = 0; kp < 2; ++kp) if (2 * kp <= Lt) {
                const v2u x0 = *(const LAS v2u*)(L + L_XT + ((16 * Pt + r16) * TP + 32 * kp + 4 * q4) * 2), x1 = *(const LAS v2u*)(L + L_XT + ((16 * Pt + r16) * TP + 32 * kp + 16 + 4 * q4) * 2);
                const v4u xb = {x0.x, x0.y, x1.x, x1.y};
                yd = __builtin_amdgcn_mfma_f32_16x16x32_bf16(Wf[kp], __builtin_bit_cast(bf16x8, xb), yd, 0, 0, 0); }
            if (c > 0) {
#pragma unroll
                for (int ks = 0; ks < 4; ++ks) yo = __builtin_amdgcn_mfma_f32_16x16x32_bf16(cf[ks], ld16(L + L_H + ((16 * Pt + r16) * CP + 32 * ks + 8 * q4) * 2), yo, 0, 0, 0); }
#pragma unroll
            for (int r = 0; r < 4; ++r) *(LAS float*)(L + L_Y + ((16 * Lt + 4 * q4 + r) * YP + 16 * Pt + r16) * 4) = yd[r] + __expf(al4[r]) * yo[r];
        }
        { const float dl = __expf(alast);
#pragma unroll
          for (int pt = 0; pt < 4; ++pt) Hacc[pt] = Hacc[pt] * dl;
#pragma unroll
          for (int ks = 0; ks < 2; ++ks) { const bf16x8 af = ld16(L + L_BT + ((16 * w + r16) * TP + 32 * ks + 8 * q4) * 2);
#pragma unroll
              for (int pt = 0; pt < 4; ++pt) Hacc[pt] = __builtin_amdgcn_mfma_f32_16x16x32_bf16(af, ld16(L + L_XD + ((16 * pt + r16) * TP + 32 * ks + 8 * q4) * 2), Hacc[pt], 0, 0, 0); } }
        __syncthreads();
#pragma unroll
        for (int pt = 0; pt < 4; ++pt) { v2u t; t.x = pk2(Hacc[pt][0], Hacc[pt][1]); t.y = pk2(Hacc[pt][2], Hacc[pt][3]); *(LAS v2u*)(L + L_H + ((16 * pt + r16) * CP + 16 * w + 4 * q4) * 2) = t; }
        SSD_SCAN(c + 1);
        { const f32x4 y0 = *(const LAS f32x4*)(L + L_Y + (nrow * YP + np8) * 4), y1 = *(const LAS f32x4*)(L + L_Y + (nrow * YP + np8 + 4) * 4);
          const v4u xs_ = *(const LAS v4u*)(L + L_XS + (nrow * TP + np8) * 2), zs_ = *(const LAS v4u*)(L + L_Z + (nrow * TP + np8) * 2);
          if (c + 1 < SEQ / 64) nat_store(cmX, bmX, xsX, zsX);
          if (c + 3 < SEQ / 64) SSD_LOAD(c + 3, cmX, bmX, xsX, zsX);
          float xv[8], zv[8], o[8]; unpack8(xs_, xv); unpack8(zs_, zv); const float yv[8] = {y0.x, y0.y, y0.z, y0.w, y1.x, y1.y, y1.z, y1.w}; float ss = 0.f;
#pragma unroll
          for (int j = 0; j < 8; ++j) { o[j] = (yv[j] + xv[j] * dsk) * siluf_(zv[j]); ss += o[j] * o[j]; }
          *(v4u*)(mixp + (size_t)(c * 64 + nrow) * DM + np8) = pack8f(o);
          ss += __shfl_xor(ss, 1); ss += __shfl_xor(ss, 2); ss += __shfl_xor(ss, 4);
          if ((tid & 7) == 0) atomicAdd(ssq + c * 64 + nrow, ss); }
    };
    for (int c = 0; c < SEQ / 64; c += 2) { chunk(c, cmB, bmB, xsB, zB); chunk(c + 1, cmA, bmA, xsA, zA); }
    __syncthreads();
    __syncthreads();
#undef SSD_LOAD
#undef SSD_SCAN
}
}
__device__ __forceinline__ void p3_ssd(Frame& F, float* ssq_all) {
    if (F.G == 256) {
        const int j = F.vcu & 31, x = F.vcu >> 5;
        if (j < SSD_WPX) for (int u = j; u < 8; u += SSD_WPX) ssd::unit(F, x * 8 + u, ssq_all);
        return;
    }
    for (int a = F.vcu; a < 256; a += F.G) { const int j = a & 31; if (j < 8) ssd::unit(F, (a >> 5) * 8 + j, ssq_all); }
}
constexpr int NPH = 10;
struct Args { const float* in[22]; float* out; unsigned char* ws; int ph_lo, ph_hi; };
__global__ void __launch_bounds__(NTHR, 2) mk_fwd(Args args) {
    extern __shared__ __attribute__((aligned(16))) unsigned char lds[];
    Frame F;
    F.lds = (LAS unsigned char*)lds;
    F.MISC = (volatile LAS unsigned*)(F.lds + MISC_OFF);
    F.wave = __builtin_amdgcn_readfirstlane(threadIdx.x >> 6);
    F.G = gridDim.x; { const int bx = blockIdx.x; F.vcu = (F.G % 8 == 0) ? (bx % 8) * (F.G / 8) + bx / 8 : bx; }
    F.ws = args.ws; F.ctl = (gu32*)(args.ws + WS_CTL); F.out = args.out;
    F.x = args.in[0]; F.g1 = args.in[1]; F.w_in = args.in[2]; F.fbias = args.in[3]; F.gq = args.in[4]; F.gk = args.in[5]; F.conv_w = args.in[6]; F.conv_b = args.in[7];
    F.dt_bias = args.in[8]; F.a_log = args.in[9]; F.d_skip = args.in[10]; F.ssd_g = args.in[11]; F.w_out = args.in[12]; F.g2 = args.in[13]; F.w_router = args.in[14]; F.b_router = args.in[15];
    F.w_gate = args.in[16]; F.b_gate = args.in[17]; F.w_up = args.in[18]; F.b_up = args.in[19]; F.w_down = args.in[20]; F.b_down = args.in[21];
    for (int u = threadIdx.x; u < (LDS_BYTES - LDSCTL_OFF) / 4; u += NTHR) ((LAS unsigned*)(F.lds + LDSCTL_OFF))[u] = 0u;
    __syncthreads();
    const int lo = args.ph_lo, hi = args.ph_hi;
    XcdBarrier bar; bar.bar = (unsigned*)(F.ctl + CW_BAR); bar.x = 0; bar.st = nullptr;
    if (hi - lo > 1) bar = xcd_barrier_post((unsigned*)(F.ctl + CW_BAR), F.MISC);
#define IN(k) (lo <= (k) && (k) < hi)
#ifndef PROBE_REPEAT
#define PROBE_REPEAT 0
#endif
#define REP(k) for (int rep_ = 0; rep_ < (((PROBE_REPEAT >> (k)) & 1) ? 2 : 1); ++rep_)
#if PROBE_T
#define STAMP(i) do { if (blockIdx.x == 0 && threadIdx.x == 0) { const unsigned long long t_ = __builtin_amdgcn_s_memrealtime(); __hip_atomic_store(F.ctl + CW_PROBE + 16 + 2 * (i), (unsigned)t_, RLX_AGENT); __hip_atomic_store(F.ctl + CW_PROBE + 17 + 2 * (i), (unsigned)(t_ >> 32), RLX_AGENT); } } while (0)
#else
#define STAMP(i) do { } while (0)
#endif
#define SEAM(k) do { if (IN(k) && IN((k) + 1)) xcd_barrier(bar); STAMP((k) + 1); } while (0)

    const bool roles = BG_POOL && F.G == 256;
    const int xc = F.vcu >> 5, jr = F.vcu & 31;
    constexpr int NC1 = NC1_CFG, NC5 = NC5_CFG, NC7 = NC7_CFG;
    const bool conv1 = roles && jr >= 32 - NC1, conv5 = roles && jr >= 32 - NC5, conv7 = roles && jr >= 32 - NC7;
    const int G5 = roles ? 8 * (32 - NC5) : F.G, c5s = roles ? jr * 8 + xc : (int)blockIdx.x;
    const int G1 = roles ? 8 * (32 - NC1) : F.G, c1s = roles ? jr * 8 + xc : (int)blockIdx.x;
    const int G7 = roles ? 8 * (32 - NC7) : F.G, c7m = roles ? xc * (32 - NC7) + jr : F.vcu;
    bool pool_open = BG_POOL && !CONV_IN_P0 && PEEK_CFG;
#define BG_PEEK() do { if (PEEK_CFG && pool_open) pool_open = bg_peek_open(F); } while (0)
#define BG_FILL(k, lim) do { if (BG_POOL && !CONV_IN_P0 && IN((k) + 1) && ((k) == 1 || !PEEK_CFG || pool_open)) bg_fill(F, (k), (lim)); } while (0)

    STAMP(0);
    if (IN(0)) REP(0) { p0_prologue(F); if (CONV_IN_P0) (void)bg_finish(F, POOL_ALL); SEAM(0); }

    if (IN(1)) REP(1) {
        if (!conv1) {
        typedef OrderStaticT<(NSPLIT_CFG != 0)> Ord1;
        Ord1 S; S.init(NTOK, NP, G1, c1s, WSP(bf16, WS_XN), WSP(bf16, WS_WIN));
        EpiProj E{WSP(bf16, WS_PROJ), NP};
        pg8::gemm_phase<EpiProj, Ord1, false, (ALIGN_EPI_CFG & 1) != 0>(F.lds + RING_OFF, S, E);
        }
        BG_FILL(1, POOL_ALL);
        SEAM(1);
    }
    if (IN(2)) REP(2) { BG_PEEK(); p2_post(F); if (FIN2_CFG && BG_POOL) (void)bg_finish(F, POOL_ALL); SEAM(2); }
    if (IN(3)) {
#if NAIVE_ATTN
        p3_attn_naive(F);
#else
        p3_attn(F);
#endif
        __syncthreads();
#if NAIVE_SSD
        p3_ssd_naive(F);
#elif !SPLIT_P3
        p3_ssd(F, (float*)(F.ctl + CW_SSQ));
#endif
#if PROBE_P3
        __syncthreads(); p3_attn(F); __syncthreads(); p3_ssd(F, WSP(float, WS_YSLOT));
#endif
        BG_FILL(3, POOL_ALL);
        SEAM(3);
    }
#if SPLIT_P3
    if (IN(4)) { p3_ssd(F, (float*)(F.ctl + CW_SSQ)); SEAM(4); }
#endif
    if (!FUSE_P4 && IN(4)) { p4_ssdnorm(F); SEAM(4); }
    if (IN(5)) BG_PEEK();
    if (IN(5)) REP(5) {
        if (!conv5) {
        OrderStatic S; S.init(NTOK, DM, G5, c5s, WSP(bf16, WS_MIX), WSP(bf16, WS_WOUT));
        EpiRes E{F.x, H_BF16 ? WSP(float, WS_H) : F.out, F.ctl + CW_SSQ};
        pg8::gemm_phase<EpiRes, OrderStatic, false, false>(F.lds + RING_OFF, S, E);
        }
        BG_FILL(5, POOL_ALL);
        SEAM(5);
    }
    if (IN(6)) { BG_PEEK(); p6_router(F); if (BG_POOL && (!PEEK_CFG || pool_open)) (void)bg_finish(F, POOL_GU); SEAM(6); }
    constexpr int MOE_RB = FP8_MOE ? 2048 : 4096;
    if (IN(7)) BG_PEEK();
    if (IN(7)) REP(7) {
        if (!conv7) {
        moe_tables(F);
        const LAS int* TB = (const LAS int*)(F.lds + TB_OFF);
        typedef OrderMoe<16, true, MOE_RB> Ord;
        Ord S; S.init(G7, c7m, TB, TB + 64, TLANE(), WSP(char, WS_XN), WSP(char, WS_WGU), (size_t)4096 * MOE_RB, WSP(int, WS_STOK), F.ctl + CW_MOEQ, (volatile LAS int*)(F.lds + BGW_OFF) + 4, DYN_MOE && G7 == 256);
        S.xprobe = (const char*)F.w_down;
        EpiGlu E{WSP(void, WS_ACT), F.b_gate, F.b_up};
        pg8::gemm_phase<EpiGlu, Ord, true, (ALIGN_EPI_CFG & 2) != 0, FP8_MOE != 0>(F.lds + RING_OFF, S, E);
        }
        BG_FILL(7, POOL_ALL);
        if (BG_POOL && (!PEEK_CFG || pool_open)) (void)bg_finish(F, POOL_ALL);
        SEAM(7);
    }
    if (IN(8)) REP(8) {
        moe_tables(F);
        const LAS int* TB = (const LAS int*)(F.lds + TB_OFF);
        typedef OrderMoe<8, false, MOE_RB> Ord;
        Ord S; S.init(F.G, F.vcu, TB, TB + 64, TLANE(), WSP(char, WS_ACT), WSP(char, WS_WD), (size_t)2048 * MOE_RB, WSP(int, WS_STOK), F.ctl + CW_MOEQ + 64 * 8, (volatile LAS int*)(F.lds + BGW_OFF) + 4, DYN_MOE && F.G == 256);
        S.xprobe = nullptr;
        EpiDown E{WSP(bf16, WS_YSLOT), F.b_down, WSP(float, WS_SGATE), WSP(int, WS_SDEST)};
        pg8::gemm_phase<EpiDown, Ord, false, (ALIGN_EPI_CFG & 4) != 0, FP8_MOE != 0>(F.lds + RING_OFF, S, E);
        SEAM(8);
    }
#if PROBE_T
    if (blockIdx.x == 0 && threadIdx.x == 0) {
        const unsigned a0_ = __hip_atomic_load(F.ctl + CW_PROBE + 16 + 2 * PROBE_KA, RLX_AGENT), a1_ = __hip_atomic_load(F.ctl + CW_PROBE + 16 + 2 * (PROBE_KA + 1), RLX_AGENT);
        const unsigned b0_ = __hip_atomic_load(F.ctl + CW_PROBE + 16 + 2 * PROBE_KB, RLX_AGENT), b1_ = __hip_atomic_load(F.ctl + CW_PROBE + 16 + 2 * (PROBE_KB + 1), RLX_AGENT);
        const float ua = (float)(a1_ - a0_) * 0.01f, ub = (float)(b1_ - b0_) * 0.01f;
        __hip_atomic_store(F.ctl + CW_PROBE, __builtin_bit_cast(unsigned, ua * PROBE_GA), RLX_AGENT); __hip_atomic_store(F.ctl + CW_PROBE + 1, __builtin_bit_cast(unsigned, 100.f + ub), RLX_AGENT); }
    xcd_barrier(bar);
#endif
    if (IN(9)) { p9_combine(F); }
#undef IN
#undef SEAM
}

extern "C" void kernel_launch(void* const* d_in, const int* in_sizes, int n_in, void* d_out, int out_size, void* d_ws, size_t ws_size, hipStream_t stream) {
    static int grid = 0;
    if (grid == 0) {
        if (n_in != 22 || in_sizes[0] != NTOK * DM || out_size != NTOK * DM || ws_size < WS_END) { fprintf(stderr, "kernel_launch: unexpected shapes (n_in %d, in0 %d, out %d, ws %zu)\n", n_in, n_in > 0 ? in_sizes[0] : -1, out_size, ws_size); grid = -1; return; }
        int dev = 0, cus = 0, per_cu = 0;
        if (hipGetDevice(&dev) != hipSuccess || hipDeviceGetAttribute(&cus, hipDeviceAttributeMultiprocessorCount, dev) != hipSuccess) { grid = -1; return; }
        if (hipFuncSetAttribute((const void*)mk_fwd, hipFuncAttributeMaxDynamicSharedMemorySize, LDS_BYTES) != hipSuccess) { fprintf(stderr, "kernel_launch: hipFuncSetAttribute failed\n"); grid = -1; return; }
        if (hipOccupancyMaxActiveBlocksPerMultiprocessor(&per_cu, (const void*)mk_fwd, NTHR, LDS_BYTES) != hipSuccess || per_cu < 1) { fprintf(stderr, "kernel_launch: occupancy query says %d blocks per CU\n", per_cu); }
        (void)hipGetLastError();
        grid = cus;
    }
    if (grid < 0) return;
    (void)hipMemsetAsync((char*)d_ws + WS_CTL, 0, CTL_ZERO_BYTES, stream);
    Args a{};
    for (int i = 0; i < 22; ++i) a.in[i] = (const float*)d_in[i];
    a.out = (float*)d_out; a.ws = (unsigned char*)d_ws;
#if MK_N_LAUNCHES == 1
    a.ph_lo = 0; a.ph_hi = NPH;
    hipLaunchKernelGGL(mk_fwd, dim3(grid), dim3(NTHR), LDS_BYTES, stream, a);
#else
    for (int p = 0; p < NPH; ++p) { a.ph_lo = p; a.ph_hi = p + 1; hipLaunchKernelGGL(mk_fwd, dim3(grid), dim3(NTHR), LDS_BYTES, stream, a); }
#endif
}
```

```cpp
#include <hip/hip_runtime.h>
#define MK_N_LAUNCHES 1
#define NAIVE_ATTN 0
#define NAIVE_SSD 0
#define FP8_MOE 1
#define NC1_CFG 18
#define NC5_CFG 0
#define NC7_CFG 0
#define SSD_WPX 8
#define YSLOT_FP8 1
#include <cstdio>
#include <cstdint>

#ifndef MK_N_LAUNCHES
#define MK_N_LAUNCHES 1
#endif
#ifndef NAIVE_ATTN
#define NAIVE_ATTN 1
#endif
#ifndef NAIVE_SSD
#define NAIVE_SSD 1
#endif

#define GAS __attribute__((address_space(1)))
#define LAS __attribute__((address_space(3)))
typedef unsigned short bf16;
typedef unsigned v4u __attribute__((ext_vector_type(4)));
typedef unsigned v2u __attribute__((ext_vector_type(2)));
typedef float f32x4 __attribute__((ext_vector_type(4)));
typedef float f32x2 __attribute__((ext_vector_type(2)));
typedef short bf16x8 __attribute__((ext_vector_type(8)));
typedef GAS unsigned gu32;
#define RLX_AGENT __ATOMIC_RELAXED, __HIP_MEMORY_SCOPE_AGENT
#define LDS_WAIT() asm volatile("s_waitcnt lgkmcnt(0)" ::: "memory")
#define VM_WAIT() asm volatile("s_waitcnt vmcnt(0)" ::: "memory")

constexpr int BATCH = 4, SEQ = 2048, DM = 2048, NTOK = BATCH * SEQ;
constexpr int AH = 8, AHD = 128, AW = AH * AHD;
constexpr int SW = 1024, SHD = 64, SH = 16, SG = 2, SN = 128, CONVCH = SW + 2 * SG * SN;
constexpr int NE = 32, TOPK = 4, DFF = 2048;
constexpr int INCOLS = 5656, NP = 5888;
constexpr int O_Q = 0, O_K = 1024, O_V = 2048, O_F = 3072, O_Z = 3080, O_XBC = 4104, O_DT = 5640;
constexpr float EPS = 1e-6f, SW_ALPHA = 1.702f, SW_LIMIT = 7.0f;
constexpr float LOG2E = 1.4426950408889634f;
constexpr float QSCALE = 0.08838834764831845f * LOG2E;
constexpr int SLOTCAP = NTOK;
constexpr int MAXMT = (NTOK * TOPK) / 256 + NE;

constexpr size_t MiB = 1u << 20;
constexpr size_t WS_CTL = 0, CTL_ZERO_BYTES = 1 * MiB;
constexpr size_t WS_WIN = 1 * MiB;
constexpr size_t WS_WOUT = 24 * MiB;
constexpr size_t WS_WR = 32 * MiB;
constexpr size_t WS_ACUM = 33 * MiB;
constexpr size_t WS_DTV = 34 * MiB, WS_DAV = 35 * MiB;
constexpr size_t WS_STOK = 36 * MiB, WS_SGATE = 37 * MiB, WS_SDEST = 38 * MiB;
constexpr size_t WS_XN = 40 * MiB;
constexpr size_t WS_PROJ = 72 * MiB;
constexpr size_t WS_H = WS_PROJ;
constexpr size_t WS_QN = 164 * MiB, WS_KN = 180 * MiB;
constexpr size_t WS_XCONV = 196 * MiB;
constexpr size_t WS_MIX = 220 * MiB;
constexpr size_t WS_ACT = 252 * MiB;
constexpr size_t WS_YSLOT = 412 * MiB;
constexpr size_t WS_WGU = 540 * MiB;
constexpr size_t WS_WD = 1052 * MiB;
constexpr size_t WS_END = 1308 * MiB;
constexpr int CW_BAR = 4096;
constexpr int CW_HEAD = 8192;
constexpr int CW_DONE = 8192 + 64;
constexpr int CW_PROBE = 12288;
constexpr int CW_MOEQ = 10240;
constexpr int CW_CNT = 16384;
constexpr int CW_SSQ = 32768;
static_assert((CW_SSQ + NTOK) * 4 <= (int)CTL_ZERO_BYTES, "ctl");

constexpr int RING_OFF = 0, RING_BYTES = 131072;
constexpr int LDSCTL_OFF = RING_BYTES;
constexpr int MISC_OFF = LDSCTL_OFF;
constexpr int BGW_OFF = LDSCTL_OFF + 64;
constexpr int TB_OFF = LDSCTL_OFF + 256;
constexpr int DMA_T_OFF = LDSCTL_OFF + 1024;
constexpr int LDS_BYTES = 163840 - 8192;
constexpr int NWAVES = 8, NTHR = 512;

__device__ __forceinline__ unsigned f2bf(float f) { unsigned u = __builtin_bit_cast(unsigned, f); return (u + 0x7fffu + ((u >> 16) & 1u)) >> 16; }
__device__ __forceinline__ unsigned pk2(float lo, float hi) { unsigned r; asm volatile("v_cvt_pk_bf16_f32 %0, %1, %2" : "=v"(r) : "v"(lo), "v"(hi)); return r; }
__device__ __forceinline__ float bf2f(unsigned h) { return __builtin_bit_cast(float, h << 16); }
__device__ __forceinline__ float bflo(unsigned w) { return __builtin_bit_cast(float, w << 16); }
__device__ __forceinline__ float bfhi(unsigned w) { return __builtin_bit_cast(float, w & 0xffff0000u); }
__device__ __forceinline__ float wave_sum(float v) {
#pragma unroll
    for (int o = 1; o < 64; o <<= 1) v += __shfl_xor(v, o);
    return v;
}
__device__ __forceinline__ float wave_max(float v) {
#pragma unroll
    for (int o = 1; o < 64; o <<= 1) v = fmaxf(v, __shfl_xor(v, o));
    return v;
}
#ifndef NC1_CFG
#define NC1_CFG 9
#endif
#ifndef NC5_CFG
#define NC5_CFG 16
#endif
#ifndef NC7_CFG
#define NC7_CFG 3
#endif
#ifndef SSD_WPX
#define SSD_WPX 4
#endif
#ifndef PROBE_P3
#define PROBE_P3 0
#endif
#ifndef CONV_IN_P0
#define CONV_IN_P0 0
#endif
#ifndef PROBE_T
#define PROBE_T 0
#endif
#ifndef PROBE_KA
#define PROBE_KA 0
#endif
#ifndef PROBE_KB
#define PROBE_KB 1
#endif
#ifndef PROBE_GA
#define PROBE_GA 0.001f
#endif
#ifndef HALF_LAST
#define HALF_LAST 0
#endif
#ifndef CONV_NTS
#define CONV_NTS 1
#endif
#ifndef CONV_NT
#define CONV_NT 1
#endif
#ifndef DYN_MOE
#define DYN_MOE 0
#endif
#ifndef HALF_UNITS_CFG
#define HALF_UNITS_CFG 1
#endif
#ifndef YSLOT_FP8
#define YSLOT_FP8 0
#endif
#ifndef CONV_DMA
#define CONV_DMA 0
#endif
#ifndef BGB_CFG
#define BGB_CFG 4
#endif
#ifndef CONV_WG
#define CONV_WG 1
#endif
#ifndef CONV_PIPE
#define CONV_PIPE 0
#endif
#ifndef BG_POOL
#define BG_POOL 1
#endif
#ifndef FP8_MOE
#define FP8_MOE 1
#endif
#ifndef H_BF16
#define H_BF16 1
#endif
#ifndef PEEK_CFG
#define PEEK_CFG 1
#endif
#ifndef NSPLIT_CFG
#define NSPLIT_CFG 1
#endif
#ifndef ALIGN_EPI_CFG
#define ALIGN_EPI_CFG 7
#endif
#ifndef P9_NTS
#define P9_NTS 0
#endif
#ifndef SPLIT_P3
#define SPLIT_P3 0
#endif
#ifndef FUSE_P4
#define FUSE_P4 1
#endif
#ifndef PROBE_EPI2
#define PROBE_EPI2 0
#endif
#ifndef LOOSE_EPI_WAIT
#define LOOSE_EPI_WAIT 0
#endif
#ifndef FIN2_CFG
#define FIN2_CFG 0
#endif
#ifndef PROBE_KLD
#define PROBE_KLD 0
#endif
#ifndef EMU_IN8
#define EMU_IN8 0
#endif
#ifndef EMU_OUT8
#define EMU_OUT8 0
#endif
#ifndef EMU_FP8
#define EMU_FP8 0
#endif
__device__ __forceinline__ unsigned pk4_fp8(float a, float b, float c, float d) { int p = __builtin_amdgcn_cvt_pk_fp8_f32(a, b, 0, false); p = __builtin_amdgcn_cvt_pk_fp8_f32(c, d, p, true); return (unsigned)p; }
typedef short v2s_ __attribute__((ext_vector_type(2)));
#ifndef CVT_SCALE
#define CVT_SCALE 0.015625f
#endif
__device__ __forceinline__ unsigned pk4_fp8_x64(float a, float b, float c, float d) { v2s_ o = {0, 0}; o = __builtin_amdgcn_cvt_scalef32_pk_fp8_f32(o, a, b, CVT_SCALE, false); o = __builtin_amdgcn_cvt_scalef32_pk_fp8_f32(o, c, d, CVT_SCALE, true); return __builtin_bit_cast(unsigned, o); }
__device__ __forceinline__ float q8(float x) { return __builtin_amdgcn_cvt_f32_fp8(__builtin_amdgcn_cvt_pk_fp8_f32(x, x, 0, false), 0); }
__device__ __forceinline__ float sigmoidf_(float x) { return 1.f / (1.f + __expf(-x)); }
template <int CTRL> __device__ __forceinline__ float dpp_f(float v) { return __builtin_bit_cast(float, __builtin_amdgcn_update_dpp(0, __builtin_bit_cast(int, v), CTRL, 0xf, 0xf, true)); }
template <int CTRL> __device__ __forceinline__ int dpp_i(int v) { return __builtin_amdgcn_update_dpp(0, v, CTRL, 0xf, 0xf, true); }
__device__ __forceinline__ float dpp_scan64f(float x) {
    float v = x;
#define DPP_ADD_(ctrl, rowmask) do { const int t_ = __builtin_amdgcn_update_dpp(0, __builtin_bit_cast(int, v), (ctrl), (rowmask), 0xf, true); v += __builtin_bit_cast(float, t_); } while (0)
    DPP_ADD_(0x111, 0xf); DPP_ADD_(0x112, 0xf); DPP_ADD_(0x114, 0xf); DPP_ADD_(0x118, 0xf); DPP_ADD_(0x142, 0xa); DPP_ADD_(0x143, 0xc);
#undef DPP_ADD_
    return v;
}
__device__ __forceinline__ float siluf_(float x) { return x * __builtin_amdgcn_rcpf(1.f + __expf(-x)); }
__device__ __forceinline__ float softplusf_(float x) { return fmaxf(x, 0.f) + log1pf(__expf(-fabsf(x))); }

#define XB_TMO      128
#define XB_XCNT(j)  (256  + 64 * (j))
#define XB_XSUB(j)  (1280 + 64 * (j))
#define XB_XGEN(j)  (2304 + 64 * (j))
#define XB_TOP      3328
#define XB_TOPGEN   3392
#define XCD_BAR_WORDS 3456
#define XB_SPIN_CAP (1u << 18)

__device__ __forceinline__ unsigned xb_ld(unsigned* p)              { return __hip_atomic_load(p, __ATOMIC_RELAXED, __HIP_MEMORY_SCOPE_AGENT); }
__device__ __forceinline__ unsigned xb_add(unsigned* p, unsigned v) { return __hip_atomic_fetch_add(p, v, __ATOMIC_RELAXED, __HIP_MEMORY_SCOPE_AGENT); }
__device__ __forceinline__ unsigned xb_xcc_id() { return (unsigned)__builtin_amdgcn_s_getreg((3 << 11) | 20) & 0xFu; }
#define XB_SPIN(cond, bar) do { unsigned _sp = 0; while (cond) { __builtin_amdgcn_s_sleep(1); \
    if ((++_sp & 255u) == 0u) { if (xb_ld(&(bar)[XB_TMO])) break; if (_sp > XB_SPIN_CAP) { atomicAdd(&(bar)[XB_TMO], 1u); break; } } } } while (0)

struct XcdBarrier {
    unsigned* bar; unsigned x;
    volatile LAS unsigned* st;
};
__device__ __forceinline__ XcdBarrier xcd_barrier_post(unsigned* bar, volatile LAS unsigned* st) {
    XcdBarrier b; b.bar = bar; b.x = xb_xcc_id(); b.st = st;
    if (threadIdx.x == 0) (void)xb_add(&bar[XB_XCNT(b.x)], 1u);
    return b;
}
__device__ __forceinline__ void xcd_barrier_complete(unsigned* bar, unsigned x, unsigned& nloc, unsigned& nx) {
    const unsigned G = gridDim.x * gridDim.y * gridDim.z;
    unsigned sum, cnt, mine, sp = 0u;
    for (;;) {
        sum = 0u; cnt = 0u; mine = 0u;
#pragma unroll
        for (unsigned j = 0; j < 16; ++j) { const unsigned c = xb_ld(&bar[XB_XCNT(j)]); sum += c; cnt += (c > 0u) ? 1u : 0u; mine = (j == x) ? c : mine; }
        if (sum == G) break;
        __builtin_amdgcn_s_sleep(1);
        if ((++sp & 255u) == 0u) { if (xb_ld(&bar[XB_TMO])) break; if (sp > XB_SPIN_CAP) { atomicAdd(&bar[XB_TMO], 1u); break; } }
    }
    nloc = mine > 0u ? mine : 1u; nx = cnt > 0u ? cnt : 1u;
}
__device__ __forceinline__ void xcd_barrier(const XcdBarrier& b) {
    asm volatile("s_waitcnt vmcnt(0)" ::: "memory");
    __syncthreads();
    if (threadIdx.x == 0) {
        unsigned* bar = b.bar;
        __builtin_amdgcn_s_waitcnt(0);
        unsigned nloc = b.st[0], nx = b.st[1];
        if (nloc == 0u) { xcd_barrier_complete(bar, b.x, nloc, nx); b.st[0] = nloc; b.st[1] = nx; }
        const unsigned old = xb_add(&bar[XB_XSUB(b.x)], 1u);
        const unsigned gen = old / nloc;
        if (old + 1u == (gen + 1u) * nloc) {
            __builtin_amdgcn_fence(__ATOMIC_RELEASE, "agent");
            asm volatile("s_waitcnt vmcnt(0)" ::: "memory");
            const unsigned og = xb_add(&bar[XB_TOP], 1u);
            const unsigned tg = og / nx;
            if (og + 1u == (tg + 1u) * nx) xb_add(&bar[XB_TOPGEN], 1u);
            else XB_SPIN(xb_ld(&bar[XB_TOPGEN]) == tg, bar);
            __builtin_amdgcn_fence(__ATOMIC_ACQUIRE, "agent");
            xb_add(&bar[XB_XGEN(b.x)], 1u);
            asm volatile("s_waitcnt vmcnt(0)" ::: "memory");
        } else {
            XB_SPIN(xb_ld(&bar[XB_XGEN(b.x)]) == gen, bar);
            __builtin_amdgcn_fence(__ATOMIC_ACQUIRE, "agent");
            asm volatile("s_waitcnt vmcnt(0)" ::: "memory");
        }
    }
    __syncthreads();
}
#ifndef B_NT_CFG
#define B_NT_CFG 0
#endif
#ifndef FP8_DIAG
#define FP8_DIAG 0
#endif
#ifndef FP8_NOSCALE
#define FP8_NOSCALE 0
#endif
namespace pg8 {
#define PG8_LAS __attribute__((address_space(3)))
typedef unsigned short bf16_t;
typedef short bf16x8 __attribute__((ext_vector_type(8)));
typedef float f32x4 __attribute__((ext_vector_type(4)));
typedef unsigned u32x4 __attribute__((ext_vector_type(4)));
constexpr int BM = 256, BK = 64, HALF = 128, HTB = HALF * BK * 2  , STAGE_BYTES = 8 * HTB, NXCD = 8, WGM = 8;
constexpr int GK = 2048;
typedef int i32x8 __attribute__((ext_vector_type(8)));
typedef int i32x4_ __attribute__((ext_vector_type(4)));

__host__ __device__ __forceinline__ int lds_byte(int r, int c) { const int st = (r >> 4) * 2 + (c >> 5), rr = r & 15, cc = c & 31, ob = rr * 64 + cc * 2; return st * 1024 + (ob ^ (((ob >> 9) & 1) << 5)); }
__host__ __device__ __forceinline__ void stage_rc(int b, int& R, int& C) { const int st = b / 1024, sb = b % 1024, swz = sb ^ (((sb >> 9) & 1) << 5); R = (st >> 1) * 16 + swz / 64; C = (st & 1) * 32 + (swz % 64) / 2; }
__host__ __device__ __forceinline__ int perm32(int rho) { const int n = rho >> 4, i = rho & 15; return 8 * (i >> 2) + 4 * n + (i & 3); }

struct Unit { int pm, pn, e, mt, nrows, nh, rh, roff; };

__device__ __forceinline__ unsigned cvt_pk_bf16(float lo, float hi) { unsigned r; asm volatile("v_cvt_pk_bf16_f32 %0, %1, %2" : "=v"(r) : "v"(lo), "v"(hi)); return r; }

template <class Epi, class Sched, bool GATHER, bool ALIGN_EPI, bool FP8 = false>
__device__ __forceinline__ void gemm_phase(PG8_LAS unsigned char* lds, const Sched& S, const Epi& E) {
    const int tid = threadIdx.x, wid = __builtin_amdgcn_readfirstlane(tid >> 6), lane = tid & 63, wr = wid >> 2, wc = wid & 3, fr = lane & 15, fq = lane >> 4;
    constexpr int K = FP8 ? GK / 2 : GK, nt = K / BK;
    unsigned vB[2]; int Ri[2], Ci[2];
#pragma unroll
    for (int i = 0; i < 2; ++i) { int R, C; stage_rc(tid * 16 + i * 8192, R, C); const int Rb = Epi::PERM ? ((R & ~31) + perm32(R & 31)) : R;
        vB[i] = Sched::B_BLOCKED ? (unsigned)(Rb * BK + C) * 2u : (unsigned)(Rb * K + C) * 2u; Ri[i] = R; Ci[i] = C; }
    constexpr unsigned kstep = (unsigned)(BK * 2);
    constexpr unsigned hstepB = Sched::B_BLOCKED ? (unsigned)HALF * BK * 2 : (unsigned)HALF * K * 2;
    const unsigned kstepB = Sched::B_BLOCKED ? S.b_kstep() : kstep;
    const char* const rA = (const char*)S.a_base(); const char* const rB = (const char*)S.b_base();
    const unsigned ldsw = (unsigned)wid * 1024u;
    const int aoff = lds_byte(wr * 64 + fr, fq * 8), boff = lds_byte(wc * 32 + fr, fq * 8);
#define PG8_SA(b, h) (((b) * 2 + (h)) * HTB)
#define PG8_SB(b, h) ((4 + (b) * 2 + (h)) * HTB)
#define PG8_STAGE(bufoff, gbase, soff, voff) do { _Pragma("unroll") for (int _i = 0; _i < 2; ++_i) { \
        if (FP8 && B_NT_CFG && (bufoff) >= 4 * HTB) __builtin_amdgcn_global_load_lds((const unsigned*)((gbase) + (size_t)(soff) + (voff)[_i]), (PG8_LAS unsigned*)(lds + (bufoff) + ldsw + _i * 8192), 16, 0, 2); \
        else __builtin_amdgcn_global_load_lds((const unsigned*)((gbase) + (size_t)(soff) + (voff)[_i]), (PG8_LAS unsigned*)(lds + (bufoff) + ldsw + _i * 8192), 16, 0, 0); } } while (0)
#define PG8_LDA(dst, b, h) do { _Pragma("unroll") for (int m = 0; m < 4; ++m) { dst[m].lo = *(const PG8_LAS i32x4_*)(lds + PG8_SA(b, h) + aoff + m * 2048); dst[m].hi = *(const PG8_LAS i32x4_*)(lds + PG8_SA(b, h) + aoff + m * 2048 + 1024); } } while (0)
#define PG8_LDB(dst, b, h) do { _Pragma("unroll") for (int n = 0; n < 2; ++n) { dst[n].lo = *(const PG8_LAS i32x4_*)(lds + PG8_SB(b, h) + boff + n * 2048); dst[n].hi = *(const PG8_LAS i32x4_*)(lds + PG8_SB(b, h) + boff + n * 2048 + 1024); } } while (0)
#define PG8_MMA(ai, bj, At, Bt) do { __builtin_amdgcn_s_setprio(1); _Pragma("unroll") for (int m = 0; m < 4; ++m) _Pragma("unroll") for (int n = 0; n < 2; ++n) { \
        if constexpr (FP8) { if (FP8_DIAG) { _Pragma("unroll") for (int q_ = 0; q_ < 4; ++q_) { \
                const long b_ = (long)(unsigned)Bt[n][2 * q_] | ((long)Bt[n][2 * q_ + 1] << 32), a_ = (long)(unsigned)At[m][2 * q_] | ((long)At[m][2 * q_ + 1] << 32); \
                acc[ai][bj][m][n] = __builtin_amdgcn_mfma_f32_16x16x32_fp8_fp8(b_, a_, acc[ai][bj][m][n], 0, 0, 0); } } \
            else if (FP8_NOSCALE) asm volatile("v_mfma_f32_16x16x128_f8f6f4 %0, %1, %2, %0" : "+v"(acc[ai][bj][m][n]) : "v"(Bt[n]), "v"(At[m])); \
            else asm volatile("v_mfma_scale_f32_16x16x128_f8f6f4 %0, %1, %2, %0, %3, %3 op_sel_hi:[0,0,0]" : "+v"(acc[ai][bj][m][n]) : "v"(Bt[n]), "v"(At[m]), "v"(sc8)); } \
        else { const i32x4_ bl_ = __builtin_shufflevector(Bt[n], Bt[n], 0, 1, 2, 3), bh_ = __builtin_shufflevector(Bt[n], Bt[n], 4, 5, 6, 7), al_ = __builtin_shufflevector(At[m], At[m], 0, 1, 2, 3), ah_ = __builtin_shufflevector(At[m], At[m], 4, 5, 6, 7); \
               acc[ai][bj][m][n] = __builtin_amdgcn_mfma_f32_16x16x32_bf16(__builtin_bit_cast(bf16x8, bl_), __builtin_bit_cast(bf16x8, al_), acc[ai][bj][m][n], 0, 0, 0); \
               acc[ai][bj][m][n] = __builtin_amdgcn_mfma_f32_16x16x32_bf16(__builtin_bit_cast(bf16x8, bh_), __builtin_bit_cast(bf16x8, ah_), acc[ai][bj][m][n], 0, 0, 0); } } \
        __builtin_amdgcn_s_setprio(0); } while (0)
#define PG8_WAIT_V(n) asm volatile("s_waitcnt vmcnt(" #n ")" ::: "memory")
#define PG8_WAIT_L(n) asm volatile("s_waitcnt lgkmcnt(" #n ")" ::: "memory")
#define PG8_BAR __builtin_amdgcn_s_barrier()
#define PG8_SCHED __builtin_amdgcn_sched_barrier(0)
#define PG8_VOFF(v, u) do { _Pragma("unroll") for (int h_ = 0; h_ < 2; ++h_) _Pragma("unroll") for (int i_ = 0; i_ < 2; ++i_) { \
        const int r_ = h_ * HALF + Ri[i_]; const int src_ = GATHER ? S.a_row(u, r_) : r_; v[h_][i_] = (unsigned)(src_ * K + Ci[i_]) * 2u; } } while (0)
#define PG8_WAIT_SEL(loose, NL) asm volatile("s_cmp_lg_u32 %0, 0\n\ts_cbranch_scc0 .Lw8_%=\n\ts_waitcnt vmcnt(%1)\n\ts_branch .Lwe_%=\n.Lw8_%=:\n\ts_waitcnt vmcnt(8)\n.Lwe_%=:" :: "s"(loose), "n"(NL) : "memory", "scc")
#define PG8_ITER(W1, W2, W3, W4) do { \
            if (nh != 2) PG8_LDB(B0, 0, 0); if (nh != 1) PG8_LDB(B1, 0, 1); PG8_SCHED; PG8_LDA(At, 0, 0); PG8_STAGE(PG8_SA(1, 1), rA, a1, vAc[1]); \
            W1; PG8_WAIT_L(0); PG8_BAR; if (nh != 2) PG8_MMA(0, 0, At, B0); if (nh != 1) PG8_MMA(0, 1, At, B1); PG8_BAR; PG8_SCHED; \
            if (!halfu) PG8_LDA(At, 0, 1); PG8_STAGE(PG8_SB(0, 0), rB, b2, vB); PG8_STAGE(PG8_SB(0, 1), rB, b2 + hstepB, vB); PG8_STAGE(PG8_SA(0, 0), rA, a2, v2[0]); \
            W2; PG8_WAIT_L(0); PG8_BAR; if (!halfu) { if (nh != 2) PG8_MMA(1, 0, At, B0); if (nh != 1) PG8_MMA(1, 1, At, B1); } PG8_BAR; PG8_SCHED; \
            if (nh != 2) PG8_LDB(B0, 1, 0); if (nh != 1) PG8_LDB(B1, 1, 1); PG8_SCHED; PG8_LDA(At, 1, 0); PG8_STAGE(PG8_SA(0, 1), rA, a2, v2[1]); \
            W3; PG8_WAIT_L(0); PG8_BAR; if (nh != 2) PG8_MMA(0, 0, At, B0); if (nh != 1) PG8_MMA(0, 1, At, B1); PG8_BAR; PG8_SCHED; \
            if (!halfu) PG8_LDA(At, 1, 1); PG8_STAGE(PG8_SB(1, 0), rB, b3, vB); PG8_STAGE(PG8_SB(1, 1), rB, b3 + hstepB, vB); PG8_STAGE(PG8_SA(1, 0), rA, a3, v2[0]); \
            W4; PG8_WAIT_L(0); PG8_BAR; if (!halfu) { if (nh != 2) PG8_MMA(1, 0, At, B0); if (nh != 1) PG8_MMA(1, 1, At, B1); } PG8_BAR; PG8_SCHED; } while (0)
    Unit cur, nxt; int ui = 0;
    if (!S.next(0, cur)) return;
    f32x4 acc[2][2][4][2];
#pragma unroll
    for (int a = 0; a < 2; ++a)
#pragma unroll
        for (int b = 0; b < 2; ++b)
#pragma unroll
            for (int m = 0; m < 4; ++m)
#pragma unroll
                for (int n = 0; n < 2; ++n) acc[a][b][m][n] = (f32x4){0.f, 0.f, 0.f, 0.f};
    const int sc8 = 0x7c7c7c7c;
    i32x8 At[4], B0[2], B1[2];
    unsigned vAc[2][2], vAn[2][2];
    PG8_VOFF(vAc, cur);
    constexpr int KROT = Epi::MIDSCALE ? nt / 2 : 0;
    float mraw = 0.f;
#define PG8_KA(t_) ((unsigned)(((t_) + KROT) & (nt - 1)) * kstep)
#define PG8_KB(t_) ((unsigned)(((t_) + KROT) & (nt - 1)) * kstepB)
    unsigned cA = S.a_off(cur), cB = S.b_off(cur);
    PG8_STAGE(PG8_SB(0, 0), rB, cB + PG8_KB(0), vB); PG8_STAGE(PG8_SB(0, 1), rB, cB + PG8_KB(0) + hstepB, vB); PG8_STAGE(PG8_SA(0, 0), rA, cA + PG8_KA(0), vAc[0]); PG8_STAGE(PG8_SA(0, 1), rA, cA + PG8_KA(0), vAc[1]);
    if (wr == 1) PG8_BAR;
    PG8_WAIT_V(2); PG8_BAR;
    PG8_STAGE(PG8_SB(1, 0), rB, cB + PG8_KB(1), vB); PG8_STAGE(PG8_SA(1, 0), rA, cA + PG8_KA(1), vAc[0]); PG8_STAGE(PG8_SB(1, 1), rB, cB + hstepB + PG8_KB(1), vB);
    PG8_WAIT_V(6); PG8_BAR;
    for (;;) {
        const bool has_next = S.next(ui + 1, nxt);
        unsigned nA = cA, nB = cB;
        if (has_next) { nA = S.a_off(nxt); nB = S.b_off(nxt); PG8_VOFF(vAn, nxt); }
        else {
#pragma unroll
            for (int h = 0; h < 2; ++h)
#pragma unroll
                for (int i = 0; i < 2; ++i) vAn[h][i] = vAc[h][i]; }
        if constexpr (Epi::MIDSCALE) mraw = E.mid_load(cur);
        const int nh = Sched::NSPLIT ? __builtin_amdgcn_readfirstlane(cur.nh) : 0;
        const bool halfu = Sched::HALF_UNITS && cur.nrows <= HALF;
        for (int t = 0; t < nt; t += 2) {
            const bool last = (t == nt - 2);
            const unsigned a1 = cA + PG8_KA(t + 1);
            const unsigned a2 = last ? nA + PG8_KA(0) : cA + PG8_KA(t + 2), b2 = last ? nB + PG8_KB(0) : cB + PG8_KB(t + 2);
            const unsigned a3 = a2 + kstep, b3 = b2 + kstepB;
            if constexpr (Epi::MIDSCALE) { if (t == nt / 2 - 2) { if (tid < 256) ((PG8_LAS float*)(lds + (LDSCTL_OFF - RING_OFF) + 4096))[tid] = E.mid_factor(mraw); } }
            if constexpr (Epi::MIDSCALE) { if (t == nt / 2) {
#pragma unroll
                for (int a = 0; a < 2; ++a)
#pragma unroll
                    for (int m = 0; m < 4; ++m) { const float f_ = ((const PG8_LAS float*)(lds + (LDSCTL_OFF - RING_OFF) + 4096))[a * 128 + wr * 64 + m * 16 + fr];
#pragma unroll
                        for (int b = 0; b < 2; ++b)
#pragma unroll
                            for (int n = 0; n < 2; ++n) acc[a][b][m][n] = acc[a][b][m][n] * f_; } } }
            unsigned v2[2][2];
#pragma unroll
            for (int h = 0; h < 2; ++h)
#pragma unroll
                for (int i = 0; i < 2; ++i) v2[h][i] = last ? vAn[h][i] : vAc[h][i];
            const int loose = __builtin_amdgcn_readfirstlane((LOOSE_EPI_WAIT && t == 0 && ui > 0) ? 1 : 0);
            PG8_ITER(PG8_WAIT_SEL(loose, 8 + Epi::NVM), PG8_WAIT_SEL(loose, 8 + Epi::NVM), PG8_WAIT_SEL(loose, 8 + Epi::NVM), PG8_WAIT_V(8));
        }
        if constexpr (FP8) asm volatile("s_nop 15\n\ts_nop 15" ::: "memory");
        if constexpr (ALIGN_EPI) { if (wr == 0) PG8_BAR; }
        E(acc, cur, wr, wc, fr, fq);
        if (PROBE_EPI2) { asm volatile("" ::: "memory"); E(acc, cur, wr, wc, fr, fq); }
        if (!has_next) break;
#pragma unroll
        for (int a = 0; a < 2; ++a)
#pragma unroll
            for (int b = 0; b < 2; ++b)
#pragma unroll
                for (int m = 0; m < 4; ++m)
#pragma unroll
                    for (int n = 0; n < 2; ++n) acc[a][b][m][n] = (f32x4){0.f, 0.f, 0.f, 0.f};
        cur = nxt; cA = nA; cB = nB; ++ui;
#pragma unroll
        for (int h = 0; h < 2; ++h)
#pragma unroll
            for (int i = 0; i < 2; ++i) vAc[h][i] = vAn[h][i];
        if constexpr (ALIGN_EPI) { if (wr == 1) PG8_BAR; }
    }
    PG8_WAIT_V(0);
    if constexpr (!ALIGN_EPI) { if (wr == 0) PG8_BAR; }
    PG8_BAR;
#undef PG8_KA
#undef PG8_KB
#undef PG8_ITER
#undef PG8_WAIT_SEL
#undef PG8_SA
#undef PG8_SB
#undef PG8_STAGE
#undef PG8_LDA
#undef PG8_LDB
#undef PG8_MMA
#undef PG8_WAIT_V
#undef PG8_WAIT_L
#undef PG8_BAR
#undef PG8_SCHED
#undef PG8_VOFF
}
}
struct Frame {
    LAS unsigned char* lds;
    volatile LAS unsigned* MISC;
    gu32* ctl;
    int wave, vcu, G;
    const float *x, *g1, *w_in, *fbias, *gq, *gk, *conv_w, *conv_b, *dt_bias, *a_log, *d_skip, *ssd_g, *w_out, *g2, *w_router, *b_router, *w_gate, *b_gate, *w_up, *b_up, *w_down, *b_down;
    float* out; unsigned char* ws;
};
#define WSP(T, off) ((T*)(F.ws + (off)))
__device__ __forceinline__ int TTID() { int t = threadIdx.x; asm volatile("" : "+v"(t)); return t; }
__device__ __forceinline__ int TLANE() { return TTID() & 63; }

template <bool Q8>
__device__ __forceinline__ void conv_item(const float* W, int ldn, int nvalid, int k0, int n0, bf16* dst, LAS unsigned* T, int lane, const float* rowgain = nullptr) {
    const int kq = lane >> 4, nq = lane & 15, col = n0 + 4 * nq;
    const bool ok = col < nvalid;
    f32x4 a[8], b[8];
#pragma unroll
    for (int i = 0; i < 8; ++i) { const float* p = W + (size_t)(k0 + 8 * i + 2 * kq) * ldn + col;
        a[i] = ok ? *(const f32x4*)p : (f32x4){0.f, 0.f, 0.f, 0.f}; b[i] = ok ? *(const f32x4*)(p + ldn) : (f32x4){0.f, 0.f, 0.f, 0.f}; }
    if (rowgain) {
#pragma unroll
        for (int i = 0; i < 8; ++i) { const float ga = rowgain[8 * i + 2 * kq], gb = rowgain[8 * i + 2 * kq + 1]; a[i] = a[i] * ga; b[i] = b[i] * gb; } }
#pragma unroll
    for (int i = 0; i < 8; ++i)
#pragma unroll
        for (int j = 0; j < 4; ++j) T[(4 * nq + j) * 33 + 4 * i + kq] = (Q8 && (EMU_FP8 || EMU_IN8 || EMU_OUT8)) ? pk2(q8(a[i][j] * 64.f) * (1.f / 64.f), q8(b[i][j] * 64.f) * (1.f / 64.f)) : pk2(a[i][j], b[i][j]);
    LDS_WAIT();
    const int c = lane & 7;
#pragma unroll
    for (int r = 0; r < 8; ++r) { const int n = 8 * r + (lane >> 3); const LAS unsigned* s = T + n * 33 + 4 * c;
        v4u o; o.x = s[0]; o.y = s[1]; o.z = s[2]; o.w = s[3];
        *(v4u*)(dst + (size_t)n * 2048 + k0 + 8 * c) = o; }
    LDS_WAIT();
}
__device__ __forceinline__ void conv_item8(const float* W, int k0, int n0, unsigned char* dst, LAS unsigned* T, int lane) {
    const int kq = lane >> 4, nq = lane & 15, col = n0 + 4 * nq;
    f32x4 a[8][4];
#pragma unroll
    for (int i = 0; i < 8; ++i)
#pragma unroll
        for (int r = 0; r < 4; ++r) a[i][r] = __builtin_nontemporal_load((const GAS f32x4*)(W + (size_t)(k0 + 16 * i + 4 * kq + r) * 2048 + col));
#pragma unroll
    for (int i = 0; i < 8; ++i)
#pragma unroll
        for (int j = 0; j < 4; ++j) T[(4 * nq + j) * 33 + 4 * i + kq] = pk4_fp8_x64(a[i][0][j], a[i][1][j], a[i][2][j], a[i][3][j]);
    LDS_WAIT();
    const int c = lane & 7;
#pragma unroll
    for (int r = 0; r < 8; ++r) { const int n = 8 * r + (lane >> 3); const LAS unsigned* s = T + n * 33 + 4 * c;
        v4u o; o.x = s[0]; o.y = s[1]; o.z = s[2]; o.w = s[3];
        *(GAS v4u*)(dst + (size_t)n * 128 + 16 * c) = o; }
    LDS_WAIT();
}
struct Conv8Regs { f32x4 a[4][4]; };
__device__ __forceinline__ void conv8_load(Conv8Regs& R, const float* W, int k0, int n0, int lane) {
    const int kq = lane >> 4, nq = lane & 15, col = n0 + 4 * nq;
#pragma unroll
    for (int i = 0; i < 4; ++i)
#pragma unroll
        for (int r = 0; r < 4; ++r) R.a[i][r] = __builtin_nontemporal_load((const GAS f32x4*)(W + (size_t)(k0 + 16 * i + 4 * kq + r) * 2048 + col));
}
__device__ __forceinline__ void conv8_pack(const Conv8Regs& R, int k0, unsigned char* dst, LAS unsigned* T, int lane) {
    const int kq = lane >> 4, nq = lane & 15;
#pragma unroll
    for (int i = 0; i < 4; ++i)
#pragma unroll
        for (int j = 0; j < 4; ++j) T[(4 * nq + j) * 17 + 4 * i + kq] = pk4_fp8_x64(R.a[i][0][j], R.a[i][1][j], R.a[i][2][j], R.a[i][3][j]);
    LDS_WAIT();
    const int c = lane & 3;
#pragma unroll
    for (int r = 0; r < 4; ++r) { const int n = 16 * r + (lane >> 2); const LAS unsigned* s = T + n * 17 + 4 * c;
        v4u o; o.x = s[0]; o.y = s[1]; o.z = s[2]; o.w = s[3];
        *(GAS v4u*)(dst + (size_t)n * 2048 + k0 + 16 * c) = o; }
    LDS_WAIT();
}
constexpr int MKB = (FP8_MOE && !CONV_PIPE) ? 16 : 32;
constexpr int IT_IN = 32 * (NP / 64), IT_OUT = 32 * 32, IT_EXP = MKB * 32, IT_MOE = 3 * NE * IT_EXP, IT_TOTAL = IT_IN + IT_OUT + IT_MOE;
constexpr int IT_GU = 2 * NE * IT_EXP;
struct MoeItem { const float* src; unsigned char* dst; int k0, n0; };
__device__ __forceinline__ MoeItem moe_item(Frame& F, int r) {
    const int m = r / (NE * IT_EXP); r -= m * (NE * IT_EXP);
    const int e = r / IT_EXP; r -= e * IT_EXP; const int kb = r >> 5, nb = r & 31;
    const size_t eo = (size_t)e * 2048 * 2048; const int es = FP8_MOE ? 1 : 2;
    MoeItem it; it.k0 = kb * ((FP8_MOE && !CONV_PIPE) ? 128 : 64); it.n0 = nb * 64;
    const int rgu = (nb >> 1) * 256 + (nb & 1) * 64;
#if FP8_MOE && !CONV_PIPE
    unsigned char* dgu = WSP(unsigned char, WS_WGU) + (size_t)e * (4096 * 2048) + ((size_t)kb * 4096 + rgu) * 128;
    unsigned char* ddn = WSP(unsigned char, WS_WD) + (size_t)e * (2048 * 2048) + ((size_t)kb * 2048 + nb * 64) * 128;
    constexpr size_t up_off = (size_t)128 * 128;
#else
    unsigned char* dgu = WSP(unsigned char, WS_WGU) + ((size_t)e * 4096 + rgu) * (2048 * es);
    unsigned char* ddn = WSP(unsigned char, WS_WD) + ((size_t)e * 2048 + nb * 64) * (2048 * es);
    constexpr size_t up_off = (size_t)128 * (2048 * es);
#endif
    const float* pg = F.w_gate; const float* pu = F.w_up; const float* pd = F.w_down; asm volatile("" : "+s"(pg), "+s"(pu), "+s"(pd));
    const float* base = pg; it.dst = dgu;
    if (m == 1) { base = pu; it.dst = dgu + up_off; }
    if (m == 2) { base = pd; it.dst = ddn; }
    it.src = base + eo; return it;
}
__device__ __forceinline__ void conv_moe_item(Frame& F, int r, LAS unsigned* T, int lane0) {
    const MoeItem it = moe_item(F, r);
#if FP8_MOE && CONV_PIPE
    { Conv8Regs R; conv8_load(R, it.src, it.k0, it.n0, lane0); conv8_pack(R, it.k0, it.dst, T, lane0); }
#elif FP8_MOE
    conv_item8(it.src, it.k0, it.n0, it.dst, T, lane0);
#else
    conv_item<true>(it.src, 2048, 2048, it.k0, it.n0, (bf16*)it.dst, T, lane0);
#endif
}
__device__ __forceinline__ void conv_dispatch(Frame& F, int it, LAS unsigned* T, int lane0) {
    int r = it;
    if (r < IT_IN) { const int kb = r / (NP / 64), nb = r % (NP / 64); conv_item<(EMU_IN8 != 0)>(F.w_in, INCOLS, INCOLS, kb * 64, nb * 64, WSP(bf16, WS_WIN) + (size_t)(nb * 64) * 2048, T, lane0); return; }
    r -= IT_IN;
    if (r < IT_OUT) { const int kb = r >> 5, nb = r & 31; conv_item<(EMU_OUT8 != 0)>(F.w_out, DM, DM, kb * 64, nb * 64, WSP(bf16, WS_WOUT) + (size_t)(nb * 64) * 2048, T, lane0, (FUSE_P4 && kb >= 16) ? F.ssd_g + (kb * 64 - 1024) : nullptr); return; }
    r -= IT_OUT;
    conv_moe_item(F, r, T, lane0);
}
constexpr int WNB = CONV_DMA ? 16 : 8;
constexpr int WIT_EXP = 16 * WNB, WIT_GU = 2 * NE * WIT_EXP, WIT_MOE = 3 * NE * WIT_EXP;
struct WgItem { const float* src; unsigned char* blk; int m, nb; };
__device__ __forceinline__ WgItem wg_item(Frame& F, int r) {
    const int m = r / (NE * WIT_EXP); r -= m * (NE * WIT_EXP);
    const int e = r / WIT_EXP; r -= e * WIT_EXP; const int kb = r / WNB, nb = r % WNB;
    const float* pg = F.w_gate; const float* pu = F.w_up; const float* pd = F.w_down; asm volatile("" : "+s"(pg), "+s"(pu), "+s"(pd));
    WgItem it; it.m = m; it.nb = nb;
    const float* base = pg; if (m == 1) base = pu; if (m == 2) base = pd;
    it.src = base + (size_t)e * 2048 * 2048 + (size_t)(kb * 128) * 2048 + nb * (CONV_DMA ? 128 : 256);
    it.blk = (m == 2) ? WSP(unsigned char, WS_WD) + (size_t)e * (2048 * 2048) + (size_t)kb * (2048 * 128)
                      : WSP(unsigned char, WS_WGU) + (size_t)e * (4096 * 2048) + (size_t)kb * (4096 * 128);
    return it;
}
__device__ __forceinline__ void wg_load(f32x4 (&a)[16], const WgItem& it, int wave, int lane) {
#pragma unroll
    for (int i = 0; i < 16; ++i) a[i] = CONV_NT ? __builtin_nontemporal_load((const GAS f32x4*)(it.src + (size_t)(16 * wave + i) * 2048 + 4 * lane)) : *(const GAS f32x4*)(it.src + (size_t)(16 * wave + i) * 2048 + 4 * lane);
}
__device__ __forceinline__ void wg_pack(const f32x4 (&a)[16], LAS unsigned char* T, int wave, int lane) {
#pragma unroll
    for (int j = 0; j < 4; ++j) { v4u d;
        d.x = pk4_fp8_x64(a[0][j], a[1][j], a[2][j], a[3][j]); d.y = pk4_fp8_x64(a[4][j], a[5][j], a[6][j], a[7][j]);
        d.z = pk4_fp8_x64(a[8][j], a[9][j], a[10][j], a[11][j]); d.w = pk4_fp8_x64(a[12][j], a[13][j], a[14][j], a[15][j]);
        *(LAS v4u*)(T + (4 * lane + j) * 128 + ((wave ^ (lane & 7)) << 4)) = d; }
}
__device__ __forceinline__ void wg_store(const LAS unsigned char* T, const WgItem& it, int wave, int lane) {
    const int rb = (it.m == 2) ? it.nb * 256 : (2 * it.nb + (wave >> 2)) * 256 + (it.m == 1 ? 128 : 0);
#pragma unroll
    for (int s = 0; s < 4; ++s) { const int n = 32 * wave + 8 * s + (lane >> 3), c = lane & 7;
        const v4u v = *(const LAS v4u*)(T + n * 128 + ((c ^ ((n >> 2) & 7)) << 4));
        const int row = (it.m == 2) ? rb + n : rb + (n & 127);
        if (CONV_NTS) __builtin_nontemporal_store(v, (GAS v4u*)(it.blk + (size_t)row * 128 + 16 * c)); else *(GAS v4u*)(it.blk + (size_t)row * 128 + 16 * c) = v; }
}
__device__ __forceinline__ void dma_issue(const WgItem& it, unsigned sbase, int wave, int lane) {
#pragma unroll
    for (int i2 = 0; i2 < 8; ++i2) { const float* g = it.src + (size_t)(16 * wave + 2 * i2 + (lane >> 5)) * 2048 + 4 * (lane & 31); unsigned keep;
        asm volatile("s_mov_b32 %0, m0\n\ts_mov_b32 m0, %2\n\ts_nop 0\n\tglobal_load_lds_dwordx4 %1, off nt\n\ts_mov_b32 m0, %0" : "=&s"(keep) : "v"(g), "s"(sbase + 1024u * i2) : "memory"); }
}
__device__ __forceinline__ void dma_pack(const LAS unsigned char* Sw, LAS unsigned char* T, int wave, int lane) {
    const int n4 = lane & 31, kh = lane >> 5;
    f32x4 a[8];
#pragma unroll
    for (int r = 0; r < 8; ++r) { const int k = 8 * kh + r; a[r] = *(const LAS f32x4*)(Sw + (k >> 1) * 1024 + (k & 1) * 512 + n4 * 16); }
#pragma unroll
    for (int j = 0; j < 4; ++j) { v2u d; d.x = pk4_fp8_x64(a[0][j], a[1][j], a[2][j], a[3][j]); d.y = pk4_fp8_x64(a[4][j], a[5][j], a[6][j], a[7][j]);
        const int n = 4 * n4 + j; *(LAS v2u*)(T + n * 128 + ((wave ^ (n4 & 7)) << 4) + 8 * kh) = d; }
}
__device__ __forceinline__ void dma_store(const LAS unsigned char* T, const WgItem& it, int wave, int lane) {
    const int rb = (it.m == 2) ? it.nb * 128 : it.nb * 256 + (it.m == 1 ? 128 : 0);
#pragma unroll
    for (int s = 0; s < 2; ++s) { const int n = 16 * wave + 8 * s + (lane >> 3), c = lane & 7;
        const v4u v = *(const LAS v4u*)(T + n * 128 + ((c ^ ((n >> 2) & 7)) << 4));
        *(GAS v4u*)(it.blk + (size_t)(rb + n) * 128 + 16 * c) = v; }
}
constexpr int BG_BATCH = CONV_WG ? BGB_CFG : 32;
constexpr int POOL_GU = CONV_WG ? WIT_GU : IT_GU, POOL_ALL = CONV_WG ? WIT_MOE : IT_MOE;
__device__ __forceinline__ bool bg_batch(Frame& F, int limit) {
    LAS unsigned* T = (LAS unsigned*)(F.lds + RING_OFF + F.wave * 16384); volatile LAS int* BW = (volatile LAS int*)(F.lds + BGW_OFF);
    const int lane = TLANE();
    if (F.wave == 0) { int v = (int)__hip_atomic_load(F.ctl + CW_HEAD, RLX_AGENT);
        if (v < limit) v = (int)__hip_atomic_fetch_add(F.ctl + CW_HEAD, lane == 0 ? (unsigned)BG_BATCH : 0u, RLX_AGENT); else v = POOL_ALL;
        BW[0] = __builtin_amdgcn_readfirstlane(v); }
    __syncthreads();
    const int it0 = __builtin_amdgcn_readfirstlane(BW[0]);
    __syncthreads();
    if (it0 >= POOL_ALL) return false;
#if CONV_WG && CONV_DMA
    { LAS unsigned char* S0 = F.lds + RING_OFF; LAS unsigned char* T = F.lds + DMA_T_OFF; const int w = F.wave;
      const unsigned sb0 = (unsigned)(uintptr_t)(S0 + 8192 * w), sb1 = sb0 + 65536u;
      const WgItem i0 = wg_item(F, it0), i1 = wg_item(F, it0 + 1), i2 = wg_item(F, it0 + 2), i3 = wg_item(F, it0 + 3);
#define DMA_STEP(cur, sbc, NEXT_ISSUE, NWAIT) do { NEXT_ISSUE; asm volatile("s_waitcnt vmcnt(" #NWAIT ")" ::: "memory"); \
        dma_pack(S0 + ((sbc) - sb0) + 8192 * w, T, w, lane); LDS_WAIT(); __syncthreads(); dma_store(T, cur, w, lane); LDS_WAIT(); __syncthreads(); } while (0)
      dma_issue(i0, sb0, w, lane);
      DMA_STEP(i0, sb0, dma_issue(i1, sb1, w, lane), 8);
      DMA_STEP(i1, sb1, dma_issue(i2, sb0, w, lane), 8);
      DMA_STEP(i2, sb0, dma_issue(i3, sb1, w, lane), 8);
      DMA_STEP(i3, sb1, (void)0, 0);
#undef DMA_STEP
    }
#elif CONV_WG
    { LAS unsigned char* T0 = F.lds + RING_OFF; LAS unsigned char* T1 = T0 + 32768; const int w = F.wave;
      f32x4 A[16], B[16];
#if BGB_CFG == 6
      f32x4 C[16];
      const WgItem i0 = wg_item(F, it0), i1 = wg_item(F, it0 + 1), i2 = wg_item(F, it0 + 2), i3 = wg_item(F, it0 + 3), i4 = wg_item(F, it0 + 4), i5 = wg_item(F, it0 + 5);
      wg_load(A, i0, w, lane); wg_load(B, i1, w, lane); wg_load(C, i2, w, lane);
      wg_pack(A, T0, w, lane); LDS_WAIT(); __syncthreads(); wg_store(T0, i0, w, lane); wg_load(A, i3, w, lane);
      wg_pack(B, T1, w, lane); LDS_WAIT(); __syncthreads(); wg_store(T1, i1, w, lane); wg_load(B, i4, w, lane);
      wg_pack(C, T0, w, lane); LDS_WAIT(); __syncthreads(); wg_store(T0, i2, w, lane); wg_load(C, i5, w, lane);
      wg_pack(A, T1, w, lane); LDS_WAIT(); __syncthreads(); wg_store(T1, i3, w, lane);
      wg_pack(B, T0, w, lane); LDS_WAIT(); __syncthreads(); wg_store(T0, i4, w, lane);
      wg_pack(C, T1, w, lane); LDS_WAIT(); __syncthreads(); wg_store(T1, i5, w, lane);
#elif BGB_CFG == 4
      const WgItem i0 = wg_item(F, it0), i1 = wg_item(F, it0 + 1), i2 = wg_item(F, it0 + 2), i3 = wg_item(F, it0 + 3);
      wg_load(A, i0, w, lane);
      wg_load(B, i1, w, lane); wg_pack(A, T0, w, lane); LDS_WAIT(); __syncthreads(); wg_store(T0, i0, w, lane);
      wg_load(A, i2, w, lane); wg_pack(B, T1, w, lane); LDS_WAIT(); __syncthreads(); wg_store(T1, i1, w, lane);
      wg_load(B, i3, w, lane); wg_pack(A, T0, w, lane); LDS_WAIT(); __syncthreads(); wg_store(T0, i2, w, lane);
      wg_pack(B, T1, w, lane); LDS_WAIT(); __syncthreads(); wg_store(T1, i3, w, lane);
#elif BGB_CFG == 2
      const WgItem i0 = wg_item(F, it0), i1 = wg_item(F, it0 + 1);
      wg_load(A, i0, w, lane);
      wg_load(B, i1, w, lane); wg_pack(A, T0, w, lane); LDS_WAIT(); __syncthreads(); wg_store(T0, i0, w, lane);
      wg_pack(B, T1, w, lane); LDS_WAIT(); __syncthreads(); wg_store(T1, i1, w, lane);
#else
      const WgItem i0 = wg_item(F, it0);
      wg_load(A, i0, w, lane); wg_pack(A, T0, w, lane); LDS_WAIT(); __syncthreads(); wg_store(T0, i0, w, lane);
#endif
      LDS_WAIT(); __syncthreads(); }
#else
#pragma unroll 1
    for (int j = 0; j < BG_BATCH / NWAVES; ++j) conv_moe_item(F, it0 + j * NWAVES + F.wave, T, lane);
#endif
    return true;
}
__device__ __forceinline__ void bg_fill(Frame& F, int k, int limit) {
    volatile LAS int* BW = (volatile LAS int*)(F.lds + BGW_OFF);
    const int lane = TLANE();
    VM_WAIT(); __syncthreads();
    if (F.wave == 0) (void)__hip_atomic_fetch_add(F.ctl + CW_DONE + 64 * k, lane == 0 ? 1u : 0u, RLX_AGENT);
    bool more = true;
    while (more) {
        if (F.wave == 0) BW[1] = ((int)__hip_atomic_load(F.ctl + CW_DONE + 64 * k, RLX_AGENT) >= F.G) ? 1 : 0;
        __syncthreads();
        const int stop = __builtin_amdgcn_readfirstlane(BW[1]);
        __syncthreads();
        more = !stop;
        if (more) more = bg_batch(F, limit);
    }
}
__device__ __forceinline__ bool bg_finish(Frame& F, int limit) {
    bool any = false;
    while (bg_batch(F, limit)) any = true;
    return any;
}
__device__ __forceinline__ bool bg_peek_open(Frame& F) {
    volatile LAS int* BW = (volatile LAS int*)(F.lds + BGW_OFF);
    if (F.wave == 0) BW[2] = ((int)__hip_atomic_load(F.ctl + CW_HEAD, RLX_AGENT) < POOL_ALL) ? 1 : 0;
    __syncthreads();
    const int v = __builtin_amdgcn_readfirstlane(BW[2]);
    __syncthreads();
    return v != 0;
}
__device__ __forceinline__ bool bg_open(Frame& F, int limit) {
    return (int)__hip_atomic_load(F.ctl + CW_HEAD, RLX_AGENT) < limit;
}
__device__ __forceinline__ void rms_row_to_bf16(const float* xrow, const float* g, bf16* orow, int lane) {
    const f32x4* xr = (const f32x4*)xrow + lane; const f32x4* gr = (const f32x4*)g + lane;
    f32x4 v[8]; float s = 0.f;
#pragma unroll
    for (int j = 0; j < 8; ++j) { v[j] = xr[64 * j]; s += (v[j].x * v[j].x + v[j].y * v[j].y) + (v[j].z * v[j].z + v[j].w * v[j].w); }
    const float rstd = 1.f / sqrtf(wave_sum(s) * (1.f / 2048.f) + EPS);
    v2u* o8 = (v2u*)orow + lane;
#pragma unroll
    for (int j = 0; j < 8; ++j) { const f32x4 gg = gr[64 * j]; v2u w; w.x = pk2(v[j].x * rstd * gg.x, v[j].y * rstd * gg.y); w.y = pk2(v[j].z * rstd * gg.z, v[j].w * rstd * gg.w); o8[64 * j] = w; }
}
__device__ __forceinline__ void p0_prologue(Frame& F) {
    LAS unsigned* T = (LAS unsigned*)(F.lds + RING_OFF + F.wave * 16384); const int lane0 = TLANE();
    const int gw = F.vcu * NWAVES + F.wave, NGW = F.G * NWAVES;
    for (int it = gw; it < (BG_POOL ? IT_IN + IT_OUT : IT_TOTAL); it += NGW) conv_dispatch(F, it, T, lane0);
    for (int i = gw * 64 + lane0; i < NE * 2048; i += NGW * 64) { const int e = i >> 11, k = i & 2047; const float w = F.g2[k] * F.w_router[k * NE + e];
        const unsigned hi = f2bf(w); const float lo = w - bf2f(hi); WSP(bf16, WS_WR)[i] = (bf16)hi; WSP(bf16, WS_WR)[NE * 2048 + i] = (bf16)f2bf(lo); }
    for (int m0 = 2 * gw; m0 < NTOK; m0 += 2 * NGW) {
        const f32x4* x0 = (const f32x4*)(F.x + (size_t)m0 * DM) + lane0; const f32x4* x1 = x0 + DM / 4; const f32x4* gr = (const f32x4*)F.g1 + lane0;
        f32x4 v0[8], v1[8]; float s0 = 0.f, s1 = 0.f;
#pragma unroll
        for (int j = 0; j < 8; ++j) { v0[j] = x0[64 * j]; v1[j] = x1[64 * j]; }
#pragma unroll
        for (int j = 0; j < 8; ++j) { s0 += (v0[j].x * v0[j].x + v0[j].y * v0[j].y) + (v0[j].z * v0[j].z + v0[j].w * v0[j].w); s1 += (v1[j].x * v1[j].x + v1[j].y * v1[j].y) + (v1[j].z * v1[j].z + v1[j].w * v1[j].w); }
        const float r0 = 1.f / sqrtf(wave_sum(s0) * (1.f / 2048.f) + EPS), r1 = 1.f / sqrtf(wave_sum(s1) * (1.f / 2048.f) + EPS);
        v2u* o0 = (v2u*)(WSP(bf16, WS_XN) + (size_t)m0 * DM) + lane0; v2u* o1 = o0 + DM / 4;
#pragma unroll
        for (int j = 0; j < 8; ++j) { const f32x4 gg = gr[64 * j]; v2u w;
#if EMU_IN8
            w.x = pk2(q8(v0[j].x * r0 * gg.x), q8(v0[j].y * r0 * gg.y)); w.y = pk2(q8(v0[j].z * r0 * gg.z), q8(v0[j].w * r0 * gg.w)); o0[64 * j] = w;
            w.x = pk2(q8(v1[j].x * r1 * gg.x), q8(v1[j].y * r1 * gg.y)); w.y = pk2(q8(v1[j].z * r1 * gg.z), q8(v1[j].w * r1 * gg.w)); o1[64 * j] = w; }
#else
            w.x = pk2(v0[j].x * r0 * gg.x, v0[j].y * r0 * gg.y); w.y = pk2(v0[j].z * r0 * gg.z, v0[j].w * r0 * gg.w); o0[64 * j] = w;
            w.x = pk2(v1[j].x * r1 * gg.x, v1[j].y * r1 * gg.y); w.y = pk2(v1[j].z * r1 * gg.z, v1[j].w * r1 * gg.w); o1[64 * j] = w; }
#endif
    }
}

template <bool NS> struct OrderStaticT {
    static constexpr bool B_BLOCKED = false, HALF_UNITS = false, NSPLIT = NS, RSPLIT = false; __device__ __forceinline__ unsigned b_kstep() const { return 128u; }
    int nM, nN, nwg, G, c; const char* A; const char* Bt; const char* xprobe;
    __device__ __forceinline__ void init(int M, int N, int G_, int c_, const void* A_, const void* Bt_) { nM = M / 256; nN = N / 256; nwg = nM * nN; G = G_; c = c_; A = (const char*)A_; Bt = (const char*)Bt_; }
    __device__ __forceinline__ bool next(int i, pg8::Unit& u) const {
        long L = (long)i * G + c; u.nh = 0; u.rh = 0; u.roff = 0;
        if (NS) { const int R = nwg / G, T = nwg - R * G;
            if (T > 0 && 2 * T <= G && L >= (long)R * G) { const int Lp = (int)(L - (long)R * G); if (Lp >= 2 * T) return false; L = (long)R * G + (Lp >> 1); u.nh = 1 + (Lp & 1); } }
        if (L >= nwg) return false;
        int wgid = (int)L; { const int q = nwg / 8, r = nwg % 8, xcd = wgid % 8, off = wgid / 8; wgid = (xcd < r ? xcd * (q + 1) : r * (q + 1) + (xcd - r) * q) + off; }
        const int nig = 8 * nN, gid = wgid / nig, fm = gid * 8, gsz = (nM - fm) < 8 ? (nM - fm) : 8;
        u.pm = fm + ((wgid % nig) % gsz); u.pn = (wgid % nig) / gsz; u.e = 0; u.mt = 0; u.nrows = 256; return true;
    }
    __device__ __forceinline__ const void* a_base() const { return A; }
    __device__ __forceinline__ const void* b_base() const { return Bt; }
    __device__ __forceinline__ unsigned a_off(const pg8::Unit& u) const { return (unsigned)u.pm * (256u * 2048 * 2); }
    __device__ __forceinline__ unsigned b_off(const pg8::Unit& u) const { return (unsigned)u.pn * (256u * 2048 * 2); }
    __device__ __forceinline__ int a_row(const pg8::Unit&, int r) const { return r; }
};
typedef OrderStaticT<false> OrderStatic;
template <int NT, bool GATHER_A, int RB  > struct OrderMoe {
    static constexpr bool HALF_UNITS = HALF_UNITS_CFG != 0;
    static constexpr bool RSPLIT = NSPLIT_CFG != 0 && NT == 16;
    static constexpr bool NSPLIT = NSPLIT_CFG != 0 && NT == 8;
    static constexpr bool B_BLOCKED = FP8_MOE != 0;
    __device__ __forceinline__ unsigned b_kstep() const { return (unsigned)(bstride / 16); }
    int G, c, tb_lane, cn_lane, tbf_lane, tbh_lane; const char* A; const char* Bt; const int* stok; size_t bstride;
    const char* xprobe; gu32* qcnt; volatile LAS int* bw; int xc; bool dyn;
    __device__ __forceinline__ void init(int G_, int c_, const LAS int* TB, const LAS int* CN, int lane, const void* A_, const void* Bt_, size_t bstride_, const int* stok_, gu32* qcnt_, volatile LAS int* bw_, bool dyn_) {
        G = G_; c = c_; tb_lane = TB[lane < 32 ? lane : 32]; cn_lane = CN[lane & 31]; tbf_lane = TB[128 + (lane < 32 ? lane : 32)]; tbh_lane = TB[192 + (lane < 32 ? lane : 32)]; A = (const char*)A_; Bt = (const char*)Bt_; bstride = bstride_; stok = stok_;
        dyn = dyn_; xc = c_ >> 5; qcnt = qcnt_ + 64 * xc; bw = bw_; }
    __device__ __forceinline__ bool next(int i, pg8::Unit& u) const {
        int L = i * G + c;
        if (dyn) {
            if (__builtin_amdgcn_readfirstlane((int)(threadIdx.x >> 6)) == 0) { const unsigned v = __hip_atomic_fetch_add(qcnt, (threadIdx.x & 63) == 0 ? 1u : 0u, RLX_AGENT); bw[0] = __builtin_amdgcn_readfirstlane((int)v); }
            asm volatile("s_waitcnt lgkmcnt(0)" ::: "memory"); __builtin_amdgcn_s_barrier(); asm volatile("" ::: "memory");
            const int j = __builtin_amdgcn_readfirstlane(bw[0]);
            L = ((j >> 5) * 8 + xc) * 32 + (j & 31);
        }
        const int tfl = HALF_LAST ? tbf_lane : tb_lane;
        const int nfull = __builtin_amdgcn_readlane(tfl, 32) * NT, total = nfull + (HALF_LAST ? __builtin_amdgcn_readlane(tbh_lane, 32) * NT : 0);
        u.nh = 0; u.rh = 0; u.roff = 0;
        if ((NSPLIT || RSPLIT) && !dyn) { const int R = total / G, T = total - R * G;
            if (T > 0 && 2 * T <= G && L >= R * G) { const int Lp = L - R * G; if (Lp >= 2 * T) return false; L = R * G + (Lp >> 1); if (NSPLIT) u.nh = 1 + (Lp & 1); else u.rh = 1 + (Lp & 1); } }
        if (L >= total) return false;
        const int lane = threadIdx.x & 63;
        if (L < nfull) {
            const unsigned long long mk = __ballot(lane < 32 && tfl * NT <= L);
            const int e = __builtin_popcountll(mk) - 1;
            const int tfe = __builtin_amdgcn_readlane(tfl, e), tfe1 = __builtin_amdgcn_readlane(tfl, e + 1), tbe = __builtin_amdgcn_readlane(tb_lane, e), cne = __builtin_amdgcn_readlane(cn_lane, e);
            const int r = L - tfe * NT, mtiles = tfe1 - tfe, grp = mtiles * 8, ng = r / grp, r2 = r - ng * grp, mt = r2 >> 3, n8 = r2 & 7;
            u.e = e; u.mt = mt; u.pm = tbe + mt; u.pn = ng * 8 + n8; const int left = cne - mt * 256; u.nrows = left < 256 ? left : 256;
        } else {
            const int Lh = L - nfull;
            const unsigned long long mk = __ballot(lane < 32 && tbh_lane * NT <= Lh);
            const int e = __builtin_popcountll(mk) - 1;
            const int the = __builtin_amdgcn_readlane(tbh_lane, e), tbe = __builtin_amdgcn_readlane(tb_lane, e), tbe1 = __builtin_amdgcn_readlane(tb_lane, e + 1), cne = __builtin_amdgcn_readlane(cn_lane, e);
            const int mt = tbe1 - tbe - 1;
            u.e = e; u.mt = mt; u.pm = tbe + mt; u.pn = Lh - the * NT; u.nrows = cne - mt * 256;
        }
        if (RSPLIT && u.rh) {
            if (u.rh == 1) u.nrows = u.nrows < 128 ? u.nrows : 128;
            else if (u.nrows > 128) { u.roff = 128; u.nrows -= 128; }
            else { u.rh = 3; }
        }
        return true;
    }
    __device__ __forceinline__ const void* a_base() const { return A; }
    __device__ __forceinline__ const void* b_base() const { return Bt; }
    __device__ __forceinline__ unsigned a_off(const pg8::Unit& u) const { return GATHER_A ? 0u : (unsigned)u.pm * (256u * RB); }
    __device__ __forceinline__ unsigned b_off(const pg8::Unit& u) const { return (unsigned)u.e * (unsigned)bstride + (unsigned)u.pn * (256u * (B_BLOCKED ? 128 : RB)); }
    __device__ __forceinline__ int a_row(const pg8::Unit& u, int r) const { return stok[u.e * SLOTCAP + u.mt * 256 + u.roff + (r < u.nrows ? r : 0)]; }
};

struct EpiProj {
    static constexpr bool MIDSCALE = false; static constexpr int NVM = 16;
    static constexpr bool PERM = true; bf16* O; int ldc;
    __device__ __forceinline__ void operator()(const f32x4 (&acc)[2][2][4][2], const pg8::Unit& u, int wr, int wc, int fr, int fq) const {
        const int row0 = u.pm * 256 + wr * 64 + fr, col0 = u.pn * 256 + wc * 32 + 8 * fq;
#pragma unroll
        for (int ai = 0; ai < 2; ++ai)
#pragma unroll
            for (int m = 0; m < 4; ++m) { bf16* rowp = O + (size_t)(row0 + ai * 128 + m * 16) * ldc + col0;
#pragma unroll
                for (int bj = 0; bj < 2; ++bj) { if (u.nh == 2 - bj) continue; const f32x4 v0 = acc[ai][bj][m][0], v1 = acc[ai][bj][m][1];
                    v4u w; w.x = pk2(v0[0], v0[1]); w.y = pk2(v0[2], v0[3]); w.z = pk2(v1[0], v1[1]); w.w = pk2(v1[2], v1[3]);
                    *(v4u*)(rowp + bj * 128) = w; } }
    }
};
struct EpiRes {
    static constexpr int NVM = 48; static constexpr bool PERM = H_BF16 != 0; const float* base; float* out;
    static constexpr bool MIDSCALE = FUSE_P4 != 0; gu32* ssq;
    __device__ __forceinline__ float mid_load(const pg8::Unit& u) const { const int t = threadIdx.x; return t < 256 ? __builtin_bit_cast(float, __hip_atomic_load(ssq + u.pm * 256 + t, RLX_AGENT)) : 0.f; }
    __device__ __forceinline__ float mid_factor(float raw) const { return 1.f / sqrtf(raw * (1.f / 1024.f) + EPS); }
    __device__ __forceinline__ void operator()(const f32x4 (&acc)[2][2][4][2], const pg8::Unit& u, int wr, int wc, int fr, int fq) const {
#if H_BF16
        const int row0 = u.pm * 256 + wr * 64 + fr, col0 = u.pn * 256 + wc * 32 + 8 * fq;
#pragma unroll
        for (int ai = 0; ai < 2; ++ai)
#pragma unroll
            for (int m = 0; m < 4; ++m) { const size_t off = (size_t)(row0 + ai * 128 + m * 16) * DM + col0;
#pragma unroll
                for (int bj = 0; bj < 2; ++bj) { const f32x4 x0 = *(const f32x4*)(base + off + bj * 128), x1 = *(const f32x4*)(base + off + bj * 128 + 4); const f32x4 v0 = x0 + acc[ai][bj][m][0], v1 = x1 + acc[ai][bj][m][1];
                    v4u w; w.x = pk2(v0[0], v0[1]); w.y = pk2(v0[2], v0[3]); w.z = pk2(v1[0], v1[1]); w.w = pk2(v1[2], v1[3]);
                    *(v4u*)((bf16*)out + off + bj * 128) = w; } }
#else
        const int row0 = u.pm * 256 + wr * 64 + fr, col0 = u.pn * 256 + wc * 32 + 4 * fq;
#pragma unroll
        for (int ai = 0; ai < 2; ++ai)
#pragma unroll
            for (int m = 0; m < 4; ++m) { const size_t off = (size_t)(row0 + ai * 128 + m * 16) * DM + col0;
                f32x4 xb[2][2];
#pragma unroll
                for (int bj = 0; bj < 2; ++bj)
#pragma unroll
                    for (int n = 0; n < 2; ++n) xb[bj][n] = *(const f32x4*)(base + off + bj * 128 + n * 16);
#pragma unroll
                for (int bj = 0; bj < 2; ++bj)
#pragma unroll
                    for (int n = 0; n < 2; ++n) *(f32x4*)(out + off + bj * 128 + n * 16) = xb[bj][n] + acc[ai][bj][m][n]; }
#endif
    }
};
__device__ __forceinline__ float swiglu1(float g, float u) {
    g = fminf(g, SW_LIMIT); u = fminf(fmaxf(u, -SW_LIMIT), SW_LIMIT);
    const float glu = g * __builtin_amdgcn_rcpf(1.f + __expf(-SW_ALPHA * g));
    return (u + 1.f) * glu;
}
__device__ __forceinline__ f32x2 swiglu2(f32x2 g, f32x2 u) {
    g.x = fminf(g.x, SW_LIMIT); g.y = fminf(g.y, SW_LIMIT);
    u.x = fminf(fmaxf(u.x, -SW_LIMIT), SW_LIMIT); u.y = fminf(fmaxf(u.y, -SW_LIMIT), SW_LIMIT);
    const f32x2 t = g * (f32x2){-SW_ALPHA * LOG2E, -SW_ALPHA * LOG2E};
    f32x2 e; e.x = __builtin_amdgcn_exp2f(t.x); e.y = __builtin_amdgcn_exp2f(t.y);
    e = e + (f32x2){1.f, 1.f};
    f32x2 r; r.x = __builtin_amdgcn_rcpf(e.x); r.y = __builtin_amdgcn_rcpf(e.y);
    const f32x2 glu = g * r;
    return __builtin_elementwise_fma(u, glu, glu);
}
struct EpiGlu {
    static constexpr bool MIDSCALE = false; static constexpr int NVM = 8; static constexpr bool PERM = true; void* act; const float* bg; const float* bu;
    __device__ __forceinline__ void operator()(const f32x4 (&acc)[2][2][4][2], const pg8::Unit& u, int wr, int wc, int fr, int fq) const {
        if (u.rh == 3) return;
        const int row0 = u.pm * 256 + u.roff + wr * 64 + fr, colf = u.pn * 128 + wc * 32 + 8 * fq;
        f32x4 g_b[2], u_b[2];
#pragma unroll
        for (int n = 0; n < 2; ++n) { g_b[n] = *(const f32x4*)(bg + (size_t)u.e * DFF + colf + 4 * n); u_b[n] = *(const f32x4*)(bu + (size_t)u.e * DFF + colf + 4 * n); }
#pragma unroll
        for (int ai = 0; ai < 2; ++ai) { if (u.rh != 0 && ai == 1) continue;
#pragma unroll
            for (int m = 0; m < 4; ++m) { float r[8];
#pragma unroll
                for (int n = 0; n < 2; ++n) { const float ds_ = (FP8_MOE && (FP8_DIAG || FP8_NOSCALE)) ? (1.f / 64.f) : 1.f; const f32x4 g = acc[ai][0][m][n] * ds_ + g_b[n], uu = acc[ai][1][m][n] * ds_ + u_b[n];
#pragma unroll
                    for (int j = 0; j < 4; j += 2) { const f32x2 r2 = swiglu2((f32x2){g[j], g[j + 1]}, (f32x2){uu[j], uu[j + 1]}); r[4 * n + j] = r2.x; r[4 * n + j + 1] = r2.y;
                        if (EMU_FP8) { r[4 * n + j] = q8(r[4 * n + j]); r[4 * n + j + 1] = q8(r[4 * n + j + 1]); } } }
#if FP8_MOE
                v2u w; w.x = pk4_fp8(r[0], r[1], r[2], r[3]); w.y = pk4_fp8(r[4], r[5], r[6], r[7]);
                *(v2u*)((unsigned char*)act + (size_t)(row0 + ai * 128 + m * 16) * DFF + colf) = w; }
#else
                v4u w; w.x = pk2(r[0], r[1]); w.y = pk2(r[2], r[3]); w.z = pk2(r[4], r[5]); w.w = pk2(r[6], r[7]);
                *(v4u*)((bf16*)act + (size_t)(row0 + ai * 128 + m * 16) * DFF + colf) = w; }
#endif
        }
    }
};
struct EpiDown {
    static constexpr bool MIDSCALE = false; static constexpr int NVM = 16; static constexpr bool PERM = true; bf16* ys; const float* bd; const float* sgate; const int* sdest;
    __device__ __forceinline__ void operator()(const f32x4 (&acc)[2][2][4][2], const pg8::Unit& u, int wr, int wc, int fr, int fq) const {
        const int col0 = u.pn * 256 + wc * 32 + 8 * fq;
        f32x4 bv[2][2];
#pragma unroll
        for (int bj = 0; bj < 2; ++bj)
#pragma unroll
            for (int n = 0; n < 2; ++n) bv[bj][n] = *(const f32x4*)(bd + (size_t)u.e * DM + col0 + bj * 128 + 4 * n);
        float gts[2][4]; int dsts[2][4];
#pragma unroll
        for (int ai = 0; ai < 2; ++ai)
#pragma unroll
            for (int m = 0; m < 4; ++m) { const int rl = ai * 128 + wr * 64 + m * 16 + fr; const int slot = u.e * SLOTCAP + u.mt * 256 + (rl < u.nrows ? rl : 0); gts[ai][m] = sgate[slot]; dsts[ai][m] = sdest[slot]; }
#pragma unroll
        for (int ai = 0; ai < 2; ++ai)
#pragma unroll
            for (int m = 0; m < 4; ++m) { const int rl = ai * 128 + wr * 64 + m * 16 + fr;
                if (rl < u.nrows) { const float gt = gts[ai][m]; const int dest = dsts[ai][m];
#pragma unroll
                    for (int bj = 0; bj < 2; ++bj) { if (u.nh == 2 - bj) continue; const float ds_ = (FP8_MOE && (FP8_DIAG || FP8_NOSCALE)) ? (1.f / 64.f) : 1.f; const f32x4 v0 = (acc[ai][bj][m][0] * ds_ + bv[bj][0]) * gt, v1 = (acc[ai][bj][m][1] * ds_ + bv[bj][1]) * gt;
#if YSLOT_FP8
                        v2u w; w.x = pk4_fp8(v0[0], v0[1], v0[2], v0[3]); w.y = pk4_fp8(v1[0], v1[1], v1[2], v1[3]);
                        *(v2u*)((unsigned char*)ys + (size_t)dest * DM + col0 + bj * 128) = w; } } }
#else
                        v4u w; w.x = pk2(v0[0], v0[1]); w.y = pk2(v0[2], v0[3]); w.z = pk2(v1[0], v1[1]); w.w = pk2(v1[2], v1[3]);
                        *(v4u*)(ys + (size_t)dest * DM + col0 + bj * 128) = w; } } }
#endif
    }
};

__device__ __forceinline__ void unpack8(const v4u w, float (&f)[8]) { f[0] = bflo(w.x); f[1] = bfhi(w.x); f[2] = bflo(w.y); f[3] = bfhi(w.y); f[4] = bflo(w.z); f[5] = bfhi(w.z); f[6] = bflo(w.w); f[7] = bfhi(w.w); }
__device__ __forceinline__ v4u pack8f(const float (&f)[8]) { v4u w; w.x = pk2(f[0], f[1]); w.y = pk2(f[2], f[3]); w.z = pk2(f[4], f[5]); w.w = pk2(f[6], f[7]); return w; }
__device__ __forceinline__ void p2_post(Frame& F) {
    const int gw = F.vcu * NWAVES + F.wave, NGW = F.G * NWAVES, lane = TLANE();
    const bf16* proj = WSP(bf16, WS_PROJ);
    const bool scan = F.vcu < BATCH * AH;
    float fraw[4] = {0.f, 0.f, 0.f, 0.f};
    if (scan) { const int b = F.vcu >> 3, h = F.vcu & 7;
#pragma unroll
        for (int i = 0; i < 4; ++i) fraw[i] = bf2f(proj[(size_t)(b * SEQ + 256 * F.wave + 4 * lane + i) * NP + O_F + h]); }
    for (int t0 = 4 * gw; t0 < NTOK; t0 += 4 * NGW) {
        const int s0 = t0 & 2047;
        v4u xr[3][7];
#pragma unroll
        for (int j8 = 0; j8 < 2; ++j8)
#pragma unroll
            for (int i = 0; i < 7; ++i) { xr[j8][i] = (v4u){0u, 0u, 0u, 0u}; if (s0 + i - 3 >= 0) xr[j8][i] = *(const v4u*)(proj + (size_t)(t0 + i - 3) * NP + O_XBC + 512 * j8 + 8 * lane); }
        v4u raw[4][2][2];
#pragma unroll
        for (int ti = 0; ti < 4; ++ti)
#pragma unroll
            for (int qk = 0; qk < 2; ++qk) { const v4u* src = (const v4u*)(proj + (size_t)(t0 + ti) * NP + (qk ? O_K : O_Q) + 16 * lane); raw[ti][qk][0] = src[0]; raw[ti][qk][1] = src[1]; }
        float dtraw[4];
#pragma unroll
        for (int ti = 0; ti < 4; ++ti) dtraw[ti] = bf2f(proj[(size_t)(t0 + ti) * NP + O_DT + (lane & 15)]);
        {
            const int d0 = (16 * lane) & 127, h = lane >> 3;
            float gqv[16], gkv[16];
#pragma unroll
            for (int j = 0; j < 16; ++j) { gqv[j] = F.gq[d0 + j] * QSCALE; gkv[j] = F.gk[d0 + j]; }
            const float dtb = F.dt_bias[lane & 15], An = -__expf(F.a_log[lane & 15]);
#pragma unroll
            for (int ti = 0; ti < 4; ++ti) { const int t = t0 + ti, b = t >> 11, s = t & 2047;
#pragma unroll
                for (int qk = 0; qk < 2; ++qk) {
                    float f[16]; { float a[8], c[8]; unpack8(raw[ti][qk][0], a); unpack8(raw[ti][qk][1], c);
#pragma unroll
                        for (int j = 0; j < 8; ++j) { f[j] = a[j]; f[8 + j] = c[j]; } }
                    float ss = 0.f;
#pragma unroll
                    for (int j = 0; j < 16; ++j) ss += f[j] * f[j];
                    ss += __shfl_xor(ss, 1); ss += __shfl_xor(ss, 2); ss += __shfl_xor(ss, 4);
                    const float rstd = 1.f / sqrtf(ss * (1.f / 128.f) + EPS);
                    float o0[8], o1[8];
#pragma unroll
                    for (int j = 0; j < 8; ++j) { o0[j] = f[j] * rstd * (qk ? gkv[j] : gqv[j]); o1[j] = f[8 + j] * rstd * (qk ? gkv[8 + j] : gqv[8 + j]); }
                    v4u* dst = (v4u*)(WSP(bf16, qk ? WS_KN : WS_QN) + ((size_t)((b * AH + h) * SEQ + s)) * AHD + d0);
                    dst[0] = pack8f(o0); dst[1] = pack8f(o1);
                }
                if (lane < 16) { const float dt = softplusf_(dtraw[ti] + dtb);
                    WSP(float, WS_DTV)[t * 16 + lane] = dt; WSP(float, WS_DAV)[t * 16 + lane] = dt * An; } }
        }
#pragma unroll
        for (int i = 0; i < 7; ++i) { xr[2][i] = (v4u){0u, 0u, 0u, 0u}; if (s0 + i - 3 >= 0) xr[2][i] = *(const v4u*)(proj + (size_t)(t0 + i - 3) * NP + O_XBC + 1024 + 8 * lane); }
#pragma unroll
        for (int j8 = 0; j8 < 3; ++j8) {
            const int c0 = 512 * j8 + 8 * lane;
            float cw[4][8], cb[8];
#pragma unroll
            for (int tap = 0; tap < 4; ++tap)
#pragma unroll
                for (int j = 0; j < 8; ++j) cw[tap][j] = F.conv_w[tap * CONVCH + c0 + j];
#pragma unroll
            for (int j = 0; j < 8; ++j) cb[j] = F.conv_b[c0 + j];
#pragma unroll
            for (int ti = 0; ti < 4; ++ti) { float a[8];
#pragma unroll
                for (int j = 0; j < 8; ++j) a[j] = cb[j];
#pragma unroll
                for (int tap = 0; tap < 4; ++tap) { float xv[8]; unpack8(xr[j8][ti + tap], xv);
#pragma unroll
                    for (int j = 0; j < 8; ++j) a[j] += cw[tap][j] * xv[j]; }
#pragma unroll
                for (int j = 0; j < 8; ++j) a[j] = siluf_(a[j]);
                *(v4u*)(WSP(bf16, WS_XCONV) + (size_t)(t0 + ti) * CONVCH + c0) = pack8f(a); }
        }
    }
    if (scan) {
        LAS float* WT = (LAS float*)(F.lds + RING_OFF);
        const int bh = F.vcu, h = bh & 7; const float fb = F.fbias[h];
        float lf[4]; float tot = 0.f;
#pragma unroll
        for (int i = 0; i < 4; ++i) { const float xv = fraw[i] + fb; lf[i] = fminf(xv, 0.f) - log1pf(__expf(-fabsf(xv))); tot += lf[i]; }
        const float inc = dpp_scan64f(tot);
        if (lane == 63) WT[F.wave] = inc;
        LDS_WAIT(); __syncthreads();
        float run = inc - tot;
        for (int w = 0; w < F.wave; ++w) run += WT[w];
        f32x4 o;
        run += lf[0]; o.x = run * LOG2E; run += lf[1]; o.y = run * LOG2E; run += lf[2]; o.z = run * LOG2E; run += lf[3]; o.w = run * LOG2E;
        *(f32x4*)(WSP(float, WS_ACUM) + (size_t)bh * SEQ + 256 * F.wave + 4 * lane) = o;
        __syncthreads();
    }
}

__device__ __forceinline__ void p3_attn_naive(Frame& F) {
    const int gw = F.vcu * NWAVES + F.wave, NGW = F.G * NWAVES, lane = TLANE();
    LAS float* qs = (LAS float*)(F.lds + RING_OFF + F.wave * 1024);
    const bf16* QN = WSP(bf16, WS_QN); const bf16* KN = WSP(bf16, WS_KN); const bf16* proj = WSP(bf16, WS_PROJ); const float* AC = WSP(float, WS_ACUM);
    for (int idx = gw; idx < BATCH * AH * SEQ; idx += NGW) {
        const int bh = idx >> 11, q = ((idx & 2047) + bh * 1031) & 2047, b = bh >> 3, h = bh & 7;
        { const unsigned w = *(const unsigned*)(QN + ((size_t)bh * SEQ + q) * AHD + 2 * lane); qs[2 * lane] = bflo(w); qs[2 * lane + 1] = bfhi(w); }
        LDS_WAIT();
        const float Aq = AC[(size_t)bh * SEQ + q];
        float m = -1e30f, l = 0.f, o0 = 0.f, o1 = 0.f;
        for (int kt = 0; kt * 64 <= q; ++kt) {
            const int key = kt * 64 + lane;
            const v4u* kp = (const v4u*)(KN + ((size_t)bh * SEQ + key) * AHD);
            float s = 0.f;
#pragma unroll
            for (int c = 0; c < 16; ++c) { float kf[8]; unpack8(kp[c], kf); const f32x4 q0 = ((const LAS f32x4*)qs)[2 * c], q1 = ((const LAS f32x4*)qs)[2 * c + 1];
                s += kf[0] * q0.x + kf[1] * q0.y + kf[2] * q0.z + kf[3] * q0.w + kf[4] * q1.x + kf[5] * q1.y + kf[6] * q1.z + kf[7] * q1.w; }
            s += Aq - AC[(size_t)bh * SEQ + key];
            if (key > q) s = -__builtin_inff();
            const float mt = wave_max(s), mn = fmaxf(m, mt), alpha = __builtin_amdgcn_exp2f(m - mn), p = __builtin_amdgcn_exp2f(s - mn);
            l = l * alpha + wave_sum(p); o0 *= alpha; o1 *= alpha; m = mn;
            const int nk = (q - kt * 64 + 1) < 64 ? (q - kt * 64 + 1) : 64;
            for (int kk = 0; kk < nk; ++kk) { const float pk = __shfl(p, kk);
                const unsigned w = *(const unsigned*)(proj + (size_t)(b * SEQ + kt * 64 + kk) * NP + O_V + h * AHD + 2 * lane);
                o0 += pk * bflo(w); o1 += pk * bfhi(w); }
        }
        const float il = 1.f / l;
        *(unsigned*)(WSP(bf16, WS_MIX) + (size_t)(b * SEQ + q) * DM + h * AHD + 2 * lane) = pk2(o0 * il, o1 * il);
        LDS_WAIT();
    }
}
__device__ __forceinline__ void p3_ssd_naive(Frame& F) {
    const int gw = F.vcu * NWAVES + F.wave, lane = TLANE();
    if (gw >= BATCH * SH) return;
    const int b = gw >> 4, h = gw & 15, g = h >> 3;
    LAS float* LB = (LAS float*)(F.lds + RING_OFF + 8192 + F.wave * 1024); LAS float* LC = LB + 128;
    const bf16* xc = WSP(bf16, WS_XCONV); const bf16* proj = WSP(bf16, WS_PROJ);
    const float dsk = F.d_skip[h];
    float hst[128];
#pragma unroll
    for (int n = 0; n < 128; ++n) hst[n] = 0.f;
    for (int t = 0; t < SEQ; ++t) {
        const int tok = b * SEQ + t;
        const float dt = WSP(float, WS_DTV)[tok * 16 + h], dec = __expf(WSP(float, WS_DAV)[tok * 16 + h]);
        const float xs = bf2f(xc[(size_t)tok * CONVCH + h * SHD + lane]), xdt = xs * dt;
        const unsigned bw = *(const unsigned*)(xc + (size_t)tok * CONVCH + SW + g * SN + 2 * lane), cw = *(const unsigned*)(xc + (size_t)tok * CONVCH + SW + SG * SN + g * SN + 2 * lane);
        LB[2 * lane] = bflo(bw); LB[2 * lane + 1] = bfhi(bw); LC[2 * lane] = bflo(cw); LC[2 * lane + 1] = bfhi(cw);
        LDS_WAIT();
        float y = 0.f;
#pragma unroll
        for (int n4 = 0; n4 < 32; ++n4) { const f32x4 bv = ((const LAS f32x4*)LB)[n4], cv = ((const LAS f32x4*)LC)[n4];
#pragma unroll
            for (int j = 0; j < 4; ++j) { hst[4 * n4 + j] = hst[4 * n4 + j] * dec + xdt * bv[j]; y += cv[j] * hst[4 * n4 + j]; } }
        LDS_WAIT();
        y += xs * dsk;
        const float z = bf2f(proj[(size_t)tok * NP + O_Z + h * SHD + lane]);
        const float yg = y * siluf_(z);
        const float ss = wave_sum(yg * yg);
        if (lane == 0) atomicAdd((float*)(F.ctl + CW_SSQ) + tok, ss);
        WSP(bf16, WS_MIX)[(size_t)tok * DM + AW + h * SHD + lane] = (bf16)f2bf(yg);
    }
}

__device__ __forceinline__ void p4_ssdnorm(Frame& F) {
    const int gw = F.vcu * NWAVES + F.wave, NGW = F.G * NWAVES, lane = TLANE();
    float gv[16];
#pragma unroll
    for (int j = 0; j < 16; ++j) gv[j] = F.ssd_g[16 * lane + j];
    for (int t0 = 4 * gw; t0 < NTOK; t0 += 4 * NGW) {
        float ssq[4]; v4u r0[4], r1[4];
#pragma unroll
        for (int ti = 0; ti < 4; ++ti) { ssq[ti] = __builtin_bit_cast(float, __hip_atomic_load(F.ctl + CW_SSQ + t0 + ti, RLX_AGENT));
            const v4u* p = (const v4u*)(WSP(bf16, WS_MIX) + (size_t)(t0 + ti) * DM + AW + 16 * lane); r0[ti] = p[0]; r1[ti] = p[1]; }
#pragma unroll
        for (int ti = 0; ti < 4; ++ti) { const float rs = 1.f / sqrtf(ssq[ti] * (1.f / 1024.f) + EPS);
            float a[8], c[8]; unpack8(r0[ti], a); unpack8(r1[ti], c);
#pragma unroll
            for (int j = 0; j < 8; ++j) { a[j] *= rs * gv[j]; c[j] *= rs * gv[8 + j]; if (EMU_OUT8) { a[j] = q8(a[j]); c[j] = q8(c[j]); } }
            v4u* p = (v4u*)(WSP(bf16, WS_MIX) + (size_t)(t0 + ti) * DM + AW + 16 * lane); p[0] = pack8f(a); p[1] = pack8f(c); }
    }
#if EMU_OUT8
    for (int t0 = gw; t0 < NTOK; t0 += NGW) { v4u* p = (v4u*)(WSP(bf16, WS_MIX) + (size_t)t0 * DM + 16 * lane); v4u r0 = p[0], r1 = p[1]; float a[8], c[8]; unpack8(r0, a); unpack8(r1, c);
        for (int j = 0; j < 8; ++j) { a[j] = q8(a[j]); c[j] = q8(c[j]); } p[0] = pack8f(a); p[1] = pack8f(c); }
#endif
}

__device__ __forceinline__ void p6_router(Frame& F) {
    const int tid = TTID(), lane = tid & 63, wave = F.wave, r16 = lane & 15, q4 = lane >> 4;
    LAS float* RED = (LAS float*)(F.lds + RING_OFF);
    LAS int* LC = (LAS int*)(F.lds + RING_OFF + 8 * 32 * 33 * 4); LAS int* LB = LC + 32;
    const bf16* WRH = WSP(bf16, WS_WR); const bf16* WRL = WRH + NE * 2048;
    gu32* cnt = F.ctl + CW_CNT;
    for (int unit = F.vcu; unit < NTOK / 32; unit += F.G) {
        const int T0 = unit * 32;
        float rs[4];
#if H_BF16 && FP8_MOE
        { const int tok = T0 + 4 * wave; const bf16* hr = WSP(bf16, WS_H) + (size_t)tok * DM + 8 * lane;
            v4u v[4][4];
#pragma unroll
            for (int q = 0; q < 4; ++q)
#pragma unroll
                for (int j = 0; j < 4; ++j) v[q][j] = *(const v4u*)(hr + (size_t)q * DM + 512 * j);
#pragma unroll
            for (int q = 0; q < 4; ++q) { float s0 = 0.f;
#pragma unroll
                for (int j = 0; j < 4; ++j) { float f[8]; unpack8(v[q][j], f);
#pragma unroll
                    for (int i = 0; i < 8; ++i) s0 += f[i] * f[i]; }
                rs[q] = 1.f / sqrtf(wave_sum(s0) * (1.f / 2048.f) + EPS); }
#pragma unroll
            for (int j = 0; j < 4; ++j) { const f32x4 g0 = *(const f32x4*)(F.g2 + 8 * lane + 512 * j), g1 = *(const f32x4*)(F.g2 + 8 * lane + 512 * j + 4);
#pragma unroll
                for (int q = 0; q < 4; ++q) { const float rstd = rs[q]; float f[8]; unpack8(v[q][j], f);
                    v2u w; w.x = pk4_fp8(f[0] * rstd * g0.x, f[1] * rstd * g0.y, f[2] * rstd * g0.z, f[3] * rstd * g0.w); w.y = pk4_fp8(f[4] * rstd * g1.x, f[5] * rstd * g1.y, f[6] * rstd * g1.z, f[7] * rstd * g1.w);
                    *(v2u*)(WSP(unsigned char, WS_XN) + (size_t)(tok + q) * DM + 8 * lane + 512 * j) = w; } }
        }
#else
        { const int tok = T0 + 4 * wave; const f32x4* xr = (const f32x4*)(F.out + (size_t)tok * DM) + lane; const f32x4* gr = (const f32x4*)F.g2 + lane;
            f32x4 v[4][8];
#pragma unroll
            for (int q = 0; q < 4; ++q)
#pragma unroll
                for (int j = 0; j < 8; ++j) v[q][j] = xr[q * (DM / 4) + 64 * j];
#pragma unroll
            for (int q = 0; q < 4; ++q) { float s0 = 0.f;
#pragma unroll
                for (int j = 0; j < 8; ++j) s0 += (v[q][j].x * v[q][j].x + v[q][j].y * v[q][j].y) + (v[q][j].z * v[q][j].z + v[q][j].w * v[q][j].w);
                rs[q] = 1.f / sqrtf(wave_sum(s0) * (1.f / 2048.f) + EPS); }
#pragma unroll
            for (int j = 0; j < 8; ++j) { const f32x4 gg = gr[64 * j];
#pragma unroll
                for (int q = 0; q < 4; ++q) { const float rstd = rs[q];
                    f32x4 t = {v[q][j].x * rstd * gg.x, v[q][j].y * rstd * gg.y, v[q][j].z * rstd * gg.z, v[q][j].w * rstd * gg.w};
                    if (EMU_FP8) { t.x = q8(t.x); t.y = q8(t.y); t.z = q8(t.z); t.w = q8(t.w); }
#if FP8_MOE
                    ((unsigned*)(WSP(unsigned char, WS_XN) + (size_t)(tok + q) * DM))[lane + 64 * j] = pk4_fp8(t.x, t.y, t.z, t.w); }
#else
                    v2u w; w.x = pk2(t.x, t.y); w.y = pk2(t.z, t.w); ((v2u*)(WSP(bf16, WS_XN) + (size_t)(tok + q) * DM) + lane)[64 * j] = w; }
#endif
            }
        }
#endif
        f32x4 acc[2][2];
#pragma unroll
        for (int a = 0; a < 2; ++a)
#pragma unroll
            for (int c = 0; c < 2; ++c) acc[a][c] = (f32x4){0.f, 0.f, 0.f, 0.f};
#pragma unroll 4
        for (int ks = 0; ks < 8; ++ks) { const int k = 256 * wave + 32 * ks + 8 * q4;
            bf16x8 bh[2], bl[2];
#pragma unroll
            for (int n = 0; n < 2; ++n) { bh[n] = *(const bf16x8*)(WRH + (size_t)(16 * n + r16) * 2048 + k); bl[n] = *(const bf16x8*)(WRL + (size_t)(16 * n + r16) * 2048 + k); }
#pragma unroll
#if H_BF16
            for (int mt = 0; mt < 2; ++mt) { const bf16x8 ah = *(const bf16x8*)(WSP(bf16, WS_H) + (size_t)(T0 + 16 * mt + r16) * DM + k);
#pragma unroll
                for (int n = 0; n < 2; ++n) { acc[mt][n] = __builtin_amdgcn_mfma_f32_16x16x32_bf16(ah, bh[n], acc[mt][n], 0, 0, 0); acc[mt][n] = __builtin_amdgcn_mfma_f32_16x16x32_bf16(ah, bl[n], acc[mt][n], 0, 0, 0); } }
#else
            for (int mt = 0; mt < 2; ++mt) { const float* xp = F.out + (size_t)(T0 + 16 * mt + r16) * DM + k;
                const f32x4 x0 = *(const f32x4*)xp, x1 = *(const f32x4*)(xp + 4);
                float xv[8] = {x0.x, x0.y, x0.z, x0.w, x1.x, x1.y, x1.z, x1.w}; float hv[8], lv[8];
#pragma unroll
                for (int j = 0; j < 8; ++j) { hv[j] = bf2f(f2bf(xv[j])); lv[j] = xv[j] - hv[j]; }
                const v4u ahw = pack8f(hv), alw = pack8f(lv);
                const bf16x8 ah = __builtin_bit_cast(bf16x8, ahw), al = __builtin_bit_cast(bf16x8, alw);
#pragma unroll
                for (int n = 0; n < 2; ++n) { acc[mt][n] = __builtin_amdgcn_mfma_f32_16x16x32_bf16(ah, bh[n], acc[mt][n], 0, 0, 0);
                    acc[mt][n] = __builtin_amdgcn_mfma_f32_16x16x32_bf16(ah, bl[n], acc[mt][n], 0, 0, 0);
                    acc[mt][n] = __builtin_amdgcn_mfma_f32_16x16x32_bf16(al, bh[n], acc[mt][n], 0, 0, 0); } }
#endif
        }
#pragma unroll
        for (int mt = 0; mt < 2; ++mt)
#pragma unroll
            for (int n = 0; n < 2; ++n)
#pragma unroll
                for (int rg = 0; rg < 4; ++rg) RED[(wave * 32 + 16 * mt + 4 * q4 + rg) * 33 + 16 * n + r16] = acc[mt][n][rg];
        if (tid < 32) LC[tid] = 0;
        __syncthreads();
        { const int tokl = tid >> 4, e2 = r16 * 2;
          const float rsel = q4 == 0 ? rs[0] : q4 == 1 ? rs[1] : q4 == 2 ? rs[2] : rs[3];
          float l0 = 0.f, l1 = 0.f;
#pragma unroll
          for (int w = 0; w < 8; ++w) { l0 += RED[(w * 32 + tokl) * 33 + e2]; l1 += RED[(w * 32 + tokl) * 33 + e2 + 1]; }
          l0 = l0 * rsel + F.b_router[e2]; l1 = l1 * rsel + F.b_router[e2 + 1];
          float val[4]; int idx[4];
#pragma unroll
          for (int k = 0; k < 4; ++k) { float bv = l0; int bi = e2; if (l1 > l0) { bv = l1; bi = e2 + 1; }
#pragma unroll
              for (int m = 1; m < 16; m <<= 1) { const float ov = __shfl_xor(bv, m); const int oi = __shfl_xor(bi, m); if (ov > bv || (ov == bv && oi < bi)) { bv = ov; bi = oi; } }
              val[k] = bv; idx[k] = bi;
              if (bi == e2) l0 = -__builtin_inff(); if (bi == e2 + 1) l1 = -__builtin_inff(); }
          float ex[4], sum = 0.f;
#pragma unroll
          for (int k = 0; k < 4; ++k) { ex[k] = __expf(val[k] - val[0]); sum += ex[k]; }
          const float inv = 1.f / sum;
          int esel = 0, loc = 0; float gsel = 0.f;
          if (r16 < 4) { const int k = r16;
              const int e = k == 0 ? idx[0] : k == 1 ? idx[1] : k == 2 ? idx[2] : idx[3]; const float g = (k == 0 ? ex[0] : k == 1 ? ex[1] : k == 2 ? ex[2] : ex[3]) * inv;
              esel = e; gsel = g; loc = __hip_atomic_fetch_add(LC + e, 1, __ATOMIC_RELAXED, __HIP_MEMORY_SCOPE_WORKGROUP); }
          __syncthreads();
          if (tid < 32) { const int c = LC[tid]; LB[tid] = c > 0 ? (int)__hip_atomic_fetch_add(cnt + 64 * tid, (unsigned)c, RLX_AGENT) : 0; }
#ifdef PROBE_AT2
          __syncthreads();
          if (tid < 32) { const int c = LC[tid]; const int d = c > 0 ? (int)__hip_atomic_fetch_add(cnt + 64 * tid + 32, (unsigned)c, RLX_AGENT) : 0; if (d < 0) LB[tid] = d; }
#endif
          __syncthreads();
          if (r16 < 4) { const int tok = T0 + tokl; const size_t sl = (size_t)esel * SLOTCAP + (LB[esel] + loc); WSP(int, WS_STOK)[sl] = tok; WSP(float, WS_SGATE)[sl] = gsel; WSP(int, WS_SDEST)[sl] = tok * 4 + r16; } }
        __syncthreads();
    }
}
__device__ __forceinline__ void moe_tables(Frame& F) {
    LAS int* TB = (LAS int*)(F.lds + TB_OFF); LAS int* CN = TB + 64; LAS int* MT = CN + 32; LAS int* TBF = MT + 32; LAS int* TBH = TBF + 64;
    const int tid = TTID();
    if (tid < NE) { const int c = (int)__hip_atomic_load(F.ctl + CW_CNT + 64 * tid, RLX_AGENT); CN[tid] = c; MT[tid] = (c + 255) >> 8; }
    __syncthreads();
    if (tid == 0) { int run = 0, rf = 0, rh = 0;
        for (int e = 0; e < NE; ++e) { const int mt = MT[e], rem = CN[e] - (mt - 1) * 256, hf = (HALF_UNITS_CFG && mt > 0 && rem <= 128) ? 1 : 0;
            TB[e] = run; TBF[e] = rf; TBH[e] = rh; run += mt; rf += mt - hf; rh += hf; }
        TB[NE] = run; TBF[NE] = rf; TBH[NE] = rh; }
    __syncthreads();
}
__device__ __forceinline__ void p9_combine(Frame& F) {
    const int gw = F.vcu * NWAVES + F.wave, NGW = F.G * NWAVES, lane = TLANE();
#if PROBE_T
    const float probe_s = 1.f + __builtin_bit_cast(float, __hip_atomic_load(F.ctl + CW_PROBE, RLX_AGENT)), probe_a = __builtin_bit_cast(float, __hip_atomic_load(F.ctl + CW_PROBE + 1, RLX_AGENT));
#endif
#if YSLOT_FP8 && H_BF16
    const unsigned char* ys = WSP(unsigned char, WS_YSLOT); const bf16* hb = WSP(bf16, WS_H);
    for (int t = gw; t < NTOK; t += NGW) {
        v4u hh[2][2], yy[2][4];
#pragma unroll
        for (int j = 0; j < 2; ++j) { const int col = 16 * lane + 1024 * j;
            hh[j][0] = *(const v4u*)(hb + (size_t)t * DM + col); hh[j][1] = *(const v4u*)(hb + (size_t)t * DM + col + 8);
#pragma unroll
            for (int k = 0; k < 4; ++k) yy[j][k] = *(const v4u*)(ys + (size_t)(4 * t + k) * DM + col); }
#pragma unroll
        for (int j = 0; j < 2; ++j) { float* op = F.out + (size_t)t * DM + 16 * lane + 1024 * j;
            float a[16]; { float f0[8], f1[8]; unpack8(hh[j][0], f0); unpack8(hh[j][1], f1);
#pragma unroll
                for (int i = 0; i < 8; ++i) { a[i] = f0[i]; a[8 + i] = f1[i]; } }
#pragma unroll
            for (int k = 0; k < 4; ++k) { const unsigned yw[4] = {yy[j][k].x, yy[j][k].y, yy[j][k].z, yy[j][k].w};
#pragma unroll
                for (int q = 0; q < 4; ++q) { a[4 * q] += __builtin_amdgcn_cvt_f32_fp8((int)yw[q], 0); a[4 * q + 1] += __builtin_amdgcn_cvt_f32_fp8((int)yw[q], 1); a[4 * q + 2] += __builtin_amdgcn_cvt_f32_fp8((int)yw[q], 2); a[4 * q + 3] += __builtin_amdgcn_cvt_f32_fp8((int)yw[q], 3); } }
#pragma unroll
            for (int q = 0; q < 4; ++q) { f32x4 o = {a[4 * q], a[4 * q + 1], a[4 * q + 2], a[4 * q + 3]};
#if PROBE_T
                o = o * probe_s; if (t == 0 && lane == 0 && j == 0 && q == 0) o.x += probe_a;
#endif
                *(f32x4*)(op + 4 * q) = o; } }
    }
#elif YSLOT_FP8
    const unsigned char* ys = WSP(unsigned char, WS_YSLOT);
    for (int t = gw; t < NTOK; t += NGW) {
#pragma unroll
        for (int j = 0; j < 2; ++j) { const int col = 16 * lane + 1024 * j; float* op = F.out + (size_t)t * DM + col;
            f32x4 a[4];
#pragma unroll
            for (int q = 0; q < 4; ++q) a[q] = *(const f32x4*)(op + 4 * q);
#pragma unroll
            for (int k = 0; k < 4; ++k) { const v4u y = *(const v4u*)(ys + (size_t)(4 * t + k) * DM + col); const unsigned yw[4] = {y.x, y.y, y.z, y.w};
#pragma unroll
                for (int q = 0; q < 4; ++q) { a[q].x += __builtin_amdgcn_cvt_f32_fp8((int)yw[q], 0); a[q].y += __builtin_amdgcn_cvt_f32_fp8((int)yw[q], 1); a[q].z += __builtin_amdgcn_cvt_f32_fp8((int)yw[q], 2); a[q].w += __builtin_amdgcn_cvt_f32_fp8((int)yw[q], 3); } }
#pragma unroll
            for (int q = 0; q < 4; ++q) *(f32x4*)(op + 4 * q) = a[q]; }
    }
#else
    const bf16* ys = WSP(bf16, WS_YSLOT);
    for (int t = gw; t < NTOK; t += NGW) {
        float* op = F.out + (size_t)t * DM + 8 * lane;
        f32x4 a0[4], a1[4]; v4u y[4][4];
#pragma unroll
        for (int j = 0; j < 4; ++j) { a0[j] = *(const f32x4*)(op + 512 * j); a1[j] = *(const f32x4*)(op + 512 * j + 4);
#pragma unroll
            for (int k = 0; k < 4; ++k) y[j][k] = __builtin_nontemporal_load((const GAS v4u*)(ys + (size_t)(4 * t + k) * DM + 8 * lane + 512 * j)); }
#pragma unroll
        for (int j = 0; j < 4; ++j) {
#pragma unroll
            for (int k = 0; k < 4; ++k) { float yv[8]; unpack8(y[j][k], yv);
                a0[j].x += yv[0]; a0[j].y += yv[1]; a0[j].z += yv[2]; a0[j].w += yv[3]; a1[j].x += yv[4]; a1[j].y += yv[5]; a1[j].z += yv[6]; a1[j].w += yv[7]; }
#if PROBE_T
            a0[j] = a0[j] * probe_s; a1[j] = a1[j] * probe_s; if (t == 0 && lane == 0 && j == 0) a0[j].x = probe_a;
#endif
            __builtin_nontemporal_store(a0[j], (GAS f32x4*)(op + 512 * j)); __builtin_nontemporal_store(a1[j], (GAS f32x4*)(op + 512 * j + 4)); }
    }
#endif
}
namespace attn {
constexpr int D = 128, NW = 8, QBLK = 32, KVBLK = 64, QB = NW * QBLK;
constexpr int SHM_V = KVBLK * D * 2, SHM_K = KVBLK * D * 2;
constexpr int ATT_LDS_BYTES = 2 * SHM_V + 2 * SHM_K + NW * 64 * 4;
constexpr int KPITCH = 128, VPITCH = NP, OPITCH = DM;
constexpr float THR2 = 11.5416f;
typedef short s16x4 __attribute__((ext_vector_type(4)));
typedef float f32x16 __attribute__((ext_vector_type(16)));
typedef unsigned u32x4 __attribute__((ext_vector_type(4)));

#define KSWZ(row, colB) ((row) * 256 + ((colB) ^ (((row) & 7) << 4)))
#define SBAR() __builtin_amdgcn_sched_barrier(0)
__device__ __forceinline__ int v_st(int k, int c) { const int kk = (k & ~0xC) | ((k & 4) << 1) | ((k & 8) >> 1); return ((kk >> 3) * 4 + (c >> 5)) * 512 + ((kk & 7) * 32 + (c & 31)) * 2; }
__device__ __forceinline__ int v_rd_base(int lane) { return ((lane & 3) << 3) | (((lane >> 2) & 3) << 6) | (((lane >> 4) & 1) << 5) | (((lane >> 5) & 1) << 8); }
constexpr int v_rd_off(int d0, int ks, int half) { return d0 * 512 + ks * 4096 + half * 2048; }
__device__ __forceinline__ int crow(int r, int hi) { return (r & 3) + 8 * (r >> 2) + 4 * hi; }
__device__ __forceinline__ unsigned cvtpk(float lo, float hi) { unsigned r; asm volatile("v_cvt_pk_bf16_f32 %0, %1, %2" : "=v"(r) : "v"(lo), "v"(hi)); return r; }
__device__ __forceinline__ void mask_tile(f32x16& p0, f32x16& p1, int dq) {
    const float NEG = -__builtin_inff();
#pragma unroll
    for (int r = 0; r < 16; ++r) {
        const int c = (r & 3) + 8 * (r >> 2);
        if (dq - c < 0) p0[r] = NEG;
        if (dq - c - 32 < 0) p1[r] = NEG;
    }
}
__device__ __forceinline__ void partialSM(f32x16& p0, f32x16& p1, float& m_reg, float& mn, float& alpha) {
    float pmax = p0[0]; for (int r = 1; r < 16; ++r) pmax = fmaxf(pmax, p0[r]); for (int r = 0; r < 16; ++r) pmax = fmaxf(pmax, p1[r]);
    { auto rr = __builtin_amdgcn_permlane32_swap(__float_as_uint(pmax), __float_as_uint(pmax), false, false);
      pmax = fmaxf(__uint_as_float(rr[0]), __uint_as_float(rr[1])); }
    if (__builtin_expect(__all((pmax - m_reg) <= THR2), 1)) { mn = m_reg; alpha = 1.f; }
    else { mn = fmaxf(m_reg, pmax); alpha = __builtin_amdgcn_exp2f(m_reg - mn); m_reg = mn; }
    for (int r = 0; r < 16; ++r) p0[r] = p0[r] - mn; for (int r = 0; r < 16; ++r) p1[r] = p1[r] - mn;
    for (int r = 0; r < 16; ++r) p0[r] = __builtin_amdgcn_exp2f(p0[r]);
}
__device__ __forceinline__ void finishSM(f32x16& p0, f32x16& p1, float alpha, float& l_reg, bf16x8& pa0, bf16x8& pa1, bf16x8& pa2, bf16x8& pa3) {
    for (int r = 0; r < 16; ++r) p1[r] = __builtin_amdgcn_exp2f(p1[r]);
    float ps = 0; for (int r = 0; r < 16; ++r) ps += p0[r]; for (int r = 0; r < 16; ++r) ps += p1[r];
    { auto rr = __builtin_amdgcn_permlane32_swap(__float_as_uint(ps), __float_as_uint(ps), false, false);
      ps = __uint_as_float(rr[0]) + __uint_as_float(rr[1]); }
    l_reg = l_reg * alpha + ps;
#define PK4(P, B_, OUT) do { unsigned a0 = cvtpk(P[B_+0], P[B_+1]), a1 = cvtpk(P[B_+2], P[B_+3]);                          \
        unsigned b0 = cvtpk(P[B_+4], P[B_+5]), b1 = cvtpk(P[B_+6], P[B_+7]);                                             \
        auto r0 = __builtin_amdgcn_permlane32_swap(a0, b0, false, false); auto r1 = __builtin_amdgcn_permlane32_swap(a1, b1, false, false); \
        u32x4 w = {r0[0], r1[0], r0[1], r1[1]}; OUT = *reinterpret_cast<bf16x8*>(&w); } while (0)
    PK4(p0, 0, pa0); PK4(p0, 8, pa1); PK4(p1, 0, pa2); PK4(p1, 8, pa3);
#undef PK4
}
__device__ __forceinline__ unsigned split2(float a) { const unsigned h = cvtpk(a, 0.f) & 0xffffu; const float r1 = a - __uint_as_float(h << 16); return h | (cvtpk(r1, 0.f) << 16); }
__device__ __forceinline__ bf16x8 q_aug(unsigned w) { u32x4 v = {w, 0x3f803f80u, 0u, 0u}; return *reinterpret_cast<bf16x8*>(&v); }
__device__ __forceinline__ bf16x8 k_aug(float nk, int hi) { u32x4 v = {0x3f803f80u, split2(nk), 0u, 0u}; if (hi) v = (u32x4){0u, 0u, 0u, 0u}; return *reinterpret_cast<bf16x8*>(&v); }
template <int KB>
__device__ __forceinline__ void qkt(f32x16& p0, f32x16& p1, const char* K_lds, int r32, int hi, const bf16x8* qr, unsigned qa, float ak0, float ak1, float aref) {
    p0 = f32x16{}; p1 = f32x16{};
    const char* kb[4];
#pragma unroll
    for (int dd = 0; dd < 4; ++dd) kb[dd] = K_lds + KB * SHM_K + KSWZ(r32, (dd * 16 + hi * 8) * 2);
#pragma unroll
    for (int d0 = 0; d0 < 8; ++d0) { const char* a = kb[d0 & 3] + (d0 >> 2) * 128;
        bf16x8 b0 = *reinterpret_cast<const bf16x8*>(a);
        bf16x8 b1 = *reinterpret_cast<const bf16x8*>(a + 32 * 256);
        p0 = __builtin_amdgcn_mfma_f32_32x32x16_bf16(b0, qr[d0], p0, 0, 0, 0);
        p1 = __builtin_amdgcn_mfma_f32_32x32x16_bf16(b1, qr[d0], p1, 0, 0, 0); }
    p0 = __builtin_amdgcn_mfma_f32_32x32x16_bf16(k_aug(aref - ak0, hi), q_aug(qa), p0, 0, 0, 0);
    p1 = __builtin_amdgcn_mfma_f32_32x32x16_bf16(k_aug(aref - ak1, hi), q_aug(qa), p1, 0, 0, 0);
}
template <int VB>
__device__ __forceinline__ void pv_tile(f32x16* o, int vb0, bf16x8 pa0, bf16x8 pa1, bf16x8 pa2, bf16x8 pa3) {
#define TRRD(dst, off) asm volatile("ds_read_b64_tr_b16 %0, %1 offset:%2" : "=&v"(dst) : "v"(vb0), "i"(off) : "memory")
#define PV_D0(d0) do { s16x4 l0, l1, l2, l3, h0, h1, h2, h3; constexpr int b_ = VB * SHM_V + v_rd_off(d0, 0, 0);   \
        TRRD(l0, b_); TRRD(h0, b_ + 2048); TRRD(l1, b_ + 4096); TRRD(h1, b_ + 6144); TRRD(l2, b_ + 8192); TRRD(h2, b_ + 10240); TRRD(l3, b_ + 12288); TRRD(h3, b_ + 14336); \
        asm volatile("s_waitcnt lgkmcnt(0)" ::: "memory"); SBAR();                                                                    \
        o[d0] = __builtin_amdgcn_mfma_f32_32x32x16_bf16(pa0, (bf16x8){l0[0], l0[1], l0[2], l0[3], h0[0], h0[1], h0[2], h0[3]}, o[d0], 0, 0, 0);   \
        o[d0] = __builtin_amdgcn_mfma_f32_32x32x16_bf16(pa1, (bf16x8){l1[0], l1[1], l1[2], l1[3], h1[0], h1[1], h1[2], h1[3]}, o[d0], 0, 0, 0);   \
        o[d0] = __builtin_amdgcn_mfma_f32_32x32x16_bf16(pa2, (bf16x8){l2[0], l2[1], l2[2], l2[3], h2[0], h2[1], h2[2], h2[3]}, o[d0], 0, 0, 0);   \
        o[d0] = __builtin_amdgcn_mfma_f32_32x32x16_bf16(pa3, (bf16x8){l3[0], l3[1], l3[2], l3[3], h3[0], h3[1], h3[2], h3[3]}, o[d0], 0, 0, 0); } while (0)
    PV_D0(0); PV_D0(1); PV_D0(2); PV_D0(3);
#undef PV_D0
#undef TRRD
}
struct BlockRef { const bf16* Q; const bf16* K; const bf16* V; bf16* O; const float* A; int P0; };
struct Seam { bf16x8 qr[8]; unsigned qa; bf16x8 st_v0, st_v1, st_k0, st_k1; float ak[2][2]; };
#define VMW() asm volatile("s_waitcnt vmcnt(0)" ::: "memory")
#define VMWN(n) asm volatile("s_waitcnt vmcnt(%0)" :: "i"(n) : "memory")
#define LD8(p) (*reinterpret_cast<const bf16x8*>(p))
#define SLOAD_H(Kp, Vp, Ap, k0, AB) do { S.st_v0 = LD8((Vp) + (size_t)((k0) + sr) * VPITCH + sc); S.st_v1 = LD8((Vp) + (size_t)((k0) + 32 + sr) * VPITCH + sc);   \
                         S.st_k0 = LD8((Kp) + (size_t)((k0) + sr) * KPITCH + sc); S.st_k1 = LD8((Kp) + (size_t)((k0) + 32 + sr) * KPITCH + sc);                      \
                         S.ak[AB][0] = (Ap)[(k0) + r32]; S.ak[AB][1] = (Ap)[(k0) + 32 + r32]; } while (0)
#define SWRITE_HK(bf) do { *(bf16x8*)(K_lds + (bf) * SHM_K + kws) = S.st_k0; *(bf16x8*)(K_lds + (bf) * SHM_K + kws + 32 * 256) = S.st_k1; } while (0)
#define SWRITE_HV(bf) do { *(bf16x8*)(V_lds + (bf) * SHM_V + vst0) = S.st_v0; *(bf16x8*)(V_lds + (bf) * SHM_V + vst1) = S.st_v1; } while (0)
#define SWRITE_H(bf) do { SWRITE_HV(bf); SWRITE_HK(bf); } while (0)
#define QLOAD(R) do { _Pragma("unroll") for (int d0 = 0; d0 < 8; ++d0) S.qr[d0] = LD8((R).Q + (size_t)(wid * QBLK + r32) * KPITCH + d0 * 16 + hi * 8);   \
                      S.qa = split2((R).A[(R).P0 + wid * QBLK + r32] - (R).A[(R).P0]); } while (0)
__device__ __forceinline__ void block_prime(const BlockRef& cur, char* lds, Seam& S) {
    int tid = threadIdx.x; asm volatile("" : "+v"(tid));
    const int wid = __builtin_amdgcn_readfirstlane(tid >> 6), lane = tid & 63, r32 = lane & 31, hi = lane >> 5;
    const int sr = tid >> 4, sc = (tid & 15) * 8, kws = KSWZ(sr, sc * 2); char* K_lds = lds + 2 * SHM_V;
    QLOAD(cur);
    SLOAD_H(cur.K, cur.V, cur.A, 0, 0); VMW(); SWRITE_HK(0);
    __syncthreads();
}
__device__ __forceinline__ void block_run(const BlockRef& cur, char* lds, Seam& S) {
    int tid = threadIdx.x; asm volatile("" : "+v"(tid));
    const int wid = __builtin_amdgcn_readfirstlane(tid >> 6), lane = tid & 63, r32 = lane & 31, hi = lane >> 5;
    const int NT = (cur.P0 + QB - 1) / KVBLK + 1;
    const int qlo = cur.P0 + wid * QBLK, qm = qlo + r32 - 4 * hi;
    char* V_lds = lds; char* K_lds = lds + 2 * SHM_V;
    float* ws = (float*)(lds + 2 * SHM_V + 2 * SHM_K) + wid * 64; float* li_l = ws, * al_l = ws + 32;
    float m_reg = -1e30f, l_reg = 0; f32x16 o[4] = {};
    const int sr = tid >> 4, sc = (tid & 15) * 8, vst0 = v_st(sr, sc), vst1 = v_st(32 + sr, sc), kws = KSWZ(sr, sc * 2);
    const int vb0 = (int)(uintptr_t)V_lds + v_rd_base(lane);
    const bf16* Kh = cur.K; const bf16* Vh = cur.V; const float* Ah = cur.A; const float aref = cur.A[cur.P0];
#define RESC(a) do { if (__any((a) < 1.f)) { if (hi == 0) al_l[r32] = (a); asm volatile("s_waitcnt lgkmcnt(0)" ::: "memory");              \
                     for (int d_ = 0; d_ < 4; ++d_) for (int r = 0; r < 16; ++r) o[d_][r] *= al_l[crow(r, hi)]; } } while (0)
#define KBASE(t) ((t) * KVBLK)
#define MASKT(P0_, P1_, t) do { const int kb_ = KBASE(t); if (kb_ + KVBLK - 1 > qlo) mask_tile(P0_, P1_, qm - kb_); } while (0)
    f32x16 pA0, pA1, pB0, pB1; float mnA, mnB, alA, alB; bf16x8 pa0, pa1, pa2, pa3;
    SWRITE_HV(0); SBAR();
    const float a00 = S.ak[0][0], a01 = S.ak[0][1];
    if (NT > 1) SLOAD_H(Kh, Vh, Ah, KBASE(1), 1);
    SBAR(); qkt<0>(pA0, pA1, K_lds, r32, hi, S.qr, S.qa, a00, a01, aref);
    MASKT(pA0, pA1, 0); partialSM(pA0, pA1, m_reg, mnA, alA);
    if (NT > 1) { VMW(); SWRITE_H(1); }
    __syncthreads();
#define HALF_STEP(PX0, PX1, mnX, alX, PY0, PY1, alY, t, KB, VB, SB) do {                                                      \
        SBAR(); qkt<KB>(PX0, PX1, K_lds, r32, hi, S.qr, S.qa, S.ak[KB][0], S.ak[KB][1], aref);                                             \
        finishSM(PY0, PY1, alY, l_reg, pa0, pa1, pa2, pa3); SBAR();                                                           \
        if ((t) + 1 < NT) { SLOAD_H(Kh, Vh, Ah, KBASE((t) + 1), SB); SBAR(); }                                                \
        pv_tile<VB>(o, vb0, pa0, pa1, pa2, pa3); MASKT(PX0, PX1, (t)); partialSM(PX0, PX1, m_reg, mnX, alX);                  \
        __syncthreads();                                                                                                      \
        if ((t) + 1 < NT) { VMW(); SWRITE_H(SB); }                                                                            \
        RESC(alX); __syncthreads(); } while (0)
    for (int t = 1; t + 1 < NT; t += 2) {
        HALF_STEP(pB0, pB1, mnB, alB, pA0, pA1, alA, t, 1, 0, 0);
        HALF_STEP(pA0, pA1, mnA, alA, pB0, pB1, alB, t + 1, 0, 1, 1);
    }
    const bool even = (NT & 1) == 0;
    if (even) { SBAR(); qkt<1>(pB0, pB1, K_lds, r32, hi, S.qr, S.qa, S.ak[1][0], S.ak[1][1], aref); SBAR(); }
    finishSM(pA0, pA1, alA, l_reg, pa0, pa1, pa2, pa3); SBAR();
    pv_tile<0>(o, vb0, pa0, pa1, pa2, pa3);
    if (even) { MASKT(pB0, pB1, NT - 1); partialSM(pB0, pB1, m_reg, mnB, alB); __syncthreads(); RESC(alB);
        finishSM(pB0, pB1, alB, l_reg, pa0, pa1, pa2, pa3); SBAR(); pv_tile<1>(o, vb0, pa0, pa1, pa2, pa3); }
    if (hi == 0) li_l[r32] = l_reg; asm volatile("s_waitcnt lgkmcnt(0)" ::: "memory");
    float rli[16];
#pragma unroll
    for (int r = 0; r < 16; ++r) rli[r] = __builtin_amdgcn_rcpf(li_l[crow(r, hi)]);
    bf16* Ow = cur.O + (size_t)(wid * QBLK) * OPITCH;
#pragma unroll
    for (int r = 0; r < 16; ++r) { const int orow = crow(r, hi);
#pragma unroll
        for (int d0 = 0; d0 < 4; ++d0) { const float v = o[d0][r] * rli[r];
            const float vn = __shfl_xor(v, 1);
            if ((r32 & 1) == 0) *(unsigned*)(Ow + (size_t)orow * OPITCH + d0 * 32 + r32) = cvtpk(v, vn); } }
    __syncthreads();
#undef RESC
#undef KBASE
#undef MASKT
#undef HALF_STEP
}
#undef VMW
#undef VMWN
#undef LD8
#undef SLOAD_H
#undef SWRITE_HK
#undef SWRITE_HV
#undef SWRITE_H
#undef QLOAD
#undef KSWZ
#undef SBAR
}

__device__ __forceinline__ attn::BlockRef attn_ref(Frame& F, int a) {
    const int x = a >> 5, j = a & 31, bh = 4 * x + (j & 3), qb = j >> 2, b = bh >> 3, h = bh & 7;
    attn::BlockRef r;
    r.Q = WSP(bf16, WS_QN) + ((size_t)bh * SEQ + qb * 256) * AHD; r.K = WSP(bf16, WS_KN) + (size_t)bh * SEQ * AHD;
    r.V = WSP(bf16, WS_PROJ) + (size_t)(b * SEQ) * NP + O_V + h * AHD; r.O = WSP(bf16, WS_MIX) + (size_t)(b * SEQ + qb * 256) * DM + h * AHD;
    r.A = WSP(float, WS_ACUM) + (size_t)bh * SEQ; r.P0 = qb * 256; return r;
}
__device__ __forceinline__ void p3_attn(Frame& F) {
    char* lds = (char*)(F.lds + RING_OFF);
    if (F.G == 256) {
        const int j = F.vcu & 31;
        if (j < SSD_WPX) return;
        { const attn::BlockRef cur = attn_ref(F, F.vcu); attn::Seam S; attn::block_prime(cur, lds, S); attn::block_run(cur, lds, S); }
        if (j >= 8 && j < 8 + SSD_WPX) { const attn::BlockRef cur = attn_ref(F, F.vcu - 8); attn::Seam S; attn::block_prime(cur, lds, S); attn::block_run(cur, lds, S); }
        return;
    }
    for (int a = F.vcu; a < BATCH * AH * (SEQ / 256); a += F.G) {
        const attn::BlockRef cur = attn_ref(F, a);
        attn::Seam S;
        attn::block_prime(cur, lds, S);
        attn::block_run(cur, lds, S);
    }
}
namespace ssd {
__device__ __forceinline__ float dpp_scan64(float x) {
    float v = x;
#define SSD_DPP_ADD(ctrl, rowmask) do { const int t_ = __builtin_amdgcn_update_dpp(0, __builtin_bit_cast(int, v), (ctrl), (rowmask), 0xf, true); v += __builtin_bit_cast(float, t_); } while (0)
    SSD_DPP_ADD(0x111, 0xf); SSD_DPP_ADD(0x112, 0xf); SSD_DPP_ADD(0x114, 0xf); SSD_DPP_ADD(0x118, 0xf);
    SSD_DPP_ADD(0x142, 0xa); SSD_DPP_ADD(0x143, 0xc);
#undef SSD_DPP_ADD
    return v;
}
constexpr int CP = 136, TP = 72, YP = 68;
constexpr int L_CM = 0, L_BM = L_CM + 64 * CP * 2, L_BT = L_BM + 64 * CP * 2, L_XT = L_BT + 128 * TP * 2, L_XD = L_XT + 64 * TP * 2, L_H = L_XD + 64 * TP * 2,
              L_Y = L_H + 64 * CP * 2, L_XS = L_Y + 64 * YP * 4, L_ACS = L_XS + 64 * TP * 2, L_DT = L_ACS + 512  , L_DEC = L_DT + 512, L_SS = L_DEC + 512, L_Z = L_SS + 256, L_END = L_Z + 64 * TP * 2;
static_assert(L_END <= RING_BYTES, "ssd lds");
typedef LAS unsigned char* lptr;
__device__ __forceinline__ bf16x8 ld16(lptr p) { return *(const LAS bf16x8*)p; }
__device__ __forceinline__ void unit(Frame& F, int un, float* ssq_all) {
    const int b = un >> 4, h = un & 15, g = h >> 3;
    const int tid = TTID();
    const int lane = tid & 63, w = F.wave, r16 = lane & 15, q4 = lane >> 4, Lt = w >> 1;
    const int nrow = tid >> 3, np8 = (tid & 7) * 8;
    const int crow = tid >> 4, cc8 = (tid & 15) * 8;
    lptr L = F.lds + RING_OFF;
    const bf16* xc = WSP(bf16, WS_XCONV) + (size_t)(b * SEQ) * CONVCH;
    const bf16* pz = WSP(bf16, WS_PROJ) + (size_t)(b * SEQ) * NP + O_Z + h * SHD;
    const float* dtp = WSP(float, WS_DTV) + (size_t)(b * SEQ) * 16 + h; const float* dap = WSP(float, WS_DAV) + (size_t)(b * SEQ) * 16 + h;
    bf16* mixp = WSP(bf16, WS_MIX) + (size_t)(b * SEQ) * DM + AW + h * SHD;
    float* ssq = ssq_all + b * SEQ;
    const float dsk = F.d_skip[h];
    f32x4 Hacc[4];
#pragma unroll
    for (int i = 0; i < 4; ++i) Hacc[i] = (f32x4){0.f, 0.f, 0.f, 0.f};
    v4u cmA[2], bmA[2], xsA, zA, cmB[2], bmB[2], xsB, zB; float dtw = 0.f, daw = 0.f;
#define SSD_LOAD(c, CM, BM, XS, ZR) do { const size_t t0_ = (size_t)(c) * 64; \
        _Pragma("unroll") for (int i_ = 0; i_ < 2; ++i_) { CM[i_] = *(const v4u*)(xc + (t0_ + crow + 32 * i_) * CONVCH + SW + SG * SN + g * SN + cc8); BM[i_] = *(const v4u*)(xc + (t0_ + crow + 32 * i_) * CONVCH + SW + g * SN + cc8); } \
        XS = *(const v4u*)(xc + (t0_ + nrow) * CONVCH + h * SHD + np8); ZR = *(const v4u*)(pz + (t0_ + nrow) * NP + np8); } while (0)
#define SSD_SCAN(c) do { if (w == 0) { const float acs_ = dpp_scan64(daw);     \
        const float al_ = __builtin_bit_cast(float, __builtin_amdgcn_readlane(__builtin_bit_cast(int, acs_), 63)); \
        *(LAS float*)(L + L_ACS + (((c) & 1) * 64 + lane) * 4) = acs_; *(LAS float*)(L + L_DT + lane * 4) = dtw; *(LAS float*)(L + L_DEC + lane * 4) = __expf(al_ - acs_); \
        if ((c) + 1 < SEQ / 64) { dtw = dtp[(size_t)(((c) + 1) * 64 + lane) * 16]; daw = dap[(size_t)(((c) + 1) * 64 + lane) * 16]; } } } while (0)
    if (w == 0) { dtw = dtp[(size_t)lane * 16]; daw = dap[(size_t)lane * 16]; }
    SSD_LOAD(0, cmA, bmA, xsA, zA);
    SSD_LOAD(1, cmB, bmB, xsB, zB);
    SSD_SCAN(0);
    auto nat_store = [&](const v4u (&cm)[2], const v4u (&bm)[2], const v4u& xs, const v4u& zs) __attribute__((always_inline)) {
#pragma unroll
        for (int i = 0; i < 2; ++i) { *(LAS v4u*)(L + L_CM + ((crow + 32 * i) * CP + cc8) * 2) = cm[i]; *(LAS v4u*)(L + L_BM + ((crow + 32 * i) * CP + cc8) * 2) = bm[i]; }
        *(LAS v4u*)(L + L_XS + (nrow * TP + np8) * 2) = xs; *(LAS v4u*)(L + L_Z + (nrow * TP + np8) * 2) = zs; };
    nat_store(cmA, bmA, xsA, zA);
    SSD_LOAD(2, cmA, bmA, xsA, zA);
    auto chunk = [&](const int c, v4u (&cmX)[2], v4u (&bmX)[2], v4u& xsX, v4u& zsX) __attribute__((always_inline)) {
        lptr ACS = L + L_ACS + (c & 1) * 256;
        __syncthreads();
        if (c > 0 && w == 0) atomicAdd(ssq + (c - 1) * 64 + lane, *(const LAS float*)(L + L_SS + lane * 4));
        { const float dtl = *(const LAS float*)(L + L_DT + lane * 4), decl = *(const LAS float*)(L + L_DEC + lane * 4);
#pragma unroll
          for (int i = 0; i < 2; ++i) { const int c8 = 8 * (w + 8 * i); const v4u bm = *(const LAS v4u*)(L + L_BM + (lane * CP + c8) * 2);
              const unsigned ww[4] = {bm.x, bm.y, bm.z, bm.w};
#pragma unroll
              for (int j = 0; j < 4; ++j) { *(LAS bf16*)(L + L_BT + ((c8 + 2 * j) * TP + lane) * 2) = (bf16)(ww[j] & 0xffffu); *(LAS bf16*)(L + L_BT + ((c8 + 2 * j + 1) * TP + lane) * 2) = (bf16)(ww[j] >> 16); } }
          float xv[8]; unpack8(*(const LAS v4u*)(L + L_XS + (lane * TP + 8 * w) * 2), xv);
#pragma unroll
          for (int j = 0; j < 8; j += 2) { const float X0 = xv[j] * dtl, X1 = xv[j + 1] * dtl; const unsigned a = pk2(X0, X1), d = pk2(X0 * decl, X1 * decl);
              *(LAS bf16*)(L + L_XT + ((8 * w + j) * TP + lane) * 2) = (bf16)(a & 0xffffu); *(LAS bf16*)(L + L_XT + ((8 * w + j + 1) * TP + lane) * 2) = (bf16)(a >> 16);
              *(LAS bf16*)(L + L_XD + ((8 * w + j) * TP + lane) * 2) = (bf16)(d & 0xffffu); *(LAS bf16*)(L + L_XD + ((8 * w + j + 1) * TP + lane) * 2) = (bf16)(d >> 16); } }
        __syncthreads();
        bf16x8 cf[4];
#pragma unroll
        for (int ks = 0; ks < 4; ++ks) cf[ks] = ld16(L + L_CM + ((16 * Lt + r16) * CP + 32 * ks + 8 * q4) * 2);
        const float acs_l = *(const LAS float*)(ACS + (16 * Lt + r16) * 4);
        float Wv[4][4];
#pragma unroll
        for (int T = 0; T < 4; ++T) {
            f32x4 st = (f32x4){0.f, 0.f, 0.f, 0.f};
            if (T <= Lt) {
#pragma unroll
                for (int ks = 0; ks < 4; ++ks) st = __builtin_amdgcn_mfma_f32_16x16x32_bf16(ld16(L + L_BM + ((16 * T + r16) * CP + 32 * ks + 8 * q4) * 2), cf[ks], st, 0, 0, 0);
            }
            const f32x4 as4 = *(const LAS f32x4*)(ACS + (16 * T + 4 * q4) * 4);
#pragma unroll
            for (int r = 0; r < 4; ++r) { const int s = 16 * T + 4 * q4 + r, l = 16 * Lt + r16; Wv[T][r] = (T <= Lt && s <= l) ? st[r] * __expf(acs_l - as4[r]) : 0.f; }
        }
        bf16x8 Wf[2];
#pragma unroll
        for (int kp = 0; kp < 2; ++kp) { v4u t; t.x = pk2(Wv[2 * kp][0], Wv[2 * kp][1]); t.y = pk2(Wv[2 * kp][2], Wv[2 * kp][3]); t.z = pk2(Wv[2 * kp + 1][0], Wv[2 * kp + 1][1]); t.w = pk2(Wv[2 * kp + 1][2], Wv[2 * kp + 1][3]);
            Wf[kp] = __builtin_bit_cast(bf16x8, t); }
        const f32x4 al4 = *(const LAS f32x4*)(ACS + (16 * Lt + 4 * q4) * 4);
        const float alast = *(const LAS float*)(ACS + 63 * 4);
#pragma unroll
        for (int pp = 0; pp < 2; ++pp) { const int Pt = 2 * (w & 1) + pp;
            f32x4 yd = (f32x4){0.f, 0.f, 0.f, 0.f}, yo = (f32x4){0.f, 0.f, 0.f, 0.f};
#pragma unroll
            for (int kp = 0; kp < 2; ++kp) if (2 * kp <= Lt) {
                const v2u x0 = *(const LAS v2u*)(L + L_XT + ((16 * Pt + r16) * TP + 32 * kp + 4 * q4) * 2), x1 = *(const LAS v2u*)(L + L_XT + ((16 * Pt + r16) * TP + 32 * kp + 16 + 4 * q4) * 2);
                const v4u xb = {x0.x, x0.y, x1.x, x1.y};
                yd = __builtin_amdgcn_mfma_f32_16x16x32_bf16(Wf[kp], __builtin_bit_cast(bf16x8, xb), yd, 0, 0, 0); }
            if (c > 0) {
#pragma unroll
                for (int ks = 0; ks < 4; ++ks) yo = __builtin_amdgcn_mfma_f32_16x16x32_bf16(cf[ks], ld16(L + L_H + ((16 * Pt + r16) * CP + 32 * ks + 8 * q4) * 2), yo, 0, 0, 0); }
#pragma unroll
            for (int r = 0; r < 4; ++r) *(LAS float*)(L + L_Y + ((16 * Lt + 4 * q4 + r) * YP + 16 * Pt + r16) * 4) = yd[r] + __expf(al4[r]) * yo[r];
        }
        { const float dl = __expf(alast);
#pragma unroll
          for (int pt = 0; pt < 4; ++pt) Hacc[pt] = Hacc[pt] * dl;
#pragma unroll
          for (int ks = 0; ks < 2; ++ks) { const bf16x8 af = ld16(L + L_BT + ((16 * w + r16) * TP + 32 * ks + 8 * q4) * 2);
#pragma unroll
              for (int pt = 0; pt < 4; ++pt) Hacc[pt] = __builtin_amdgcn_mfma_f32_16x16x32_bf16(af, ld16(L + L_XD + ((16 * pt + r16) * TP + 32 * ks + 8 * q4) * 2), Hacc[pt], 0, 0, 0); } }
        __syncthreads();
#pragma unroll
        for (int pt = 0; pt < 4; ++pt) { v2u t; t.x = pk2(Hacc[pt][0], Hacc[pt][1]); t.y = pk2(Hacc[pt][2], Hacc[pt][3]); *(LAS v2u*)(L + L_H + ((16 * pt + r16) * CP + 16 * w + 4 * q4) * 2) = t; }
        SSD_SCAN(c + 1);
        { const f32x4 y0 = *(const LAS f32x4*)(L + L_Y + (nrow * YP + np8) * 4), y1 = *(const LAS f32x4*)(L + L_Y + (nrow * YP + np8 + 4) * 4);
          const v4u xs_ = *(const LAS v4u*)(L + L_XS + (nrow * TP + np8) * 2), zs_ = *(const LAS v4u*)(L + L_Z + (nrow * TP + np8) * 2);
          if (c + 1 < SEQ / 64) nat_store(cmX, bmX, xsX, zsX);
          if (c + 3 < SEQ / 64) SSD_LOAD(c + 3, cmX, bmX, xsX, zsX);
          float xv[8], zv[8], o[8]; unpack8(xs_, xv); unpack8(zs_, zv); const float yv[8] = {y0.x, y0.y, y0.z, y0.w, y1.x, y1.y, y1.z, y1.w}; float ss = 0.f;
#pragma unroll
          for (int j = 0; j < 8; ++j) { o[j] = (yv[j] + xv[j] * dsk) * siluf_(zv[j]); ss += o[j] * o[j]; }
          *(v4u*)(mixp + (size_t)(c * 64 + nrow) * DM + np8) = pack8f(o);
          ss += __shfl_xor(ss, 1); ss += __shfl_xor(ss, 2); ss += __shfl_xor(ss, 4);
          if ((tid & 7) == 0) *(LAS float*)(L + L_SS + nrow * 4) = ss; }
    };
    for (int c = 0; c < SEQ / 64; c += 2) { chunk(c, cmB, bmB, xsB, zB); chunk(c + 1, cmA, bmA, xsA, zA); }
    __syncthreads();
    if (w == 0) atomicAdd(ssq + (SEQ / 64 - 1) * 64 + lane, *(const LAS float*)(L + L_SS + lane * 4));
    __syncthreads();
#undef SSD_LOAD
#undef SSD_SCAN
}
}
__device__ __forceinline__ void p3_ssd(Frame& F, float* ssq_all) {
    if (F.G == 256) {
        const int j = F.vcu & 31, x = F.vcu >> 5;
        if (j < SSD_WPX) for (int u = j; u < 8; u += SSD_WPX) ssd::unit(F, x * 8 + u, ssq_all);
        return;
    }
    for (int a = F.vcu; a < 256; a += F.G) { const int j = a & 31; if (j < 8) ssd::unit(F, (a >> 5) * 8 + j, ssq_all); }
}
constexpr int NPH = 10;
struct Args { const float* in[22]; float* out; unsigned char* ws; int ph_lo, ph_hi; };
__global__ void __launch_bounds__(NTHR, 2) mk_fwd(Args args) {
    extern __shared__ __attribute__((aligned(16))) unsigned char lds[];
    Frame F;
    F.lds = (LAS unsigned char*)lds;
    F.MISC = (volatile LAS unsigned*)(F.lds + MISC_OFF);
    F.wave = __builtin_amdgcn_readfirstlane(threadIdx.x >> 6);
    F.G = gridDim.x; { const int bx = blockIdx.x; F.vcu = (F.G % 8 == 0) ? (bx % 8) * (F.G / 8) + bx / 8 : bx; }
    F.ws = args.ws; F.ctl = (gu32*)(args.ws + WS_CTL); F.out = args.out;
    F.x = args.in[0]; F.g1 = args.in[1]; F.w_in = args.in[2]; F.fbias = args.in[3]; F.gq = args.in[4]; F.gk = args.in[5]; F.conv_w = args.in[6]; F.conv_b = args.in[7];
    F.dt_bias = args.in[8]; F.a_log = args.in[9]; F.d_skip = args.in[10]; F.ssd_g = args.in[11]; F.w_out = args.in[12]; F.g2 = args.in[13]; F.w_router = args.in[14]; F.b_router = args.in[15];
    F.w_gate = args.in[16]; F.b_gate = args.in[17]; F.w_up = args.in[18]; F.b_up = args.in[19]; F.w_down = args.in[20]; F.b_down = args.in[21];
    for (int u = threadIdx.x; u < (LDS_BYTES - LDSCTL_OFF) / 4; u += NTHR) ((LAS unsigned*)(F.lds + LDSCTL_OFF))[u] = 0u;
    __syncthreads();
    const int lo = args.ph_lo, hi = args.ph_hi;
    XcdBarrier bar; bar.bar = (unsigned*)(F.ctl + CW_BAR); bar.x = 0; bar.st = nullptr;
    if (hi - lo > 1) bar = xcd_barrier_post((unsigned*)(F.ctl + CW_BAR), F.MISC);
#define IN(k) (lo <= (k) && (k) < hi)
#ifndef PROBE_REPEAT
#define PROBE_REPEAT 0
#endif
#define REP(k) for (int rep_ = 0; rep_ < (((PROBE_REPEAT >> (k)) & 1) ? 2 : 1); ++rep_)
#if PROBE_T
#define STAMP(i) do { if (blockIdx.x == 0 && threadIdx.x == 0) { const unsigned long long t_ = __builtin_amdgcn_s_memrealtime(); __hip_atomic_store(F.ctl + CW_PROBE + 16 + 2 * (i), (unsigned)t_, RLX_AGENT); __hip_atomic_store(F.ctl + CW_PROBE + 17 + 2 * (i), (unsigned)(t_ >> 32), RLX_AGENT); } } while (0)
#else
#define STAMP(i) do { } while (0)
#endif
#define SEAM(k) do { if (IN(k) && IN((k) + 1)) xcd_barrier(bar); STAMP((k) + 1); } while (0)

    const bool roles = BG_POOL && F.G == 256;
    const int xc = F.vcu >> 5, jr = F.vcu & 31;
    constexpr int NC1 = NC1_CFG, NC5 = NC5_CFG, NC7 = NC7_CFG;
    const bool conv1 = roles && jr >= 32 - NC1, conv5 = roles && jr >= 32 - NC5, conv7 = roles && jr >= 32 - NC7;
    const int G5 = roles ? 8 * (32 - NC5) : F.G, c5s = roles ? jr * 8 + xc : (int)blockIdx.x;
    const int G1 = roles ? 8 * (32 - NC1) : F.G, c1s = roles ? jr * 8 + xc : (int)blockIdx.x;
    const int G7 = roles ? 8 * (32 - NC7) : F.G, c7m = roles ? xc * (32 - NC7) + jr : F.vcu;
    bool pool_open = BG_POOL && !CONV_IN_P0 && PEEK_CFG;
#define BG_PEEK() do { if (PEEK_CFG && pool_open) pool_open = bg_peek_open(F); } while (0)
#define BG_FILL(k, lim) do { if (BG_POOL && !CONV_IN_P0 && IN((k) + 1) && ((k) == 1 || !PEEK_CFG || pool_open)) bg_fill(F, (k), (lim)); } while (0)

    STAMP(0);
    if (IN(0)) REP(0) { p0_prologue(F); if (CONV_IN_P0) (void)bg_finish(F, POOL_ALL); SEAM(0); }

    if (IN(1)) REP(1) {
        if (!conv1) {
        typedef OrderStaticT<(NSPLIT_CFG != 0)> Ord1;
        Ord1 S; S.init(NTOK, NP, G1, c1s, WSP(bf16, WS_XN), WSP(bf16, WS_WIN));
        EpiProj E{WSP(bf16, WS_PROJ), NP};
        pg8::gemm_phase<EpiProj, Ord1, false, (ALIGN_EPI_CFG & 1) != 0>(F.lds + RING_OFF, S, E);
        }
        BG_FILL(1, POOL_ALL);
        SEAM(1);
    }
    if (IN(2)) REP(2) { BG_PEEK(); p2_post(F); if (FIN2_CFG && BG_POOL) (void)bg_finish(F, POOL_ALL); SEAM(2); }
    if (IN(3)) {
#if NAIVE_ATTN
        p3_attn_naive(F);
#else
        p3_attn(F);
#endif
        __syncthreads();
#if NAIVE_SSD
        p3_ssd_naive(F);
#elif !SPLIT_P3
        p3_ssd(F, (float*)(F.ctl + CW_SSQ));
#endif
#if PROBE_P3
        __syncthreads(); p3_attn(F); __syncthreads(); p3_ssd(F, WSP(float, WS_YSLOT));
#endif
        BG_FILL(3, POOL_ALL);
        SEAM(3);
    }
#if SPLIT_P3
    if (IN(4)) { p3_ssd(F, (float*)(F.ctl + CW_SSQ)); SEAM(4); }
#endif
    if (!FUSE_P4 && IN(4)) { p4_ssdnorm(F); SEAM(4); }
    if (IN(5)) BG_PEEK();
    if (IN(5)) REP(5) {
        if (!conv5) {
        OrderStatic S; S.init(NTOK, DM, G5, c5s, WSP(bf16, WS_MIX), WSP(bf16, WS_WOUT));
        EpiRes E{F.x, H_BF16 ? WSP(float, WS_H) : F.out, F.ctl + CW_SSQ};
        pg8::gemm_phase<EpiRes, OrderStatic, false, false>(F.lds + RING_OFF, S, E);
        }
        BG_FILL(5, POOL_ALL);
        SEAM(5);
    }
    if (IN(6)) { BG_PEEK(); p6_router(F); if (BG_POOL && (!PEEK_CFG || pool_open)) (void)bg_finish(F, POOL_GU); SEAM(6); }
    constexpr int MOE_RB = FP8_MOE ? 2048 : 4096;
    if (IN(7)) BG_PEEK();
    if (IN(7)) REP(7) {
        if (!conv7) {
        moe_tables(F);
        const LAS int* TB = (const LAS int*)(F.lds + TB_OFF);
        typedef OrderMoe<16, true, MOE_RB> Ord;
        Ord S; S.init(G7, c7m, TB, TB + 64, TLANE(), WSP(char, WS_XN), WSP(char, WS_WGU), (size_t)4096 * MOE_RB, WSP(int, WS_STOK), F.ctl + CW_MOEQ, (volatile LAS int*)(F.lds + BGW_OFF) + 4, DYN_MOE && G7 == 256);
        S.xprobe = (const char*)F.w_down;
        EpiGlu E{WSP(void, WS_ACT), F.b_gate, F.b_up};
        pg8::gemm_phase<EpiGlu, Ord, true, (ALIGN_EPI_CFG & 2) != 0, FP8_MOE != 0>(F.lds + RING_OFF, S, E);
        }
        BG_FILL(7, POOL_ALL);
        if (BG_POOL && (!PEEK_CFG || pool_open)) (void)bg_finish(F, POOL_ALL);
        SEAM(7);
    }
    if (IN(8)) REP(8) {
        moe_tables(F);
        const LAS int* TB = (const LAS int*)(F.lds + TB_OFF);
        typedef OrderMoe<8, false, MOE_RB> Ord;
        Ord S; S.init(F.G, F.vcu, TB, TB + 64, TLANE(), WSP(char, WS_ACT), WSP(char, WS_WD), (size_t)2048 * MOE_RB, WSP(int, WS_STOK), F.ctl + CW_MOEQ + 64 * 8, (volatile LAS int*)(F.lds + BGW_OFF) + 4, DYN_MOE && F.G == 256);
        S.xprobe = nullptr;
        EpiDown E{WSP(bf16, WS_YSLOT), F.b_down, WSP(float, WS_SGATE), WSP(int, WS_SDEST)};
        pg8::gemm_phase<EpiDown, Ord, false, (ALIGN_EPI_CFG & 4) != 0, FP8_MOE != 0>(F.lds + RING_OFF, S, E);
        SEAM(8);
    }
#if PROBE_T
    if (blockIdx.x == 0 && threadIdx.x == 0) {
        const unsigned a0_ = __hip_atomic_load(F.ctl + CW_PROBE + 16 + 2 * PROBE_KA, RLX_AGENT), a1_ = __hip_atomic_load(F.ctl + CW_PROBE + 16 + 2 * (PROBE_KA + 1), RLX_AGENT);
        const unsigned b0_ = __hip_atomic_load(F.ctl + CW_PROBE + 16 + 2 * PROBE_KB, RLX_AGENT), b1_ = __hip_atomic_load(F.ctl + CW_PROBE + 16 + 2 * (PROBE_KB + 1), RLX_AGENT);
        const float ua = (float)(a1_ - a0_) * 0.01f, ub = (float)(b1_ - b0_) * 0.01f;
        __hip_atomic_store(F.ctl + CW_PROBE, __builtin_bit_cast(unsigned, ua * PROBE_GA), RLX_AGENT); __hip_atomic_store(F.ctl + CW_PROBE + 1, __builtin_bit_cast(unsigned, 100.f + ub), RLX_AGENT); }
    xcd_barrier(bar);
#endif
    if (IN(9)) { p9_combine(F); }
#undef IN
#undef SEAM
}

extern "C" void kernel_launch(void* const* d_in, const int* in_sizes, int n_in, void* d_out, int out_size, void* d_ws, size_t ws_size, hipStream_t stream) {
    static int grid = 0;
    if (grid == 0) {
        if (n_in != 22 || in_sizes[0] != NTOK * DM || out_size != NTOK * DM || ws_size < WS_END) { fprintf(stderr, "kernel_launch: unexpected shapes (n_in %d, in0 %d, out %d, ws %zu)\n", n_in, n_in > 0 ? in_sizes[0] : -1, out_size, ws_size); grid = -1; return; }
        int dev = 0, cus = 0, per_cu = 0;
        if (hipGetDevice(&dev) != hipSuccess || hipDeviceGetAttribute(&cus, hipDeviceAttributeMultiprocessorCount, dev) != hipSuccess) { grid = -1; return; }
        if (hipFuncSetAttribute((const void*)mk_fwd, hipFuncAttributeMaxDynamicSharedMemorySize, LDS_BYTES) != hipSuccess) { fprintf(stderr, "kernel_launch: hipFuncSetAttribute failed\n"); grid = -1; return; }
        if (hipOccupancyMaxActiveBlocksPerMultiprocessor(&per_cu, (const void*)mk_fwd, NTHR, LDS_BYTES) != hipSuccess || per_cu < 1) { fprintf(stderr, "kernel_launch: occupancy query says %d blocks per CU\n", per_cu); }
        (void)hipGetLastError();
        grid = cus;
    }
    if (grid < 0) return;
    (void)hipMemsetAsync((char*)d_ws + WS_CTL, 0, CTL_ZERO_BYTES, stream);
    Args a{};
    for (int i = 0; i < 22; ++i) a.in[i] = (const float*)d_in[i];
    a.out = (float*)d_out; a.ws = (unsigned char*)d_ws;
#if MK_N_LAUNCHES == 1
    a.ph_lo = 0; a.ph_hi = NPH;
    hipLaunchKernelGGL(mk_fwd, dim3(grid), dim3(NTHR), LDS_BYTES, stream, a);
#else
    for (int p = 0; p < NPH; ++p) { a.ph_lo = p; a.ph_hi = p + 1; hipLaunchKernelGGL(mk_fwd, dim3(grid), dim3(NTHR), LDS_BYTES, stream, a); }
#endif
}
```

```cpp
#include <hip/hip_runtime.h>
#define MK_N_LAUNCHES 1
#define NAIVE_ATTN 0
#define NAIVE_SSD 0
#define FP8_MOE 1
#define NC1_CFG 18
#define NC5_CFG 0
#define NC7_CFG 0
#define SSD_WPX 8
#define YSLOT_FP8 1
#include <cstdio>
#include <cstdint>

#ifndef MK_N_LAUNCHES
#define MK_N_LAUNCHES 1
#endif
#ifndef NAIVE_ATTN
#define NAIVE_ATTN 1
#endif
#ifndef NAIVE_SSD
#define NAIVE_SSD 1
#endif

#define GAS __attribute__((address_space(1)))
#define LAS __attribute__((address_space(3)))
typedef unsigned short bf16;
typedef unsigned v4u __attribute__((ext_vector_type(4)));
typedef unsigned v2u __attribute__((ext_vector_type(2)));
typedef float f32x4 __attribute__((ext_vector_type(4)));
typedef float f32x2 __attribute__((ext_vector_type(2)));
typedef short bf16x8 __attribute__((ext_vector_type(8)));
typedef GAS unsigned gu32;
#define RLX_AGENT __ATOMIC_RELAXED, __HIP_MEMORY_SCOPE_AGENT
#define LDS_WAIT() asm volatile("s_waitcnt lgkmcnt(0)" ::: "memory")
#define VM_WAIT() asm volatile("s_waitcnt vmcnt(0)" ::: "memory")

constexpr int BATCH = 4, SEQ = 2048, DM = 2048, NTOK = BATCH * SEQ;
constexpr int AH = 8, AHD = 128, AW = AH * AHD;
constexpr int SW = 1024, SHD = 64, SH = 16, SG = 2, SN = 128, CONVCH = SW + 2 * SG * SN;
constexpr int NE = 32, TOPK = 4, DFF = 2048;
constexpr int INCOLS = 5656, NP = 5888;
constexpr int O_Q = 0, O_K = 1024, O_V = 2048, O_F = 3072, O_Z = 3080, O_XBC = 4104, O_DT = 5640;
constexpr float EPS = 1e-6f, SW_ALPHA = 1.702f, SW_LIMIT = 7.0f;
constexpr float LOG2E = 1.4426950408889634f;
constexpr float QSCALE = 0.08838834764831845f * LOG2E;
constexpr int SLOTCAP = NTOK;
constexpr int MAXMT = (NTOK * TOPK) / 256 + NE;

constexpr size_t MiB = 1u << 20;
constexpr size_t WS_CTL = 0, CTL_ZERO_BYTES = 192 * 1024;
constexpr size_t WS_WIN = 1 * MiB;
constexpr size_t WS_WOUT = 24 * MiB;
constexpr size_t WS_WR = 32 * MiB;
constexpr size_t WS_ACUM = 33 * MiB;
constexpr size_t WS_DTV = 34 * MiB, WS_DAV = 35 * MiB;
constexpr size_t WS_STOK = 36 * MiB, WS_SGATE = 37 * MiB, WS_SDEST = 38 * MiB;
constexpr size_t WS_XN = 40 * MiB;
constexpr size_t WS_PROJ = 72 * MiB;
constexpr size_t WS_H = WS_PROJ;
constexpr size_t WS_QN = 164 * MiB, WS_KN = 180 * MiB;
constexpr size_t WS_XCONV = 196 * MiB;
constexpr size_t WS_MIX = 220 * MiB;
constexpr size_t WS_ACT = 252 * MiB;
constexpr size_t WS_YSLOT = 412 * MiB;
constexpr size_t WS_WGU = 540 * MiB;
constexpr size_t WS_WD = 1052 * MiB;
constexpr size_t WS_END = 1308 * MiB;
constexpr int CW_BAR = 4096;
constexpr int CW_HEAD = 8192;
constexpr int CW_DONE = 8192 + 64;
constexpr int CW_PROBE = 12288;
constexpr int CW_MOEQ = 10240;
constexpr int CW_CNT = 16384;
constexpr int CW_SSQ = 32768;
static_assert((CW_SSQ + NTOK) * 4 <= (int)CTL_ZERO_BYTES, "ctl");

constexpr int RING_OFF = 0, RING_BYTES = 131072;
constexpr int LDSCTL_OFF = RING_BYTES;
constexpr int MISC_OFF = LDSCTL_OFF;
constexpr int BGW_OFF = LDSCTL_OFF + 64;
constexpr int TB_OFF = LDSCTL_OFF + 256;
constexpr int DMA_T_OFF = LDSCTL_OFF + 1024;
constexpr int LDS_BYTES = 163840 - 8192;
constexpr int NWAVES = 8, NTHR = 512;

__device__ __forceinline__ unsigned f2bf(float f) { unsigned u = __builtin_bit_cast(unsigned, f); return (u + 0x7fffu + ((u >> 16) & 1u)) >> 16; }
__device__ __forceinline__ unsigned pk2(float lo, float hi) { unsigned r; asm volatile("v_cvt_pk_bf16_f32 %0, %1, %2" : "=v"(r) : "v"(lo), "v"(hi)); return r; }
__device__ __forceinline__ float bf2f(unsigned h) { return __builtin_bit_cast(float, h << 16); }
__device__ __forceinline__ float bflo(unsigned w) { return __builtin_bit_cast(float, w << 16); }
__device__ __forceinline__ float bfhi(unsigned w) { return __builtin_bit_cast(float, w & 0xffff0000u); }
__device__ __forceinline__ float wave_sum(float v) {
#pragma unroll
    for (int o = 1; o < 64; o <<= 1) v += __shfl_xor(v, o);
    return v;
}
__device__ __forceinline__ float wave_max(float v) {
#pragma unroll
    for (int o = 1; o < 64; o <<= 1) v = fmaxf(v, __shfl_xor(v, o));
    return v;
}
#ifndef NC1_CFG
#define NC1_CFG 9
#endif
#ifndef NC5_CFG
#define NC5_CFG 16
#endif
#ifndef NC7_CFG
#define NC7_CFG 3
#endif
#ifndef SSD_WPX
#define SSD_WPX 4
#endif
#ifndef PROBE_P3
#define PROBE_P3 0
#endif
#ifndef CONV_IN_P0
#define CONV_IN_P0 0
#endif
#ifndef PROBE_T
#define PROBE_T 0
#endif
#ifndef PROBE_KA
#define PROBE_KA 0
#endif
#ifndef PROBE_KB
#define PROBE_KB 1
#endif
#ifndef PROBE_GA
#define PROBE_GA 0.001f
#endif
#ifndef HALF_LAST
#define HALF_LAST 0
#endif
#ifndef CONV_NTS
#define CONV_NTS 1
#endif
#ifndef CONV_NT
#define CONV_NT 1
#endif
#ifndef DYN_MOE
#define DYN_MOE 0
#endif
#ifndef HALF_UNITS_CFG
#define HALF_UNITS_CFG 1
#endif
#ifndef YSLOT_FP8
#define YSLOT_FP8 0
#endif
#ifndef CONV_DMA
#define CONV_DMA 0
#endif
#ifndef BGB_CFG
#define BGB_CFG 4
#endif
#ifndef CONV_WG
#define CONV_WG 1
#endif
#ifndef CONV_PIPE
#define CONV_PIPE 0
#endif
#ifndef BG_POOL
#define BG_POOL 1
#endif
#ifndef FP8_MOE
#define FP8_MOE 1
#endif
#ifndef H_BF16
#define H_BF16 1
#endif
#ifndef PEEK_CFG
#define PEEK_CFG 1
#endif
#ifndef NSPLIT_CFG
#define NSPLIT_CFG 1
#endif
#ifndef ALIGN_EPI_CFG
#define ALIGN_EPI_CFG 7
#endif
#ifndef P9_NTS
#define P9_NTS 0
#endif
#ifndef SPLIT_P3
#define SPLIT_P3 0
#endif
#ifndef FUSE_P4
#define FUSE_P4 1
#endif
#ifndef PROBE_EPI2
#define PROBE_EPI2 0
#endif
#ifndef LOOSE_EPI_WAIT
#define LOOSE_EPI_WAIT 0
#endif
#ifndef FIN2_CFG
#define FIN2_CFG 0
#endif
#ifndef PROBE_KLD
#define PROBE_KLD 0
#endif
#ifndef EMU_IN8
#define EMU_IN8 0
#endif
#ifndef EMU_OUT8
#define EMU_OUT8 0
#endif
#ifndef EMU_FP8
#define EMU_FP8 0
#endif
__device__ __forceinline__ unsigned pk4_fp8(float a, float b, float c, float d) { int p = __builtin_amdgcn_cvt_pk_fp8_f32(a, b, 0, false); p = __builtin_amdgcn_cvt_pk_fp8_f32(c, d, p, true); return (unsigned)p; }
typedef short v2s_ __attribute__((ext_vector_type(2)));
#ifndef CVT_SCALE
#define CVT_SCALE 0.015625f
#endif
__device__ __forceinline__ unsigned pk4_fp8_x64(float a, float b, float c, float d) { v2s_ o = {0, 0}; o = __builtin_amdgcn_cvt_scalef32_pk_fp8_f32(o, a, b, CVT_SCALE, false); o = __builtin_amdgcn_cvt_scalef32_pk_fp8_f32(o, c, d, CVT_SCALE, true); return __builtin_bit_cast(unsigned, o); }
__device__ __forceinline__ float q8(float x) { return __builtin_amdgcn_cvt_f32_fp8(__builtin_amdgcn_cvt_pk_fp8_f32(x, x, 0, false), 0); }
__device__ __forceinline__ float sigmoidf_(float x) { return 1.f / (1.f + __expf(-x)); }
__device__ __forceinline__ float siluf_(float x) { return x * __builtin_amdgcn_rcpf(1.f + __expf(-x)); }
__device__ __forceinline__ float softplusf_(float x) { return fmaxf(x, 0.f) + log1pf(__expf(-fabsf(x))); }

#define XB_TMO      128
#define XB_XCNT(j)  (256  + 64 * (j))
#define XB_XSUB(j)  (1280 + 64 * (j))
#define XB_XGEN(j)  (2304 + 64 * (j))
#define XB_TOP      3328
#define XB_TOPGEN   3392
#define XCD_BAR_WORDS 3456
#define XB_SPIN_CAP (1u << 18)

__device__ __forceinline__ unsigned xb_ld(unsigned* p)              { return __hip_atomic_load(p, __ATOMIC_RELAXED, __HIP_MEMORY_SCOPE_AGENT); }
__device__ __forceinline__ unsigned xb_add(unsigned* p, unsigned v) { return __hip_atomic_fetch_add(p, v, __ATOMIC_RELAXED, __HIP_MEMORY_SCOPE_AGENT); }
__device__ __forceinline__ unsigned xb_xcc_id() { return (unsigned)__builtin_amdgcn_s_getreg((3 << 11) | 20) & 0xFu; }
#define XB_SPIN(cond, bar) do { unsigned _sp = 0; while (cond) { __builtin_amdgcn_s_sleep(1); \
    if ((++_sp & 255u) == 0u) { if (xb_ld(&(bar)[XB_TMO])) break; if (_sp > XB_SPIN_CAP) { atomicAdd(&(bar)[XB_TMO], 1u); break; } } } } while (0)

struct XcdBarrier {
    unsigned* bar; unsigned x;
    volatile LAS unsigned* st;
};
__device__ __forceinline__ XcdBarrier xcd_barrier_post(unsigned* bar, volatile LAS unsigned* st) {
    XcdBarrier b; b.bar = bar; b.x = xb_xcc_id(); b.st = st;
    if (threadIdx.x == 0) (void)xb_add(&bar[XB_XCNT(b.x)], 1u);
    return b;
}
__device__ __forceinline__ void xcd_barrier_complete(unsigned* bar, unsigned x, unsigned& nloc, unsigned& nx) {
    const unsigned G = gridDim.x * gridDim.y * gridDim.z;
    unsigned sum, cnt, mine, sp = 0u;
    for (;;) {
        sum = 0u; cnt = 0u; mine = 0u;
#pragma unroll
        for (unsigned j = 0; j < 16; ++j) { const unsigned c = xb_ld(&bar[XB_XCNT(j)]); sum += c; cnt += (c > 0u) ? 1u : 0u; mine = (j == x) ? c : mine; }
        if (sum == G) break;
        __builtin_amdgcn_s_sleep(1);
        if ((++sp & 255u) == 0u) { if (xb_ld(&bar[XB_TMO])) break; if (sp > XB_SPIN_CAP) { atomicAdd(&bar[XB_TMO], 1u); break; } }
    }
    nloc = mine > 0u ? mine : 1u; nx = cnt > 0u ? cnt : 1u;
}
__device__ __forceinline__ void xcd_barrier(const XcdBarrier& b) {
    asm volatile("s_waitcnt vmcnt(0)" ::: "memory");
    __syncthreads();
    if (threadIdx.x == 0) {
        unsigned* bar = b.bar;
        __builtin_amdgcn_s_waitcnt(0);
        unsigned nloc = b.st[0], nx = b.st[1];
        if (nloc == 0u) { xcd_barrier_complete(bar, b.x, nloc, nx); b.st[0] = nloc; b.st[1] = nx; }
        const unsigned old = xb_add(&bar[XB_XSUB(b.x)], 1u);
        const unsigned gen = old / nloc;
        if (old + 1u == (gen + 1u) * nloc) {
            __builtin_amdgcn_fence(__ATOMIC_RELEASE, "agent");
            asm volatile("s_waitcnt vmcnt(0)" ::: "memory");
            const unsigned og = xb_add(&bar[XB_TOP], 1u);
            const unsigned tg = og / nx;
            if (og + 1u == (tg + 1u) * nx) xb_add(&bar[XB_TOPGEN], 1u);
            else XB_SPIN(xb_ld(&bar[XB_TOPGEN]) == tg, bar);
            __builtin_amdgcn_fence(__ATOMIC_ACQUIRE, "agent");
            xb_add(&bar[XB_XGEN(b.x)], 1u);
            asm volatile("s_waitcnt vmcnt(0)" ::: "memory");
        } else {
            XB_SPIN(xb_ld(&bar[XB_XGEN(b.x)]) == gen, bar);
            __builtin_amdgcn_fence(__ATOMIC_ACQUIRE, "agent");
            asm volatile("s_waitcnt vmcnt(0)" ::: "memory");
        }
    }
    __syncthreads();
}
#ifndef B_NT_CFG
#define B_NT_CFG 0
#endif
#ifndef FP8_DIAG
#define FP8_DIAG 0
#endif
#ifndef FP8_NOSCALE
#define FP8_NOSCALE 0
#endif
namespace pg8 {
#define PG8_LAS __attribute__((address_space(3)))
typedef unsigned short bf16_t;
typedef short bf16x8 __attribute__((ext_vector_type(8)));
typedef float f32x4 __attribute__((ext_vector_type(4)));
typedef unsigned u32x4 __attribute__((ext_vector_type(4)));
constexpr int BM = 256, BK = 64, HALF = 128, HTB = HALF * BK * 2  , STAGE_BYTES = 8 * HTB, NXCD = 8, WGM = 8;
constexpr int GK = 2048;
typedef int i32x8 __attribute__((ext_vector_type(8)));
typedef int i32x4_ __attribute__((ext_vector_type(4)));

__host__ __device__ __forceinline__ int lds_byte(int r, int c) { const int st = (r >> 4) * 2 + (c >> 5), rr = r & 15, cc = c & 31, ob = rr * 64 + cc * 2; return st * 1024 + (ob ^ (((ob >> 9) & 1) << 5)); }
__host__ __device__ __forceinline__ void stage_rc(int b, int& R, int& C) { const int st = b / 1024, sb = b % 1024, swz = sb ^ (((sb >> 9) & 1) << 5); R = (st >> 1) * 16 + swz / 64; C = (st & 1) * 32 + (swz % 64) / 2; }
__host__ __device__ __forceinline__ int perm32(int rho) { const int n = rho >> 4, i = rho & 15; return 8 * (i >> 2) + 4 * n + (i & 3); }

struct Unit { int pm, pn, e, mt, nrows, nh, rh, roff; };

__device__ __forceinline__ unsigned cvt_pk_bf16(float lo, float hi) { unsigned r; asm volatile("v_cvt_pk_bf16_f32 %0, %1, %2" : "=v"(r) : "v"(lo), "v"(hi)); return r; }

template <class Epi, class Sched, bool GATHER, bool ALIGN_EPI, bool FP8 = false>
__device__ __forceinline__ void gemm_phase(PG8_LAS unsigned char* lds, const Sched& S, const Epi& E) {
    const int tid = threadIdx.x, wid = __builtin_amdgcn_readfirstlane(tid >> 6), lane = tid & 63, wr = wid >> 2, wc = wid & 3, fr = lane & 15, fq = lane >> 4;
    constexpr int K = FP8 ? GK / 2 : GK, nt = K / BK;
    unsigned vB[2]; int Ri[2], Ci[2];
#pragma unroll
    for (int i = 0; i < 2; ++i) { int R, C; stage_rc(tid * 16 + i * 8192, R, C); const int Rb = Epi::PERM ? ((R & ~31) + perm32(R & 31)) : R;
        vB[i] = Sched::B_BLOCKED ? (unsigned)(Rb * BK + C) * 2u : (unsigned)(Rb * K + C) * 2u; Ri[i] = R; Ci[i] = C; }
    constexpr unsigned kstep = (unsigned)(BK * 2);
    constexpr unsigned hstepB = Sched::B_BLOCKED ? (unsigned)HALF * BK * 2 : (unsigned)HALF * K * 2;
    const unsigned kstepB = Sched::B_BLOCKED ? S.b_kstep() : kstep;
    const char* const rA = (const char*)S.a_base(); const char* const rB = (const char*)S.b_base();
    const unsigned ldsw = (unsigned)wid * 1024u;
    const int aoff = lds_byte(wr * 64 + fr, fq * 8), boff = lds_byte(wc * 32 + fr, fq * 8);
#define PG8_SA(b, h) (((b) * 2 + (h)) * HTB)
#define PG8_SB(b, h) ((4 + (b) * 2 + (h)) * HTB)
#define PG8_STAGE(bufoff, gbase, soff, voff) do { _Pragma("unroll") for (int _i = 0; _i < 2; ++_i) { \
        if (FP8 && B_NT_CFG && (bufoff) >= 4 * HTB) __builtin_amdgcn_global_load_lds((const unsigned*)((gbase) + (size_t)(soff) + (voff)[_i]), (PG8_LAS unsigned*)(lds + (bufoff) + ldsw + _i * 8192), 16, 0, 2); \
        else __builtin_amdgcn_global_load_lds((const unsigned*)((gbase) + (size_t)(soff) + (voff)[_i]), (PG8_LAS unsigned*)(lds + (bufoff) + ldsw + _i * 8192), 16, 0, 0); } } while (0)
#define PG8_LDA(dst, b, h) do { _Pragma("unroll") for (int m = 0; m < 4; ++m) { dst[m].lo = *(const PG8_LAS i32x4_*)(lds + PG8_SA(b, h) + aoff + m * 2048); dst[m].hi = *(const PG8_LAS i32x4_*)(lds + PG8_SA(b, h) + aoff + m * 2048 + 1024); } } while (0)
#define PG8_LDB(dst, b, h) do { _Pragma("unroll") for (int n = 0; n < 2; ++n) { dst[n].lo = *(const PG8_LAS i32x4_*)(lds + PG8_SB(b, h) + boff + n * 2048); dst[n].hi = *(const PG8_LAS i32x4_*)(lds + PG8_SB(b, h) + boff + n * 2048 + 1024); } } while (0)
#define PG8_MMA(ai, bj, At, Bt) do { __builtin_amdgcn_s_setprio(1); _Pragma("unroll") for (int m = 0; m < 4; ++m) _Pragma("unroll") for (int n = 0; n < 2; ++n) { \
        if constexpr (FP8) { if (FP8_DIAG) { _Pragma("unroll") for (int q_ = 0; q_ < 4; ++q_) { \
                const long b_ = (long)(unsigned)Bt[n][2 * q_] | ((long)Bt[n][2 * q_ + 1] << 32), a_ = (long)(unsigned)At[m][2 * q_] | ((long)At[m][2 * q_ + 1] << 32); \
                acc[ai][bj][m][n] = __builtin_amdgcn_mfma_f32_16x16x32_fp8_fp8(b_, a_, acc[ai][bj][m][n], 0, 0, 0); } } \
            else if (FP8_NOSCALE) asm volatile("v_mfma_f32_16x16x128_f8f6f4 %0, %1, %2, %0" : "+v"(acc[ai][bj][m][n]) : "v"(Bt[n]), "v"(At[m])); \
            else asm volatile("v_mfma_scale_f32_16x16x128_f8f6f4 %0, %1, %2, %0, %3, %3 op_sel_hi:[0,0,0]" : "+v"(acc[ai][bj][m][n]) : "v"(Bt[n]), "v"(At[m]), "v"(sc8)); } \
        else { const i32x4_ bl_ = __builtin_shufflevector(Bt[n], Bt[n], 0, 1, 2, 3), bh_ = __builtin_shufflevector(Bt[n], Bt[n], 4, 5, 6, 7), al_ = __builtin_shufflevector(At[m], At[m], 0, 1, 2, 3), ah_ = __builtin_shufflevector(At[m], At[m], 4, 5, 6, 7); \
               acc[ai][bj][m][n] = __builtin_amdgcn_mfma_f32_16x16x32_bf16(__builtin_bit_cast(bf16x8, bl_), __builtin_bit_cast(bf16x8, al_), acc[ai][bj][m][n], 0, 0, 0); \
               acc[ai][bj][m][n] = __builtin_amdgcn_mfma_f32_16x16x32_bf16(__builtin_bit_cast(bf16x8, bh_), __builtin_bit_cast(bf16x8, ah_), acc[ai][bj][m][n], 0, 0, 0); } } \
        __builtin_amdgcn_s_setprio(0); } while (0)
#define PG8_WAIT_V(n) asm volatile("s_waitcnt vmcnt(" #n ")" ::: "memory")
#define PG8_WAIT_L(n) asm volatile("s_waitcnt lgkmcnt(" #n ")" ::: "memory")
#define PG8_BAR __builtin_amdgcn_s_barrier()
#define PG8_SCHED __builtin_amdgcn_sched_barrier(0)
#define PG8_VOFF(v, u) do { _Pragma("unroll") for (int h_ = 0; h_ < 2; ++h_) _Pragma("unroll") for (int i_ = 0; i_ < 2; ++i_) { \
        const int r_ = h_ * HALF + Ri[i_]; const int src_ = GATHER ? S.a_row(u, r_) : r_; v[h_][i_] = (unsigned)(src_ * K + Ci[i_]) * 2u; } } while (0)
#define PG8_WAIT_SEL(loose, NL) asm volatile("s_cmp_lg_u32 %0, 0\n\ts_cbranch_scc0 .Lw8_%=\n\ts_waitcnt vmcnt(%1)\n\ts_branch .Lwe_%=\n.Lw8_%=:\n\ts_waitcnt vmcnt(8)\n.Lwe_%=:" :: "s"(loose), "n"(NL) : "memory", "scc")
#define PG8_ITER(W1, W2, W3, W4) do { \
            if (nh != 2) PG8_LDB(B0, 0, 0); if (nh != 1) PG8_LDB(B1, 0, 1); PG8_SCHED; PG8_LDA(At, 0, 0); PG8_STAGE(PG8_SA(1, 1), rA, a1, vAc[1]); \
            W1; PG8_WAIT_L(0); PG8_BAR; if (nh != 2) PG8_MMA(0, 0, At, B0); if (nh != 1) PG8_MMA(0, 1, At, B1); PG8_BAR; PG8_SCHED; \
            if (!halfu) PG8_LDA(At, 0, 1); PG8_STAGE(PG8_SB(0, 0), rB, b2, vB); PG8_STAGE(PG8_SB(0, 1), rB, b2 + hstepB, vB); PG8_STAGE(PG8_SA(0, 0), rA, a2, v2[0]); \
            W2; PG8_WAIT_L(0); PG8_BAR; if (!halfu) { if (nh != 2) PG8_MMA(1, 0, At, B0); if (nh != 1) PG8_MMA(1, 1, At, B1); } PG8_BAR; PG8_SCHED; \
            if (nh != 2) PG8_LDB(B0, 1, 0); if (nh != 1) PG8_LDB(B1, 1, 1); PG8_SCHED; PG8_LDA(At, 1, 0); PG8_STAGE(PG8_SA(0, 1), rA, a2, v2[1]); \
            W3; PG8_WAIT_L(0); PG8_BAR; if (nh != 2) PG8_MMA(0, 0, At, B0); if (nh != 1) PG8_MMA(0, 1, At, B1); PG8_BAR; PG8_SCHED; \
            if (!halfu) PG8_LDA(At, 1, 1); PG8_STAGE(PG8_SB(1, 0), rB, b3, vB); PG8_STAGE(PG8_SB(1, 1), rB, b3 + hstepB, vB); PG8_STAGE(PG8_SA(1, 0), rA, a3, v2[0]); \
            W4; PG8_WAIT_L(0); PG8_BAR; if (!halfu) { if (nh != 2) PG8_MMA(1, 0, At, B0); if (nh != 1) PG8_MMA(1, 1, At, B1); } PG8_BAR; PG8_SCHED; } while (0)
    Unit cur, nxt; int ui = 0;
    if (!S.next(0, cur)) return;
    f32x4 acc[2][2][4][2];
#pragma unroll
    for (int a = 0; a < 2; ++a)
#pragma unroll
        for (int b = 0; b < 2; ++b)
#pragma unroll
            for (int m = 0; m < 4; ++m)
#pragma unroll
                for (int n = 0; n < 2; ++n) acc[a][b][m][n] = (f32x4){0.f, 0.f, 0.f, 0.f};
    const int sc8 = 0x7c7c7c7c;
    i32x8 At[4], B0[2], B1[2];
    unsigned vAc[2][2], vAn[2][2];
    PG8_VOFF(vAc, cur);
    constexpr int KROT = Epi::MIDSCALE ? nt / 2 : 0;
    float mraw = 0.f;
#define PG8_KA(t_) ((unsigned)(((t_) + KROT) & (nt - 1)) * kstep)
#define PG8_KB(t_) ((unsigned)(((t_) + KROT) & (nt - 1)) * kstepB)
    unsigned cA = S.a_off(cur), cB = S.b_off(cur);
    PG8_STAGE(PG8_SB(0, 0), rB, cB + PG8_KB(0), vB); PG8_STAGE(PG8_SB(0, 1), rB, cB + PG8_KB(0) + hstepB, vB); PG8_STAGE(PG8_SA(0, 0), rA, cA + PG8_KA(0), vAc[0]); PG8_STAGE(PG8_SA(0, 1), rA, cA + PG8_KA(0), vAc[1]);
    if (wr == 1) PG8_BAR;
    PG8_WAIT_V(2); PG8_BAR;
    PG8_STAGE(PG8_SB(1, 0), rB, cB + PG8_KB(1), vB); PG8_STAGE(PG8_SA(1, 0), rA, cA + PG8_KA(1), vAc[0]); PG8_STAGE(PG8_SB(1, 1), rB, cB + hstepB + PG8_KB(1), vB);
    PG8_WAIT_V(6); PG8_BAR;
    for (;;) {
        const bool has_next = S.next(ui + 1, nxt);
        unsigned nA = cA, nB = cB;
        if (has_next) { nA = S.a_off(nxt); nB = S.b_off(nxt); PG8_VOFF(vAn, nxt); }
        else {
#pragma unroll
            for (int h = 0; h < 2; ++h)
#pragma unroll
                for (int i = 0; i < 2; ++i) vAn[h][i] = vAc[h][i]; }
        if constexpr (Epi::MIDSCALE) mraw = E.mid_load(cur);
        const int nh = Sched::NSPLIT ? __builtin_amdgcn_readfirstlane(cur.nh) : 0;
        const bool halfu = Sched::HALF_UNITS && cur.nrows <= HALF;
        for (int t = 0; t < nt; t += 2) {
            const bool last = (t == nt - 2);
            const unsigned a1 = cA + PG8_KA(t + 1);
            const unsigned a2 = last ? nA + PG8_KA(0) : cA + PG8_KA(t + 2), b2 = last ? nB + PG8_KB(0) : cB + PG8_KB(t + 2);
            const unsigned a3 = a2 + kstep, b3 = b2 + kstepB;
            if constexpr (Epi::MIDSCALE) { if (t == nt / 2 - 2) { if (tid < 256) ((PG8_LAS float*)(lds + (LDSCTL_OFF - RING_OFF) + 4096))[tid] = E.mid_factor(mraw); } }
            if constexpr (Epi::MIDSCALE) { if (t == nt / 2) {
#pragma unroll
                for (int a = 0; a < 2; ++a)
#pragma unroll
                    for (int m = 0; m < 4; ++m) { const float f_ = ((const PG8_LAS float*)(lds + (LDSCTL_OFF - RING_OFF) + 4096))[a * 128 + wr * 64 + m * 16 + fr];
#pragma unroll
                        for (int b = 0; b < 2; ++b)
#pragma unroll
                            for (int n = 0; n < 2; ++n) acc[a][b][m][n] = acc[a][b][m][n] * f_; } } }
            unsigned v2[2][2];
#pragma unroll
            for (int h = 0; h < 2; ++h)
#pragma unroll
                for (int i = 0; i < 2; ++i) v2[h][i] = last ? vAn[h][i] : vAc[h][i];
            const int loose = __builtin_amdgcn_readfirstlane((LOOSE_EPI_WAIT && t == 0 && ui > 0) ? 1 : 0);
            PG8_ITER(PG8_WAIT_SEL(loose, 8 + Epi::NVM), PG8_WAIT_SEL(loose, 8 + Epi::NVM), PG8_WAIT_SEL(loose, 8 + Epi::NVM), PG8_WAIT_V(8));
        }
        if constexpr (FP8) asm volatile("s_nop 15\n\ts_nop 15" ::: "memory");
        if constexpr (ALIGN_EPI) { if (wr == 0) PG8_BAR; }
        E(acc, cur, wr, wc, fr, fq);
        if (PROBE_EPI2) { asm volatile("" ::: "memory"); E(acc, cur, wr, wc, fr, fq); }
        if (!has_next) break;
#pragma unroll
        for (int a = 0; a < 2; ++a)
#pragma unroll
            for (int b = 0; b < 2; ++b)
#pragma unroll
                for (int m = 0; m < 4; ++m)
#pragma unroll
                    for (int n = 0; n < 2; ++n) acc[a][b][m][n] = (f32x4){0.f, 0.f, 0.f, 0.f};
        cur = nxt; cA = nA; cB = nB; ++ui;
#pragma unroll
        for (int h = 0; h < 2; ++h)
#pragma unroll
            for (int i = 0; i < 2; ++i) vAc[h][i] = vAn[h][i];
        if constexpr (ALIGN_EPI) { if (wr == 1) PG8_BAR; }
    }
    PG8_WAIT_V(0);
    if constexpr (!ALIGN_EPI) { if (wr == 0) PG8_BAR; }
    PG8_BAR;
#undef PG8_KA
#undef PG8_KB
#undef PG8_ITER
#undef PG8_WAIT_SEL
#undef PG8_SA
#undef PG8_SB
#undef PG8_STAGE
#undef PG8_LDA
#undef PG8_LDB
#undef PG8_MMA
#undef PG8_WAIT_V
#undef PG8_WAIT_L
#undef PG8_BAR
#undef PG8_SCHED
#undef PG8_VOFF
}
}
struct Frame {
    LAS unsigned char* lds;
    volatile LAS unsigned* MISC;
    gu32* ctl;
    int wave, vcu, G;
    const float *x, *g1, *w_in, *fbias, *gq, *gk, *conv_w, *conv_b, *dt_bias, *a_log, *d_skip, *ssd_g, *w_out, *g2, *w_router, *b_router, *w_gate, *b_gate, *w_up, *b_up, *w_down, *b_down;
    float* out; unsigned char* ws;
};
#define WSP(T, off) ((T*)(F.ws + (off)))
__device__ __forceinline__ int TTID() { int t = threadIdx.x; asm volatile("" : "+v"(t)); return t; }
__device__ __forceinline__ int TLANE() { return TTID() & 63; }

template <bool Q8>
__device__ __forceinline__ void conv_item(const float* W, int ldn, int nvalid, int k0, int n0, bf16* dst, LAS unsigned* T, int lane, const float* rowgain = nullptr) {
    const int kq = lane >> 4, nq = lane & 15, col = n0 + 4 * nq;
    const bool ok = col < nvalid;
    f32x4 a[8], b[8];
#pragma unroll
    for (int i = 0; i < 8; ++i) { const float* p = W + (size_t)(k0 + 8 * i + 2 * kq) * ldn + col;
        a[i] = ok ? *(const f32x4*)p : (f32x4){0.f, 0.f, 0.f, 0.f}; b[i] = ok ? *(const f32x4*)(p + ldn) : (f32x4){0.f, 0.f, 0.f, 0.f}; }
    if (rowgain) {
#pragma unroll
        for (int i = 0; i < 8; ++i) { const float ga = rowgain[8 * i + 2 * kq], gb = rowgain[8 * i + 2 * kq + 1]; a[i] = a[i] * ga; b[i] = b[i] * gb; } }
#pragma unroll
    for (int i = 0; i < 8; ++i)
#pragma unroll
        for (int j = 0; j < 4; ++j) T[(4 * nq + j) * 33 + 4 * i + kq] = (Q8 && (EMU_FP8 || EMU_IN8 || EMU_OUT8)) ? pk2(q8(a[i][j] * 64.f) * (1.f / 64.f), q8(b[i][j] * 64.f) * (1.f / 64.f)) : pk2(a[i][j], b[i][j]);
    LDS_WAIT();
    const int c = lane & 7;
#pragma unroll
    for (int r = 0; r < 8; ++r) { const int n = 8 * r + (lane >> 3); const LAS unsigned* s = T + n * 33 + 4 * c;
        v4u o; o.x = s[0]; o.y = s[1]; o.z = s[2]; o.w = s[3];
        *(v4u*)(dst + (size_t)n * 2048 + k0 + 8 * c) = o; }
    LDS_WAIT();
}
__device__ __forceinline__ void conv_item8(const float* W, int k0, int n0, unsigned char* dst, LAS unsigned* T, int lane) {
    const int kq = lane >> 4, nq = lane & 15, col = n0 + 4 * nq;
    f32x4 a[8][4];
#pragma unroll
    for (int i = 0; i < 8; ++i)
#pragma unroll
        for (int r = 0; r < 4; ++r) a[i][r] = __builtin_nontemporal_load((const GAS f32x4*)(W + (size_t)(k0 + 16 * i + 4 * kq + r) * 2048 + col));
#pragma unroll
    for (int i = 0; i < 8; ++i)
#pragma unroll
        for (int j = 0; j < 4; ++j) T[(4 * nq + j) * 33 + 4 * i + kq] = pk4_fp8_x64(a[i][0][j], a[i][1][j], a[i][2][j], a[i][3][j]);
    LDS_WAIT();
    const int c = lane & 7;
#pragma unroll
    for (int r = 0; r < 8; ++r) { const int n = 8 * r + (lane >> 3); const LAS unsigned* s = T + n * 33 + 4 * c;
        v4u o; o.x = s[0]; o.y = s[1]; o.z = s[2]; o.w = s[3];
        *(GAS v4u*)(dst + (size_t)n * 128 + 16 * c) = o; }
    LDS_WAIT();
}
struct Conv8Regs { f32x4 a[4][4]; };
__device__ __forceinline__ void conv8_load(Conv8Regs& R, const float* W, int k0, int n0, int lane) {
    const int kq = lane >> 4, nq = lane & 15, col = n0 + 4 * nq;
#pragma unroll
    for (int i = 0; i < 4; ++i)
#pragma unroll
        for (int r = 0; r < 4; ++r) R.a[i][r] = __builtin_nontemporal_load((const GAS f32x4*)(W + (size_t)(k0 + 16 * i + 4 * kq + r) * 2048 + col));
}
__device__ __forceinline__ void conv8_pack(const Conv8Regs& R, int k0, unsigned char* dst, LAS unsigned* T, int lane) {
    const int kq = lane >> 4, nq = lane & 15;
#pragma unroll
    for (int i = 0; i < 4; ++i)
#pragma unroll
        for (int j = 0; j < 4; ++j) T[(4 * nq + j) * 17 + 4 * i + kq] = pk4_fp8_x64(R.a[i][0][j], R.a[i][1][j], R.a[i][2][j], R.a[i][3][j]);
    LDS_WAIT();
    const int c = lane & 3;
#pragma unroll
    for (int r = 0; r < 4; ++r) { const int n = 16 * r + (lane >> 2); const LAS unsigned* s = T + n * 17 + 4 * c;
        v4u o; o.x = s[0]; o.y = s[1]; o.z = s[2]; o.w = s[3];
        *(GAS v4u*)(dst + (size_t)n * 2048 + k0 + 16 * c) = o; }
    LDS_WAIT();
}
constexpr int MKB = (FP8_MOE && !CONV_PIPE) ? 16 : 32;
constexpr int IT_IN = 32 * (NP / 64), IT_OUT = 32 * 32, IT_EXP = MKB * 32, IT_MOE = 3 * NE * IT_EXP, IT_TOTAL = IT_IN + IT_OUT + IT_MOE;
constexpr int IT_GU = 2 * NE * IT_EXP;
struct MoeItem { const float* src; unsigned char* dst; int k0, n0; };
__device__ __forceinline__ MoeItem moe_item(Frame& F, int r) {
    const int m = r / (NE * IT_EXP); r -= m * (NE * IT_EXP);
    const int e = r / IT_EXP; r -= e * IT_EXP; const int kb = r >> 5, nb = r & 31;
    const size_t eo = (size_t)e * 2048 * 2048; const int es = FP8_MOE ? 1 : 2;
    MoeItem it; it.k0 = kb * ((FP8_MOE && !CONV_PIPE) ? 128 : 64); it.n0 = nb * 64;
    const int rgu = (nb >> 1) * 256 + (nb & 1) * 64;
#if FP8_MOE && !CONV_PIPE
    unsigned char* dgu = WSP(unsigned char, WS_WGU) + (size_t)e * (4096 * 2048) + ((size_t)kb * 4096 + rgu) * 128;
    unsigned char* ddn = WSP(unsigned char, WS_WD) + (size_t)e * (2048 * 2048) + ((size_t)kb * 2048 + nb * 64) * 128;
    constexpr size_t up_off = (size_t)128 * 128;
#else
    unsigned char* dgu = WSP(unsigned char, WS_WGU) + ((size_t)e * 4096 + rgu) * (2048 * es);
    unsigned char* ddn = WSP(unsigned char, WS_WD) + ((size_t)e * 2048 + nb * 64) * (2048 * es);
    constexpr size_t up_off = (size_t)128 * (2048 * es);
#endif
    const float* pg = F.w_gate; const float* pu = F.w_up; const float* pd = F.w_down; asm volatile("" : "+s"(pg), "+s"(pu), "+s"(pd));
    const float* base = pg; it.dst = dgu;
    if (m == 1) { base = pu; it.dst = dgu + up_off; }
    if (m == 2) { base = pd; it.dst = ddn; }
    it.src = base + eo; return it;
}
__device__ __forceinline__ void conv_moe_item(Frame& F, int r, LAS unsigned* T, int lane0) {
    const MoeItem it = moe_item(F, r);
#if FP8_MOE && CONV_PIPE
    { Conv8Regs R; conv8_load(R, it.src, it.k0, it.n0, lane0); conv8_pack(R, it.k0, it.dst, T, lane0); }
#elif FP8_MOE
    conv_item8(it.src, it.k0, it.n0, it.dst, T, lane0);
#else
    conv_item<true>(it.src, 2048, 2048, it.k0, it.n0, (bf16*)it.dst, T, lane0);
#endif
}
__device__ __forceinline__ void conv_dispatch(Frame& F, int it, LAS unsigned* T, int lane0) {
    int r = it;
    if (r < IT_IN) { const int kb = r / (NP / 64), nb = r % (NP / 64); conv_item<(EMU_IN8 != 0)>(F.w_in, INCOLS, INCOLS, kb * 64, nb * 64, WSP(bf16, WS_WIN) + (size_t)(nb * 64) * 2048, T, lane0); return; }
    r -= IT_IN;
    if (r < IT_OUT) { const int kb = r >> 5, nb = r & 31; conv_item<(EMU_OUT8 != 0)>(F.w_out, DM, DM, kb * 64, nb * 64, WSP(bf16, WS_WOUT) + (size_t)(nb * 64) * 2048, T, lane0, (FUSE_P4 && kb >= 16) ? F.ssd_g + (kb * 64 - 1024) : nullptr); return; }
    r -= IT_OUT;
    conv_moe_item(F, r, T, lane0);
}
constexpr int WNB = CONV_DMA ? 16 : 8;
constexpr int WIT_EXP = 16 * WNB, WIT_GU = 2 * NE * WIT_EXP, WIT_MOE = 3 * NE * WIT_EXP;
struct WgItem { const float* src; unsigned char* blk; int m, nb; };
__device__ __forceinline__ WgItem wg_item(Frame& F, int r) {
    const int m = r / (NE * WIT_EXP); r -= m * (NE * WIT_EXP);
    const int e = r / WIT_EXP; r -= e * WIT_EXP; const int kb = r / WNB, nb = r % WNB;
    const float* pg = F.w_gate; const float* pu = F.w_up; const float* pd = F.w_down; asm volatile("" : "+s"(pg), "+s"(pu), "+s"(pd));
    WgItem it; it.m = m; it.nb = nb;
    const float* base = pg; if (m == 1) base = pu; if (m == 2) base = pd;
    it.src = base + (size_t)e * 2048 * 2048 + (size_t)(kb * 128) * 2048 + nb * (CONV_DMA ? 128 : 256);
    it.blk = (m == 2) ? WSP(unsigned char, WS_WD) + (size_t)e * (2048 * 2048) + (size_t)kb * (2048 * 128)
                      : WSP(unsigned char, WS_WGU) + (size_t)e * (4096 * 2048) + (size_t)kb * (4096 * 128);
    return it;
}
__device__ __forceinline__ void wg_load(f32x4 (&a)[16], const WgItem& it, int wave, int lane) {
#pragma unroll
    for (int i = 0; i < 16; ++i) a[i] = CONV_NT ? __builtin_nontemporal_load((const GAS f32x4*)(it.src + (size_t)(16 * wave + i) * 2048 + 4 * lane)) : *(const GAS f32x4*)(it.src + (size_t)(16 * wave + i) * 2048 + 4 * lane);
}
__device__ __forceinline__ void wg_pack(const f32x4 (&a)[16], LAS unsigned char* T, int wave, int lane) {
#pragma unroll
    for (int j = 0; j < 4; ++j) { v4u d;
        d.x = pk4_fp8_x64(a[0][j], a[1][j], a[2][j], a[3][j]); d.y = pk4_fp8_x64(a[4][j], a[5][j], a[6][j], a[7][j]);
        d.z = pk4_fp8_x64(a[8][j], a[9][j], a[10][j], a[11][j]); d.w = pk4_fp8_x64(a[12][j], a[13][j], a[14][j], a[15][j]);
        *(LAS v4u*)(T + (4 * lane + j) * 128 + ((wave ^ (lane & 7)) << 4)) = d; }
}
__device__ __forceinline__ void wg_store(const LAS unsigned char* T, const WgItem& it, int wave, int lane) {
    const int rb = (it.m == 2) ? it.nb * 256 : (2 * it.nb + (wave >> 2)) * 256 + (it.m == 1 ? 128 : 0);
#pragma unroll
    for (int s = 0; s < 4; ++s) { const int n = 32 * wave + 8 * s + (lane >> 3), c = lane & 7;
        const v4u v = *(const LAS v4u*)(T + n * 128 + ((c ^ ((n >> 2) & 7)) << 4));
        const int row = (it.m == 2) ? rb + n : rb + (n & 127);
        if (CONV_NTS) __builtin_nontemporal_store(v, (GAS v4u*)(it.blk + (size_t)row * 128 + 16 * c)); else *(GAS v4u*)(it.blk + (size_t)row * 128 + 16 * c) = v; }
}
__device__ __forceinline__ void dma_issue(const WgItem& it, unsigned sbase, int wave, int lane) {
#pragma unroll
    for (int i2 = 0; i2 < 8; ++i2) { const float* g = it.src + (size_t)(16 * wave + 2 * i2 + (lane >> 5)) * 2048 + 4 * (lane & 31); unsigned keep;
        asm volatile("s_mov_b32 %0, m0\n\ts_mov_b32 m0, %2\n\ts_nop 0\n\tglobal_load_lds_dwordx4 %1, off nt\n\ts_mov_b32 m0, %0" : "=&s"(keep) : "v"(g), "s"(sbase + 1024u * i2) : "memory"); }
}
__device__ __forceinline__ void dma_pack(const LAS unsigned char* Sw, LAS unsigned char* T, int wave, int lane) {
    const int n4 = lane & 31, kh = lane >> 5;
    f32x4 a[8];
#pragma unroll
    for (int r = 0; r < 8; ++r) { const int k = 8 * kh + r; a[r] = *(const LAS f32x4*)(Sw + (k >> 1) * 1024 + (k & 1) * 512 + n4 * 16); }
#pragma unroll
    for (int j = 0; j < 4; ++j) { v2u d; d.x = pk4_fp8_x64(a[0][j], a[1][j], a[2][j], a[3][j]); d.y = pk4_fp8_x64(a[4][j], a[5][j], a[6][j], a[7][j]);
        const int n = 4 * n4 + j; *(LAS v2u*)(T + n * 128 + ((wave ^ (n4 & 7)) << 4) + 8 * kh) = d; }
}
__device__ __forceinline__ void dma_store(const LAS unsigned char* T, const WgItem& it, int wave, int lane) {
    const int rb = (it.m == 2) ? it.nb * 128 : it.nb * 256 + (it.m == 1 ? 128 : 0);
#pragma unroll
    for (int s = 0; s < 2; ++s) { const int n = 16 * wave + 8 * s + (lane >> 3), c = lane & 7;
        const v4u v = *(const LAS v4u*)(T + n * 128 + ((c ^ ((n >> 2) & 7)) << 4));
        *(GAS v4u*)(it.blk + (size_t)(rb + n) * 128 + 16 * c) = v; }
}
constexpr int BG_BATCH = CONV_WG ? BGB_CFG : 32;
constexpr int POOL_GU = CONV_WG ? WIT_GU : IT_GU, POOL_ALL = CONV_WG ? WIT_MOE : IT_MOE;
__device__ __forceinline__ bool bg_batch(Frame& F, int limit) {
    LAS unsigned* T = (LAS unsigned*)(F.lds + RING_OFF + F.wave * 16384); volatile LAS int* BW = (volatile LAS int*)(F.lds + BGW_OFF);
    const int lane = TLANE();
    if (F.wave == 0) { int v = (int)__hip_atomic_load(F.ctl + CW_HEAD, RLX_AGENT);
        if (v < limit) v = (int)__hip_atomic_fetch_add(F.ctl + CW_HEAD, lane == 0 ? (unsigned)BG_BATCH : 0u, RLX_AGENT); else v = POOL_ALL;
        BW[0] = __builtin_amdgcn_readfirstlane(v); }
    __syncthreads();
    const int it0 = __builtin_amdgcn_readfirstlane(BW[0]);
    __syncthreads();
    if (it0 >= POOL_ALL) return false;
#if CONV_WG && CONV_DMA
    { LAS unsigned char* S0 = F.lds + RING_OFF; LAS unsigned char* T = F.lds + DMA_T_OFF; const int w = F.wave;
      const unsigned sb0 = (unsigned)(uintptr_t)(S0 + 8192 * w), sb1 = sb0 + 65536u;
      const WgItem i0 = wg_item(F, it0), i1 = wg_item(F, it0 + 1), i2 = wg_item(F, it0 + 2), i3 = wg_item(F, it0 + 3);
#define DMA_STEP(cur, sbc, NEXT_ISSUE, NWAIT) do { NEXT_ISSUE; asm volatile("s_waitcnt vmcnt(" #NWAIT ")" ::: "memory"); \
        dma_pack(S0 + ((sbc) - sb0) + 8192 * w, T, w, lane); LDS_WAIT(); __syncthreads(); dma_store(T, cur, w, lane); LDS_WAIT(); __syncthreads(); } while (0)
      dma_issue(i0, sb0, w, lane);
      DMA_STEP(i0, sb0, dma_issue(i1, sb1, w, lane), 8);
      DMA_STEP(i1, sb1, dma_issue(i2, sb0, w, lane), 8);
      DMA_STEP(i2, sb0, dma_issue(i3, sb1, w, lane), 8);
      DMA_STEP(i3, sb1, (void)0, 0);
#undef DMA_STEP
    }
#elif CONV_WG
    { LAS unsigned char* T0 = F.lds + RING_OFF; LAS unsigned char* T1 = T0 + 32768; const int w = F.wave;
      f32x4 A[16], B[16];
#if BGB_CFG == 6
      f32x4 C[16];
      const WgItem i0 = wg_item(F, it0), i1 = wg_item(F, it0 + 1), i2 = wg_item(F, it0 + 2), i3 = wg_item(F, it0 + 3), i4 = wg_item(F, it0 + 4), i5 = wg_item(F, it0 + 5);
      wg_load(A, i0, w, lane); wg_load(B, i1, w, lane); wg_load(C, i2, w, lane);
      wg_pack(A, T0, w, lane); LDS_WAIT(); __syncthreads(); wg_store(T0, i0, w, lane); wg_load(A, i3, w, lane);
      wg_pack(B, T1, w, lane); LDS_WAIT(); __syncthreads(); wg_store(T1, i1, w, lane); wg_load(B, i4, w, lane);
      wg_pack(C, T0, w, lane); LDS_WAIT(); __syncthreads(); wg_store(T0, i2, w, lane); wg_load(C, i5, w, lane);
      wg_pack(A, T1, w, lane); LDS_WAIT(); __syncthreads(); wg_store(T1, i3, w, lane);
      wg_pack(B, T0, w, lane); LDS_WAIT(); __syncthreads(); wg_store(T0, i4, w, lane);
      wg_pack(C, T1, w, lane); LDS_WAIT(); __syncthreads(); wg_store(T1, i5, w, lane);
#elif BGB_CFG == 4
      const WgItem i0 = wg_item(F, it0), i1 = wg_item(F, it0 + 1), i2 = wg_item(F, it0 + 2), i3 = wg_item(F, it0 + 3);
      wg_load(A, i0, w, lane);
      wg_load(B, i1, w, lane); wg_pack(A, T0, w, lane); LDS_WAIT(); __syncthreads(); wg_store(T0, i0, w, lane);
      wg_load(A, i2, w, lane); wg_pack(B, T1, w, lane); LDS_WAIT(); __syncthreads(); wg_store(T1, i1, w, lane);
      wg_load(B, i3, w, lane); wg_pack(A, T0, w, lane); LDS_WAIT(); __syncthreads(); wg_store(T0, i2, w, lane);
      wg_pack(B, T1, w, lane); LDS_WAIT(); __syncthreads(); wg_store(T1, i3, w, lane);
#elif BGB_CFG == 2
      const WgItem i0 = wg_item(F, it0), i1 = wg_item(F, it0 + 1);
      wg_load(A, i0, w, lane);
      wg_load(B, i1, w, lane); wg_pack(A, T0, w, lane); LDS_WAIT(); __syncthreads(); wg_store(T0, i0, w, lane);
      wg_pack(B, T1, w, lane); LDS_WAIT(); __syncthreads(); wg_store(T1, i1, w, lane);
#else
      const WgItem i0 = wg_item(F, it0);
      wg_load(A, i0, w, lane); wg_pack(A, T0, w, lane); LDS_WAIT(); __syncthreads(); wg_store(T0, i0, w, lane);
#endif
      LDS_WAIT(); __syncthreads(); }
#else
#pragma unroll 1
    for (int j = 0; j < BG_BATCH / NWAVES; ++j) conv_moe_item(F, it0 + j * NWAVES + F.wave, T, lane);
#endif
    return true;
}
__device__ __forceinline__ void bg_fill(Frame& F, int k, int limit) {
    volatile LAS int* BW = (volatile LAS int*)(F.lds + BGW_OFF);
    const int lane = TLANE();
    VM_WAIT(); __syncthreads();
    if (F.wave == 0) (void)__hip_atomic_fetch_add(F.ctl + CW_DONE + 64 * k, lane == 0 ? 1u : 0u, RLX_AGENT);
    bool more = true;
    while (more) {
        if (F.wave == 0) BW[1] = ((int)__hip_atomic_load(F.ctl + CW_DONE + 64 * k, RLX_AGENT) >= F.G) ? 1 : 0;
        __syncthreads();
        const int stop = __builtin_amdgcn_readfirstlane(BW[1]);
        __syncthreads();
        more = !stop;
        if (more) more = bg_batch(F, limit);
    }
}
__device__ __forceinline__ bool bg_finish(Frame& F, int limit) {
    bool any = false;
    while (bg_batch(F, limit)) any = true;
    return any;
}
__device__ __forceinline__ bool bg_peek_open(Frame& F) {
    volatile LAS int* BW = (volatile LAS int*)(F.lds + BGW_OFF);
    if (F.wave == 0) BW[2] = ((int)__hip_atomic_load(F.ctl + CW_HEAD, RLX_AGENT) < POOL_ALL) ? 1 : 0;
    __syncthreads();
    const int v = __builtin_amdgcn_readfirstlane(BW[2]);
    __syncthreads();
    return v != 0;
}
__device__ __forceinline__ bool bg_open(Frame& F, int limit) {
    return (int)__hip_atomic_load(F.ctl + CW_HEAD, RLX_AGENT) < limit;
}
__device__ __forceinline__ void rms_row_to_bf16(const float* xrow, const float* g, bf16* orow, int lane) {
    const f32x4* xr = (const f32x4*)xrow + lane; const f32x4* gr = (const f32x4*)g + lane;
    f32x4 v[8]; float s = 0.f;
#pragma unroll
    for (int j = 0; j < 8; ++j) { v[j] = xr[64 * j]; s += (v[j].x * v[j].x + v[j].y * v[j].y) + (v[j].z * v[j].z + v[j].w * v[j].w); }
    const float rstd = 1.f / sqrtf(wave_sum(s) * (1.f / 2048.f) + EPS);
    v2u* o8 = (v2u*)orow + lane;
#pragma unroll
    for (int j = 0; j < 8; ++j) { const f32x4 gg = gr[64 * j]; v2u w; w.x = pk2(v[j].x * rstd * gg.x, v[j].y * rstd * gg.y); w.y = pk2(v[j].z * rstd * gg.z, v[j].w * rstd * gg.w); o8[64 * j] = w; }
}
__device__ __forceinline__ void p0_prologue(Frame& F) {
    LAS unsigned* T = (LAS unsigned*)(F.lds + RING_OFF + F.wave * 16384); const int lane0 = TLANE();
    const int gw = F.vcu * NWAVES + F.wave, NGW = F.G * NWAVES;
    for (int it = gw; it < (BG_POOL ? IT_IN + IT_OUT : IT_TOTAL); it += NGW) conv_dispatch(F, it, T, lane0);
    for (int i = gw * 64 + lane0; i < NE * 2048; i += NGW * 64) { const int e = i >> 11, k = i & 2047; const float w = F.g2[k] * F.w_router[k * NE + e];
        const unsigned hi = f2bf(w); const float lo = w - bf2f(hi); WSP(bf16, WS_WR)[i] = (bf16)hi; WSP(bf16, WS_WR)[NE * 2048 + i] = (bf16)f2bf(lo); }
    for (int m0 = 2 * gw; m0 < NTOK; m0 += 2 * NGW) {
        const f32x4* x0 = (const f32x4*)(F.x + (size_t)m0 * DM) + lane0; const f32x4* x1 = x0 + DM / 4; const f32x4* gr = (const f32x4*)F.g1 + lane0;
        f32x4 v0[8], v1[8]; float s0 = 0.f, s1 = 0.f;
#pragma unroll
        for (int j = 0; j < 8; ++j) { v0[j] = x0[64 * j]; v1[j] = x1[64 * j]; }
#pragma unroll
        for (int j = 0; j < 8; ++j) { s0 += (v0[j].x * v0[j].x + v0[j].y * v0[j].y) + (v0[j].z * v0[j].z + v0[j].w * v0[j].w); s1 += (v1[j].x * v1[j].x + v1[j].y * v1[j].y) + (v1[j].z * v1[j].z + v1[j].w * v1[j].w); }
        const float r0 = 1.f / sqrtf(wave_sum(s0) * (1.f / 2048.f) + EPS), r1 = 1.f / sqrtf(wave_sum(s1) * (1.f / 2048.f) + EPS);
        v2u* o0 = (v2u*)(WSP(bf16, WS_XN) + (size_t)m0 * DM) + lane0; v2u* o1 = o0 + DM / 4;
#pragma unroll
        for (int j = 0; j < 8; ++j) { const f32x4 gg = gr[64 * j]; v2u w;
#if EMU_IN8
            w.x = pk2(q8(v0[j].x * r0 * gg.x), q8(v0[j].y * r0 * gg.y)); w.y = pk2(q8(v0[j].z * r0 * gg.z), q8(v0[j].w * r0 * gg.w)); o0[64 * j] = w;
            w.x = pk2(q8(v1[j].x * r1 * gg.x), q8(v1[j].y * r1 * gg.y)); w.y = pk2(q8(v1[j].z * r1 * gg.z), q8(v1[j].w * r1 * gg.w)); o1[64 * j] = w; }
#else
            w.x = pk2(v0[j].x * r0 * gg.x, v0[j].y * r0 * gg.y); w.y = pk2(v0[j].z * r0 * gg.z, v0[j].w * r0 * gg.w); o0[64 * j] = w;
            w.x = pk2(v1[j].x * r1 * gg.x, v1[j].y * r1 * gg.y); w.y = pk2(v1[j].z * r1 * gg.z, v1[j].w * r1 * gg.w); o1[64 * j] = w; }
#endif
    }
}

template <bool NS> struct OrderStaticT {
    static constexpr bool B_BLOCKED = false, HALF_UNITS = false, NSPLIT = NS, RSPLIT = false; __device__ __forceinline__ unsigned b_kstep() const { return 128u; }
    int nM, nN, nwg, G, c; const char* A; const char* Bt; const char* xprobe;
    __device__ __forceinline__ void init(int M, int N, int G_, int c_, const void* A_, const void* Bt_) { nM = M / 256; nN = N / 256; nwg = nM * nN; G = G_; c = c_; A = (const char*)A_; Bt = (const char*)Bt_; }
    __device__ __forceinline__ bool next(int i, pg8::Unit& u) const {
        long L = (long)i * G + c; u.nh = 0; u.rh = 0; u.roff = 0;
        if (NS) { const int R = nwg / G, T = nwg - R * G;
            if (T > 0 && 2 * T <= G && L >= (long)R * G) { const int Lp = (int)(L - (long)R * G); if (Lp >= 2 * T) return false; L = (long)R * G + (Lp >> 1); u.nh = 1 + (Lp & 1); } }
        if (L >= nwg) return false;
        int wgid = (int)L; { const int q = nwg / 8, r = nwg % 8, xcd = wgid % 8, off = wgid / 8; wgid = (xcd < r ? xcd * (q + 1) : r * (q + 1) + (xcd - r) * q) + off; }
        const int nig = 8 * nN, gid = wgid / nig, fm = gid * 8, gsz = (nM - fm) < 8 ? (nM - fm) : 8;
        u.pm = fm + ((wgid % nig) % gsz); u.pn = (wgid % nig) / gsz; u.e = 0; u.mt = 0; u.nrows = 256; return true;
    }
    __device__ __forceinline__ const void* a_base() const { return A; }
    __device__ __forceinline__ const void* b_base() const { return Bt; }
    __device__ __forceinline__ unsigned a_off(const pg8::Unit& u) const { return (unsigned)u.pm * (256u * 2048 * 2); }
    __device__ __forceinline__ unsigned b_off(const pg8::Unit& u) const { return (unsigned)u.pn * (256u * 2048 * 2); }
    __device__ __forceinline__ int a_row(const pg8::Unit&, int r) const { return r; }
};
typedef OrderStaticT<false> OrderStatic;
template <int NT, bool GATHER_A, int RB  > struct OrderMoe {
    static constexpr bool HALF_UNITS = HALF_UNITS_CFG != 0;
    static constexpr bool RSPLIT = NSPLIT_CFG != 0 && NT == 16;
    static constexpr bool NSPLIT = NSPLIT_CFG != 0 && NT == 8;
    static constexpr bool B_BLOCKED = FP8_MOE != 0;
    __device__ __forceinline__ unsigned b_kstep() const { return (unsigned)(bstride / 16); }
    int G, c, tb_lane, cn_lane, tbf_lane, tbh_lane; const char* A; const char* Bt; const int* stok; size_t bstride;
    const char* xprobe; gu32* qcnt; volatile LAS int* bw; int xc; bool dyn;
    __device__ __forceinline__ void init(int G_, int c_, const LAS int* TB, const LAS int* CN, int lane, const void* A_, const void* Bt_, size_t bstride_, const int* stok_, gu32* qcnt_, volatile LAS int* bw_, bool dyn_) {
        G = G_; c = c_; tb_lane = TB[lane < 32 ? lane : 32]; cn_lane = CN[lane & 31]; tbf_lane = TB[128 + (lane < 32 ? lane : 32)]; tbh_lane = TB[192 + (lane < 32 ? lane : 32)]; A = (const char*)A_; Bt = (const char*)Bt_; bstride = bstride_; stok = stok_;
        dyn = dyn_; xc = c_ >> 5; qcnt = qcnt_ + 64 * xc; bw = bw_; }
    __device__ __forceinline__ bool next(int i, pg8::Unit& u) const {
        int L = i * G + c;
        if (dyn) {
            if (__builtin_amdgcn_readfirstlane((int)(threadIdx.x >> 6)) == 0) { const unsigned v = __hip_atomic_fetch_add(qcnt, (threadIdx.x & 63) == 0 ? 1u : 0u, RLX_AGENT); bw[0] = __builtin_amdgcn_readfirstlane((int)v); }
            asm volatile("s_waitcnt lgkmcnt(0)" ::: "memory"); __builtin_amdgcn_s_barrier(); asm volatile("" ::: "memory");
            const int j = __builtin_amdgcn_readfirstlane(bw[0]);
            L = ((j >> 5) * 8 + xc) * 32 + (j & 31);
        }
        const int tfl = HALF_LAST ? tbf_lane : tb_lane;
        const int nfull = __builtin_amdgcn_readlane(tfl, 32) * NT, total = nfull + (HALF_LAST ? __builtin_amdgcn_readlane(tbh_lane, 32) * NT : 0);
        u.nh = 0; u.rh = 0; u.roff = 0;
        if ((NSPLIT || RSPLIT) && !dyn) { const int R = total / G, T = total - R * G;
            if (T > 0 && 2 * T <= G && L >= R * G) { const int Lp = L - R * G; if (Lp >= 2 * T) return false; L = R * G + (Lp >> 1); if (NSPLIT) u.nh = 1 + (Lp & 1); else u.rh = 1 + (Lp & 1); } }
        if (L >= total) return false;
        const int lane = threadIdx.x & 63;
        if (L < nfull) {
            const unsigned long long mk = __ballot(lane < 32 && tfl * NT <= L);
            const int e = __builtin_popcountll(mk) - 1;
            const int tfe = __builtin_amdgcn_readlane(tfl, e), tfe1 = __builtin_amdgcn_readlane(tfl, e + 1), tbe = __builtin_amdgcn_readlane(tb_lane, e), cne = __builtin_amdgcn_readlane(cn_lane, e);
            const int r = L - tfe * NT, mtiles = tfe1 - tfe, grp = mtiles * 8, ng = r / grp, r2 = r - ng * grp, mt = r2 >> 3, n8 = r2 & 7;
            u.e = e; u.mt = mt; u.pm = tbe + mt; u.pn = ng * 8 + n8; const int left = cne - mt * 256; u.nrows = left < 256 ? left : 256;
        } else {
            const int Lh = L - nfull;
            const unsigned long long mk = __ballot(lane < 32 && tbh_lane * NT <= Lh);
            const int e = __builtin_popcountll(mk) - 1;
            const int the = __builtin_amdgcn_readlane(tbh_lane, e), tbe = __builtin_amdgcn_readlane(tb_lane, e), tbe1 = __builtin_amdgcn_readlane(tb_lane, e + 1), cne = __builtin_amdgcn_readlane(cn_lane, e);
            const int mt = tbe1 - tbe - 1;
            u.e = e; u.mt = mt; u.pm = tbe + mt; u.pn = Lh - the * NT; u.nrows = cne - mt * 256;
        }
        if (RSPLIT && u.rh) {
            if (u.rh == 1) u.nrows = u.nrows < 128 ? u.nrows : 128;
            else if (u.nrows > 128) { u.roff = 128; u.nrows -= 128; }
            else { u.rh = 3; }
        }
        return true;
    }
    __device__ __forceinline__ const void* a_base() const { return A; }
    __device__ __forceinline__ const void* b_base() const { return Bt; }
    __device__ __forceinline__ unsigned a_off(const pg8::Unit& u) const { return GATHER_A ? 0u : (unsigned)u.pm * (256u * RB); }
    __device__ __forceinline__ unsigned b_off(const pg8::Unit& u) const { return (unsigned)u.e * (unsigned)bstride + (unsigned)u.pn * (256u * (B_BLOCKED ? 128 : RB)); }
    __device__ __forceinline__ int a_row(const pg8::Unit& u, int r) const { return stok[u.e * SLOTCAP + u.mt * 256 + u.roff + (r < u.nrows ? r : 0)]; }
};

struct EpiProj {
    static constexpr bool MIDSCALE = false; static constexpr int NVM = 16;
    static constexpr bool PERM = true; bf16* O; int ldc;
    __device__ __forceinline__ void operator()(const f32x4 (&acc)[2][2][4][2], const pg8::Unit& u, int wr, int wc, int fr, int fq) const {
        const int row0 = u.pm * 256 + wr * 64 + fr, col0 = u.pn * 256 + wc * 32 + 8 * fq;
#pragma unroll
        for (int ai = 0; ai < 2; ++ai)
#pragma unroll
            for (int m = 0; m < 4; ++m) { bf16* rowp = O + (size_t)(row0 + ai * 128 + m * 16) * ldc + col0;
#pragma unroll
                for (int bj = 0; bj < 2; ++bj) { if (u.nh == 2 - bj) continue; const f32x4 v0 = acc[ai][bj][m][0], v1 = acc[ai][bj][m][1];
                    v4u w; w.x = pk2(v0[0], v0[1]); w.y = pk2(v0[2], v0[3]); w.z = pk2(v1[0], v1[1]); w.w = pk2(v1[2], v1[3]);
                    *(v4u*)(rowp + bj * 128) = w; } }
    }
};
struct EpiRes {
    static constexpr int NVM = 48; static constexpr bool PERM = H_BF16 != 0; const float* base; float* out;
    static constexpr bool MIDSCALE = FUSE_P4 != 0; gu32* ssq;
    __device__ __forceinline__ float mid_load(const pg8::Unit& u) const { const int t = threadIdx.x; return t < 256 ? __builtin_bit_cast(float, __hip_atomic_load(ssq + u.pm * 256 + t, RLX_AGENT)) : 0.f; }
    __device__ __forceinline__ float mid_factor(float raw) const { return 1.f / sqrtf(raw * (1.f / 1024.f) + EPS); }
    __device__ __forceinline__ void operator()(const f32x4 (&acc)[2][2][4][2], const pg8::Unit& u, int wr, int wc, int fr, int fq) const {
#if H_BF16
        const int row0 = u.pm * 256 + wr * 64 + fr, col0 = u.pn * 256 + wc * 32 + 8 * fq;
#pragma unroll
        for (int ai = 0; ai < 2; ++ai)
#pragma unroll
            for (int m = 0; m < 4; ++m) { const size_t off = (size_t)(row0 + ai * 128 + m * 16) * DM + col0;
#pragma unroll
                for (int bj = 0; bj < 2; ++bj) { const f32x4 x0 = *(const f32x4*)(base + off + bj * 128), x1 = *(const f32x4*)(base + off + bj * 128 + 4); const f32x4 v0 = x0 + acc[ai][bj][m][0], v1 = x1 + acc[ai][bj][m][1];
                    v4u w; w.x = pk2(v0[0], v0[1]); w.y = pk2(v0[2], v0[3]); w.z = pk2(v1[0], v1[1]); w.w = pk2(v1[2], v1[3]);
                    *(v4u*)((bf16*)out + off + bj * 128) = w; } }
#else
        const int row0 = u.pm * 256 + wr * 64 + fr, col0 = u.pn * 256 + wc * 32 + 4 * fq;
#pragma unroll
        for (int ai = 0; ai < 2; ++ai)
#pragma unroll
            for (int m = 0; m < 4; ++m) { const size_t off = (size_t)(row0 + ai * 128 + m * 16) * DM + col0;
                f32x4 xb[2][2];
#pragma unroll
                for (int bj = 0; bj < 2; ++bj)
#pragma unroll
                    for (int n = 0; n < 2; ++n) xb[bj][n] = *(const f32x4*)(base + off + bj * 128 + n * 16);
#pragma unroll
                for (int bj = 0; bj < 2; ++bj)
#pragma unroll
                    for (int n = 0; n < 2; ++n) *(f32x4*)(out + off + bj * 128 + n * 16) = xb[bj][n] + acc[ai][bj][m][n]; }
#endif
    }
};
__device__ __forceinline__ float swiglu1(float g, float u) {
    g = fminf(g, SW_LIMIT); u = fminf(fmaxf(u, -SW_LIMIT), SW_LIMIT);
    const float glu = g * __builtin_amdgcn_rcpf(1.f + __expf(-SW_ALPHA * g));
    return (u + 1.f) * glu;
}
__device__ __forceinline__ f32x2 swiglu2(f32x2 g, f32x2 u) {
    g.x = fminf(g.x, SW_LIMIT); g.y = fminf(g.y, SW_LIMIT);
    u.x = fminf(fmaxf(u.x, -SW_LIMIT), SW_LIMIT); u.y = fminf(fmaxf(u.y, -SW_LIMIT), SW_LIMIT);
    const f32x2 t = g * (f32x2){-SW_ALPHA * LOG2E, -SW_ALPHA * LOG2E};
    f32x2 e; e.x = __builtin_amdgcn_exp2f(t.x); e.y = __builtin_amdgcn_exp2f(t.y);
    e = e + (f32x2){1.f, 1.f};
    f32x2 r; r.x = __builtin_amdgcn_rcpf(e.x); r.y = __builtin_amdgcn_rcpf(e.y);
    const f32x2 glu = g * r;
    return __builtin_elementwise_fma(u, glu, glu);
}
struct EpiGlu {
    static constexpr bool MIDSCALE = false; static constexpr int NVM = 8; static constexpr bool PERM = true; void* act; const float* bg; const float* bu;
    __device__ __forceinline__ void operator()(const f32x4 (&acc)[2][2][4][2], const pg8::Unit& u, int wr, int wc, int fr, int fq) const {
        if (u.rh == 3) return;
        const int row0 = u.pm * 256 + u.roff + wr * 64 + fr, colf = u.pn * 128 + wc * 32 + 8 * fq;
        f32x4 g_b[2], u_b[2];
#pragma unroll
        for (int n = 0; n < 2; ++n) { g_b[n] = *(const f32x4*)(bg + (size_t)u.e * DFF + colf + 4 * n); u_b[n] = *(const f32x4*)(bu + (size_t)u.e * DFF + colf + 4 * n); }
#pragma unroll
        for (int ai = 0; ai < 2; ++ai) { if (u.rh != 0 && ai == 1) continue;
#pragma unroll
            for (int m = 0; m < 4; ++m) { float r[8];
#pragma unroll
                for (int n = 0; n < 2; ++n) { const float ds_ = (FP8_MOE && (FP8_DIAG || FP8_NOSCALE)) ? (1.f / 64.f) : 1.f; const f32x4 g = acc[ai][0][m][n] * ds_ + g_b[n], uu = acc[ai][1][m][n] * ds_ + u_b[n];
#pragma unroll
                    for (int j = 0; j < 4; j += 2) { const f32x2 r2 = swiglu2((f32x2){g[j], g[j + 1]}, (f32x2){uu[j], uu[j + 1]}); r[4 * n + j] = r2.x; r[4 * n + j + 1] = r2.y;
                        if (EMU_FP8) { r[4 * n + j] = q8(r[4 * n + j]); r[4 * n + j + 1] = q8(r[4 * n + j + 1]); } } }
#if FP8_MOE
                v2u w; w.x = pk4_fp8(r[0], r[1], r[2], r[3]); w.y = pk4_fp8(r[4], r[5], r[6], r[7]);
                *(v2u*)((unsigned char*)act + (size_t)(row0 + ai * 128 + m * 16) * DFF + colf) = w; }
#else
                v4u w; w.x = pk2(r[0], r[1]); w.y = pk2(r[2], r[3]); w.z = pk2(r[4], r[5]); w.w = pk2(r[6], r[7]);
                *(v4u*)((bf16*)act + (size_t)(row0 + ai * 128 + m * 16) * DFF + colf) = w; }
#endif
        }
    }
};
struct EpiDown {
    static constexpr bool MIDSCALE = false; static constexpr int NVM = 16; static constexpr bool PERM = true; bf16* ys; const float* bd; const float* sgate; const int* sdest;
    __device__ __forceinline__ void operator()(const f32x4 (&acc)[2][2][4][2], const pg8::Unit& u, int wr, int wc, int fr, int fq) const {
        const int col0 = u.pn * 256 + wc * 32 + 8 * fq;
        f32x4 bv[2][2];
#pragma unroll
        for (int bj = 0; bj < 2; ++bj)
#pragma unroll
            for (int n = 0; n < 2; ++n) bv[bj][n] = *(const f32x4*)(bd + (size_t)u.e * DM + col0 + bj * 128 + 4 * n);
        float gts[2][4]; int dsts[2][4];
#pragma unroll
        for (int ai = 0; ai < 2; ++ai)
#pragma unroll
            for (int m = 0; m < 4; ++m) { const int rl = ai * 128 + wr * 64 + m * 16 + fr; const int slot = u.e * SLOTCAP + u.mt * 256 + (rl < u.nrows ? rl : 0); gts[ai][m] = sgate[slot]; dsts[ai][m] = sdest[slot]; }
#pragma unroll
        for (int ai = 0; ai < 2; ++ai)
#pragma unroll
            for (int m = 0; m < 4; ++m) { const int rl = ai * 128 + wr * 64 + m * 16 + fr;
                if (rl < u.nrows) { const float gt = gts[ai][m]; const int dest = dsts[ai][m];
#pragma unroll
                    for (int bj = 0; bj < 2; ++bj) { if (u.nh == 2 - bj) continue; const float ds_ = (FP8_MOE && (FP8_DIAG || FP8_NOSCALE)) ? (1.f / 64.f) : 1.f; const f32x4 v0 = (acc[ai][bj][m][0] * ds_ + bv[bj][0]) * gt, v1 = (acc[ai][bj][m][1] * ds_ + bv[bj][1]) * gt;
#if YSLOT_FP8
                        v2u w; w.x = pk4_fp8(v0[0], v0[1], v0[2], v0[3]); w.y = pk4_fp8(v1[0], v1[1], v1[2], v1[3]);
                        *(v2u*)((unsigned char*)ys + (size_t)dest * DM + col0 + bj * 128) = w; } } }
#else
                        v4u w; w.x = pk2(v0[0], v0[1]); w.y = pk2(v0[2], v0[3]); w.z = pk2(v1[0], v1[1]); w.w = pk2(v1[2], v1[3]);
                        *(v4u*)(ys + (size_t)dest * DM + col0 + bj * 128) = w; } } }
#endif
    }
};

__device__ __forceinline__ void unpack8(const v4u w, float (&f)[8]) { f[0] = bflo(w.x); f[1] = bfhi(w.x); f[2] = bflo(w.y); f[3] = bfhi(w.y); f[4] = bflo(w.z); f[5] = bfhi(w.z); f[6] = bflo(w.w); f[7] = bfhi(w.w); }
__device__ __forceinline__ v4u pack8f(const float (&f)[8]) { v4u w; w.x = pk2(f[0], f[1]); w.y = pk2(f[2], f[3]); w.z = pk2(f[4], f[5]); w.w = pk2(f[6], f[7]); return w; }
__device__ __forceinline__ void p2_post(Frame& F) {
    const int gw = F.vcu * NWAVES + F.wave, NGW = F.G * NWAVES, lane = TLANE();
    const bf16* proj = WSP(bf16, WS_PROJ);
    const bool scan = F.vcu < BATCH * AH;
    float fraw[4] = {0.f, 0.f, 0.f, 0.f};
    if (scan) { const int b = F.vcu >> 3, h = F.vcu & 7;
#pragma unroll
        for (int i = 0; i < 4; ++i) fraw[i] = bf2f(proj[(size_t)(b * SEQ + 256 * F.wave + 4 * lane + i) * NP + O_F + h]); }
    for (int t0 = 4 * gw; t0 < NTOK; t0 += 4 * NGW) {
        const int s0 = t0 & 2047;
        v4u xr[3][7];
#pragma unroll
        for (int j8 = 0; j8 < 2; ++j8)
#pragma unroll
            for (int i = 0; i < 7; ++i) { xr[j8][i] = (v4u){0u, 0u, 0u, 0u}; if (s0 + i - 3 >= 0) xr[j8][i] = *(const v4u*)(proj + (size_t)(t0 + i - 3) * NP + O_XBC + 512 * j8 + 8 * lane); }
        v4u raw[4][2][2];
#pragma unroll
        for (int ti = 0; ti < 4; ++ti)
#pragma unroll
            for (int qk = 0; qk < 2; ++qk) { const v4u* src = (const v4u*)(proj + (size_t)(t0 + ti) * NP + (qk ? O_K : O_Q) + 16 * lane); raw[ti][qk][0] = src[0]; raw[ti][qk][1] = src[1]; }
        float dtraw[4];
#pragma unroll
        for (int ti = 0; ti < 4; ++ti) dtraw[ti] = bf2f(proj[(size_t)(t0 + ti) * NP + O_DT + (lane & 15)]);
        {
            const int d0 = (16 * lane) & 127, h = lane >> 3;
            float gqv[16], gkv[16];
#pragma unroll
            for (int j = 0; j < 16; ++j) { gqv[j] = F.gq[d0 + j] * QSCALE; gkv[j] = F.gk[d0 + j]; }
            const float dtb = F.dt_bias[lane & 15], An = -__expf(F.a_log[lane & 15]);
#pragma unroll
            for (int ti = 0; ti < 4; ++ti) { const int t = t0 + ti, b = t >> 11, s = t & 2047;
#pragma unroll
                for (int qk = 0; qk < 2; ++qk) {
                    float f[16]; { float a[8], c[8]; unpack8(raw[ti][qk][0], a); unpack8(raw[ti][qk][1], c);
#pragma unroll
                        for (int j = 0; j < 8; ++j) { f[j] = a[j]; f[8 + j] = c[j]; } }
                    float ss = 0.f;
#pragma unroll
                    for (int j = 0; j < 16; ++j) ss += f[j] * f[j];
                    ss += __shfl_xor(ss, 1); ss += __shfl_xor(ss, 2); ss += __shfl_xor(ss, 4);
                    const float rstd = 1.f / sqrtf(ss * (1.f / 128.f) + EPS);
                    float o0[8], o1[8];
#pragma unroll
                    for (int j = 0; j < 8; ++j) { o0[j] = f[j] * rstd * (qk ? gkv[j] : gqv[j]); o1[j] = f[8 + j] * rstd * (qk ? gkv[8 + j] : gqv[8 + j]); }
                    v4u* dst = (v4u*)(WSP(bf16, qk ? WS_KN : WS_QN) + ((size_t)((b * AH + h) * SEQ + s)) * AHD + d0);
                    dst[0] = pack8f(o0); dst[1] = pack8f(o1);
                }
                if (lane < 16) { const float dt = softplusf_(dtraw[ti] + dtb);
                    WSP(float, WS_DTV)[t * 16 + lane] = dt; WSP(float, WS_DAV)[t * 16 + lane] = dt * An; } }
        }
#pragma unroll
        for (int i = 0; i < 7; ++i) { xr[2][i] = (v4u){0u, 0u, 0u, 0u}; if (s0 + i - 3 >= 0) xr[2][i] = *(const v4u*)(proj + (size_t)(t0 + i - 3) * NP + O_XBC + 1024 + 8 * lane); }
#pragma unroll
        for (int j8 = 0; j8 < 3; ++j8) {
            const int c0 = 512 * j8 + 8 * lane;
            float cw[4][8], cb[8];
#pragma unroll
            for (int tap = 0; tap < 4; ++tap)
#pragma unroll
                for (int j = 0; j < 8; ++j) cw[tap][j] = F.conv_w[tap * CONVCH + c0 + j];
#pragma unroll
            for (int j = 0; j < 8; ++j) cb[j] = F.conv_b[c0 + j];
#pragma unroll
            for (int ti = 0; ti < 4; ++ti) { float a[8];
#pragma unroll
                for (int j = 0; j < 8; ++j) a[j] = cb[j];
#pragma unroll
                for (int tap = 0; tap < 4; ++tap) { float xv[8]; unpack8(xr[j8][ti + tap], xv);
#pragma unroll
                    for (int j = 0; j < 8; ++j) a[j] += cw[tap][j] * xv[j]; }
#pragma unroll
                for (int j = 0; j < 8; ++j) a[j] = siluf_(a[j]);
                *(v4u*)(WSP(bf16, WS_XCONV) + (size_t)(t0 + ti) * CONVCH + c0) = pack8f(a); }
        }
    }
    if (scan) {
        LAS float* WT = (LAS float*)(F.lds + RING_OFF);
        const int bh = F.vcu, h = bh & 7; const float fb = F.fbias[h];
        float lf[4]; float tot = 0.f;
#pragma unroll
        for (int i = 0; i < 4; ++i) { const float xv = fraw[i] + fb; lf[i] = fminf(xv, 0.f) - log1pf(__expf(-fabsf(xv))); tot += lf[i]; }
        float inc = tot;
#pragma unroll
        for (int o = 1; o < 64; o <<= 1) { const float v = __shfl_up(inc, o); if (lane >= o) inc += v; }
        if (lane == 63) WT[F.wave] = inc;
        LDS_WAIT(); __syncthreads();
        float run = inc - tot;
        for (int w = 0; w < F.wave; ++w) run += WT[w];
        f32x4 o;
        run += lf[0]; o.x = run * LOG2E; run += lf[1]; o.y = run * LOG2E; run += lf[2]; o.z = run * LOG2E; run += lf[3]; o.w = run * LOG2E;
        *(f32x4*)(WSP(float, WS_ACUM) + (size_t)bh * SEQ + 256 * F.wave + 4 * lane) = o;
        __syncthreads();
    }
}

__device__ __forceinline__ void p3_attn_naive(Frame& F) {
    const int gw = F.vcu * NWAVES + F.wave, NGW = F.G * NWAVES, lane = TLANE();
    LAS float* qs = (LAS float*)(F.lds + RING_OFF + F.wave * 1024);
    const bf16* QN = WSP(bf16, WS_QN); const bf16* KN = WSP(bf16, WS_KN); const bf16* proj = WSP(bf16, WS_PROJ); const float* AC = WSP(float, WS_ACUM);
    for (int idx = gw; idx < BATCH * AH * SEQ; idx += NGW) {
        const int bh = idx >> 11, q = ((idx & 2047) + bh * 1031) & 2047, b = bh >> 3, h = bh & 7;
        { const unsigned w = *(const unsigned*)(QN + ((size_t)bh * SEQ + q) * AHD + 2 * lane); qs[2 * lane] = bflo(w); qs[2 * lane + 1] = bfhi(w); }
        LDS_WAIT();
        const float Aq = AC[(size_t)bh * SEQ + q];
        float m = -1e30f, l = 0.f, o0 = 0.f, o1 = 0.f;
        for (int kt = 0; kt * 64 <= q; ++kt) {
            const int key = kt * 64 + lane;
            const v4u* kp = (const v4u*)(KN + ((size_t)bh * SEQ + key) * AHD);
            float s = 0.f;
#pragma unroll
            for (int c = 0; c < 16; ++c) { float kf[8]; unpack8(kp[c], kf); const f32x4 q0 = ((const LAS f32x4*)qs)[2 * c], q1 = ((const LAS f32x4*)qs)[2 * c + 1];
                s += kf[0] * q0.x + kf[1] * q0.y + kf[2] * q0.z + kf[3] * q0.w + kf[4] * q1.x + kf[5] * q1.y + kf[6] * q1.z + kf[7] * q1.w; }
            s += Aq - AC[(size_t)bh * SEQ + key];
            if (key > q) s = -__builtin_inff();
            const float mt = wave_max(s), mn = fmaxf(m, mt), alpha = __builtin_amdgcn_exp2f(m - mn), p = __builtin_amdgcn_exp2f(s - mn);
            l = l * alpha + wave_sum(p); o0 *= alpha; o1 *= alpha; m = mn;
            const int nk = (q - kt * 64 + 1) < 64 ? (q - kt * 64 + 1) : 64;
            for (int kk = 0; kk < nk; ++kk) { const float pk = __shfl(p, kk);
                const unsigned w = *(const unsigned*)(proj + (size_t)(b * SEQ + kt * 64 + kk) * NP + O_V + h * AHD + 2 * lane);
                o0 += pk * bflo(w); o1 += pk * bfhi(w); }
        }
        const float il = 1.f / l;
        *(unsigned*)(WSP(bf16, WS_MIX) + (size_t)(b * SEQ + q) * DM + h * AHD + 2 * lane) = pk2(o0 * il, o1 * il);
        LDS_WAIT();
    }
}
__device__ __forceinline__ void p3_ssd_naive(Frame& F) {
    const int gw = F.vcu * NWAVES + F.wave, lane = TLANE();
    if (gw >= BATCH * SH) return;
    const int b = gw >> 4, h = gw & 15, g = h >> 3;
    LAS float* LB = (LAS float*)(F.lds + RING_OFF + 8192 + F.wave * 1024); LAS float* LC = LB + 128;
    const bf16* xc = WSP(bf16, WS_XCONV); const bf16* proj = WSP(bf16, WS_PROJ);
    const float dsk = F.d_skip[h];
    float hst[128];
#pragma unroll
    for (int n = 0; n < 128; ++n) hst[n] = 0.f;
    for (int t = 0; t < SEQ; ++t) {
        const int tok = b * SEQ + t;
        const float dt = WSP(float, WS_DTV)[tok * 16 + h], dec = __expf(WSP(float, WS_DAV)[tok * 16 + h]);
        const float xs = bf2f(xc[(size_t)tok * CONVCH + h * SHD + lane]), xdt = xs * dt;
        const unsigned bw = *(const unsigned*)(xc + (size_t)tok * CONVCH + SW + g * SN + 2 * lane), cw = *(const unsigned*)(xc + (size_t)tok * CONVCH + SW + SG * SN + g * SN + 2 * lane);
        LB[2 * lane] = bflo(bw); LB[2 * lane + 1] = bfhi(bw); LC[2 * lane] = bflo(cw); LC[2 * lane + 1] = bfhi(cw);
        LDS_WAIT();
        float y = 0.f;
#pragma unroll
        for (int n4 = 0; n4 < 32; ++n4) { const f32x4 bv = ((const LAS f32x4*)LB)[n4], cv = ((const LAS f32x4*)LC)[n4];
#pragma unroll
            for (int j = 0; j < 4; ++j) { hst[4 * n4 + j] = hst[4 * n4 + j] * dec + xdt * bv[j]; y += cv[j] * hst[4 * n4 + j]; } }
        LDS_WAIT();
        y += xs * dsk;
        const float z = bf2f(proj[(size_t)tok * NP + O_Z + h * SHD + lane]);
        const float yg = y * siluf_(z);
        const float ss = wave_sum(yg * yg);
        if (lane == 0) atomicAdd((float*)(F.ctl + CW_SSQ) + tok, ss);
        WSP(bf16, WS_MIX)[(size_t)tok * DM + AW + h * SHD + lane] = (bf16)f2bf(yg);
    }
}

__device__ __forceinline__ void p4_ssdnorm(Frame& F) {
    const int gw = F.vcu * NWAVES + F.wave, NGW = F.G * NWAVES, lane = TLANE();
    float gv[16];
#pragma unroll
    for (int j = 0; j < 16; ++j) gv[j] = F.ssd_g[16 * lane + j];
    for (int t0 = 4 * gw; t0 < NTOK; t0 += 4 * NGW) {
        float ssq[4]; v4u r0[4], r1[4];
#pragma unroll
        for (int ti = 0; ti < 4; ++ti) { ssq[ti] = __builtin_bit_cast(float, __hip_atomic_load(F.ctl + CW_SSQ + t0 + ti, RLX_AGENT));
            const v4u* p = (const v4u*)(WSP(bf16, WS_MIX) + (size_t)(t0 + ti) * DM + AW + 16 * lane); r0[ti] = p[0]; r1[ti] = p[1]; }
#pragma unroll
        for (int ti = 0; ti < 4; ++ti) { const float rs = 1.f / sqrtf(ssq[ti] * (1.f / 1024.f) + EPS);
            float a[8], c[8]; unpack8(r0[ti], a); unpack8(r1[ti], c);
#pragma unroll
            for (int j = 0; j < 8; ++j) { a[j] *= rs * gv[j]; c[j] *= rs * gv[8 + j]; if (EMU_OUT8) { a[j] = q8(a[j]); c[j] = q8(c[j]); } }
            v4u* p = (v4u*)(WSP(bf16, WS_MIX) + (size_t)(t0 + ti) * DM + AW + 16 * lane); p[0] = pack8f(a); p[1] = pack8f(c); }
    }
#if EMU_OUT8
    for (int t0 = gw; t0 < NTOK; t0 += NGW) { v4u* p = (v4u*)(WSP(bf16, WS_MIX) + (size_t)t0 * DM + 16 * lane); v4u r0 = p[0], r1 = p[1]; float a[8], c[8]; unpack8(r0, a); unpack8(r1, c);
        for (int j = 0; j < 8; ++j) { a[j] = q8(a[j]); c[j] = q8(c[j]); } p[0] = pack8f(a); p[1] = pack8f(c); }
#endif
}

__device__ __forceinline__ void p6_router(Frame& F) {
    const int tid = TTID(), lane = tid & 63, wave = F.wave, r16 = lane & 15, q4 = lane >> 4;
    LAS float* RED = (LAS float*)(F.lds + RING_OFF);
    LAS int* LC = (LAS int*)(F.lds + RING_OFF + 8 * 32 * 33 * 4); LAS int* LB = LC + 32;
    const bf16* WRH = WSP(bf16, WS_WR); const bf16* WRL = WRH + NE * 2048;
    gu32* cnt = F.ctl + CW_CNT;
    for (int unit = F.vcu; unit < NTOK / 32; unit += F.G) {
        const int T0 = unit * 32;
        float rs[4];
#if H_BF16 && FP8_MOE
        { const int tok = T0 + 4 * wave; const bf16* hr = WSP(bf16, WS_H) + (size_t)tok * DM + 8 * lane;
            v4u v[4][4];
#pragma unroll
            for (int q = 0; q < 4; ++q)
#pragma unroll
                for (int j = 0; j < 4; ++j) v[q][j] = *(const v4u*)(hr + (size_t)q * DM + 512 * j);
#pragma unroll
            for (int q = 0; q < 4; ++q) { float s0 = 0.f;
#pragma unroll
                for (int j = 0; j < 4; ++j) { float f[8]; unpack8(v[q][j], f);
#pragma unroll
                    for (int i = 0; i < 8; ++i) s0 += f[i] * f[i]; }
                rs[q] = 1.f / sqrtf(wave_sum(s0) * (1.f / 2048.f) + EPS); }
#pragma unroll
            for (int j = 0; j < 4; ++j) { const f32x4 g0 = *(const f32x4*)(F.g2 + 8 * lane + 512 * j), g1 = *(const f32x4*)(F.g2 + 8 * lane + 512 * j + 4);
#pragma unroll
                for (int q = 0; q < 4; ++q) { const float rstd = rs[q]; float f[8]; unpack8(v[q][j], f);
                    v2u w; w.x = pk4_fp8(f[0] * rstd * g0.x, f[1] * rstd * g0.y, f[2] * rstd * g0.z, f[3] * rstd * g0.w); w.y = pk4_fp8(f[4] * rstd * g1.x, f[5] * rstd * g1.y, f[6] * rstd * g1.z, f[7] * rstd * g1.w);
                    *(v2u*)(WSP(unsigned char, WS_XN) + (size_t)(tok + q) * DM + 8 * lane + 512 * j) = w; } }
        }
#else
        { const int tok = T0 + 4 * wave; const f32x4* xr = (const f32x4*)(F.out + (size_t)tok * DM) + lane; const f32x4* gr = (const f32x4*)F.g2 + lane;
            f32x4 v[4][8];
#pragma unroll
            for (int q = 0; q < 4; ++q)
#pragma unroll
                for (int j = 0; j < 8; ++j) v[q][j] = xr[q * (DM / 4) + 64 * j];
#pragma unroll
            for (int q = 0; q < 4; ++q) { float s0 = 0.f;
#pragma unroll
                for (int j = 0; j < 8; ++j) s0 += (v[q][j].x * v[q][j].x + v[q][j].y * v[q][j].y) + (v[q][j].z * v[q][j].z + v[q][j].w * v[q][j].w);
                rs[q] = 1.f / sqrtf(wave_sum(s0) * (1.f / 2048.f) + EPS); }
#pragma unroll
            for (int j = 0; j < 8; ++j) { const f32x4 gg = gr[64 * j];
#pragma unroll
                for (int q = 0; q < 4; ++q) { const float rstd = rs[q];
                    f32x4 t = {v[q][j].x * rstd * gg.x, v[q][j].y * rstd * gg.y, v[q][j].z * rstd * gg.z, v[q][j].w * rstd * gg.w};
                    if (EMU_FP8) { t.x = q8(t.x); t.y = q8(t.y); t.z = q8(t.z); t.w = q8(t.w); }
#if FP8_MOE
                    ((unsigned*)(WSP(unsigned char, WS_XN) + (size_t)(tok + q) * DM))[lane + 64 * j] = pk4_fp8(t.x, t.y, t.z, t.w); }
#else
                    v2u w; w.x = pk2(t.x, t.y); w.y = pk2(t.z, t.w); ((v2u*)(WSP(bf16, WS_XN) + (size_t)(tok + q) * DM) + lane)[64 * j] = w; }
#endif
            }
        }
#endif
        f32x4 acc[2][2];
#pragma unroll
        for (int a = 0; a < 2; ++a)
#pragma unroll
            for (int c = 0; c < 2; ++c) acc[a][c] = (f32x4){0.f, 0.f, 0.f, 0.f};
#pragma unroll 4
        for (int ks = 0; ks < 8; ++ks) { const int k = 256 * wave + 32 * ks + 8 * q4;
            bf16x8 bh[2], bl[2];
#pragma unroll
            for (int n = 0; n < 2; ++n) { bh[n] = *(const bf16x8*)(WRH + (size_t)(16 * n + r16) * 2048 + k); bl[n] = *(const bf16x8*)(WRL + (size_t)(16 * n + r16) * 2048 + k); }
#pragma unroll
#if H_BF16
            for (int mt = 0; mt < 2; ++mt) { const bf16x8 ah = *(const bf16x8*)(WSP(bf16, WS_H) + (size_t)(T0 + 16 * mt + r16) * DM + k);
#pragma unroll
                for (int n = 0; n < 2; ++n) { acc[mt][n] = __builtin_amdgcn_mfma_f32_16x16x32_bf16(ah, bh[n], acc[mt][n], 0, 0, 0); acc[mt][n] = __builtin_amdgcn_mfma_f32_16x16x32_bf16(ah, bl[n], acc[mt][n], 0, 0, 0); } }
#else
            for (int mt = 0; mt < 2; ++mt) { const float* xp = F.out + (size_t)(T0 + 16 * mt + r16) * DM + k;
                const f32x4 x0 = *(const f32x4*)xp, x1 = *(const f32x4*)(xp + 4);
                float xv[8] = {x0.x, x0.y, x0.z, x0.w, x1.x, x1.y, x1.z, x1.w}; float hv[8], lv[8];
#pragma unroll
                for (int j = 0; j < 8; ++j) { hv[j] = bf2f(f2bf(xv[j])); lv[j] = xv[j] - hv[j]; }
                const v4u ahw = pack8f(hv), alw = pack8f(lv);
                const bf16x8 ah = __builtin_bit_cast(bf16x8, ahw), al = __builtin_bit_cast(bf16x8, alw);
#pragma unroll
                for (int n = 0; n < 2; ++n) { acc[mt][n] = __builtin_amdgcn_mfma_f32_16x16x32_bf16(ah, bh[n], acc[mt][n], 0, 0, 0);
                    acc[mt][n] = __builtin_amdgcn_mfma_f32_16x16x32_bf16(ah, bl[n], acc[mt][n], 0, 0, 0);
                    acc[mt][n] = __builtin_amdgcn_mfma_f32_16x16x32_bf16(al, bh[n], acc[mt][n], 0, 0, 0); } }
#endif
        }
#pragma unroll
        for (int mt = 0; mt < 2; ++mt)
#pragma unroll
            for (int n = 0; n < 2; ++n)
#pragma unroll
                for (int rg = 0; rg < 4; ++rg) RED[(wave * 32 + 16 * mt + 4 * q4 + rg) * 33 + 16 * n + r16] = acc[mt][n][rg];
        if (tid < 32) LC[tid] = 0;
        __syncthreads();
        { const int tokl = tid >> 4, e2 = r16 * 2;
          const float rsel = q4 == 0 ? rs[0] : q4 == 1 ? rs[1] : q4 == 2 ? rs[2] : rs[3];
          float l0 = 0.f, l1 = 0.f;
#pragma unroll
          for (int w = 0; w < 8; ++w) { l0 += RED[(w * 32 + tokl) * 33 + e2]; l1 += RED[(w * 32 + tokl) * 33 + e2 + 1]; }
          l0 = l0 * rsel + F.b_router[e2]; l1 = l1 * rsel + F.b_router[e2 + 1];
          float val[4]; int idx[4];
#pragma unroll
          for (int k = 0; k < 4; ++k) { float bv = l0; int bi = e2; if (l1 > l0) { bv = l1; bi = e2 + 1; }
#pragma unroll
              for (int m = 1; m < 16; m <<= 1) { const float ov = __shfl_xor(bv, m); const int oi = __shfl_xor(bi, m); if (ov > bv || (ov == bv && oi < bi)) { bv = ov; bi = oi; } }
              val[k] = bv; idx[k] = bi;
              if (bi == e2) l0 = -__builtin_inff(); if (bi == e2 + 1) l1 = -__builtin_inff(); }
          float ex[4], sum = 0.f;
#pragma unroll
          for (int k = 0; k < 4; ++k) { ex[k] = __expf(val[k] - val[0]); sum += ex[k]; }
          const float inv = 1.f / sum;
          int esel = 0, loc = 0; float gsel = 0.f;
          if (r16 < 4) { const int k = r16;
              const int e = k == 0 ? idx[0] : k == 1 ? idx[1] : k == 2 ? idx[2] : idx[3]; const float g = (k == 0 ? ex[0] : k == 1 ? ex[1] : k == 2 ? ex[2] : ex[3]) * inv;
              esel = e; gsel = g; loc = __hip_atomic_fetch_add(LC + e, 1, __ATOMIC_RELAXED, __HIP_MEMORY_SCOPE_WORKGROUP); }
          __syncthreads();
          if (tid < 32) { const int c = LC[tid]; LB[tid] = c > 0 ? (int)__hip_atomic_fetch_add(cnt + 64 * tid, (unsigned)c, RLX_AGENT) : 0; }
#ifdef PROBE_AT2
          __syncthreads();
          if (tid < 32) { const int c = LC[tid]; const int d = c > 0 ? (int)__hip_atomic_fetch_add(cnt + 64 * tid + 32, (unsigned)c, RLX_AGENT) : 0; if (d < 0) LB[tid] = d; }
#endif
          __syncthreads();
          if (r16 < 4) { const int tok = T0 + tokl; const size_t sl = (size_t)esel * SLOTCAP + (LB[esel] + loc); WSP(int, WS_STOK)[sl] = tok; WSP(float, WS_SGATE)[sl] = gsel; WSP(int, WS_SDEST)[sl] = tok * 4 + r16; } }
        __syncthreads();
    }
}
__device__ __forceinline__ void moe_tables(Frame& F) {
    LAS int* TB = (LAS int*)(F.lds + TB_OFF); LAS int* CN = TB + 64; LAS int* MT = CN + 32; LAS int* TBF = MT + 32; LAS int* TBH = TBF + 64;
    const int tid = TTID();
    if (tid < NE) { const int c = (int)__hip_atomic_load(F.ctl + CW_CNT + 64 * tid, RLX_AGENT); CN[tid] = c; MT[tid] = (c + 255) >> 8; }
    __syncthreads();
    if (tid == 0) { int run = 0, rf = 0, rh = 0;
        for (int e = 0; e < NE; ++e) { const int mt = MT[e], rem = CN[e] - (mt - 1) * 256, hf = (HALF_UNITS_CFG && mt > 0 && rem <= 128) ? 1 : 0;
            TB[e] = run; TBF[e] = rf; TBH[e] = rh; run += mt; rf += mt - hf; rh += hf; }
        TB[NE] = run; TBF[NE] = rf; TBH[NE] = rh; }
    __syncthreads();
}
__device__ __forceinline__ void p9_combine(Frame& F) {
    const int gw = F.vcu * NWAVES + F.wave, NGW = F.G * NWAVES, lane = TLANE();
#if PROBE_T
    const float probe_s = 1.f + __builtin_bit_cast(float, __hip_atomic_load(F.ctl + CW_PROBE, RLX_AGENT)), probe_a = __builtin_bit_cast(float, __hip_atomic_load(F.ctl + CW_PROBE + 1, RLX_AGENT));
#endif
#if YSLOT_FP8 && H_BF16
    const unsigned char* ys = WSP(unsigned char, WS_YSLOT); const bf16* hb = WSP(bf16, WS_H);
    for (int t = gw; t < NTOK; t += NGW) {
        v4u hh[2][2], yy[2][4];
#pragma unroll
        for (int j = 0; j < 2; ++j) { const int col = 16 * lane + 1024 * j;
            hh[j][0] = *(const v4u*)(hb + (size_t)t * DM + col); hh[j][1] = *(const v4u*)(hb + (size_t)t * DM + col + 8);
#pragma unroll
            for (int k = 0; k < 4; ++k) yy[j][k] = *(const v4u*)(ys + (size_t)(4 * t + k) * DM + col); }
#pragma unroll
        for (int j = 0; j < 2; ++j) { float* op = F.out + (size_t)t * DM + 16 * lane + 1024 * j;
            float a[16]; { float f0[8], f1[8]; unpack8(hh[j][0], f0); unpack8(hh[j][1], f1);
#pragma unroll
                for (int i = 0; i < 8; ++i) { a[i] = f0[i]; a[8 + i] = f1[i]; } }
#pragma unroll
            for (int k = 0; k < 4; ++k) { const unsigned yw[4] = {yy[j][k].x, yy[j][k].y, yy[j][k].z, yy[j][k].w};
#pragma unroll
                for (int q = 0; q < 4; ++q) { a[4 * q] += __builtin_amdgcn_cvt_f32_fp8((int)yw[q], 0); a[4 * q + 1] += __builtin_amdgcn_cvt_f32_fp8((int)yw[q], 1); a[4 * q + 2] += __builtin_amdgcn_cvt_f32_fp8((int)yw[q], 2); a[4 * q + 3] += __builtin_amdgcn_cvt_f32_fp8((int)yw[q], 3); } }
#pragma unroll
            for (int q = 0; q < 4; ++q) { f32x4 o = {a[4 * q], a[4 * q + 1], a[4 * q + 2], a[4 * q + 3]};
#if PROBE_T
                o = o * probe_s; if (t == 0 && lane == 0 && j == 0 && q == 0) o.x += probe_a;
#endif
                *(f32x4*)(op + 4 * q) = o; } }
    }
#elif YSLOT_FP8
    const unsigned char* ys = WSP(unsigned char, WS_YSLOT);
    for (int t = gw; t < NTOK; t += NGW) {
#pragma unroll
        for (int j = 0; j < 2; ++j) { const int col = 16 * lane + 1024 * j; float* op = F.out + (size_t)t * DM + col;
            f32x4 a[4];
#pragma unroll
            for (int q = 0; q < 4; ++q) a[q] = *(const f32x4*)(op + 4 * q);
#pragma unroll
            for (int k = 0; k < 4; ++k) { const v4u y = *(const v4u*)(ys + (size_t)(4 * t + k) * DM + col); const unsigned yw[4] = {y.x, y.y, y.z, y.w};
#pragma unroll
                for (int q = 0; q < 4; ++q) { a[q].x += __builtin_amdgcn_cvt_f32_fp8((int)yw[q], 0); a[q].y += __builtin_amdgcn_cvt_f32_fp8((int)yw[q], 1); a[q].z += __builtin_amdgcn_cvt_f32_fp8((int)yw[q], 2); a[q].w += __builtin_amdgcn_cvt_f32_fp8((int)yw[q], 3); } }
#pragma unroll
            for (int q = 0; q < 4; ++q) *(f32x4*)(op + 4 * q) = a[q]; }
    }
#else
    const bf16* ys = WSP(bf16, WS_YSLOT);
    for (int t = gw; t < NTOK; t += NGW) {
        float* op = F.out + (size_t)t * DM + 8 * lane;
        f32x4 a0[4], a1[4]; v4u y[4][4];
#pragma unroll
        for (int j = 0; j < 4; ++j) { a0[j] = *(const f32x4*)(op + 512 * j); a1[j] = *(const f32x4*)(op + 512 * j + 4);
#pragma unroll
            for (int k = 0; k < 4; ++k) y[j][k] = __builtin_nontemporal_load((const GAS v4u*)(ys + (size_t)(4 * t + k) * DM + 8 * lane + 512 * j)); }
#pragma unroll
        for (int j = 0; j < 4; ++j) {
#pragma unroll
            for (int k = 0; k < 4; ++k) { float yv[8]; unpack8(y[j][k], yv);
                a0[j].x += yv[0]; a0[j].y += yv[1]; a0[j].z += yv[2]; a0[j].w += yv[3]; a1[j].x += yv[4]; a1[j].y += yv[5]; a1[j].z += yv[6]; a1[j].w += yv[7]; }
#if PROBE_T
            a0[j] = a0[j] * probe_s; a1[j] = a1[j] * probe_s; if (t == 0 && lane == 0 && j == 0) a0[j].x = probe_a;
#endif
            __builtin_nontemporal_store(a0[j], (GAS f32x4*)(op + 512 * j)); __builtin_nontemporal_store(a1[j], (GAS f32x4*)(op + 512 * j + 4)); }
    }
#endif
}
namespace attn {
constexpr int D = 128, NW = 8, QBLK = 32, KVBLK = 64, QB = NW * QBLK;
constexpr int SHM_V = KVBLK * D * 2, SHM_K = KVBLK * D * 2;
constexpr int ATT_LDS_BYTES = 2 * SHM_V + 2 * SHM_K + NW * 64 * 4;
constexpr int KPITCH = 128, VPITCH = NP, OPITCH = DM;
constexpr float THR2 = 11.5416f;
typedef short s16x4 __attribute__((ext_vector_type(4)));
typedef float f32x16 __attribute__((ext_vector_type(16)));
typedef unsigned u32x4 __attribute__((ext_vector_type(4)));

#define KSWZ(row, colB) ((row) * 256 + ((colB) ^ (((row) & 7) << 4)))
#define SBAR() __builtin_amdgcn_sched_barrier(0)
__device__ __forceinline__ int v_st(int k, int c) { const int kk = (k & ~0xC) | ((k & 4) << 1) | ((k & 8) >> 1); return ((kk >> 3) * 4 + (c >> 5)) * 512 + ((kk & 7) * 32 + (c & 31)) * 2; }
__device__ __forceinline__ int v_rd_base(int lane) { return ((lane & 3) << 3) | (((lane >> 2) & 3) << 6) | (((lane >> 4) & 1) << 5) | (((lane >> 5) & 1) << 8); }
constexpr int v_rd_off(int d0, int ks, int half) { return d0 * 512 + ks * 4096 + half * 2048; }
__device__ __forceinline__ int crow(int r, int hi) { return (r & 3) + 8 * (r >> 2) + 4 * hi; }
__device__ __forceinline__ unsigned cvtpk(float lo, float hi) { unsigned r; asm volatile("v_cvt_pk_bf16_f32 %0, %1, %2" : "=v"(r) : "v"(lo), "v"(hi)); return r; }
__device__ __forceinline__ void mask_tile(f32x16& p0, f32x16& p1, int dq) {
    const float NEG = -__builtin_inff();
#pragma unroll
    for (int r = 0; r < 16; ++r) {
        const int c = (r & 3) + 8 * (r >> 2);
        if (dq - c < 0) p0[r] = NEG;
        if (dq - c - 32 < 0) p1[r] = NEG;
    }
}
__device__ __forceinline__ void partialSM(f32x16& p0, f32x16& p1, float& m_reg, float& mn, float& alpha) {
    float pmax = p0[0]; for (int r = 1; r < 16; ++r) pmax = fmaxf(pmax, p0[r]); for (int r = 0; r < 16; ++r) pmax = fmaxf(pmax, p1[r]);
    { auto rr = __builtin_amdgcn_permlane32_swap(__float_as_uint(pmax), __float_as_uint(pmax), false, false);
      pmax = fmaxf(__uint_as_float(rr[0]), __uint_as_float(rr[1])); }
    if (__builtin_expect(__all((pmax - m_reg) <= THR2), 1)) { mn = m_reg; alpha = 1.f; }
    else { mn = fmaxf(m_reg, pmax); alpha = __builtin_amdgcn_exp2f(m_reg - mn); m_reg = mn; }
    for (int r = 0; r < 16; ++r) p0[r] = p0[r] - mn; for (int r = 0; r < 16; ++r) p1[r] = p1[r] - mn;
    for (int r = 0; r < 16; ++r) p0[r] = __builtin_amdgcn_exp2f(p0[r]);
}
__device__ __forceinline__ void finishSM(f32x16& p0, f32x16& p1, float alpha, float& l_reg, bf16x8& pa0, bf16x8& pa1, bf16x8& pa2, bf16x8& pa3) {
    for (int r = 0; r < 16; ++r) p1[r] = __builtin_amdgcn_exp2f(p1[r]);
    float ps = 0; for (int r = 0; r < 16; ++r) ps += p0[r]; for (int r = 0; r < 16; ++r) ps += p1[r];
    { auto rr = __builtin_amdgcn_permlane32_swap(__float_as_uint(ps), __float_as_uint(ps), false, false);
      ps = __uint_as_float(rr[0]) + __uint_as_float(rr[1]); }
    l_reg = l_reg * alpha + ps;
#define PK4(P, B_, OUT) do { unsigned a0 = cvtpk(P[B_+0], P[B_+1]), a1 = cvtpk(P[B_+2], P[B_+3]);                          \
        unsigned b0 = cvtpk(P[B_+4], P[B_+5]), b1 = cvtpk(P[B_+6], P[B_+7]);                                             \
        auto r0 = __builtin_amdgcn_permlane32_swap(a0, b0, false, false); auto r1 = __builtin_amdgcn_permlane32_swap(a1, b1, false, false); \
        u32x4 w = {r0[0], r1[0], r0[1], r1[1]}; OUT = *reinterpret_cast<bf16x8*>(&w); } while (0)
    PK4(p0, 0, pa0); PK4(p0, 8, pa1); PK4(p1, 0, pa2); PK4(p1, 8, pa3);
#undef PK4
}
__device__ __forceinline__ unsigned split2(float a) { const unsigned h = cvtpk(a, 0.f) & 0xffffu; const float r1 = a - __uint_as_float(h << 16); return h | (cvtpk(r1, 0.f) << 16); }
__device__ __forceinline__ bf16x8 q_aug(unsigned w) { u32x4 v = {w, 0x3f803f80u, 0u, 0u}; return *reinterpret_cast<bf16x8*>(&v); }
__device__ __forceinline__ bf16x8 k_aug(float nk, int hi) { u32x4 v = {0x3f803f80u, split2(nk), 0u, 0u}; if (hi) v = (u32x4){0u, 0u, 0u, 0u}; return *reinterpret_cast<bf16x8*>(&v); }
template <int KB>
__device__ __forceinline__ void qkt(f32x16& p0, f32x16& p1, const char* K_lds, int r32, int hi, const bf16x8* qr, unsigned qa, float ak0, float ak1, float aref) {
    p0 = f32x16{}; p1 = f32x16{};
    const char* kb[4];
#pragma unroll
    for (int dd = 0; dd < 4; ++dd) kb[dd] = K_lds + KB * SHM_K + KSWZ(r32, (dd * 16 + hi * 8) * 2);
#pragma unroll
    for (int d0 = 0; d0 < 8; ++d0) { const char* a = kb[d0 & 3] + (d0 >> 2) * 128;
        bf16x8 b0 = *reinterpret_cast<const bf16x8*>(a);
        bf16x8 b1 = *reinterpret_cast<const bf16x8*>(a + 32 * 256);
        p0 = __builtin_amdgcn_mfma_f32_32x32x16_bf16(b0, qr[d0], p0, 0, 0, 0);
        p1 = __builtin_amdgcn_mfma_f32_32x32x16_bf16(b1, qr[d0], p1, 0, 0, 0); }
    p0 = __builtin_amdgcn_mfma_f32_32x32x16_bf16(k_aug(aref - ak0, hi), q_aug(qa), p0, 0, 0, 0);
    p1 = __builtin_amdgcn_mfma_f32_32x32x16_bf16(k_aug(aref - ak1, hi), q_aug(qa), p1, 0, 0, 0);
}
template <int VB>
__device__ __forceinline__ void pv_tile(f32x16* o, int vb0, bf16x8 pa0, bf16x8 pa1, bf16x8 pa2, bf16x8 pa3) {
#define TRRD(dst, off) asm volatile("ds_read_b64_tr_b16 %0, %1 offset:%2" : "=&v"(dst) : "v"(vb0), "i"(off) : "memory")
#define PV_D0(d0) do { s16x4 l0, l1, l2, l3, h0, h1, h2, h3; constexpr int b_ = VB * SHM_V + v_rd_off(d0, 0, 0);   \
        TRRD(l0, b_); TRRD(h0, b_ + 2048); TRRD(l1, b_ + 4096); TRRD(h1, b_ + 6144); TRRD(l2, b_ + 8192); TRRD(h2, b_ + 10240); TRRD(l3, b_ + 12288); TRRD(h3, b_ + 14336); \
        asm volatile("s_waitcnt lgkmcnt(0)" ::: "memory"); SBAR();                                                                    \
        o[d0] = __builtin_amdgcn_mfma_f32_32x32x16_bf16(pa0, (bf16x8){l0[0], l0[1], l0[2], l0[3], h0[0], h0[1], h0[2], h0[3]}, o[d0], 0, 0, 0);   \
        o[d0] = __builtin_amdgcn_mfma_f32_32x32x16_bf16(pa1, (bf16x8){l1[0], l1[1], l1[2], l1[3], h1[0], h1[1], h1[2], h1[3]}, o[d0], 0, 0, 0);   \
        o[d0] = __builtin_amdgcn_mfma_f32_32x32x16_bf16(pa2, (bf16x8){l2[0], l2[1], l2[2], l2[3], h2[0], h2[1], h2[2], h2[3]}, o[d0], 0, 0, 0);   \
        o[d0] = __builtin_amdgcn_mfma_f32_32x32x16_bf16(pa3, (bf16x8){l3[0], l3[1], l3[2], l3[3], h3[0], h3[1], h3[2], h3[3]}, o[d0], 0, 0, 0); } while (0)
    PV_D0(0); PV_D0(1); PV_D0(2); PV_D0(3);
#undef PV_D0
#undef TRRD
}
struct BlockRef { const bf16* Q; const bf16* K; const bf16* V; bf16* O; const float* A; int P0; };
struct Seam { bf16x8 qr[8]; unsigned qa; bf16x8 st_v0, st_v1, st_k0, st_k1; float ak[2][2]; };
#define VMW() asm volatile("s_waitcnt vmcnt(0)" ::: "memory")
#define VMWN(n) asm volatile("s_waitcnt vmcnt(%0)" :: "i"(n) : "memory")
#define LD8(p) (*reinterpret_cast<const bf16x8*>(p))
#define SLOAD_H(Kp, Vp, Ap, k0, AB) do { S.st_v0 = LD8((Vp) + (size_t)((k0) + sr) * VPITCH + sc); S.st_v1 = LD8((Vp) + (size_t)((k0) + 32 + sr) * VPITCH + sc);   \
                         S.st_k0 = LD8((Kp) + (size_t)((k0) + sr) * KPITCH + sc); S.st_k1 = LD8((Kp) + (size_t)((k0) + 32 + sr) * KPITCH + sc);                      \
                         S.ak[AB][0] = (Ap)[(k0) + r32]; S.ak[AB][1] = (Ap)[(k0) + 32 + r32]; } while (0)
#define SWRITE_HK(bf) do { *(bf16x8*)(K_lds + (bf) * SHM_K + kws) = S.st_k0; *(bf16x8*)(K_lds + (bf) * SHM_K + kws + 32 * 256) = S.st_k1; } while (0)
#define SWRITE_HV(bf) do { *(bf16x8*)(V_lds + (bf) * SHM_V + vst0) = S.st_v0; *(bf16x8*)(V_lds + (bf) * SHM_V + vst1) = S.st_v1; } while (0)
#define SWRITE_H(bf) do { SWRITE_HV(bf); SWRITE_HK(bf); } while (0)
#define QLOAD(R) do { _Pragma("unroll") for (int d0 = 0; d0 < 8; ++d0) S.qr[d0] = LD8((R).Q + (size_t)(wid * QBLK + r32) * KPITCH + d0 * 16 + hi * 8);   \
                      S.qa = split2((R).A[(R).P0 + wid * QBLK + r32] - (R).A[(R).P0]); } while (0)
__device__ __forceinline__ void block_prime(const BlockRef& cur, char* lds, Seam& S) {
    int tid = threadIdx.x; asm volatile("" : "+v"(tid));
    const int wid = __builtin_amdgcn_readfirstlane(tid >> 6), lane = tid & 63, r32 = lane & 31, hi = lane >> 5;
    const int sr = tid >> 4, sc = (tid & 15) * 8, kws = KSWZ(sr, sc * 2); char* K_lds = lds + 2 * SHM_V;
    QLOAD(cur);
    SLOAD_H(cur.K, cur.V, cur.A, 0, 0); VMW(); SWRITE_HK(0);
    __syncthreads();
}
__device__ __forceinline__ void block_run(const BlockRef& cur, char* lds, Seam& S) {
    int tid = threadIdx.x; asm volatile("" : "+v"(tid));
    const int wid = __builtin_amdgcn_readfirstlane(tid >> 6), lane = tid & 63, r32 = lane & 31, hi = lane >> 5;
    const int NT = (cur.P0 + QB - 1) / KVBLK + 1;
    const int qlo = cur.P0 + wid * QBLK, qm = qlo + r32 - 4 * hi;
    char* V_lds = lds; char* K_lds = lds + 2 * SHM_V;
    float* ws = (float*)(lds + 2 * SHM_V + 2 * SHM_K) + wid * 64; float* li_l = ws, * al_l = ws + 32;
    float m_reg = -1e30f, l_reg = 0; f32x16 o[4] = {};
    const int sr = tid >> 4, sc = (tid & 15) * 8, vst0 = v_st(sr, sc), vst1 = v_st(32 + sr, sc), kws = KSWZ(sr, sc * 2);
    const int vb0 = (int)(uintptr_t)V_lds + v_rd_base(lane);
    const bf16* Kh = cur.K; const bf16* Vh = cur.V; const float* Ah = cur.A; const float aref = cur.A[cur.P0];
#define RESC(a) do { if (__any((a) < 1.f)) { if (hi == 0) al_l[r32] = (a); asm volatile("s_waitcnt lgkmcnt(0)" ::: "memory");              \
                     for (int d_ = 0; d_ < 4; ++d_) for (int r = 0; r < 16; ++r) o[d_][r] *= al_l[crow(r, hi)]; } } while (0)
#define KBASE(t) ((t) * KVBLK)
#define MASKT(P0_, P1_, t) do { const int kb_ = KBASE(t); if (kb_ + KVBLK - 1 > qlo) mask_tile(P0_, P1_, qm - kb_); } while (0)
    f32x16 pA0, pA1, pB0, pB1; float mnA, mnB, alA, alB; bf16x8 pa0, pa1, pa2, pa3;
    SWRITE_HV(0); SBAR();
    const float a00 = S.ak[0][0], a01 = S.ak[0][1];
    if (NT > 1) SLOAD_H(Kh, Vh, Ah, KBASE(1), 1);
    SBAR(); qkt<0>(pA0, pA1, K_lds, r32, hi, S.qr, S.qa, a00, a01, aref);
    MASKT(pA0, pA1, 0); partialSM(pA0, pA1, m_reg, mnA, alA);
    if (NT > 1) { VMW(); SWRITE_H(1); }
    __syncthreads();
#define HALF_STEP(PX0, PX1, mnX, alX, PY0, PY1, alY, t, KB, VB, SB) do {                                                      \
        SBAR(); qkt<KB>(PX0, PX1, K_lds, r32, hi, S.qr, S.qa, S.ak[KB][0], S.ak[KB][1], aref);                                             \
        finishSM(PY0, PY1, alY, l_reg, pa0, pa1, pa2, pa3); SBAR();                                                           \
        if ((t) + 1 < NT) { SLOAD_H(Kh, Vh, Ah, KBASE((t) + 1), SB); SBAR(); }                                                \
        pv_tile<VB>(o, vb0, pa0, pa1, pa2, pa3); MASKT(PX0, PX1, (t)); partialSM(PX0, PX1, m_reg, mnX, alX);                  \
        __syncthreads();                                                                                                      \
        if ((t) + 1 < NT) { VMW(); SWRITE_H(SB); }                                                                            \
        RESC(alX); __syncthreads(); } while (0)
    for (int t = 1; t + 1 < NT; t += 2) {
        HALF_STEP(pB0, pB1, mnB, alB, pA0, pA1, alA, t, 1, 0, 0);
        HALF_STEP(pA0, pA1, mnA, alA, pB0, pB1, alB, t + 1, 0, 1, 1);
    }
    const bool even = (NT & 1) == 0;
    if (even) { SBAR(); qkt<1>(pB0, pB1, K_lds, r32, hi, S.qr, S.qa, S.ak[1][0], S.ak[1][1], aref); SBAR(); }
    finishSM(pA0, pA1, alA, l_reg, pa0, pa1, pa2, pa3); SBAR();
    pv_tile<0>(o, vb0, pa0, pa1, pa2, pa3);
    if (even) { MASKT(pB0, pB1, NT - 1); partialSM(pB0, pB1, m_reg, mnB, alB); __syncthreads(); RESC(alB);
        finishSM(pB0, pB1, alB, l_reg, pa0, pa1, pa2, pa3); SBAR(); pv_tile<1>(o, vb0, pa0, pa1, pa2, pa3); }
    if (hi == 0) li_l[r32] = l_reg; asm volatile("s_waitcnt lgkmcnt(0)" ::: "memory");
    float rli[16];
#pragma unroll
    for (int r = 0; r < 16; ++r) rli[r] = __builtin_amdgcn_rcpf(li_l[crow(r, hi)]);
    bf16* Ow = cur.O + (size_t)(wid * QBLK) * OPITCH;
#pragma unroll
    for (int r = 0; r < 16; ++r) { const int orow = crow(r, hi);
#pragma unroll
        for (int d0 = 0; d0 < 4; ++d0) { const float v = o[d0][r] * rli[r];
            const float vn = __shfl_xor(v, 1);
            if ((r32 & 1) == 0) *(unsigned*)(Ow + (size_t)orow * OPITCH + d0 * 32 + r32) = cvtpk(v, vn); } }
    __syncthreads();
#undef RESC
#undef KBASE
#undef MASKT
#undef HALF_STEP
}
#undef VMW
#undef VMWN
#undef LD8
#undef SLOAD_H
#undef SWRITE_HK
#undef SWRITE_HV
#undef SWRITE_H
#undef QLOAD
#undef KSWZ
#undef SBAR
}

__device__ __forceinline__ attn::BlockRef attn_ref(Frame& F, int a) {
    const int x = a >> 5, j = a & 31, bh = 4 * x + (j & 3), qb = j >> 2, b = bh >> 3, h = bh & 7;
    attn::BlockRef r;
    r.Q = WSP(bf16, WS_QN) + ((size_t)bh * SEQ + qb * 256) * AHD; r.K = WSP(bf16, WS_KN) + (size_t)bh * SEQ * AHD;
    r.V = WSP(bf16, WS_PROJ) + (size_t)(b * SEQ) * NP + O_V + h * AHD; r.O = WSP(bf16, WS_MIX) + (size_t)(b * SEQ + qb * 256) * DM + h * AHD;
    r.A = WSP(float, WS_ACUM) + (size_t)bh * SEQ; r.P0 = qb * 256; return r;
}
__device__ __forceinline__ void p3_attn(Frame& F) {
    char* lds = (char*)(F.lds + RING_OFF);
    if (F.G == 256) {
        const int j = F.vcu & 31;
        if (j < SSD_WPX) return;
        { const attn::BlockRef cur = attn_ref(F, F.vcu); attn::Seam S; attn::block_prime(cur, lds, S); attn::block_run(cur, lds, S); }
        if (j >= 8 && j < 8 + SSD_WPX) { const attn::BlockRef cur = attn_ref(F, F.vcu - 8); attn::Seam S; attn::block_prime(cur, lds, S); attn::block_run(cur, lds, S); }
        return;
    }
    for (int a = F.vcu; a < BATCH * AH * (SEQ / 256); a += F.G) {
        const attn::BlockRef cur = attn_ref(F, a);
        attn::Seam S;
        attn::block_prime(cur, lds, S);
        attn::block_run(cur, lds, S);
    }
}
namespace ssd {
__device__ __forceinline__ float dpp_scan64(float x) {
    float v = x;
#define SSD_DPP_ADD(ctrl, rowmask) do { const int t_ = __builtin_amdgcn_update_dpp(0, __builtin_bit_cast(int, v), (ctrl), (rowmask), 0xf, true); v += __builtin_bit_cast(float, t_); } while (0)
    SSD_DPP_ADD(0x111, 0xf); SSD_DPP_ADD(0x112, 0xf); SSD_DPP_ADD(0x114, 0xf); SSD_DPP_ADD(0x118, 0xf);
    SSD_DPP_ADD(0x142, 0xa); SSD_DPP_ADD(0x143, 0xc);
#undef SSD_DPP_ADD
    return v;
}
constexpr int CP = 136, TP = 72, YP = 68;
constexpr int L_CM = 0, L_BM = L_CM + 64 * CP * 2, L_BT = L_BM + 64 * CP * 2, L_XT = L_BT + 128 * TP * 2, L_XD = L_XT + 64 * TP * 2, L_H = L_XD + 64 * TP * 2,
              L_Y = L_H + 64 * CP * 2, L_XS = L_Y + 64 * YP * 4, L_ACS = L_XS + 64 * TP * 2, L_DT = L_ACS + 512  , L_DEC = L_DT + 512, L_SS = L_DEC + 512, L_Z = L_SS + 256, L_END = L_Z + 64 * TP * 2;
static_assert(L_END <= RING_BYTES, "ssd lds");
typedef LAS unsigned char* lptr;
__device__ __forceinline__ bf16x8 ld16(lptr p) { return *(const LAS bf16x8*)p; }
__device__ __forceinline__ void unit(Frame& F, int un, float* ssq_all) {
    const int b = un >> 4, h = un & 15, g = h >> 3;
    const int tid = TTID();
    const int lane = tid & 63, w = F.wave, r16 = lane & 15, q4 = lane >> 4, Lt = w >> 1;
    const int nrow = tid >> 3, np8 = (tid & 7) * 8;
    const int crow = tid >> 4, cc8 = (tid & 15) * 8;
    lptr L = F.lds + RING_OFF;
    const bf16* xc = WSP(bf16, WS_XCONV) + (size_t)(b * SEQ) * CONVCH;
    const bf16* pz = WSP(bf16, WS_PROJ) + (size_t)(b * SEQ) * NP + O_Z + h * SHD;
    const float* dtp = WSP(float, WS_DTV) + (size_t)(b * SEQ) * 16 + h; const float* dap = WSP(float, WS_DAV) + (size_t)(b * SEQ) * 16 + h;
    bf16* mixp = WSP(bf16, WS_MIX) + (size_t)(b * SEQ) * DM + AW + h * SHD;
    float* ssq = ssq_all + b * SEQ;
    const float dsk = F.d_skip[h];
    f32x4 Hacc[4];
#pragma unroll
    for (int i = 0; i < 4; ++i) Hacc[i] = (f32x4){0.f, 0.f, 0.f, 0.f};
    v4u cmA[2], bmA[2], xsA, zA, cmB[2], bmB[2], xsB, zB; float dtw = 0.f, daw = 0.f;
#define SSD_LOAD(c, CM, BM, XS, ZR) do { const size_t t0_ = (size_t)(c) * 64; \
        _Pragma("unroll") for (int i_ = 0; i_ < 2; ++i_) { CM[i_] = *(const v4u*)(xc + (t0_ + crow + 32 * i_) * CONVCH + SW + SG * SN + g * SN + cc8); BM[i_] = *(const v4u*)(xc + (t0_ + crow + 32 * i_) * CONVCH + SW + g * SN + cc8); } \
        XS = *(const v4u*)(xc + (t0_ + nrow) * CONVCH + h * SHD + np8); ZR = *(const v4u*)(pz + (t0_ + nrow) * NP + np8); } while (0)
#define SSD_SCAN(c) do { if (w == 0) { const float acs_ = dpp_scan64(daw);     \
        const float al_ = __builtin_bit_cast(float, __builtin_amdgcn_readlane(__builtin_bit_cast(int, acs_), 63)); \
        *(LAS float*)(L + L_ACS + (((c) & 1) * 64 + lane) * 4) = acs_; *(LAS float*)(L + L_DT + lane * 4) = dtw; *(LAS float*)(L + L_DEC + lane * 4) = __expf(al_ - acs_); \
        if ((c) + 1 < SEQ / 64) { dtw = dtp[(size_t)(((c) + 1) * 64 + lane) * 16]; daw = dap[(size_t)(((c) + 1) * 64 + lane) * 16]; } } } while (0)
    if (w == 0) { dtw = dtp[(size_t)lane * 16]; daw = dap[(size_t)lane * 16]; }
    SSD_LOAD(0, cmA, bmA, xsA, zA);
    SSD_LOAD(1, cmB, bmB, xsB, zB);
    SSD_SCAN(0);
    auto nat_store = [&](const v4u (&cm)[2], const v4u (&bm)[2], const v4u& xs, const v4u& zs) __attribute__((always_inline)) {
#pragma unroll
        for (int i = 0; i < 2; ++i) { *(LAS v4u*)(L + L_CM + ((crow + 32 * i) * CP + cc8) * 2) = cm[i]; *(LAS v4u*)(L + L_BM + ((crow + 32 * i) * CP + cc8) * 2) = bm[i]; }
        *(LAS v4u*)(L + L_XS + (nrow * TP + np8) * 2) = xs; *(LAS v4u*)(L + L_Z + (nrow * TP + np8) * 2) = zs; };
    nat_store(cmA, bmA, xsA, zA);
    SSD_LOAD(2, cmA, bmA, xsA, zA);
    auto chunk = [&](const int c, v4u (&cmX)[2], v4u (&bmX)[2], v4u& xsX, v4u& zsX) __attribute__((always_inline)) {
        lptr ACS = L + L_ACS + (c & 1) * 256;
        __syncthreads();
        if (c > 0 && w == 0) atomicAdd(ssq + (c - 1) * 64 + lane, *(const LAS float*)(L + L_SS + lane * 4));
        { const float dtl = *(const LAS float*)(L + L_DT + lane * 4), decl = *(const LAS float*)(L + L_DEC + lane * 4);
#pragma unroll
          for (int i = 0; i < 2; ++i) { const int c8 = 8 * (w + 8 * i); const v4u bm = *(const LAS v4u*)(L + L_BM + (lane * CP + c8) * 2);
              const unsigned ww[4] = {bm.x, bm.y, bm.z, bm.w};
#pragma unroll
              for (int j = 0; j < 4; ++j) { *(LAS bf16*)(L + L_BT + ((c8 + 2 * j) * TP + lane) * 2) = (bf16)(ww[j] & 0xffffu); *(LAS bf16*)(L + L_BT + ((c8 + 2 * j + 1) * TP + lane) * 2) = (bf16)(ww[j] >> 16); } }
          float xv[8]; unpack8(*(const LAS v4u*)(L + L_XS + (lane * TP + 8 * w) * 2), xv);
#pragma unroll
          for (int j = 0; j < 8; j += 2) { const float X0 = xv[j] * dtl, X1 = xv[j + 1] * dtl; const unsigned a = pk2(X0, X1), d = pk2(X0 * decl, X1 * decl);
              *(LAS bf16*)(L + L_XT + ((8 * w + j) * TP + lane) * 2) = (bf16)(a & 0xffffu); *(LAS bf16*)(L + L_XT + ((8 * w + j + 1) * TP + lane) * 2) = (bf16)(a >> 16);
              *(LAS bf16*)(L + L_XD + ((8 * w + j) * TP + lane) * 2) = (bf16)(d & 0xffffu); *(LAS bf16*)(L + L_XD + ((8 * w + j + 1) * TP + lane) * 2) = (bf16)(d >> 16); } }
        __syncthreads();
        bf16x8 cf[4];
#pragma unroll
        for (int ks = 0; ks < 4; ++ks) cf[ks] = ld16(L + L_CM + ((16 * Lt + r16) * CP + 32 * ks + 8 * q4) * 2);
        const float acs_l = *(const LAS float*)(ACS + (16 * Lt + r16) * 4);
        float Wv[4][4];
#pragma unroll
        for (int T = 0; T < 4; ++T) {
            f32x4 st = (f32x4){0.f, 0.f, 0.f, 0.f};
            if (T <= Lt) {
#pragma unroll
                for (int ks = 0; ks < 4; ++ks) st = __builtin_amdgcn_mfma_f32_16x16x32_bf16(ld16(L + L_BM + ((16 * T + r16) * CP + 32 * ks + 8 * q4) * 2), cf[ks], st, 0, 0, 0);
            }
            const f32x4 as4 = *(const LAS f32x4*)(ACS + (16 * T + 4 * q4) * 4);
#pragma unroll
            for (int r = 0; r < 4; ++r) { const int s = 16 * T + 4 * q4 + r, l = 16 * Lt + r16; Wv[T][r] = (T <= Lt && s <= l) ? st[r] * __expf(acs_l - as4[r]) : 0.f; }
        }
        bf16x8 Wf[2];
#pragma unroll
        for (int kp = 0; kp < 2; ++kp) { v4u t; t.x = pk2(Wv[2 * kp][0], Wv[2 * kp][1]); t.y = pk2(Wv[2 * kp][2], Wv[2 * kp][3]); t.z = pk2(Wv[2 * kp + 1][0], Wv[2 * kp + 1][1]); t.w = pk2(Wv[2 * kp + 1][2], Wv[2 * kp + 1][3]);
            Wf[kp] = __builtin_bit_cast(bf16x8, t); }
        const f32x4 al4 = *(const LAS f32x4*)(ACS + (16 * Lt + 4 * q4) * 4);
        const float alast = *(const LAS float*)(ACS + 63 * 4);
#pragma unroll
        for (int pp = 0; pp < 2; ++pp) { const int Pt = 2 * (w & 1) + pp;
            f32x4 yd = (f32x4){0.f, 0.f, 0.f, 0.f}, yo = (f32x4){0.f, 0.f, 0.f, 0.f};
#pragma unroll
            for (int kp = 0; kp < 2; ++kp) if (2 * kp <= Lt) {
                const v2u x0 = *(const LAS v2u*)(L + L_XT + ((16 * Pt + r16) * TP + 32 * kp + 4 * q4) * 2), x1 = *(const LAS v2u*)(L + L_XT + ((16 * Pt + r16) * TP + 32 * kp + 16 + 4 * q4) * 2);
                const v4u xb = {x0.x, x0.y, x1.x, x1.y};
                yd = __builtin_amdgcn_mfma_f32_16x16x32_bf16(Wf[kp], __builtin_bit_cast(bf16x8, xb), yd, 0, 0, 0); }
            if (c > 0) {
#pragma unroll
                for (int ks = 0; ks < 4; ++ks) yo = __builtin_amdgcn_mfma_f32_16x16x32_bf16(cf[ks], ld16(L + L_H + ((16 * Pt + r16) * CP + 32 * ks + 8 * q4) * 2), yo, 0, 0, 0); }
#pragma unroll
            for (int r = 0; r < 4; ++r) *(LAS float*)(L + L_Y + ((16 * Lt + 4 * q4 + r) * YP + 16 * Pt + r16) * 4) = yd[r] + __expf(al4[r]) * yo[r];
        }
        { const float dl = __expf(alast);
#pragma unroll
          for (int pt = 0; pt < 4; ++pt) Hacc[pt] = Hacc[pt] * dl;
#pragma unroll
          for (int ks = 0; ks < 2; ++ks) { const bf16x8 af = ld16(L + L_BT + ((16 * w + r16) * TP + 32 * ks + 8 * q4) * 2);
#pragma unroll
              for (int pt = 0; pt < 4; ++pt) Hacc[pt] = __builtin_amdgcn_mfma_f32_16x16x32_bf16(af, ld16(L + L_XD + ((16 * pt + r16) * TP + 32 * ks + 8 * q4) * 2), Hacc[pt], 0, 0, 0); } }
        __syncthreads();
#pragma unroll
        for (int pt = 0; pt < 4; ++pt) { v2u t; t.x = pk2(Hacc[pt][0], Hacc[pt][1]); t.y = pk2(Hacc[pt][2], Hacc[pt][3]); *(LAS v2u*)(L + L_H + ((16 * pt + r16) * CP + 16 * w + 4 * q4) * 2) = t; }
        SSD_SCAN(c + 1);
        { const f32x4 y0 = *(const LAS f32x4*)(L + L_Y + (nrow * YP + np8) * 4), y1 = *(const LAS f32x4*)(L + L_Y + (nrow * YP + np8 + 4) * 4);
          const v4u xs_ = *(const LAS v4u*)(L + L_XS + (nrow * TP + np8) * 2), zs_ = *(const LAS v4u*)(L + L_Z + (nrow * TP + np8) * 2);
          if (c + 1 < SEQ / 64) nat_store(cmX, bmX, xsX, zsX);
          if (c + 3 < SEQ / 64) SSD_LOAD(c + 3, cmX, bmX, xsX, zsX);
          float xv[8], zv[8], o[8]; unpack8(xs_, xv); unpack8(zs_, zv); const float yv[8] = {y0.x, y0.y, y0.z, y0.w, y1.x, y1.y, y1.z, y1.w}; float ss = 0.f;
#pragma unroll
          for (int j = 0; j < 8; ++j) { o[j] = (yv[j] + xv[j] * dsk) * siluf_(zv[j]); ss += o[j] * o[j]; }
          *(v4u*)(mixp + (size_t)(c * 64 + nrow) * DM + np8) = pack8f(o);
          ss += __shfl_xor(ss, 1); ss += __shfl_xor(ss, 2); ss += __shfl_xor(ss, 4);
          if ((tid & 7) == 0) *(LAS float*)(L + L_SS + nrow * 4) = ss; }
    };
    for (int c = 0; c < SEQ / 64; c += 2) { chunk(c, cmB, bmB, xsB, zB); chunk(c + 1, cmA, bmA, xsA, zA); }
    __syncthreads();
    if (w == 0) atomicAdd(ssq + (SEQ / 64 - 1) * 64 + lane, *(const LAS float*)(L + L_SS + lane * 4));
    __syncthreads();
#undef SSD_LOAD
#undef SSD_SCAN
}
}
__device__ __forceinline__ void p3_ssd(Frame& F, float* ssq_all) {
    if (F.G == 256) {
        const int j = F.vcu & 31, x = F.vcu >> 5;
        if (j < SSD_WPX) for (int u = j; u < 8; u += SSD_WPX) ssd::unit(F, x * 8 + u, ssq_all);
        return;
    }
    for (int a = F.vcu; a < 256; a += F.G) { const int j = a & 31; if (j < 8) ssd::unit(F, (a >> 5) * 8 + j, ssq_all); }
}
constexpr int NPH = 10;
struct Args { const float* in[22]; float* out; unsigned char* ws; int ph_lo, ph_hi; };
__global__ void __launch_bounds__(NTHR, 2) mk_fwd(Args args) {
    extern __shared__ __attribute__((aligned(16))) unsigned char lds[];
    Frame F;
    F.lds = (LAS unsigned char*)lds;
    F.MISC = (volatile LAS unsigned*)(F.lds + MISC_OFF);
    F.wave = __builtin_amdgcn_readfirstlane(threadIdx.x >> 6);
    F.G = gridDim.x; { const int bx = blockIdx.x; F.vcu = (F.G % 8 == 0) ? (bx % 8) * (F.G / 8) + bx / 8 : bx; }
    F.ws = args.ws; F.ctl = (gu32*)(args.ws + WS_CTL); F.out = args.out;
    F.x = args.in[0]; F.g1 = args.in[1]; F.w_in = args.in[2]; F.fbias = args.in[3]; F.gq = args.in[4]; F.gk = args.in[5]; F.conv_w = args.in[6]; F.conv_b = args.in[7];
    F.dt_bias = args.in[8]; F.a_log = args.in[9]; F.d_skip = args.in[10]; F.ssd_g = args.in[11]; F.w_out = args.in[12]; F.g2 = args.in[13]; F.w_router = args.in[14]; F.b_router = args.in[15];
    F.w_gate = args.in[16]; F.b_gate = args.in[17]; F.w_up = args.in[18]; F.b_up = args.in[19]; F.w_down = args.in[20]; F.b_down = args.in[21];
    for (int u = threadIdx.x; u < (LDS_BYTES - LDSCTL_OFF) / 4; u += NTHR) ((LAS unsigned*)(F.lds + LDSCTL_OFF))[u] = 0u;
    __syncthreads();
    const int lo = args.ph_lo, hi = args.ph_hi;
    XcdBarrier bar; bar.bar = (unsigned*)(F.ctl + CW_BAR); bar.x = 0; bar.st = nullptr;
    if (hi - lo > 1) bar = xcd_barrier_post((unsigned*)(F.ctl + CW_BAR), F.MISC);
#define IN(k) (lo <= (k) && (k) < hi)
#ifndef PROBE_REPEAT
#define PROBE_REPEAT 0
#endif
#define REP(k) for (int rep_ = 0; rep_ < (((PROBE_REPEAT >> (k)) & 1) ? 2 : 1); ++rep_)
#if PROBE_T
#define STAMP(i) do { if (blockIdx.x == 0 && threadIdx.x == 0) { const unsigned long long t_ = __builtin_amdgcn_s_memrealtime(); __hip_atomic_store(F.ctl + CW_PROBE + 16 + 2 * (i), (unsigned)t_, RLX_AGENT); __hip_atomic_store(F.ctl + CW_PROBE + 17 + 2 * (i), (unsigned)(t_ >> 32), RLX_AGENT); } } while (0)
#else
#define STAMP(i) do { } while (0)
#endif
#define SEAM(k) do { if (IN(k) && IN((k) + 1)) xcd_barrier(bar); STAMP((k) + 1); } while (0)

    const bool roles = BG_POOL && F.G == 256;
    const int xc = F.vcu >> 5, jr = F.vcu & 31;
    constexpr int NC1 = NC1_CFG, NC5 = NC5_CFG, NC7 = NC7_CFG;
    const bool conv1 = roles && jr >= 32 - NC1, conv5 = roles && jr >= 32 - NC5, conv7 = roles && jr >= 32 - NC7;
    const int G5 = roles ? 8 * (32 - NC5) : F.G, c5s = roles ? jr * 8 + xc : (int)blockIdx.x;
    const int G1 = roles ? 8 * (32 - NC1) : F.G, c1s = roles ? jr * 8 + xc : (int)blockIdx.x;
    const int G7 = roles ? 8 * (32 - NC7) : F.G, c7m = roles ? xc * (32 - NC7) + jr : F.vcu;
    bool pool_open = BG_POOL && !CONV_IN_P0 && PEEK_CFG;
#define BG_PEEK() do { if (PEEK_CFG && pool_open) pool_open = bg_peek_open(F); } while (0)
#define BG_FILL(k, lim) do { if (BG_POOL && !CONV_IN_P0 && IN((k) + 1) && ((k) == 1 || !PEEK_CFG || pool_open)) bg_fill(F, (k), (lim)); } while (0)

    STAMP(0);
    if (IN(0)) REP(0) { p0_prologue(F); if (CONV_IN_P0) (void)bg_finish(F, POOL_ALL); SEAM(0); }

    if (IN(1)) REP(1) {
        if (!conv1) {
        typedef OrderStaticT<(NSPLIT_CFG != 0)> Ord1;
        Ord1 S; S.init(NTOK, NP, G1, c1s, WSP(bf16, WS_XN), WSP(bf16, WS_WIN));
        EpiProj E{WSP(bf16, WS_PROJ), NP};
        pg8::gemm_phase<EpiProj, Ord1, false, (ALIGN_EPI_CFG & 1) != 0>(F.lds + RING_OFF, S, E);
        }
        BG_FILL(1, POOL_ALL);
        SEAM(1);
    }
    if (IN(2)) REP(2) { BG_PEEK(); p2_post(F); if (FIN2_CFG && BG_POOL) (void)bg_finish(F, POOL_ALL); SEAM(2); }
    if (IN(3)) {
#if NAIVE_ATTN
        p3_attn_naive(F);
#else
        p3_attn(F);
#endif
        __syncthreads();
#if NAIVE_SSD
        p3_ssd_naive(F);
#elif !SPLIT_P3
        p3_ssd(F, (float*)(F.ctl + CW_SSQ));
#endif
#if PROBE_P3
        __syncthreads(); p3_attn(F); __syncthreads(); p3_ssd(F, WSP(float, WS_YSLOT));
#endif
        BG_FILL(3, POOL_ALL);
        SEAM(3);
    }
#if SPLIT_P3
    if (IN(4)) { p3_ssd(F, (float*)(F.ctl + CW_SSQ)); SEAM(4); }
#endif
    if (!FUSE_P4 && IN(4)) { p4_ssdnorm(F); SEAM(4); }
    if (IN(5)) BG_PEEK();
    if (IN(5)) REP(5) {
        if (!conv5) {
        OrderStatic S; S.init(NTOK, DM, G5, c5s, WSP(bf16, WS_MIX), WSP(bf16, WS_WOUT));
        EpiRes E{F.x, H_BF16 ? WSP(float, WS_H) : F.out, F.ctl + CW_SSQ};
        pg8::gemm_phase<EpiRes, OrderStatic, false, false>(F.lds + RING_OFF, S, E);
        }
        BG_FILL(5, POOL_ALL);
        SEAM(5);
    }
    if (IN(6)) { BG_PEEK(); p6_router(F); if (BG_POOL && (!PEEK_CFG || pool_open)) (void)bg_finish(F, POOL_GU); SEAM(6); }
    constexpr int MOE_RB = FP8_MOE ? 2048 : 4096;
    if (IN(7)) BG_PEEK();
    if (IN(7)) REP(7) {
        if (!conv7) {
        moe_tables(F);
        const LAS int* TB = (const LAS int*)(F.lds + TB_OFF);
        typedef OrderMoe<16, true, MOE_RB> Ord;
        Ord S; S.init(G7, c7m, TB, TB + 64, TLANE(), WSP(char, WS_XN), WSP(char, WS_WGU), (size_t)4096 * MOE_RB, WSP(int, WS_STOK), F.ctl + CW_MOEQ, (volatile LAS int*)(F.lds + BGW_OFF) + 4, DYN_MOE && G7 == 256);
        S.xprobe = (const char*)F.w_down;
        EpiGlu E{WSP(void, WS_ACT), F.b_gate, F.b_up};
        pg8::gemm_phase<EpiGlu, Ord, true, (ALIGN_EPI_CFG & 2) != 0, FP8_MOE != 0>(F.lds + RING_OFF, S, E);
        }
        BG_FILL(7, POOL_ALL);
        if (BG_POOL && (!PEEK_CFG || pool_open)) (void)bg_finish(F, POOL_ALL);
        SEAM(7);
    }
    if (IN(8)) REP(8) {
        moe_tables(F);
        const LAS int* TB = (const LAS int*)(F.lds + TB_OFF);
        typedef OrderMoe<8, false, MOE_RB> Ord;
        Ord S; S.init(F.G, F.vcu, TB, TB + 64, TLANE(), WSP(char, WS_ACT), WSP(char, WS_WD), (size_t)2048 * MOE_RB, WSP(int, WS_STOK), F.ctl + CW_MOEQ + 64 * 8, (volatile LAS int*)(F.lds + BGW_OFF) + 4, DYN_MOE && F.G == 256);
        S.xprobe = nullptr;
        EpiDown E{WSP(bf16, WS_YSLOT), F.b_down, WSP(float, WS_SGATE), WSP(int, WS_SDEST)};
        pg8::gemm_phase<EpiDown, Ord, false, (ALIGN_EPI_CFG & 4) != 0, FP8_MOE != 0>(F.lds + RING_OFF, S, E);
        SEAM(8);
    }
#if PROBE_T
    if (blockIdx.x == 0 && threadIdx.x == 0) {
        const unsigned a0_ = __hip_atomic_load(F.ctl + CW_PROBE + 16 + 2 * PROBE_KA, RLX_AGENT), a1_ = __hip_atomic_load(F.ctl + CW_PROBE + 16 + 2 * (PROBE_KA + 1), RLX_AGENT);
        const unsigned b0_ = __hip_atomic_load(F.ctl + CW_PROBE + 16 + 2 * PROBE_KB, RLX_AGENT), b1_ = __hip_atomic_load(F.ctl + CW_PROBE + 16 + 2 * (PROBE_KB + 1), RLX_AGENT);
        const float ua = (float)(a1_ - a0_) * 0.01f, ub = (float)(b1_ - b0_) * 0.01f;
        __hip_atomic_store(F.ctl + CW_PROBE, __builtin_bit_cast(unsigned, ua * PROBE_GA), RLX_AGENT); __hip_atomic_store(F.ctl + CW_PROBE + 1, __builtin_bit_cast(unsigned, 100.f + ub), RLX_AGENT); }
    xcd_barrier(bar);
#endif
    if (IN(9)) { p9_combine(F); }
#undef IN
#undef SEAM
}

extern "C" void kernel_launch(void* const* d_in, const int* in_sizes, int n_in, void* d_out, int out_size, void* d_ws, size_t ws_size, hipStream_t stream) {
    static int grid = 0;
    if (grid == 0) {
        if (n_in != 22 || in_sizes[0] != NTOK * DM || out_size != NTOK * DM || ws_size < WS_END) { fprintf(stderr, "kernel_launch: unexpected shapes (n_in %d, in0 %d, out %d, ws %zu)\n", n_in, n_in > 0 ? in_sizes[0] : -1, out_size, ws_size); grid = -1; return; }
        int dev = 0, cus = 0, per_cu = 0;
        if (hipGetDevice(&dev) != hipSuccess || hipDeviceGetAttribute(&cus, hipDeviceAttributeMultiprocessorCount, dev) != hipSuccess) { grid = -1; return; }
        if (hipFuncSetAttribute((const void*)mk_fwd, hipFuncAttributeMaxDynamicSharedMemorySize, LDS_BYTES) != hipSuccess) { fprintf(stderr, "kernel_launch: hipFuncSetAttribute failed\n"); grid = -1; return; }
        if (hipOccupancyMaxActiveBlocksPerMultiprocessor(&per_cu, (const void*)mk_fwd, NTHR, LDS_BYTES) != hipSuccess || per_cu < 1) { fprintf(stderr, "kernel_launch: occupancy query says %d blocks per CU\n", per_cu); }
        (void)hipGetLastError();
        grid = cus;
    }
    if (grid < 0) return;
    (void)hipMemsetAsync((char*)d_ws + WS_CTL, 0, CTL_ZERO_BYTES, stream);
    Args a{};
    for (int i = 0; i < 22; ++i) a.in[i] = (const float*)d_in[i];
    a.out = (float*)d_out; a.ws = (unsigned char*)d_ws;
#if MK_N_LAUNCHES == 1
    a.ph_lo = 0; a.ph_hi = NPH;
    hipLaunchKernelGGL(mk_fwd, dim3(grid), dim3(NTHR), LDS_BYTES, stream, a);
#else
    for (int p = 0; p < NPH; ++p) { a.ph_lo = p; a.ph_hi = p + 1; hipLaunchKernelGGL(mk_fwd, dim3(grid), dim3(NTHR), LDS_BYTES, stream, a); }
#endif
}
```
